# Optimizing an MI355X kernel written in HIP

```python
import jax, jax.numpy as jnp
from jax import lax
import numpy as np

D_MODEL = 1024
BATCH = 4
SEQ = 8192
DEPTH = 4

MEM_LEN = 256

ATTN_HEADS = 8
ATTN_WIDTH = D_MODEL // 2
ATTN_HEAD_DIM = ATTN_WIDTH // ATTN_HEADS
POOL_GROUPS = 4
POOL_WIDTH = D_MODEL // 4
POOL_GROUP_DIM = POOL_WIDTH // POOL_GROUPS
POOL_WINDOWS = (2, 4, 8, 16)
CONV_GROUPS = 4
CONV_WIDTH = D_MODEL // 4
CONV_K = 3
MIX_WIDTH = ATTN_WIDTH + POOL_WIDTH + CONV_WIDTH
IN_SPLIT_WIDTHS = (ATTN_WIDTH, ATTN_WIDTH, ATTN_WIDTH, POOL_WIDTH, CONV_WIDTH, CONV_WIDTH, CONV_WIDTH)
IN_PROJ_WIDTH = sum(IN_SPLIT_WIDTHS)

DILATED_BRANCHES = ((128, 1), (512, 4), (2048, 16))
MAX_WINDOW = 2048
Q_BLOCK = 128
NEG_INF = -1e30

REL_BUCKETS = 32
REL_MAX_DIST = 128

XATTN_HEADS = 4
XATTN_HEAD_DIM = 128
XATTN_WIDTH = XATTN_HEADS * XATTN_HEAD_DIM

D_FF_DENSE = 2816
N_EXPERTS = 8
TOP_K = 2
D_FF_EXPERT = 3584
N_DENSE = (DEPTH + 1) // 2
N_MOE = DEPTH // 2

EPS = 1e-6

kernel_name = "hybrid_dilated_pool_conv_moe_trunk"


def rmsnorm(x, g):
    xf = x.astype(jnp.float32)
    xf = xf * lax.rsqrt(jnp.mean(xf * xf, axis=-1, keepdims=True) + EPS)
    return xf.astype(x.dtype) * g


def _t5_causal_bucket(dist):
    max_exact = REL_BUCKETS // 2
    d = np.maximum(dist, 1).astype(np.float32)
    large = max_exact + (np.log(d / max_exact) / np.log(REL_MAX_DIST / max_exact)
                         * (REL_BUCKETS - max_exact)).astype(np.int32)
    large = np.minimum(large, REL_BUCKETS - 1)
    return np.where(dist < max_exact, dist, large).astype(np.int32)


def dilated_attention(q, k, v, rel_bias):
    B, S, H, Dh = q.shape
    scale = Dh ** -0.5
    span = Q_BLOCK + MAX_WINDOW
    k_pad = jnp.pad(k, ((0, 0), (MAX_WINDOW, 0), (0, 0), (0, 0)))
    v_pad = jnp.pad(v, ((0, 0), (MAX_WINDOW, 0), (0, 0), (0, 0)))
    q_loc = np.arange(Q_BLOCK)
    branches = []
    for window, dil in DILATED_BRANCHES:
        offs = dil * np.arange(window // dil + 1)
        idx = q_loc[:, None] + MAX_WINDOW - offs[None, :]
        rel_pos = q_loc[:, None] - offs[None, :]
        bias = rel_bias[_t5_causal_bucket(offs)].T.astype(jnp.float32)
        branches.append((idx, rel_pos, bias))

    def block(i):
        t0 = i * Q_BLOCK
        qb = lax.dynamic_slice_in_dim(q, t0, Q_BLOCK, axis=1)
        kb = lax.dynamic_slice_in_dim(k_pad, t0, span, axis=1)
        vb = lax.dynamic_slice_in_dim(v_pad, t0, span, axis=1)
        outs, lses = [], []
        for idx, rel_pos, bias in branches:
            kg = kb[:, idx]
            vg = vb[:, idx]
            logits = jnp.einsum('bqhd,bqjhd->bhqj', qb, kg).astype(jnp.float32) * scale
            logits = logits + bias[None, :, None, :]
            valid = (t0 + rel_pos) >= 0
            logits = jnp.where(valid[None, None], logits, NEG_INF)
            lse = jax.nn.logsumexp(logits, axis=-1)
            p = jnp.exp(logits - lse[..., None]).astype(vg.dtype)
            outs.append(jnp.einsum('bhqj,bqjhd->bqhd', p, vg))
            lses.append(lse)
        w = jax.nn.softmax(jnp.stack(lses, axis=0), axis=0)
        w = jnp.transpose(w, (0, 1, 3, 2))[..., None].astype(q.dtype)
        return jnp.sum(w * jnp.stack(outs, axis=0), axis=0)

    out = lax.map(block, jnp.arange(S // Q_BLOCK))
    return jnp.transpose(out, (1, 0, 2, 3, 4)).reshape(B, S, H * Dh)


def multiscale_pool(u, pool_w, pool_scale):
    B, S, _ = u.shape
    uf = u.astype(jnp.float32).reshape(B, S, POOL_GROUPS, POOL_GROUP_DIM)
    csum = jnp.cumsum(uf, axis=1)
    count_base = jnp.arange(1, S + 1, dtype=jnp.float32)
    outs = []
    for g, w in enumerate(POOL_WINDOWS):
        c = csum[:, :, g]
        lag = jnp.pad(c, ((0, 0), (w, 0), (0, 0)))[:, :S]
        mean = (c - lag) / jnp.minimum(count_base, float(w))[None, :, None]
        outs.append(mean - uf[:, :, g])
    pooled = jnp.stack(outs, axis=2).astype(u.dtype)
    mixed = jnp.einsum('bsgc,gcd->bsgd', pooled, pool_w).reshape(B, S, POOL_WIDTH)
    return mixed * pool_scale


def gated_short_conv(b_gate, c_gate, h, conv_w):
    u = c_gate * h
    y = conv_w[0] * u
    for tap in range(1, CONV_K):
        y = y + conv_w[tap] * jnp.pad(u, ((0, 0), (tap, 0), (0, 0)))[:, :-tap]
    return b_gate * y


def hybrid_mixer(xn, w_in, conv_w, pool_w, pool_scale, w_out, rel_bias):
    B, S, _ = xn.shape
    proj = xn @ w_in
    split_pts = np.cumsum(IN_SPLIT_WIDTHS)[:-1].tolist()
    q, k, v, u_pool, b_gate, c_gate, h_conv = jnp.split(proj, split_pts, axis=-1)
    heads = lambda t: t.reshape(B, S, ATTN_HEADS, ATTN_HEAD_DIM)
    y_attn = dilated_attention(heads(q), heads(k), heads(v), rel_bias)
    y_pool = multiscale_pool(u_pool, pool_w, pool_scale)
    y_conv = gated_short_conv(b_gate, c_gate, h_conv, conv_w)
    y = jnp.concatenate([y_attn, y_pool, y_conv], axis=-1)
    return y @ w_out


def memory_cross_attention(xn, mem_n, wq, wkv, wo):
    B, S, _ = xn.shape
    M = mem_n.shape[1]
    q = (xn @ wq).reshape(B, S, XATTN_HEADS, XATTN_HEAD_DIM)
    k, v = jnp.split(mem_n @ wkv, 2, axis=-1)
    k = k.reshape(B, M, XATTN_HEADS, XATTN_HEAD_DIM)
    v = v.reshape(B, M, XATTN_HEADS, XATTN_HEAD_DIM)
    logits = jnp.einsum('bshd,bmhd->bhsm', q, k).astype(jnp.float32) * (XATTN_HEAD_DIM ** -0.5)
    p = jax.nn.softmax(logits, axis=-1).astype(v.dtype)
    o = jnp.einsum('bhsm,bmhd->bshd', p, v).reshape(B, S, XATTN_WIDTH)
    return o @ wo


def swiglu(x, w13, w2):
    g, u = jnp.split(x @ w13, 2, axis=-1)
    return (jax.nn.silu(g) * u) @ w2


def moe_swiglu(xn, router_w, w13, w2):
    B, S, D = xn.shape
    xt = xn.reshape(B * S, D)
    logits = (xt @ router_w).astype(jnp.float32)
    top_vals, top_idx = lax.top_k(logits, TOP_K)
    top_p = jax.nn.softmax(top_vals, axis=-1)
    gates = jnp.sum(jax.nn.one_hot(top_idx, N_EXPERTS, dtype=jnp.float32) * top_p[..., None],
                    axis=1).astype(xn.dtype)
    out = jnp.zeros_like(xt)
    for e in range(N_EXPERTS):
        out = out + gates[:, e:e + 1] * swiglu(xt, w13[e], w2[e])
    return out.reshape(B, S, D)


def setup_inputs(seed: int = 0) -> dict:
    key = jax.random.key(seed)
    ks = jax.random.split(key, 24)
    f32 = jnp.float32

    def w(k, shape, fan_in):
        return jax.random.normal(k, shape, f32) * (fan_in ** -0.5)

    def gain(k, shape):
        return 1.0 + 0.02 * jax.random.normal(k, shape, f32)

    return {
        "x": jax.random.normal(ks[0], (BATCH, SEQ, D_MODEL), f32),
        "mem": jax.random.normal(ks[1], (BATCH, MEM_LEN, D_MODEL), f32),
        "rel_bias": 0.5 * jax.random.normal(ks[2], (REL_BUCKETS, ATTN_HEADS), f32),
        "mem_norm_g": gain(ks[3], (D_MODEL,)),
        "mix_norm_g": gain(ks[4], (DEPTH, D_MODEL)),
        "w_in": w(ks[5], (DEPTH, D_MODEL, IN_PROJ_WIDTH), D_MODEL),
        "conv_w": w(ks[6], (DEPTH, CONV_K, CONV_WIDTH), CONV_K),
        "pool_w": w(ks[7], (DEPTH, POOL_GROUPS, POOL_GROUP_DIM, POOL_GROUP_DIM), POOL_GROUP_DIM),
        "pool_scale": gain(ks[8], (DEPTH, POOL_WIDTH)) + 0.1 * jax.random.normal(ks[9], (DEPTH, POOL_WIDTH), f32),
        "w_out": w(ks[10], (DEPTH, MIX_WIDTH, D_MODEL), MIX_WIDTH),
        "xattn_norm_g": gain(ks[11], (DEPTH, D_MODEL)),
        "wq_x": w(ks[12], (DEPTH, D_MODEL, XATTN_WIDTH), D_MODEL),
        "wkv_x": w(ks[13], (DEPTH, D_MODEL, 2 * XATTN_WIDTH), D_MODEL),
        "wo_x": w(ks[14], (DEPTH, XATTN_WIDTH, D_MODEL), XATTN_WIDTH),
        "ffn_norm_g": gain(ks[15], (DEPTH, D_MODEL)),
        "w13_dense": w(ks[16], (N_DENSE, D_MODEL, 2 * D_FF_DENSE), D_MODEL),
        "w2_dense": w(ks[17], (N_DENSE, D_FF_DENSE, D_MODEL), D_FF_DENSE),
        "router_w": w(ks[18], (N_MOE, D_MODEL, N_EXPERTS), D_MODEL),
        "w13_moe": w(ks[19], (N_MOE, N_EXPERTS, D_MODEL, 2 * D_FF_EXPERT), D_MODEL),
        "w2_moe": w(ks[20], (N_MOE, N_EXPERTS, D_FF_EXPERT, D_MODEL), D_FF_EXPERT),
        "final_norm_g": gain(ks[21], (D_MODEL,)),
    }


def reference(x, mem, rel_bias, mem_norm_g, mix_norm_g, w_in, conv_w, pool_w, pool_scale,
              w_out, xattn_norm_g, wq_x, wkv_x, wo_x, ffn_norm_g, w13_dense, w2_dense,
              router_w, w13_moe, w2_moe, final_norm_g):
    mem_n = rmsnorm(mem, mem_norm_g)
    for layer in range(DEPTH):
        x = x + hybrid_mixer(rmsnorm(x, mix_norm_g[layer]), w_in[layer], conv_w[layer],
                             pool_w[layer], pool_scale[layer], w_out[layer], rel_bias)
        x = x + memory_cross_attention(rmsnorm(x, xattn_norm_g[layer]), mem_n,
                                       wq_x[layer], wkv_x[layer], wo_x[layer])
        hn = rmsnorm(x, ffn_norm_g[layer])
        if layer % 2 == 0:
            x = x + swiglu(hn, w13_dense[layer // 2], w2_dense[layer // 2])
        else:
            x = x + moe_swiglu(hn, router_w[layer // 2], w13_moe[layer // 2], w2_moe[layer // 2])
    return rmsnorm(x, final_norm_g)
```

```cpp
#include <hip/hip_runtime.h>
#include <cstdio>
#include <cstdint>
namespace pg8 {
#define PG8_LAS __attribute__((address_space(3)))
typedef unsigned short bf16_t;
typedef short bf16x8 __attribute__((ext_vector_type(8)));
typedef float f32x4 __attribute__((ext_vector_type(4)));
typedef unsigned u32x4 __attribute__((ext_vector_type(4)));
constexpr int BM = 256, BK = 64, HALF = 128, HTB = HALF * BK * 2  , STAGE_BYTES = 8 * HTB, NXCD = 8, WGM = 8;

__host__ __device__ __forceinline__ int lds_byte(int r, int c) { const int st = (r >> 4) * 2 + (c >> 5), rr = r & 15, cc = c & 31, ob = rr * 64 + cc * 2; return st * 1024 + (ob ^ (((ob >> 9) & 1) << 5)); }
__host__ __device__ __forceinline__ void stage_rc(int b, int& R, int& C) { const int st = b / 1024, sb = b % 1024, swz = sb ^ (((sb >> 9) & 1) << 5); R = (st >> 1) * 16 + swz / 64; C = (st & 1) * 32 + (swz % 64) / 2; }
__host__ __device__ __forceinline__ int perm32(int rho) { const int n = rho >> 4, i = rho & 15; return 8 * (i >> 2) + 4 * n + (i & 3); }

struct Unit { int pm, pn; };
struct Gemm { const bf16_t* A; const bf16_t* Bt; int M, N, K; };

struct StaticOrder {
    int nM, nN, nwg, G, c;
    __host__ __device__ void init(int M, int N, int G_, int c_) { nM = M / BM; nN = N / BM; nwg = nM * nN; G = G_; c = c_; }
    __host__ __device__ bool next(int i, Unit& u) const {
        const long L = (long)i * G + c; if (L >= nwg) return false;
        int wgid = (int)L; { const int q = nwg / NXCD, r = nwg % NXCD, xcd = wgid % NXCD, off = wgid / NXCD; wgid = (xcd < r ? xcd * (q + 1) : r * (q + 1) + (xcd - r) * q) + off; }
        const int nig = WGM * nN, gid = wgid / nig, fm = gid * WGM, gsz = (nM - fm) < WGM ? (nM - fm) : WGM;
        u.pm = fm + ((wgid % nig) % gsz); u.pn = (wgid % nig) / gsz; return true;
    }
    __device__ __forceinline__ void a_ready(const Unit&) const {}
    __device__ __forceinline__ void done(const Unit&) const {}
};

__device__ __forceinline__ unsigned cvt_pk_bf16(float lo, float hi) { unsigned r; asm volatile("v_cvt_pk_bf16_f32 %0, %1, %2" : "=v"(r) : "v"(lo), "v"(hi)); return r; }
typedef float f32x2 __attribute__((ext_vector_type(2)));
__device__ __forceinline__ float row_rs16(const float* ssp, int row) {
    const f32x4* sp = (const f32x4*)(ssp + (size_t)row * 16); const f32x4 s0 = sp[0], s1 = sp[1], s2 = sp[2], s3 = sp[3];
    const float s = (((s0[0] + s0[1]) + (s0[2] + s0[3])) + ((s1[0] + s1[1]) + (s1[2] + s1[3]))) + (((s2[0] + s2[1]) + (s2[2] + s2[3])) + ((s3[0] + s3[1]) + (s3[2] + s3[3])));
    return __builtin_amdgcn_rsqf(s * (1.0f / 1024.0f) + 1e-6f);
}
struct EpiRowScale {
    static constexpr bool PERM = true, AFTER_DRAIN = false;
    bf16_t* O; int ldc; const float* ssp; float cs;
    __device__ __forceinline__ void operator()(const f32x4 (&acc)[2][2][4][2], const Unit& u, int wr, int wc, int fr, int fq) const {
        const int row0 = u.pm * BM + wr * 64 + fr, col0 = u.pn * BM + wc * 32 + 8 * fq;
#pragma unroll
        for (int ai = 0; ai < 2; ++ai)
#pragma unroll
            for (int m = 0; m < 4; ++m) { const int row = row0 + ai * HALF + m * 16; const float r = ssp ? row_rs16(ssp, row) * cs : cs; bf16_t* rowp = O + (size_t)row * ldc + col0;
#pragma unroll
                for (int bj = 0; bj < 2; ++bj) { const f32x4 v0 = acc[ai][bj][m][0] * r, v1 = acc[ai][bj][m][1] * r;
                    u32x4 w; w.x = cvt_pk_bf16(v0[0], v0[1]); w.y = cvt_pk_bf16(v0[2], v0[3]); w.z = cvt_pk_bf16(v1[0], v1[1]); w.w = cvt_pk_bf16(v1[2], v1[3]);
                    *(u32x4*)(rowp + bj * HALF) = w; } }
    }
};
__device__ __forceinline__ float silu_mul(float g, float u) { return g * u * __builtin_amdgcn_rcpf(1.0f + __expf(-g)); }
struct EpiSwiGLU {
    static constexpr bool PERM = true, AFTER_DRAIN = false;
    bf16_t* O; int ldc; const float* ssp; const float* rmul; int pn_mod;
    __device__ __forceinline__ void operator()(const f32x4 (&acc)[2][2][4][2], const Unit& u, int wr, int wc, int fr, int fq) const {
        const int pnl = pn_mod ? (u.pn % pn_mod) : u.pn;
        const int row0 = u.pm * BM + wr * 64 + fr, col0 = pnl * HALF + wc * 32 + 8 * fq;
#pragma unroll
        for (int ai = 0; ai < 2; ++ai)
#pragma unroll
            for (int m = 0; m < 4; ++m) { const int row = row0 + ai * HALF + m * 16; const float r = ssp ? row_rs16(ssp, row) : rmul[row];
                const f32x4 g0 = acc[ai][0][m][0] * r, g1 = acc[ai][0][m][1] * r, u0 = acc[ai][1][m][0] * r, u1 = acc[ai][1][m][1] * r;
                u32x4 w; w.x = cvt_pk_bf16(silu_mul(g0[0], u0[0]), silu_mul(g0[1], u0[1])); w.y = cvt_pk_bf16(silu_mul(g0[2], u0[2]), silu_mul(g0[3], u0[3]));
                w.z = cvt_pk_bf16(silu_mul(g1[0], u1[0]), silu_mul(g1[1], u1[1])); w.w = cvt_pk_bf16(silu_mul(g1[2], u1[2]), silu_mul(g1[3], u1[3]));
                *(u32x4*)(O + (size_t)row * ldc + col0) = w; }
    }
};
struct EpiResid {
    static constexpr bool PERM = true, AFTER_DRAIN = false;
    const float* base; float* out; bf16_t* xb; float* ssp_out;
    __device__ __forceinline__ void operator()(const f32x4 (&acc)[2][2][4][2], const Unit& u, int wr, int wc, int fr, int fq) const {
        const int row0 = u.pm * BM + wr * 64 + fr, col0 = u.pn * BM + wc * 32 + 8 * fq;
#pragma unroll
        for (int ai = 0; ai < 2; ++ai)
#pragma unroll
            for (int m = 0; m < 4; ++m) { const int row = row0 + ai * HALF + m * 16; const size_t off = (size_t)row * 1024 + col0; float q = 0.f;
#pragma unroll
                for (int bj = 0; bj < 2; ++bj) { const f32x4 b0 = *(const f32x4*)(base + off + bj * HALF), b1 = *(const f32x4*)(base + off + bj * HALF + 4);
                    const f32x4 v0 = b0 + acc[ai][bj][m][0], v1 = b1 + acc[ai][bj][m][1];
                    *(f32x4*)(out + off + bj * HALF) = v0; *(f32x4*)(out + off + bj * HALF + 4) = v1;
                    u32x4 w; w.x = cvt_pk_bf16(v0[0], v0[1]); w.y = cvt_pk_bf16(v0[2], v0[3]); w.z = cvt_pk_bf16(v1[0], v1[1]); w.w = cvt_pk_bf16(v1[2], v1[3]);
                    *(u32x4*)(xb + off + bj * HALF) = w;
                    q += ((v0[0] * v0[0] + v0[1] * v0[1]) + (v0[2] * v0[2] + v0[3] * v0[3])) + ((v1[0] * v1[0] + v1[1] * v1[1]) + (v1[2] * v1[2] + v1[3] * v1[3])); }
                q += __shfl_xor(q, 16); q += __shfl_xor(q, 32);
                if (fq == 0) ssp_out[(size_t)row * 16 + u.pn * 4 + wc] = q;
                if (m & 1) asm volatile("" ::: "memory"); }
    }
};
struct EpiMoeOut {
    static constexpr bool PERM = true, AFTER_DRAIN = false;
    float* Y; const float* gate;
    __device__ __forceinline__ void operator()(const f32x4 (&acc)[2][2][4][2], const Unit& u, int wr, int wc, int fr, int fq) const {
        const int row0 = u.pm * BM + wr * 64 + fr, col0 = (u.pn & 3) * BM + wc * 32 + 8 * fq;
#pragma unroll
        for (int ai = 0; ai < 2; ++ai)
#pragma unroll
            for (int m = 0; m < 4; ++m) { const int row = row0 + ai * HALF + m * 16; const float gt = gate[row]; float* rowp = Y + (size_t)row * 1024 + col0;
#pragma unroll
                for (int bj = 0; bj < 2; ++bj) { *(f32x4*)(rowp + bj * HALF) = acc[ai][bj][m][0] * gt; *(f32x4*)(rowp + bj * HALF + 4) = acc[ai][bj][m][1] * gt; } }
    }
};
struct MoeOrder {
    StaticOrder so; int nNl; int te[8];
    __device__ __forceinline__ bool next(int i, Unit& u) const {
        if (!so.next(i, u)) return false;
        int e = 0;
#pragma unroll
        for (int k = 0; k < 7; ++k) e += (u.pm >= te[k]) ? 1 : 0;
        u.pn += e * nNl; return true;
    }
    __device__ __forceinline__ void a_ready(const Unit&) const {}
    __device__ __forceinline__ void done(const Unit&) const {}
};

template <class Epi, class Sched, bool ALIGN_EPI = false, bool SP2 = false>
__device__ __forceinline__ void gemm_phase(PG8_LAS unsigned char* lds, const Gemm g, const Sched& S, const Epi& E, const int tid) {
    const int wid = __builtin_amdgcn_readfirstlane(tid >> 6), lane = tid & 63, wr = wid >> 2, wc = wid & 3, fr = lane & 15, fq = lane >> 4;
    const int K = g.K, nt = K / BK;
    unsigned voffA[2], voffB[2];
#pragma unroll
    for (int i = 0; i < 2; ++i) { int R, C; stage_rc(tid * 16 + i * 8192, R, C); const int Rb = Epi::PERM ? ((R & ~31) + perm32(R & 31)) : R;
        voffA[i] = (unsigned)(R * K + C) * 2u; voffB[i] = (unsigned)(Rb * K + C) * 2u; }
    const size_t kstep = (size_t)(BK * 2);
    const size_t hstep = (size_t)HALF * K * 2;
    const size_t tstep = 2 * hstep;
    const unsigned ldsw = (unsigned)wid * 1024u;
    const int aoff = lds_byte(wr * 64 + fr, fq * 8), boff = lds_byte(wc * 32 + fr, fq * 8);
#define PG8_SA(b, h) (((b) * 2 + (h)) * HTB)
#define PG8_SB(b, h) ((4 + (b) * 2 + (h)) * HTB)
#define PG8_STAGE(bufoff, gbase, voff) do { _Pragma("unroll") for (int _i = 0; _i < 2; ++_i) \
        __builtin_amdgcn_global_load_lds((const unsigned*)((const char*)(gbase) + (voff)[_i]), (PG8_LAS unsigned*)(lds + (bufoff) + ldsw + _i * 8192), 16, 0, 0); } while (0)
#define PG8_LDA(dst, b, h) do { _Pragma("unroll") for (int m = 0; m < 4; ++m) _Pragma("unroll") for (int k = 0; k < 2; ++k) dst[m][k] = *(const PG8_LAS bf16x8*)(lds + PG8_SA(b, h) + aoff + m * 2048 + k * 1024); } while (0)
#define PG8_LDB(dst, b, h) do { _Pragma("unroll") for (int n = 0; n < 2; ++n) _Pragma("unroll") for (int k = 0; k < 2; ++k) dst[n][k] = *(const PG8_LAS bf16x8*)(lds + PG8_SB(b, h) + boff + n * 2048 + k * 1024); } while (0)
#define PG8_MMA(ai, bj, At, Bt) do { __builtin_amdgcn_s_setprio(1); _Pragma("unroll") for (int m = 0; m < 4; ++m) _Pragma("unroll") for (int n = 0; n < 2; ++n) _Pragma("unroll") for (int k = 0; k < 2; ++k) \
        acc[ai][bj][m][n] = __builtin_amdgcn_mfma_f32_16x16x32_bf16(Bt[n][k], At[m][k], acc[ai][bj][m][n], 0, 0, 0); __builtin_amdgcn_s_setprio(0); } while (0)
#define PG8_WAIT_V(n) asm volatile("s_waitcnt vmcnt(" #n ")" ::: "memory")
#define PG8_WAIT_L(n) asm volatile("s_waitcnt lgkmcnt(" #n ")" ::: "memory")
#define PG8_BAR __builtin_amdgcn_s_barrier()
#define PG8_SCHED __builtin_amdgcn_sched_barrier(0)
    Unit cur, nxt; int ui = 0;
    if (!S.next(0, cur)) return;
    f32x4 acc[2][2][4][2];
#pragma unroll
    for (int a = 0; a < 2; ++a)
#pragma unroll
        for (int b = 0; b < 2; ++b)
#pragma unroll
            for (int m = 0; m < 4; ++m)
#pragma unroll
                for (int n = 0; n < 2; ++n) acc[a][b][m][n] = (f32x4){0.f, 0.f, 0.f, 0.f};
    bf16x8 At[4][2], B0[2][2], B1[2][2];
    const char* cA = (const char*)g.A + (size_t)cur.pm * tstep; const char* cB = (const char*)g.Bt + (size_t)cur.pn * tstep;
    S.a_ready(cur);
    if constexpr (SP2) {
        PG8_STAGE(PG8_SB(0, 0), cB, voffB); PG8_STAGE(PG8_SB(0, 1), cB + hstep, voffB); PG8_STAGE(PG8_SA(0, 0), cA, voffA); PG8_STAGE(PG8_SA(0, 1), cA + hstep, voffA);
        if (wr == 1) PG8_BAR;
        PG8_WAIT_V(2); PG8_BAR;
        PG8_STAGE(PG8_SB(1, 0), cB + kstep, voffB); PG8_STAGE(PG8_SA(1, 0), cA + kstep, voffA); PG8_STAGE(PG8_SB(1, 1), cB + hstep + kstep, voffB);
        PG8_WAIT_V(6); PG8_BAR;
    } else {
        PG8_STAGE(PG8_SB(0, 0), cB, voffB); PG8_STAGE(PG8_SA(0, 0), cA, voffA); PG8_STAGE(PG8_SB(0, 1), cB + hstep, voffB); PG8_STAGE(PG8_SA(0, 1), cA + hstep, voffA);
        if (wr == 1) PG8_BAR;
        PG8_WAIT_V(4); PG8_BAR;
        PG8_STAGE(PG8_SB(1, 0), cB + kstep, voffB); PG8_STAGE(PG8_SA(1, 0), cA + kstep, voffA); PG8_STAGE(PG8_SB(1, 1), cB + hstep + kstep, voffB);
        PG8_WAIT_V(6); PG8_BAR;
    }
    for (;;) {
        const bool has_next = S.next(ui + 1, nxt);
        const char* nA = has_next ? (const char*)g.A + (size_t)nxt.pm * tstep : cA; const char* nB = has_next ? (const char*)g.Bt + (size_t)nxt.pn * tstep : cB;
        for (int t = 0; t < nt; t += 2) {
            const bool last = (t == nt - 2);
            const char* a1 = cA + (size_t)(t + 1) * kstep;
            const char* a2 = last ? nA : cA + (size_t)(t + 2) * kstep; const char* b2 = last ? nB : cB + (size_t)(t + 2) * kstep;
            const char* a3 = a2 + kstep; const char* b3 = b2 + kstep;
            if (last && has_next) S.a_ready(nxt);
            if constexpr (SP2) {
            PG8_LDB(B0, 0, 0); PG8_LDB(B1, 0, 1); PG8_SCHED; PG8_LDA(At, 0, 0); PG8_STAGE(PG8_SA(1, 1), a1 + hstep, voffA);
            PG8_WAIT_V(8); PG8_WAIT_L(0); PG8_BAR; PG8_MMA(0, 0, At, B0); PG8_MMA(0, 1, At, B1); PG8_BAR; PG8_SCHED;
            PG8_LDA(At, 0, 1); PG8_STAGE(PG8_SB(0, 0), b2, voffB); PG8_STAGE(PG8_SB(0, 1), b2 + hstep, voffB); PG8_STAGE(PG8_SA(0, 0), a2, voffA);
            PG8_WAIT_V(8); PG8_WAIT_L(0); PG8_BAR; PG8_MMA(1, 0, At, B0); PG8_MMA(1, 1, At, B1); PG8_BAR; PG8_SCHED;
            PG8_LDB(B0, 1, 0); PG8_LDB(B1, 1, 1); PG8_SCHED; PG8_LDA(At, 1, 0); PG8_STAGE(PG8_SA(0, 1), a2 + hstep, voffA);
            PG8_WAIT_V(8); PG8_WAIT_L(0); PG8_BAR; PG8_MMA(0, 0, At, B0); PG8_MMA(0, 1, At, B1); PG8_BAR; PG8_SCHED;
            PG8_LDA(At, 1, 1); PG8_STAGE(PG8_SB(1, 0), b3, voffB); PG8_STAGE(PG8_SB(1, 1), b3 + hstep, voffB); PG8_STAGE(PG8_SA(1, 0), a3, voffA);
            PG8_WAIT_V(8); PG8_WAIT_L(0); PG8_BAR; PG8_MMA(1, 0, At, B0); PG8_MMA(1, 1, At, B1); PG8_BAR; PG8_SCHED;
            } else {
            PG8_LDB(B0, 0, 0); PG8_SCHED; PG8_LDA(At, 0, 0); PG8_STAGE(PG8_SA(1, 1), a1 + hstep, voffA);
            PG8_WAIT_L(8); PG8_BAR; PG8_WAIT_L(0); PG8_MMA(0, 0, At, B0); PG8_BAR; PG8_SCHED;
            PG8_LDB(B1, 0, 1); PG8_STAGE(PG8_SB(0, 0), b2, voffB);
            PG8_BAR; PG8_WAIT_L(0); PG8_MMA(0, 1, At, B1); PG8_BAR;
            PG8_LDA(At, 0, 1); PG8_STAGE(PG8_SA(0, 0), a2, voffA);
            PG8_BAR; PG8_WAIT_L(0); PG8_MMA(1, 0, At, B0); PG8_BAR; PG8_SCHED;
            PG8_STAGE(PG8_SB(0, 1), b2 + hstep, voffB);
            PG8_WAIT_V(6); PG8_BAR; PG8_MMA(1, 1, At, B1); PG8_BAR;
            PG8_LDB(B0, 1, 0); PG8_SCHED; PG8_LDA(At, 1, 0); PG8_STAGE(PG8_SA(0, 1), a2 + hstep, voffA);
            PG8_WAIT_L(8); PG8_BAR; PG8_WAIT_L(0); PG8_MMA(0, 0, At, B0); PG8_BAR; PG8_SCHED;
            PG8_LDB(B1, 1, 1); PG8_STAGE(PG8_SB(1, 0), b3, voffB);
            PG8_BAR; PG8_WAIT_L(0); PG8_MMA(0, 1, At, B1); PG8_BAR;
            PG8_LDA(At, 1, 1); PG8_STAGE(PG8_SA(1, 0), a3, voffA);
            PG8_BAR; PG8_WAIT_L(0); PG8_MMA(1, 0, At, B0); PG8_BAR; PG8_SCHED;
            PG8_STAGE(PG8_SB(1, 1), b3 + hstep, voffB);
            PG8_WAIT_V(6); PG8_BAR; PG8_MMA(1, 1, At, B1); PG8_BAR;
            }
        }
        if constexpr (ALIGN_EPI) { if (wr == 0) PG8_BAR; }
        if constexpr (!Epi::AFTER_DRAIN) { E(acc, cur, wr, wc, fr, fq); S.done(cur); }
        if (!has_next) break;
#pragma unroll
        for (int a = 0; a < 2; ++a)
#pragma unroll
            for (int b = 0; b < 2; ++b)
#pragma unroll
                for (int m = 0; m < 4; ++m)
#pragma unroll
                    for (int n = 0; n < 2; ++n) acc[a][b][m][n] = (f32x4){0.f, 0.f, 0.f, 0.f};
        cur = nxt; cA = nA; cB = nB; ++ui;
        if constexpr (ALIGN_EPI) { if (wr == 1) PG8_BAR; }
    }
    PG8_WAIT_V(0);
    if constexpr (!ALIGN_EPI) { if (wr == 0) PG8_BAR; }
    PG8_BAR;
    if constexpr (Epi::AFTER_DRAIN) { E.fused(acc, cur, wr, wc, fr, fq, lds, wid, lane); S.done(cur); }
#undef PG8_SA
#undef PG8_SB
#undef PG8_STAGE
#undef PG8_LDA
#undef PG8_LDB
#undef PG8_MMA
#undef PG8_WAIT_V
#undef PG8_WAIT_L
#undef PG8_BAR
#undef PG8_SCHED
}
}
#define GAS __attribute__((address_space(1)))
#define LAS __attribute__((address_space(3)))
typedef unsigned short bf16;
typedef unsigned v4u __attribute__((ext_vector_type(4)));
typedef float f32x4 __attribute__((ext_vector_type(4)));
typedef short bf16x8 __attribute__((ext_vector_type(8)));
typedef GAS unsigned gu32;
typedef GAS unsigned long long gu64;
#define RLX_AGENT __ATOMIC_RELAXED, __HIP_MEMORY_SCOPE_AGENT
#define LDS_WAIT() asm volatile("s_waitcnt lgkmcnt(0)" ::: "memory")
#define VM_WAIT() asm volatile("s_waitcnt vmcnt(0)" ::: "memory")
__device__ __forceinline__ unsigned long long rt() { return __builtin_amdgcn_s_memrealtime(); }
__device__ __forceinline__ unsigned f2bf(float f) { unsigned u = __builtin_bit_cast(unsigned, f); return (u + 0x7fffu + ((u >> 16) & 1u)) >> 16; }
__device__ __forceinline__ unsigned pk2(float lo, float hi) { return f2bf(lo) | (f2bf(hi) << 16); }
#define XB_TMO      128
#define XB_XCNT(j)  (256  + 64 * (j))
#define XB_XSUB(j)  (1280 + 64 * (j))
#define XB_XGEN(j)  (2304 + 64 * (j))
#define XB_TOP      3328
#define XB_TOPGEN   3392
#define XCD_BAR_WORDS 3456
#define XB_SPIN_CAP (1u << 18)

__device__ __forceinline__ unsigned xb_ld(unsigned* p)              { return __hip_atomic_load(p, __ATOMIC_RELAXED, __HIP_MEMORY_SCOPE_AGENT); }
__device__ __forceinline__ unsigned xb_add(unsigned* p, unsigned v) { return __hip_atomic_fetch_add(p, v, __ATOMIC_RELAXED, __HIP_MEMORY_SCOPE_AGENT); }
__device__ __forceinline__ unsigned xb_xcc_id() { return (unsigned)__builtin_amdgcn_s_getreg((3 << 11) | 20) & 0xFu; }
#define XB_SPIN(cond, bar) do { unsigned _sp = 0; while (cond) { __builtin_amdgcn_s_sleep(1); \
    if ((++_sp & 255u) == 0u) { if (xb_ld(&(bar)[XB_TMO])) break; if (_sp > XB_SPIN_CAP) { atomicAdd(&(bar)[XB_TMO], 1u); break; } } } } while (0)

struct XcdBarrier {
    unsigned* bar; unsigned x;
    volatile LAS unsigned* st;
};

__device__ __forceinline__ XcdBarrier xcd_barrier_post(unsigned* bar, volatile LAS unsigned* st) {
    XcdBarrier b; b.bar = bar; b.x = xb_xcc_id(); b.st = st;
    if (threadIdx.x == 0) (void)xb_add(&bar[XB_XCNT(b.x)], 1u);
    return b;
}
__device__ __forceinline__ void xcd_barrier_complete(unsigned* bar, unsigned x, unsigned& nloc, unsigned& nx) {
    const unsigned G = gridDim.x * gridDim.y * gridDim.z;
    unsigned sum, cnt, mine, sp = 0u;
    for (;;) {
        sum = 0u; cnt = 0u; mine = 0u;
#pragma unroll
        for (unsigned j = 0; j < 16; ++j) { const unsigned c = xb_ld(&bar[XB_XCNT(j)]); sum += c; cnt += (c > 0u) ? 1u : 0u; mine = (j == x) ? c : mine; }
        if (sum == G) break;
        __builtin_amdgcn_s_sleep(1);
        if ((++sp & 255u) == 0u) { if (xb_ld(&bar[XB_TMO])) break; if (sp > XB_SPIN_CAP) { atomicAdd(&bar[XB_TMO], 1u); break; } }
    }
    nloc = mine > 0u ? mine : 1u; nx = cnt > 0u ? cnt : 1u;
}

__device__ __forceinline__ void xcd_barrier(const XcdBarrier& b) {
    asm volatile("s_waitcnt vmcnt(0)" ::: "memory");
    __syncthreads();
    if (threadIdx.x == 0) {
        unsigned* bar = b.bar;
        __builtin_amdgcn_s_waitcnt(0);
        unsigned nloc = b.st[0], nx = b.st[1];
        if (nloc == 0u) { xcd_barrier_complete(bar, b.x, nloc, nx); b.st[0] = nloc; b.st[1] = nx; }
        const unsigned old = xb_add(&bar[XB_XSUB(b.x)], 1u);
        const unsigned gen = old / nloc;
        if (old + 1u == (gen + 1u) * nloc) {
            __builtin_amdgcn_fence(__ATOMIC_RELEASE, "agent");
            asm volatile("s_waitcnt vmcnt(0)" ::: "memory");
            const unsigned og = xb_add(&bar[XB_TOP], 1u);
            const unsigned tg = og / nx;
            if (og + 1u == (tg + 1u) * nx) xb_add(&bar[XB_TOPGEN], 1u);
            else XB_SPIN(xb_ld(&bar[XB_TOPGEN]) == tg, bar);
            __builtin_amdgcn_fence(__ATOMIC_ACQUIRE, "agent");
            xb_add(&bar[XB_XGEN(b.x)], 1u);
            asm volatile("s_waitcnt vmcnt(0)" ::: "memory");
        } else {
            XB_SPIN(xb_ld(&bar[XB_XGEN(b.x)]) == gen, bar);
            __builtin_amdgcn_fence(__ATOMIC_ACQUIRE, "agent");
            asm volatile("s_waitcnt vmcnt(0)" ::: "memory");
        }
    }
    __syncthreads();
}
constexpr int NWAVES = 8;
constexpr int BATCH = 4, SEQ = 8192, D = 1024, T = BATCH * SEQ, DEPTH = 4, MEML = 256, MROWS = BATCH * MEML;
constexpr int NPROJ = 2560, FFD = 2816, FFE = 3584, NEXP = 8, XW = 512;
constexpr int MP = 2 * T + NEXP * 256;
constexpr int NKEYS = 321;
constexpr int NPH = 1 + 8 + 11 + 8 + 11;
constexpr int PC_Q = 0, PC_K = 512, PC_V = 1024, PC_POOL = 1536, PC_BG = 1792, PC_CG = 2048, PC_HC = 2304;
constexpr size_t MiB = 1u << 20;
constexpr size_t WS_CTL = 0, CTL_ZERO_BYTES = 64 * 1024;
constexpr size_t WS_CNT = 1 * MiB, WS_META = 1 * MiB + 64 * 1024;
constexpr size_t WS_TOKE = 1 * MiB + 512 * 1024, WS_TOKG = 2 * MiB, WS_TOKPOS = 2 * MiB + 512 * 1024, WS_ROWGATE = 3 * MiB, WS_ROWRS = 3 * MiB + 512 * 1024;
constexpr size_t WS_SSP = 4 * MiB;
constexpr size_t WS_KVX = 30 * MiB, WS_MEMN = 38 * MiB;
constexpr size_t WS_WIN = 40 * MiB, WS_WOUT = 60 * MiB, WS_WQ = 68 * MiB, WS_WKV = 72 * MiB, WS_WO = 80 * MiB, WS_W13D = 84 * MiB, WS_W2D = 106 * MiB, WS_W13M = 117 * MiB, WS_W2M = 341 * MiB;
constexpr size_t WS_XB = 453 * MiB, WS_QX = 517 * MiB, WS_OX = 549 * MiB, WS_AG = 581 * MiB, WS_YM = 713 * MiB, WS_RA = 977 * MiB, WS_END = 1439 * MiB;
constexpr size_t WS_PROJ = WS_RA, WS_Y = WS_RA + 160 * MiB, WS_H = WS_RA;
static_assert(WS_AG + (size_t)MP * D * 2 <= WS_YM && WS_YM + (size_t)MP * D * 4 <= WS_RA && WS_RA + (size_t)MP * FFE * 2 <= WS_END, "ws map");
constexpr int CW_BAR = 4096;
constexpr int RING_BYTES = 131072, LDSCTL_OFF = RING_BYTES, MISC_OFF = LDSCTL_OFF + 320, LDS_BYTES = 147456;

__device__ __forceinline__ float wave_sum(float v) {
#pragma unroll
    for (int o = 1; o < 64; o <<= 1) v += __shfl_xor(v, o);
    return v;
}
__device__ __forceinline__ float wave_max(float v) {
#pragma unroll
    for (int o = 1; o < 64; o <<= 1) v = fmaxf(v, __shfl_xor(v, o));
    return v;
}
__device__ __forceinline__ float bflo(unsigned u) { return __uint_as_float(u << 16); }
__device__ __forceinline__ float bfhi(unsigned u) { return __uint_as_float(u & 0xffff0000u); }
__device__ __forceinline__ float bf1(bf16 h) { return __uint_as_float(((unsigned)h) << 16); }
__device__ __forceinline__ float dot8(v4u a, v4u b) {
    return (bflo(a.x) * bflo(b.x) + bfhi(a.x) * bfhi(b.x)) + (bflo(a.y) * bflo(b.y) + bfhi(a.y) * bfhi(b.y)) + (bflo(a.z) * bflo(b.z) + bfhi(a.z) * bfhi(b.z)) + (bflo(a.w) * bflo(b.w) + bfhi(a.w) * bfhi(b.w));
}
__device__ __forceinline__ int key_dist(int i) { return i < 129 ? i : (i < 225 ? 132 + 4 * (i - 129) : 528 + 16 * (i - 225)); }
__device__ __forceinline__ int key_mult(int d) { return d <= 128 ? 1 + ((d & 3) == 0 ? 1 : 0) + ((d & 15) == 0 ? 1 : 0) : (d <= 512 ? 1 + ((d & 15) == 0 ? 1 : 0) : 1); }
__device__ __forceinline__ int t5_bucket(int d) {
    if (d < 16) return d;
    int b = 16 + (int)(logf((float)d / 16.0f) / logf(8.0f) * 16.0f);
    return b < 31 ? b : 31;
}

struct Args { const float* in[21]; float* out; unsigned char* ws; int ph_lo, ph_hi; };

__device__ __forceinline__ void conv_item(const float* W, int K, int N, bf16* WT, const float* gain, int swF, LAS float* scr, int item, int lane) {
    const int nblk = N / 32, kb = item / nblk, nb = item % nblk, k0 = 64 * kb, n0 = 32 * nb;
#pragma unroll 8
    for (int i = 0; i < 32; ++i) { const int kk = 2 * i + (lane >> 5); float w = W[(size_t)(k0 + kk) * N + n0 + (lane & 31)]; if (gain) w *= gain[k0 + kk]; scr[kk * 33 + (lane & 31)] = w; }
    LDS_WAIT(); asm volatile("" ::: "memory");
    int orow0 = n0;
    if (swF) { const int isup = n0 >= swF ? 1 : 0; const int j = n0 - isup * swF; orow0 = (j >> 7) * 256 + isup * 128 + (j & 127); }
    const int c = lane & 7;
#pragma unroll
    for (int j = 0; j < 4; ++j) { const int n = (lane >> 3) + 8 * j; const LAS float* s = scr + (8 * c) * 33 + n;
        v4u o; o.x = pk2(s[0 * 33], s[1 * 33]); o.y = pk2(s[2 * 33], s[3 * 33]); o.z = pk2(s[4 * 33], s[5 * 33]); o.w = pk2(s[6 * 33], s[7 * 33]);
        *(GAS v4u*)(WT + (size_t)(orow0 + n) * K + k0 + 8 * c) = o; }
    LDS_WAIT(); asm volatile("" ::: "memory");
}

#define x_in (args.in[0])
#define mem_in (args.in[1])
#define rel_bias (args.in[2])
#define mem_g (args.in[3])
#define mix_g (args.in[4])
#define w_in (args.in[5])
#define conv_w (args.in[6])
#define pool_w (args.in[7])
#define pool_scale (args.in[8])
#define w_out (args.in[9])
#define xat_g (args.in[10])
#define wq_x (args.in[11])
#define wkv_x (args.in[12])
#define wo_x (args.in[13])
#define ffn_g (args.in[14])
#define w13_d (args.in[15])
#define w2_d (args.in[16])
#define router_w (args.in[17])
#define w13_m (args.in[18])
#define w2_m (args.in[19])
#define fin_g (args.in[20])
#define out (args.out)
#define Win_t ((bf16*)(ws + WS_WIN))
#define Wout_t ((bf16*)(ws + WS_WOUT))
#define Wq_t ((bf16*)(ws + WS_WQ))
#define Wkv_t ((bf16*)(ws + WS_WKV))
#define Wo_t ((bf16*)(ws + WS_WO))
#define W13d_t ((bf16*)(ws + WS_W13D))
#define W2d_t ((bf16*)(ws + WS_W2D))
#define W13m_t ((bf16*)(ws + WS_W13M))
#define W2m_t ((bf16*)(ws + WS_W2M))
#define xb ((bf16*)(ws + WS_XB))
#define qx ((bf16*)(ws + WS_QX))
#define ox ((bf16*)(ws + WS_OX))
#define Ag ((bf16*)(ws + WS_AG))
#define ym ((float*)(ws + WS_YM))
#define proj ((bf16*)(ws + WS_PROJ))
#define ymix ((bf16*)(ws + WS_Y))
#define hbuf ((bf16*)(ws + WS_H))
#define kvx ((bf16*)(ws + WS_KVX))
#define memn ((bf16*)(ws + WS_MEMN))
#define ssp ((float*)(ws + WS_SSP))
#define cnts ((int*)(ws + WS_CNT))
#define meta ((int*)(ws + WS_META))
#define tok_e ((int*)(ws + WS_TOKE))
#define tok_g ((float*)(ws + WS_TOKG))
#define tok_pos ((int*)(ws + WS_TOKPOS))
#define row_gate ((float*)(ws + WS_ROWGATE))
#define row_rs ((float*)(ws + WS_ROWRS))
__global__ void __launch_bounds__(NWAVES * 64, 2) trunk_fwd(Args args) {
    extern __shared__ __attribute__((aligned(16))) unsigned char lds_raw[];
    LAS unsigned char* lds = (LAS unsigned char*)lds_raw;
    volatile LAS unsigned* MISC = (volatile LAS unsigned*)(lds + MISC_OFF);
    const int tid0 = threadIdx.x;
    const int G = gridDim.x, blk = blockIdx.x;
    unsigned char* ws0 = args.ws;
    gu32* ctl = (gu32*)(ws0 + WS_CTL);
#define PH_VARS int tid = tid0; asm volatile("" : "+v"(tid)); unsigned char* ws = ws0; asm volatile("" : "+s"(ws)); const int lane = tid & 63, wave = __builtin_amdgcn_readfirstlane(tid >> 6); const int gw = blk * NWAVES + wave, NGW = G * NWAVES; (void)lane; (void)gw; (void)NGW; (void)ws
    for (int u = tid0; u < (LDS_BYTES - LDSCTL_OFF) / 4; u += NWAVES * 64) ((LAS unsigned*)(lds + LDSCTL_OFF))[u] = 0u;
    __syncthreads();
    XcdBarrier bar = xcd_barrier_post((unsigned*)(ctl + CW_BAR), MISC + 8);
    const int lo = args.ph_lo, hi = args.ph_hi;
    int ph = 0;
#define PH_ON (ph >= lo && ph < hi)
#define PH_END do { if (ph >= lo && ph + 1 < hi) xcd_barrier(bar); ++ph; } while (0)

    constexpr size_t SSP_STRIDE = (size_t)T * 16;

    if (PH_ON) { PH_VARS;
        LAS float* scr = (LAS float*)(lds + wave * 16384);
        constexpr int I_IN = 16 * 80, I_OUT = 16 * 32, I_Q = 16 * 16, I_KV = 16 * 32, I_O = 8 * 32, I_13D = 16 * 176, I_2D = 44 * 32, I_13M = 16 * 224, I_2M = 56 * 32;
        constexpr int C0 = 4 * I_IN, C1 = C0 + 4 * I_OUT, C2 = C1 + 4 * I_Q, C3 = C2 + 4 * I_KV, C4 = C3 + 4 * I_O, C5 = C4 + 2 * I_13D, C6 = C5 + 2 * I_2D, C7 = C6 + 16 * I_13M, C8 = C7 + 16 * I_2M;
        for (int it = gw; it < C8; it += NGW) {
            if (it < C0) { const int m = it / I_IN, r = it % I_IN; conv_item(w_in + (size_t)m * D * NPROJ, D, NPROJ, Win_t + (size_t)m * NPROJ * D, mix_g + m * D, 0, scr, r, lane); }
            else if (it < C1) { const int q = it - C0, m = q / I_OUT, r = q % I_OUT; conv_item(w_out + (size_t)m * D * D, D, D, Wout_t + (size_t)m * D * D, nullptr, 0, scr, r, lane); }
            else if (it < C2) { const int q = it - C1, m = q / I_Q, r = q % I_Q; conv_item(wq_x + (size_t)m * D * XW, D, XW, Wq_t + (size_t)m * XW * D, xat_g + m * D, 0, scr, r, lane); }
            else if (it < C3) { const int q = it - C2, m = q / I_KV, r = q % I_KV; conv_item(wkv_x + (size_t)m * D * 1024, D, 1024, Wkv_t + (size_t)m * 1024 * D, nullptr, 0, scr, r, lane); }
            else if (it < C4) { const int q = it - C3, m = q / I_O, r = q % I_O; conv_item(wo_x + (size_t)m * XW * D, XW, D, Wo_t + (size_t)m * D * XW, nullptr, 0, scr, r, lane); }
            else if (it < C5) { const int q = it - C4, m = q / I_13D, r = q % I_13D; conv_item(w13_d + (size_t)m * D * 2 * FFD, D, 2 * FFD, W13d_t + (size_t)m * 2 * FFD * D, ffn_g + (2 * m) * D, FFD, scr, r, lane); }
            else if (it < C6) { const int q = it - C5, m = q / I_2D, r = q % I_2D; conv_item(w2_d + (size_t)m * FFD * D, FFD, D, W2d_t + (size_t)m * D * FFD, nullptr, 0, scr, r, lane); }
            else if (it < C7) { const int q = it - C6, m = q / I_13M, r = q % I_13M; conv_item(w13_m + (size_t)m * D * 2 * FFE, D, 2 * FFE, W13m_t + (size_t)m * 2 * FFE * D, ffn_g + (2 * (m >> 3) + 1) * D, FFE, scr, r, lane); }
            else { const int q = it - C7, m = q / I_2M, r = q % I_2M; conv_item(w2_m + (size_t)m * FFE * D, FFE, D, W2m_t + (size_t)m * D * FFE, nullptr, 0, scr, r, lane); }
        }
        for (int m = gw; m < T; m += NGW) {
            const GAS f32x4* xr = (const GAS f32x4*)(x_in + (size_t)m * D) + lane; f32x4 v[4]; float s = 0.f;
#pragma unroll
            for (int j = 0; j < 4; ++j) { v[j] = xr[64 * j]; s += (v[j].x * v[j].x + v[j].y * v[j].y) + (v[j].z * v[j].z + v[j].w * v[j].w); }
            s = wave_sum(s);
            GAS unsigned long long* o8 = (GAS unsigned long long*)(xb + (size_t)m * D) + lane;
#pragma unroll
            for (int j = 0; j < 4; ++j) o8[64 * j] = (unsigned long long)pk2(v[j].x, v[j].y) | ((unsigned long long)pk2(v[j].z, v[j].w) << 32);
            if (lane < 16) ssp[(size_t)m * 16 + lane] = lane == 0 ? s : 0.f;
        }
        for (int m = gw; m < MROWS; m += NGW) {
            const GAS f32x4* xr = (const GAS f32x4*)(mem_in + (size_t)m * D) + lane; const GAS f32x4* gr = (const GAS f32x4*)mem_g + lane; f32x4 v[4]; float s = 0.f;
#pragma unroll
            for (int j = 0; j < 4; ++j) { v[j] = xr[64 * j]; s += (v[j].x * v[j].x + v[j].y * v[j].y) + (v[j].z * v[j].z + v[j].w * v[j].w); }
            const float r = 1.0f / sqrtf(wave_sum(s) * (1.0f / D) + 1e-6f);
            GAS unsigned long long* o8 = (GAS unsigned long long*)(memn + (size_t)m * D) + lane;
#pragma unroll
            for (int j = 0; j < 4; ++j) { const f32x4 g = gr[64 * j]; o8[64 * j] = (unsigned long long)pk2(v[j].x * r * g.x, v[j].y * r * g.y) | ((unsigned long long)pk2(v[j].z * r * g.z, v[j].w * r * g.w) << 32); }
        }
    }
    PH_END;

    for (int l = 0; l < DEPTH; ++l) {
#define ssp_a (ssp + (size_t)(3 * l) * SSP_STRIDE)
#define ssp_b (ssp + (size_t)(3 * l + 1) * SSP_STRIDE)
#define ssp_c (ssp + (size_t)(3 * l + 2) * SSP_STRIDE)
#define ssp_d (ssp + (size_t)(3 * l + 3) * SSP_STRIDE)
        if (PH_ON) { PH_VARS;
            if (l == 0) {
                pg8::Gemm g{memn, Wkv_t, MROWS, 4096, D}; pg8::StaticOrder S; S.init(MROWS, 4096, G, blk);
                pg8::EpiRowScale E{kvx, 4096, nullptr, 1.0f};
                pg8::gemm_phase<pg8::EpiRowScale, pg8::StaticOrder, true, true>(lds, g, S, E, tid);
            }
            pg8::Gemm g{xb, Win_t + (size_t)l * NPROJ * D, T, NPROJ, D}; pg8::StaticOrder S; S.init(T, NPROJ, G, blk);
            pg8::EpiRowScale E{proj, NPROJ, ssp_a, 1.0f};
            pg8::gemm_phase<pg8::EpiRowScale, pg8::StaticOrder, true, true>(lds, g, S, E, tid);
        }
        PH_END;
        if (PH_ON) { PH_VARS;
            LAS float* biasm = (LAS float*)lds;
            LAS float* pw = (LAS float*)(lds + 12288 + wave * 2048);
            for (int idx = tid; idx < NKEYS * 8; idx += NWAVES * 64) { const int i = idx >> 3, h = idx & 7, d = key_dist(i); biasm[idx] = rel_bias[t5_bucket(d) * 8 + h] + logf((float)key_mult(d)); }
            __syncthreads();
            const float* cw = conv_w + (size_t)l * 3 * 256; const float* pwt = pool_w + (size_t)l * 4 * 64 * 64; const float* psc = pool_scale + (size_t)l * 256;
            for (int t = gw; t < T; t += NGW) {
                const int pos = t % SEQ; const bf16* prow = proj + (size_t)t * NPROJ;
                for (int h = 0; h < 8; ++h) {
                    v4u qv[8];
#pragma unroll
                    for (int c = 0; c < 8; ++c) qv[c] = *(const GAS v4u*)(prow + PC_Q + h * 64 + c * 8);
                    float sc[6]; float mx = -1e30f;
#pragma unroll
                    for (int j = 0; j < 6; ++j) { const int i = lane + 64 * j; const int d = key_dist(i < NKEYS ? i : 0); const bool valid = (i < NKEYS) && (pos - d >= 0);
                        float s = -1e30f;
                        if (valid) { const bf16* kr = proj + (size_t)(t - d) * NPROJ + PC_K + h * 64; float a = 0.f;
#pragma unroll
                            for (int c = 0; c < 8; ++c) a += dot8(qv[c], *(const GAS v4u*)(kr + c * 8));
                            s = a * 0.125f + biasm[i * 8 + h]; }
                        sc[j] = s; mx = fmaxf(mx, s); }
                    mx = wave_max(mx); float sum = 0.f;
#pragma unroll
                    for (int j = 0; j < 6; ++j) { sc[j] = sc[j] > -1e29f ? __expf(sc[j] - mx) : 0.f; sum += sc[j]; }
                    sum = wave_sum(sum); const float inv = 1.0f / sum;
#pragma unroll
                    for (int j = 0; j < 6; ++j) { const int i = lane + 64 * j; if (i < NKEYS) pw[i] = sc[j] * inv; }
                    LDS_WAIT(); asm volatile("" ::: "memory");
                    float acc = 0.f;
                    for (int i = 0; i < NKEYS; ++i) { const int d = key_dist(i); if (pos - d < 0) continue;
                        acc += pw[i] * bf1(proj[(size_t)(t - d) * NPROJ + PC_V + h * 64 + lane]); }
                    ymix[(size_t)t * D + h * 64 + lane] = (bf16)f2bf(acc);
                    LDS_WAIT(); asm volatile("" ::: "memory");
                }
                for (int g = 0; g < 4; ++g) { const int w = 2 << g; const int n = pos + 1 < w ? pos + 1 : w; float s = 0.f;
                    for (int i = 0; i < n; ++i) s += bf1(proj[(size_t)(t - i) * NPROJ + PC_POOL + g * 64 + lane]);
                    const float pooled = s / (float)n - bf1(prow[PC_POOL + g * 64 + lane]);
                    float a = 0.f; const float* pg = pwt + (size_t)g * 4096;
                    for (int c = 0; c < 64; ++c) a += __shfl(pooled, c) * pg[c * 64 + lane];
                    ymix[(size_t)t * D + 512 + g * 64 + lane] = (bf16)f2bf(a * psc[g * 64 + lane]); }
#pragma unroll
                for (int j = 0; j < 4; ++j) { const int c = lane + 64 * j;
                    const float u0 = bf1(prow[PC_CG + c]) * bf1(prow[PC_HC + c]);
                    const float u1 = pos >= 1 ? bf1(prow[PC_CG + c - NPROJ]) * bf1(prow[PC_HC + c - NPROJ]) : 0.f;
                    const float u2 = pos >= 2 ? bf1(prow[PC_CG + c - 2 * NPROJ]) * bf1(prow[PC_HC + c - 2 * NPROJ]) : 0.f;
                    const float yv = bf1(prow[PC_BG + c]) * (cw[c] * u0 + cw[256 + c] * u1 + cw[512 + c] * u2);
                    ymix[(size_t)t * D + 768 + c] = (bf16)f2bf(yv); }
            }
            __syncthreads();
        }
        PH_END;
        if (PH_ON) { PH_VARS;
            pg8::Gemm g{ymix, Wout_t + (size_t)l * D * D, T, D, D}; pg8::StaticOrder S; S.init(T, D, G, blk);
            pg8::EpiResid E{l == 0 ? x_in : (const float*)out, out, xb, ssp_b};
            pg8::gemm_phase<pg8::EpiResid, pg8::StaticOrder, true, true>(lds, g, S, E, tid);
        }
        PH_END;
        if (PH_ON) { PH_VARS;
            pg8::Gemm g{xb, Wq_t + (size_t)l * XW * D, T, XW, D}; pg8::StaticOrder S; S.init(T, XW, G, blk);
            pg8::EpiRowScale E{qx, XW, ssp_b, 0.08838834764831845f};
            pg8::gemm_phase<pg8::EpiRowScale, pg8::StaticOrder, true, true>(lds, g, S, E, tid);
        }
        PH_END;
        if (PH_ON) { PH_VARS;
            LAS float* pw = (LAS float*)(lds + wave * 2048);
            for (int it = gw; it < T * 4; it += NGW) {
                const int t = it >> 2, h = it & 3, b = t / SEQ;
                const bf16* qr = qx + (size_t)t * XW + h * 128; const bf16* kb = kvx + (size_t)(b * MEML) * 4096 + l * 1024 + h * 128;
                v4u qv[16];
#pragma unroll
                for (int c = 0; c < 16; ++c) qv[c] = *(const GAS v4u*)(qr + c * 8);
                float sc[4]; float mx = -1e30f;
#pragma unroll
                for (int j = 0; j < 4; ++j) { const bf16* kr = kb + (size_t)(lane + 64 * j) * 4096; float a = 0.f;
#pragma unroll
                    for (int c = 0; c < 16; ++c) a += dot8(qv[c], *(const GAS v4u*)(kr + c * 8));
                    sc[j] = a; mx = fmaxf(mx, a); }
                mx = wave_max(mx); float sum = 0.f;
#pragma unroll
                for (int j = 0; j < 4; ++j) { sc[j] = __expf(sc[j] - mx); sum += sc[j]; }
                sum = wave_sum(sum); const float inv = 1.0f / sum;
#pragma unroll
                for (int j = 0; j < 4; ++j) pw[lane + 64 * j] = sc[j] * inv;
                LDS_WAIT(); asm volatile("" ::: "memory");
                float a0 = 0.f, a1 = 0.f; const bf16* vb = kb + 512 + 2 * lane;
                for (int m = 0; m < MEML; ++m) { const unsigned vv = *(const GAS unsigned*)(vb + (size_t)m * 4096); const float p = pw[m]; a0 += p * bflo(vv); a1 += p * bfhi(vv); }
                *(GAS unsigned*)(ox + (size_t)t * XW + h * 128 + 2 * lane) = pk2(a0, a1);
                LDS_WAIT(); asm volatile("" ::: "memory");
            }
            __syncthreads();
        }
        PH_END;
        if (PH_ON) { PH_VARS;
            pg8::Gemm g{ox, Wo_t + (size_t)l * D * XW, T, D, XW}; pg8::StaticOrder S; S.init(T, D, G, blk);
            pg8::EpiResid E{out, out, xb, ssp_c};
            pg8::gemm_phase<pg8::EpiResid, pg8::StaticOrder, true, true>(lds, g, S, E, tid);
        }
        PH_END;
        if ((l & 1) == 0) {
            if (PH_ON) { PH_VARS;
                pg8::Gemm g{xb, W13d_t + (size_t)(l >> 1) * 2 * FFD * D, T, 2 * FFD, D}; pg8::StaticOrder S; S.init(T, 2 * FFD, G, blk);
                pg8::EpiSwiGLU E{hbuf, FFD, ssp_c, nullptr, 0};
                pg8::gemm_phase<pg8::EpiSwiGLU, pg8::StaticOrder, true, true>(lds, g, S, E, tid);
            }
            PH_END;
            if (PH_ON) { PH_VARS;
                pg8::Gemm g{hbuf, W2d_t + (size_t)(l >> 1) * D * FFD, T, D, FFD}; pg8::StaticOrder S; S.init(T, D, G, blk);
                pg8::EpiResid E{out, out, xb, ssp_d};
                pg8::gemm_phase<pg8::EpiResid, pg8::StaticOrder, true, true>(lds, g, S, E, tid);
            }
            PH_END;
        } else {
            const int chunk = (T + G - 1) / G;
            if (PH_ON) { PH_VARS;
                LAS int* lcnt = (LAS int*)lds; const float* rw = router_w + (size_t)(l >> 1) * D * NEXP; const float* fg = ffn_g + (size_t)l * D;
                if (tid < NEXP) lcnt[tid] = 0;
                __syncthreads();
                for (int i = wave; i < chunk; i += NWAVES) { const int t = blk * chunk + i; if (t >= T) break;
                    const float r = pg8::row_rs16(ssp_c, t);
                    float lg[8];
#pragma unroll
                    for (int e = 0; e < 8; ++e) lg[e] = 0.f;
#pragma unroll
                    for (int j = 0; j < 4; ++j) { const f32x4 xv = *((const GAS f32x4*)(out + (size_t)t * D) + lane + 64 * j); const f32x4 gv = *((const GAS f32x4*)fg + lane + 64 * j);
#pragma unroll
                        for (int c = 0; c < 4; ++c) { const float hn = xv[c] * r * gv[c]; const int k = 4 * (lane + 64 * j) + c; const f32x4 w0 = *(const GAS f32x4*)(rw + (size_t)k * 8), w1 = *(const GAS f32x4*)(rw + (size_t)k * 8 + 4);
                            lg[0] += hn * w0[0]; lg[1] += hn * w0[1]; lg[2] += hn * w0[2]; lg[3] += hn * w0[3]; lg[4] += hn * w1[0]; lg[5] += hn * w1[1]; lg[6] += hn * w1[2]; lg[7] += hn * w1[3]; } }
#pragma unroll
                    for (int e = 0; e < 8; ++e) lg[e] = wave_sum(lg[e]);
                    int e0 = 0; float v0 = lg[0];
#pragma unroll
                    for (int e = 1; e < 8; ++e) if (lg[e] > v0) { v0 = lg[e]; e0 = e; }
                    int e1 = -1; float v1 = -3.0e38f;
#pragma unroll
                    for (int e = 0; e < 8; ++e) if (e != e0 && lg[e] > v1) { v1 = lg[e]; e1 = e; }
                    const float p0 = 1.0f / (1.0f + __expf(v1 - v0)), p1 = 1.0f - p0;
                    if (lane == 0) { tok_e[2 * t] = e0; tok_e[2 * t + 1] = e1; tok_g[2 * t] = p0; tok_g[2 * t + 1] = p1; atomicAdd((int*)&lcnt[e0], 1); atomicAdd((int*)&lcnt[e1], 1); }
                }
                __syncthreads();
                if (tid < NEXP) cnts[blk * NEXP + tid] = lcnt[tid];
                __syncthreads();
            }
            PH_END;
            if (PH_ON) { PH_VARS;
                LAS int* lc = (LAS int*)lds;
                LAS int* lbase = (LAS int*)(lds + 32768);
                LAS int* lseg = (LAS int*)(lds + 32768 + 64);
                LAS int* lpos = (LAS int*)(lds + 36864);
                for (int i = tid; i < G * NEXP; i += NWAVES * 64) lc[i] = cnts[i];
                __syncthreads();
                if (tid < NEXP) { int base = 0, tot = 0; for (int b2 = 0; b2 < G; ++b2) { const int c = lc[b2 * NEXP + tid]; if (b2 < blk) base += c; tot += c; } lbase[tid] = base; lseg[8 + tid] = tot; }
                __syncthreads();
                if (tid == 0) { int s = 0; for (int e = 0; e < NEXP; ++e) { lseg[e] = s; lbase[e] += s; s += (lseg[8 + e] + 255) & ~255; lseg[16 + e] = s; if (blk == 0) meta[e] = s >> 8; } }
                __syncthreads();
                if (wave == 0) {
                    int run[8];
#pragma unroll
                    for (int e = 0; e < 8; ++e) run[e] = lbase[e];
                    const int nent = 2 * chunk;
                    for (int r0 = 0; r0 < nent; r0 += 64) { const int idx = r0 + lane; const int t = blk * chunk + (idx >> 1); const bool ok = idx < nent && t < T;
                        const int e = ok ? tok_e[2 * t + (idx & 1)] : -1; int pos = 0;
#pragma unroll
                        for (int ee = 0; ee < 8; ++ee) { const unsigned long long mk = __ballot(e == ee); if (e == ee) pos = run[ee] + __popcll(mk & ((1ull << lane) - 1ull)); run[ee] += __popcll(mk); }
                        if (ok) { tok_pos[2 * t + (idx & 1)] = pos; row_gate[pos] = tok_g[2 * t + (idx & 1)]; row_rs[pos] = pg8::row_rs16(ssp_c, t); lpos[idx] = pos; } }
                }
                __syncthreads();
                for (int idx = wave; idx < 2 * chunk; idx += NWAVES) { const int t = blk * chunk + (idx >> 1); if (t >= T) break; const int pos = lpos[idx];
                    const GAS v4u* src = (const GAS v4u*)(xb + (size_t)t * D); GAS v4u* dst = (GAS v4u*)(Ag + (size_t)pos * D); dst[lane] = src[lane]; dst[lane + 64] = src[lane + 64]; }
                if (blk < NEXP) { const int r0 = lseg[blk] + lseg[8 + blk], r1 = lseg[16 + blk];
                    for (int r = r0 + wave; r < r1; r += NWAVES) { GAS v4u* dst = (GAS v4u*)(Ag + (size_t)r * D); const v4u z = {0u, 0u, 0u, 0u}; dst[lane] = z; dst[lane + 64] = z; if (lane == 0) { row_gate[r] = 0.f; row_rs[r] = 0.f; } } }
                __syncthreads();
            }
            PH_END;
            if (PH_ON) { PH_VARS;
                pg8::MoeOrder S;
#pragma unroll
                for (int e = 0; e < 8; ++e) S.te[e] = __builtin_amdgcn_readfirstlane(meta[e]);
                S.nNl = 2 * FFE / 256; S.so.init(S.te[7] * 256, 2 * FFE, G, blk);
                pg8::Gemm g{Ag, W13m_t + (size_t)(l >> 1) * NEXP * 2 * FFE * D, MP, NEXP * 2 * FFE, D};
                pg8::EpiSwiGLU E{hbuf, FFE, nullptr, row_rs, 2 * FFE / 256};
                pg8::gemm_phase<pg8::EpiSwiGLU, pg8::MoeOrder, true, true>(lds, g, S, E, tid);
            }
            PH_END;
            if (PH_ON) { PH_VARS;
                pg8::MoeOrder S;
#pragma unroll
                for (int e = 0; e < 8; ++e) S.te[e] = __builtin_amdgcn_readfirstlane(meta[e]);
                S.nNl = D / 256; S.so.init(S.te[7] * 256, D, G, blk);
                pg8::Gemm g{hbuf, W2m_t + (size_t)(l >> 1) * NEXP * D * FFE, MP, NEXP * D, FFE};
                pg8::EpiMoeOut E{ym, row_gate};
                pg8::gemm_phase<pg8::EpiMoeOut, pg8::MoeOrder, true, true>(lds, g, S, E, tid);
            }
            PH_END;
            if (PH_ON) { PH_VARS;
                const bool last = (l == DEPTH - 1);
                for (int t = gw; t < T; t += NGW) {
                    const int p0 = tok_pos[2 * t], p1 = tok_pos[2 * t + 1];
                    const GAS f32x4* xr = (const GAS f32x4*)(out + (size_t)t * D) + lane; const GAS f32x4* y0 = (const GAS f32x4*)(ym + (size_t)p0 * D) + lane; const GAS f32x4* y1 = (const GAS f32x4*)(ym + (size_t)p1 * D) + lane;
                    f32x4 v[4]; float s = 0.f;
#pragma unroll
                    for (int j = 0; j < 4; ++j) { v[j] = (xr[64 * j] + y0[64 * j]) + y1[64 * j]; s += (v[j].x * v[j].x + v[j].y * v[j].y) + (v[j].z * v[j].z + v[j].w * v[j].w); }
                    s = wave_sum(s);
                    GAS f32x4* orow = (GAS f32x4*)(out + (size_t)t * D) + lane;
                    if (last) { const float r = 1.0f / sqrtf(s * (1.0f / D) + 1e-6f); const GAS f32x4* gr = (const GAS f32x4*)fin_g + lane;
#pragma unroll
                        for (int j = 0; j < 4; ++j) orow[64 * j] = v[j] * r * gr[64 * j]; }
                    else { GAS unsigned long long* o8 = (GAS unsigned long long*)(xb + (size_t)t * D) + lane;
#pragma unroll
                        for (int j = 0; j < 4; ++j) { orow[64 * j] = v[j]; o8[64 * j] = (unsigned long long)pk2(v[j].x, v[j].y) | ((unsigned long long)pk2(v[j].z, v[j].w) << 32); }
                        if (lane < 16) ssp_d[(size_t)t * 16 + lane] = lane == 0 ? s : 0.f; }
                }
            }
            PH_END;
        }
    }
#undef PH_ON
#undef PH_END
}
#undef x_in
#undef mem_in
#undef rel_bias
#undef mem_g
#undef mix_g
#undef w_in
#undef conv_w
#undef pool_w
#undef pool_scale
#undef w_out
#undef xat_g
#undef wq_x
#undef wkv_x
#undef wo_x
#undef ffn_g
#undef w13_d
#undef w2_d
#undef router_w
#undef w13_m
#undef w2_m
#undef fin_g
#undef out
#undef Win_t
#undef Wout_t
#undef Wq_t
#undef Wkv_t
#undef Wo_t
#undef W13d_t
#undef W2d_t
#undef W13m_t
#undef W2m_t
#undef xb
#undef qx
#undef ox
#undef Ag
#undef ym
#undef proj
#undef ymix
#undef hbuf
#undef kvx
#undef memn
#undef ssp
#undef cnts
#undef meta
#undef tok_e
#undef tok_g
#undef tok_pos
#undef row_gate
#undef row_rs
#undef ssp_a
#undef ssp_b
#undef ssp_c
#undef ssp_d
#undef PH_VARS

#ifndef N_LAUNCH_MODE
#define N_LAUNCH_MODE 0
#endif
extern "C" void kernel_launch(void* const* d_in, const int* in_sizes, int n_in, void* d_out, int out_size, void* d_ws, size_t ws_size, hipStream_t stream) {
    static int grid = 0;
    if (grid == 0) {
        if (n_in != 21 || in_sizes[0] != T * D || out_size != T * D || ws_size < WS_END) { fprintf(stderr, "kernel_launch: unexpected shapes: n_in %d in0 %d out %d ws %zu (need %zu)\n", n_in, n_in > 0 ? in_sizes[0] : -1, out_size, ws_size, (size_t)WS_END); grid = -1; return; }
        int dev = 0, cus = 0, per_cu = 0;
        if (hipGetDevice(&dev) != hipSuccess || hipDeviceGetAttribute(&cus, hipDeviceAttributeMultiprocessorCount, dev) != hipSuccess) { fprintf(stderr, "kernel_launch: device query failed\n"); grid = -1; return; }
        if (hipFuncSetAttribute((const void*)trunk_fwd, hipFuncAttributeMaxDynamicSharedMemorySize, LDS_BYTES) != hipSuccess) { fprintf(stderr, "kernel_launch: hipFuncSetAttribute failed\n"); grid = -1; return; }
        if (hipOccupancyMaxActiveBlocksPerMultiprocessor(&per_cu, (const void*)trunk_fwd, NWAVES * 64, LDS_BYTES) != hipSuccess || per_cu < 1) fprintf(stderr, "kernel_launch: occupancy query reports %d\n", per_cu);
        (void)hipGetLastError();
        grid = cus;
    }
    if (grid < 0) return;
    if (hipMemsetAsync((char*)d_ws + WS_CTL, 0, CTL_ZERO_BYTES, stream) != hipSuccess) { fprintf(stderr, "kernel_launch: memset failed\n"); return; }
    Args a{};
    for (int i = 0; i < 21; ++i) a.in[i] = (const float*)d_in[i];
    a.out = (float*)d_out; a.ws = (unsigned char*)d_ws;
#if N_LAUNCH_MODE == 0
    a.ph_lo = 0; a.ph_hi = NPH;
    hipLaunchKernelGGL(trunk_fwd, dim3(grid), dim3(NWAVES * 64), LDS_BYTES, stream, a);
#else
    for (int p = 0; p < NPH; ++p) { a.ph_lo = p; a.ph_hi = p + 1; hipLaunchKernelGGL(trunk_fwd, dim3(grid), dim3(NWAVES * 64), LDS_BYTES, stream, a); }
#endif
    const hipError_t le = hipPeekAtLastError();
    if (le != hipSuccess) fprintf(stderr, "kernel_launch: launch failed: %s\n", hipGetErrorName(le));
}
```

```cpp
#define PROBE 0
#include <hip/hip_runtime.h>
#include <cstdio>
#include <cstdint>
namespace pg8 {
#define PG8_LAS __attribute__((address_space(3)))
typedef unsigned short bf16_t;
typedef short bf16x8 __attribute__((ext_vector_type(8)));
typedef float f32x4 __attribute__((ext_vector_type(4)));
typedef unsigned u32x4 __attribute__((ext_vector_type(4)));
typedef int v4i_t __attribute__((ext_vector_type(4)));
typedef long v2l_t __attribute__((ext_vector_type(2)));
typedef int v8i_t __attribute__((ext_vector_type(8)));
constexpr int BM = 256, BK = 64, HALF = 128, HTB = HALF * BK * 2  , STAGE_BYTES = 8 * HTB, NXCD = 8, WGM = 8;

__host__ __device__ __forceinline__ int lds_byte(int r, int c) { const int st = (r >> 4) * 2 + (c >> 5), rr = r & 15, cc = c & 31, ob = rr * 64 + cc * 2; return st * 1024 + (ob ^ (((ob >> 9) & 1) << 5)); }
__host__ __device__ __forceinline__ void stage_rc(int b, int& R, int& C) { const int st = b / 1024, sb = b % 1024, swz = sb ^ (((sb >> 9) & 1) << 5); R = (st >> 1) * 16 + swz / 64; C = (st & 1) * 32 + (swz % 64) / 2; }
__host__ __device__ __forceinline__ int perm32(int rho) { const int n = rho >> 4, i = rho & 15; return 8 * (i >> 2) + 4 * n + (i & 3); }

struct Unit { int pm, pn; int ko = 0; };
struct Gemm { const bf16_t* A; const bf16_t* Bt; int M, N, K; int ld = 0; };

struct StaticOrder {
    int nM, nN, nwg, G, c;
    __host__ __device__ void init(int M, int N, int G_, int c_) { nM = M / BM; nN = N / BM; nwg = nM * nN; G = G_; c = c_; }
    __host__ __device__ __forceinline__ bool next(int i, Unit& u) const {
        const long L = (long)i * G + c; if (L >= nwg) return false;
        int wgid = (int)L; { const int q = nwg / NXCD, r = nwg % NXCD, xcd = wgid % NXCD, off = wgid / NXCD; wgid = (xcd < r ? xcd * (q + 1) : r * (q + 1) + (xcd - r) * q) + off; }
        const int nig = WGM * nN, gid = wgid / nig, fm = gid * WGM, gsz = (nM - fm) < WGM ? (nM - fm) : WGM;
        u.pm = fm + ((wgid % nig) % gsz); u.pn = (wgid % nig) / gsz; return true;
    }
    __device__ __forceinline__ void a_ready(const Unit&) const {}
    __device__ __forceinline__ void done(const Unit&) const {}
};

__device__ __forceinline__ unsigned cvt_pk_bf16(float lo, float hi) { unsigned r; asm volatile("v_cvt_pk_bf16_f32 %0, %1, %2" : "=v"(r) : "v"(lo), "v"(hi)); return r; }
typedef float f32x2 __attribute__((ext_vector_type(2)));
__device__ __forceinline__ float row_rs16(const float* ssp, int row) {
    const f32x4* sp = (const f32x4*)(ssp + (size_t)row * 16); const f32x4 s0 = sp[0], s1 = sp[1], s2 = sp[2], s3 = sp[3];
    const float s = (((s0[0] + s0[1]) + (s0[2] + s0[3])) + ((s1[0] + s1[1]) + (s1[2] + s1[3]))) + (((s2[0] + s2[1]) + (s2[2] + s2[3])) + ((s3[0] + s3[1]) + (s3[2] + s3[3])));
    return __builtin_amdgcn_rsqf(s * (1.0f / 1024.0f) + 1e-6f);
}
__device__ __forceinline__ void row_rs16x8(float (&r)[8], const float* ssp, int row0, int fr, int fq) {
    f32x4 c[8];
#pragma unroll
    for (int k = 0; k < 8; ++k) c[k] = *(const f32x4*)(ssp + (size_t)(row0 + (k >> 2) * HALF + (k & 3) * 16) * 16 + 4 * fq);
#pragma unroll
    for (int k = 0; k < 8; ++k) { float s = (c[k][0] + c[k][1]) + (c[k][2] + c[k][3]);
        s += __int_as_float(__builtin_amdgcn_ds_bpermute((((fq * 16 + fr) ^ 16) << 2), __float_as_int(s)));
        { const auto rr = __builtin_amdgcn_permlane32_swap(__float_as_uint(s), __float_as_uint(s), false, false); s = __uint_as_float(rr[0]) + __uint_as_float(rr[1]); }
        r[k] = __builtin_amdgcn_rsqf(s * (1.0f / 1024.0f) + 1e-6f); }
}
struct EpiRowScale {
    static constexpr bool PERM = true, AFTER_DRAIN = false;
    bf16_t* O; int ldc; const float* ssp; float cs;
    __device__ __forceinline__ void operator()(const f32x4 (&acc)[2][2][4][2], const Unit& u, int wr, int wc, int fr, int fq) const {
        const int row0 = u.pm * BM + wr * 64 + fr, col0 = u.pn * BM + wc * 32 + 8 * fq;
        float rr8[8];
        if (ssp) row_rs16x8(rr8, ssp, row0, fr, fq); else {
#pragma unroll
            for (int k = 0; k < 8; ++k) rr8[k] = 1.0f; }
#pragma unroll
        for (int ai = 0; ai < 2; ++ai)
#pragma unroll
            for (int m = 0; m < 4; ++m) { const int row = row0 + ai * HALF + m * 16; const float r = rr8[ai * 4 + m] * cs; bf16_t* rowp = O + (size_t)row * ldc + col0;
#pragma unroll
                for (int bj = 0; bj < 2; ++bj) { const f32x4 v0 = acc[ai][bj][m][0] * r, v1 = acc[ai][bj][m][1] * r;
                    u32x4 w; w.x = cvt_pk_bf16(v0[0], v0[1]); w.y = cvt_pk_bf16(v0[2], v0[3]); w.z = cvt_pk_bf16(v1[0], v1[1]); w.w = cvt_pk_bf16(v1[2], v1[3]);
                    *(u32x4*)(rowp + bj * HALF) = w; } }
    }
};
struct EpiInProj {
    static constexpr bool PERM = true, AFTER_DRAIN = false;
    bf16_t* O; const float* ssp; bf16_t* vt;
    __device__ __forceinline__ void operator()(const f32x4 (&acc)[2][2][4][2], const Unit& u, int wr, int wc, int fr, int fq) const {
        const int row0 = u.pm * BM + wr * 64 + fr;
        if (u.pn == 4 || u.pn == 5) {
            const int cv0 = (u.pn - 4) * BM + wc * 32 + 8 * fq; constexpr size_t CS = (size_t)32768 * 512;
#pragma unroll
            for (int ai = 0; ai < 2; ++ai)
#pragma unroll
                for (int m = 0; m < 4; ++m) { const int row = row0 + ai * HALF + m * 16; const float r = row_rs16(ssp, row); const int b = row >> 13, t = row & 8191;
                    const size_t o0 = (size_t)t, o1 = CS + (size_t)(t & 3) * 2048 + (t >> 2), o2 = 2 * CS + (size_t)(t & 15) * 512 + (t >> 4);
#pragma unroll
                    for (int bj = 0; bj < 2; ++bj)
#pragma unroll
                        for (int n = 0; n < 2; ++n) { const f32x4 v = acc[ai][bj][m][n] * r; const unsigned w01 = cvt_pk_bf16(v[0], v[1]), w23 = cvt_pk_bf16(v[2], v[3]);
                            bf16_t* p = vt + (size_t)(b * 512 + cv0 + bj * HALF + 4 * n) * 8192;
                            const bf16_t e0 = (bf16_t)(w01 & 0xffffu), e1 = (bf16_t)(w01 >> 16), e2 = (bf16_t)(w23 & 0xffffu), e3 = (bf16_t)(w23 >> 16);
                            p[o0] = e0; p[o1] = e0; p[o2] = e0; p[8192 + o0] = e1; p[8192 + o1] = e1; p[8192 + o2] = e1;
                            p[2 * 8192 + o0] = e2; p[2 * 8192 + o1] = e2; p[2 * 8192 + o2] = e2; p[3 * 8192 + o0] = e3; p[3 * 8192 + o1] = e3; p[3 * 8192 + o2] = e3; } }
        } else {
            const int col0 = u.pn * BM + wc * 32 + 8 * fq;
#pragma unroll
            for (int ai = 0; ai < 2; ++ai)
#pragma unroll
                for (int m = 0; m < 4; ++m) { const int row = row0 + ai * HALF + m * 16; const float r = row_rs16(ssp, row); bf16_t* rowp = O + (size_t)row * 2560 + col0;
#pragma unroll
                    for (int bj = 0; bj < 2; ++bj) { const f32x4 v0 = acc[ai][bj][m][0] * r, v1 = acc[ai][bj][m][1] * r;
                        u32x4 w; w.x = cvt_pk_bf16(v0[0], v0[1]); w.y = cvt_pk_bf16(v0[2], v0[3]); w.z = cvt_pk_bf16(v1[0], v1[1]); w.w = cvt_pk_bf16(v1[2], v1[3]);
                        *(u32x4*)(rowp + bj * HALF) = w; } }
        }
    }
};
struct EpiKV {
    static constexpr bool PERM = true, AFTER_DRAIN = false;
    bf16_t* kvx; bf16_t* vtx;
    __device__ __forceinline__ void operator()(const f32x4 (&acc)[2][2][4][2], const Unit& u, int wr, int wc, int fr, int fq) const {
        const int row0 = u.pm * BM + wr * 64 + fr, col0 = u.pn * BM + wc * 32 + 8 * fq;
        if ((u.pn & 3) >= 2) {
            const int lx = u.pn >> 2, dv0 = (col0 & 1023) - 512;
#pragma unroll
            for (int ai = 0; ai < 2; ++ai)
#pragma unroll
                for (int m = 0; m < 4; ++m) { const int row = row0 + ai * HALF + m * 16; const int b = row >> 8, key = row & 255;
#pragma unroll
                    for (int bj = 0; bj < 2; ++bj)
#pragma unroll
                        for (int n = 0; n < 2; ++n) { const f32x4 v = acc[ai][bj][m][n]; const unsigned w01 = cvt_pk_bf16(v[0], v[1]), w23 = cvt_pk_bf16(v[2], v[3]);
                            bf16_t* p = vtx + ((size_t)((lx * 4 + b) * 512 + dv0 + bj * HALF + 4 * n)) * 256 + key;
                            p[0] = (bf16_t)(w01 & 0xffffu); p[256] = (bf16_t)(w01 >> 16); p[512] = (bf16_t)(w23 & 0xffffu); p[768] = (bf16_t)(w23 >> 16); } }
        } else {
#pragma unroll
            for (int ai = 0; ai < 2; ++ai)
#pragma unroll
                for (int m = 0; m < 4; ++m) { const int row = row0 + ai * HALF + m * 16; bf16_t* rowp = kvx + (size_t)row * 4096 + col0;
#pragma unroll
                    for (int bj = 0; bj < 2; ++bj) { const f32x4 v0 = acc[ai][bj][m][0], v1 = acc[ai][bj][m][1];
                        u32x4 w; w.x = cvt_pk_bf16(v0[0], v0[1]); w.y = cvt_pk_bf16(v0[2], v0[3]); w.z = cvt_pk_bf16(v1[0], v1[1]); w.w = cvt_pk_bf16(v1[2], v1[3]);
                        *(u32x4*)(rowp + bj * HALF) = w; } }
        }
    }
};
__device__ __forceinline__ float silu_mul(float g, float u) { return g * u * __builtin_amdgcn_rcpf(1.0f + __expf(-g)); }
struct EpiSwiGLU {
    static constexpr bool PERM = true, AFTER_DRAIN = false;
    bf16_t* O; int ldc; const float* ssp; const float* rmul; int pn_mod;
    __device__ __forceinline__ void operator()(const f32x4 (&acc)[2][2][4][2], const Unit& u, int wr, int wc, int fr, int fq) const {
        const int pnl = pn_mod ? (u.pn % pn_mod) : u.pn;
        const int row0 = u.pm * BM + wr * 64 + fr, col0 = pnl * HALF + wc * 32 + 8 * fq;
        float rr8[8];
        if (ssp) row_rs16x8(rr8, ssp, row0, fr, fq); else {
#pragma unroll
            for (int k = 0; k < 8; ++k) rr8[k] = rmul[row0 + (k >> 2) * HALF + (k & 3) * 16]; }
#pragma unroll
        for (int ai = 0; ai < 2; ++ai)
#pragma unroll
            for (int m = 0; m < 4; ++m) { const int row = row0 + ai * HALF + m * 16; const float r = rr8[ai * 4 + m];
                const f32x4 g0 = acc[ai][0][m][0] * r, g1 = acc[ai][0][m][1] * r, u0 = acc[ai][1][m][0] * r, u1 = acc[ai][1][m][1] * r;
                u32x4 w; w.x = cvt_pk_bf16(silu_mul(g0[0], u0[0]), silu_mul(g0[1], u0[1])); w.y = cvt_pk_bf16(silu_mul(g0[2], u0[2]), silu_mul(g0[3], u0[3]));
                w.z = cvt_pk_bf16(silu_mul(g1[0], u1[0]), silu_mul(g1[1], u1[1])); w.w = cvt_pk_bf16(silu_mul(g1[2], u1[2]), silu_mul(g1[3], u1[3]));
                *(u32x4*)(O + (size_t)row * ldc + col0) = w; }
    }
};
__device__ __forceinline__ float sat8(float v) { return __builtin_amdgcn_fmed3f(v, -448.0f, 448.0f); }
__device__ __forceinline__ unsigned pk4_fp8_w(float a, float b, float c, float d) { int r = __builtin_amdgcn_cvt_pk_fp8_f32(a, b, 0, false); r = __builtin_amdgcn_cvt_pk_fp8_f32(c, d, r, true); return (unsigned)r; }
__device__ __forceinline__ unsigned pk4_fp8(float a, float b, float c, float d) { int r = __builtin_amdgcn_cvt_pk_fp8_f32(sat8(a), sat8(b), 0, false); r = __builtin_amdgcn_cvt_pk_fp8_f32(sat8(c), sat8(d), r, true); return (unsigned)r; }
struct EpiSwiGLU8 {
    static constexpr bool PERM = true, AFTER_DRAIN = false;
    unsigned char* O; int ldc; const float* rmul; int pn_mod; float cs, hs; const float* ssp;
    __device__ __forceinline__ void operator()(const f32x4 (&acc)[2][2][4][2], const Unit& u, int wr, int wc, int fr, int fq) const {
        const int pnl = pn_mod ? (u.pn % pn_mod) : u.pn;
        const int row0 = u.pm * BM + wr * 64 + fr, col0 = pnl * HALF + wc * 32 + 8 * fq;
        float rr8[8];
        if (ssp) row_rs16x8(rr8, ssp, row0, fr, fq); else {
#pragma unroll
            for (int k = 0; k < 8; ++k) rr8[k] = rmul[row0 + (k >> 2) * HALF + (k & 3) * 16]; }
#pragma unroll
        for (int ai = 0; ai < 2; ++ai)
#pragma unroll
            for (int m = 0; m < 4; ++m) { const int row = row0 + ai * HALF + m * 16; const float r = rr8[ai * 4 + m] * cs, r2 = r * -1.4426950408889634f, rrh = r * r * hs;
                unsigned w[2];
#pragma unroll
                for (int n = 0; n < 2; ++n) { const f32x4 ag = acc[ai][0][m][n], au = acc[ai][1][m][n]; const f32x4 t = ag * r2;
                    f32x4 d; d[0] = __builtin_amdgcn_exp2f(t[0]); d[1] = __builtin_amdgcn_exp2f(t[1]); d[2] = __builtin_amdgcn_exp2f(t[2]); d[3] = __builtin_amdgcn_exp2f(t[3]);
                    d = d + 1.0f;
                    f32x4 iv; iv[0] = __builtin_amdgcn_rcpf(d[0]); iv[1] = __builtin_amdgcn_rcpf(d[1]); iv[2] = __builtin_amdgcn_rcpf(d[2]); iv[3] = __builtin_amdgcn_rcpf(d[3]);
                    const f32x4 hv = ((ag * au) * rrh) * iv;
                    w[n] = pk4_fp8(hv[0], hv[1], hv[2], hv[3]); }
                typedef unsigned u32x2_t __attribute__((ext_vector_type(2)));
                *(u32x2_t*)(O + (size_t)row * ldc + col0) = (u32x2_t){w[0], w[1]}; }
    }
};
struct EpiResid {
    static constexpr bool PERM = true, AFTER_DRAIN = false;
    const float* base32; bf16_t* xb; float* ssp_out; unsigned char* xb8; float cs; int w8;
    __device__ __forceinline__ void operator()(const f32x4 (&acc)[2][2][4][2], const Unit& u, int wr, int wc, int fr, int fq) const {
        const int row0 = u.pm * BM + wr * 64 + fr, col0 = u.pn * BM + wc * 32 + 8 * fq;
        u32x4 xw[2][4][2];
        if (!base32) {
#pragma unroll
            for (int ai = 0; ai < 2; ++ai)
#pragma unroll
                for (int m = 0; m < 4; ++m)
#pragma unroll
                    for (int bj = 0; bj < 2; ++bj) xw[ai][m][bj] = *(const u32x4*)(xb + (size_t)(row0 + ai * HALF + m * 16) * 1024 + col0 + bj * HALF);
        }
#pragma unroll
        for (int ai = 0; ai < 2; ++ai)
#pragma unroll
            for (int m = 0; m < 4; ++m) { const int row = row0 + ai * HALF + m * 16; const size_t off = (size_t)row * 1024 + col0; float q = 0.f;
#pragma unroll
                for (int bj = 0; bj < 2; ++bj) { f32x4 b0, b1;
                    if (base32) { b0 = *(const f32x4*)(base32 + off + bj * HALF); b1 = *(const f32x4*)(base32 + off + bj * HALF + 4); }
                    else { const u32x4 w4 = xw[ai][m][bj];
                        b0 = (f32x4){__uint_as_float(w4.x << 16), __uint_as_float(w4.x & 0xffff0000u), __uint_as_float(w4.y << 16), __uint_as_float(w4.y & 0xffff0000u)};
                        b1 = (f32x4){__uint_as_float(w4.z << 16), __uint_as_float(w4.z & 0xffff0000u), __uint_as_float(w4.w << 16), __uint_as_float(w4.w & 0xffff0000u)}; }
                    const f32x4 v0 = b0 + acc[ai][bj][m][0] * cs, v1 = b1 + acc[ai][bj][m][1] * cs;
                    u32x4 w; w.x = cvt_pk_bf16(v0[0], v0[1]); w.y = cvt_pk_bf16(v0[2], v0[3]); w.z = cvt_pk_bf16(v1[0], v1[1]); w.w = cvt_pk_bf16(v1[2], v1[3]);
                    *(u32x4*)(xb + off + bj * HALF) = w;
                    if (w8) { typedef unsigned u32x2_t __attribute__((ext_vector_type(2))); *(u32x2_t*)(xb8 + off + bj * HALF) = (u32x2_t){pk4_fp8(v0[0], v0[1], v0[2], v0[3]), pk4_fp8(v1[0], v1[1], v1[2], v1[3])}; }
                    q += ((v0[0] * v0[0] + v0[1] * v0[1]) + (v0[2] * v0[2] + v0[3] * v0[3])) + ((v1[0] * v1[0] + v1[1] * v1[1]) + (v1[2] * v1[2] + v1[3] * v1[3])); }
                q += __int_as_float(__builtin_amdgcn_ds_bpermute((((fq * 16 + fr) ^ 16) << 2), __float_as_int(q)));
                { const auto rr = __builtin_amdgcn_permlane32_swap(__float_as_uint(q), __float_as_uint(q), false, false); q = __uint_as_float(rr[0]) + __uint_as_float(rr[1]); }
                if (fq == 0) ssp_out[(size_t)row * 16 + u.pn * 4 + wc] = q;
                if (base32 && (m & 1)) asm volatile("" ::: "memory"); }
    }
};
struct EpiMoeOut {
    static constexpr bool PERM = true, AFTER_DRAIN = false;
    bf16_t* Y; const float* gate; float cs = 1.0f;
    __device__ __forceinline__ void operator()(const f32x4 (&acc)[2][2][4][2], const Unit& u, int wr, int wc, int fr, int fq) const {
        const int row0 = u.pm * BM + wr * 64 + fr, col0 = (u.pn & 3) * BM + wc * 32 + 8 * fq;
#pragma unroll
        for (int ai = 0; ai < 2; ++ai)
#pragma unroll
            for (int m = 0; m < 4; ++m) { const int row = row0 + ai * HALF + m * 16; const float gt = gate[row] * cs; bf16_t* rowp = Y + (size_t)row * 1024 + col0;
#pragma unroll
                for (int bj = 0; bj < 2; ++bj) { const f32x4 v0 = acc[ai][bj][m][0] * gt, v1 = acc[ai][bj][m][1] * gt;
                    u32x4 w; w.x = cvt_pk_bf16(v0[0], v0[1]); w.y = cvt_pk_bf16(v0[2], v0[3]); w.z = cvt_pk_bf16(v1[0], v1[1]); w.w = cvt_pk_bf16(v1[2], v1[3]);
                    *(u32x4*)(rowp + bj * HALF) = w; } }
    }
};
struct EpiNull {
    static constexpr bool PERM = true, AFTER_DRAIN = false;
    float* sink;
    __device__ __forceinline__ void operator()(const f32x4 (&acc)[2][2][4][2], const Unit& u, int wr, int wc, int fr, int fq) const {
        float s = 0.f;
#pragma unroll
        for (int ai = 0; ai < 2; ++ai)
#pragma unroll
            for (int bj = 0; bj < 2; ++bj)
#pragma unroll
                for (int m = 0; m < 4; ++m)
#pragma unroll
                    for (int n = 0; n < 2; ++n) s += (acc[ai][bj][m][n][0] + acc[ai][bj][m][n][1]) + (acc[ai][bj][m][n][2] + acc[ai][bj][m][n][3]);
        if (s == 12345.6789f) sink[u.pm * 4 + wr] = s;
    }
};
struct EpiMoePart {
    static constexpr bool PERM = true, AFTER_DRAIN = false;
    bf16_t* P; const float* gate; float cs = 1.0f; int kshift = 10;
    __device__ __forceinline__ void operator()(const f32x4 (&acc)[2][2][4][2], const Unit& u, int wr, int wc, int fr, int fq) const {
        const int row0 = u.pm * BM + wr * 64 + fr, col0 = (u.pn & 3) * BM + wc * 32 + 8 * fq; bf16_t* base = P + (size_t)(u.ko >> kshift) * (2048 * 1024);
#pragma unroll
        for (int ai = 0; ai < 2; ++ai)
#pragma unroll
            for (int m = 0; m < 4; ++m) { const int row = row0 + ai * HALF + m * 16; const float gt = gate[row] * cs; bf16_t* rowp = base + (size_t)(row - 65536) * 1024 + col0;
#pragma unroll
                for (int bj = 0; bj < 2; ++bj) { const f32x4 v0 = acc[ai][bj][m][0] * gt, v1 = acc[ai][bj][m][1] * gt;
                    u32x4 w; w.x = cvt_pk_bf16(v0[0], v0[1]); w.y = cvt_pk_bf16(v0[2], v0[3]); w.z = cvt_pk_bf16(v1[0], v1[1]); w.w = cvt_pk_bf16(v1[2], v1[3]);
                    *(u32x4*)(rowp + bj * HALF) = w; } }
    }
};
struct MoeTailOrder {
    int npieces, G, c; int te[8]; int kstep = 1024;
    __device__ __forceinline__ bool next(int i, Unit& u) const {
        const int p = i * G + c; if (p >= npieces) return false;
        const int tt = p / 7, kp = p - tt * 7; const int pm = 256 + (tt >> 2);
        int e = 0;
#pragma unroll
        for (int k = 0; k < 7; ++k) e += (pm >= te[k]) ? 1 : 0;
        u.pm = pm; u.pn = e * 4 + (tt & 3); u.ko = kp * kstep; return true;
    }
    __device__ __forceinline__ void a_ready(const Unit&) const {}
    __device__ __forceinline__ void done(const Unit&) const {}
};
struct TeamOrder {
    int pm, pn0, npn;
    __device__ __forceinline__ bool next(int i, Unit& u) const { if (i >= npn) return false; u.pm = pm; u.pn = pn0 + i; return true; }
    __device__ __forceinline__ void a_ready(const Unit&) const {}
    __device__ __forceinline__ void done(const Unit&) const {}
};
struct MoeOrder {
    StaticOrder so; int nNl; int te[8];
    __device__ __forceinline__ bool next(int i, Unit& u) const {
        if (!so.next(i, u)) return false;
        int e = 0;
#pragma unroll
        for (int k = 0; k < 7; ++k) e += (u.pm >= te[k]) ? 1 : 0;
        u.pn += e * nNl; return true;
    }
    __device__ __forceinline__ void a_ready(const Unit&) const {}
    __device__ __forceinline__ void done(const Unit&) const {}
};

template <class Epi, class Sched, bool ALIGN_EPI = false, bool SP2 = false, bool F8 = false>
__device__ __forceinline__ void gemm_phase(PG8_LAS unsigned char* lds, const Gemm g, const Sched& S, const Epi& E, const int tid) {
    const int wid = __builtin_amdgcn_readfirstlane(tid >> 6), lane = tid & 63, wr = wid >> 2, wc = wid & 3, fr = lane & 15, fq = lane >> 4;
    const int K = g.K, nt = K / BK, LD = g.ld ? g.ld : K;
    unsigned voffA[2], voffB[2];
#pragma unroll
    for (int i = 0; i < 2; ++i) { int R, C; stage_rc(tid * 16 + i * 8192, R, C); const int Rb = Epi::PERM ? ((R & ~31) + perm32(R & 31)) : R;
        voffA[i] = (unsigned)(R * LD + C) * 2u; voffB[i] = (unsigned)(Rb * LD + C) * 2u; }
    const size_t kstep = (size_t)(BK * 2);
    const size_t hstep = (size_t)HALF * LD * 2;
    const size_t tstep = 2 * hstep;
    const unsigned ldsw = (unsigned)wid * 1024u;
    const int aoff = lds_byte(wr * 64 + fr, fq * 8), boff = lds_byte(wc * 32 + fr, fq * 8);
#define PG8_SA(b, h) (((b) * 2 + (h)) * HTB)
#define PG8_SB(b, h) ((4 + (b) * 2 + (h)) * HTB)
#define PG8_STAGE(bufoff, gbase, voff) do { _Pragma("unroll") for (int _i = 0; _i < 2; ++_i) \
        __builtin_amdgcn_global_load_lds((const unsigned*)((const char*)(gbase) + (voff)[_i]), (PG8_LAS unsigned*)(lds + (bufoff) + ldsw + _i * 8192), 16, 0, 0); } while (0)
#define PG8_CAT8(x, y) __builtin_shufflevector(__builtin_bit_cast(v4i_t, x), __builtin_bit_cast(v4i_t, y), 0, 1, 2, 3, 4, 5, 6, 7)
#define PG8_LDA(dst, b, h) do { _Pragma("unroll") for (int m = 0; m < 4; ++m) { if constexpr (F8) dst##8[m] = PG8_CAT8(*(const PG8_LAS bf16x8*)(lds + PG8_SA(b, h) + aoff + m * 2048), *(const PG8_LAS bf16x8*)(lds + PG8_SA(b, h) + aoff + m * 2048 + 1024)); \
        else { _Pragma("unroll") for (int k = 0; k < 2; ++k) dst[m][k] = *(const PG8_LAS bf16x8*)(lds + PG8_SA(b, h) + aoff + m * 2048 + k * 1024); } } } while (0)
#define PG8_LDB(dst, b, h) do { _Pragma("unroll") for (int n = 0; n < 2; ++n) { if constexpr (F8) dst##8[n] = PG8_CAT8(*(const PG8_LAS bf16x8*)(lds + PG8_SB(b, h) + boff + n * 2048), *(const PG8_LAS bf16x8*)(lds + PG8_SB(b, h) + boff + n * 2048 + 1024)); \
        else { _Pragma("unroll") for (int k = 0; k < 2; ++k) dst[n][k] = *(const PG8_LAS bf16x8*)(lds + PG8_SB(b, h) + boff + n * 2048 + k * 1024); } } } while (0)
#define PG8_MMA(ai, bj, At, Bt) do { __builtin_amdgcn_s_setprio(1); _Pragma("unroll") for (int m = 0; m < 4; ++m) _Pragma("unroll") for (int n = 0; n < 2; ++n) { \
        if constexpr (F8) asm volatile("v_mfma_scale_f32_16x16x128_f8f6f4 %0, %1, %2, %0, %3, %3 op_sel_hi:[0,0,0]" : "+v"(acc[ai][bj][m][n]) : "v"(Bt##8[n]), "v"(At##8[m]), "v"(f8scale)); \
        else { _Pragma("unroll") for (int k = 0; k < 2; ++k) acc[ai][bj][m][n] = __builtin_amdgcn_mfma_f32_16x16x32_bf16(Bt[n][k], At[m][k], acc[ai][bj][m][n], 0, 0, 0); } } __builtin_amdgcn_s_setprio(0); } while (0)
#define PG8_WAIT_V(n) asm volatile("s_waitcnt vmcnt(" #n ")" ::: "memory")
#define PG8_WAIT_L(n) asm volatile("s_waitcnt lgkmcnt(" #n ")" ::: "memory")
#define PG8_BAR __builtin_amdgcn_s_barrier()
#define PG8_SCHED __builtin_amdgcn_sched_barrier(0)
    Unit cur, nxt; int ui = 0;
    if (!S.next(0, cur)) return;
    f32x4 acc[2][2][4][2];
#pragma unroll
    for (int a = 0; a < 2; ++a)
#pragma unroll
        for (int b = 0; b < 2; ++b)
#pragma unroll
            for (int m = 0; m < 4; ++m)
#pragma unroll
                for (int n = 0; n < 2; ++n) acc[a][b][m][n] = (f32x4){0.f, 0.f, 0.f, 0.f};
    const int f8scale = 0x7f7f7f7f;
    bf16x8 At[4][2], B0[2][2], B1[2][2]; v8i_t At8[4], B08[2], B18[2];
    const char* cA = (const char*)g.A + (size_t)cur.pm * tstep + cur.ko; const char* cB = (const char*)g.Bt + (size_t)cur.pn * tstep + cur.ko;
    S.a_ready(cur);
    if constexpr (SP2) {
        PG8_STAGE(PG8_SB(0, 0), cB, voffB); PG8_STAGE(PG8_SB(0, 1), cB + hstep, voffB); PG8_STAGE(PG8_SA(0, 0), cA, voffA); PG8_STAGE(PG8_SA(0, 1), cA + hstep, voffA);
        if (wr == 1) PG8_BAR;
        PG8_WAIT_V(2); PG8_BAR;
        PG8_STAGE(PG8_SB(1, 0), cB + kstep, voffB); PG8_STAGE(PG8_SA(1, 0), cA + kstep, voffA); PG8_STAGE(PG8_SB(1, 1), cB + hstep + kstep, voffB);
        PG8_WAIT_V(6); PG8_BAR;
    } else {
        PG8_STAGE(PG8_SB(0, 0), cB, voffB); PG8_STAGE(PG8_SA(0, 0), cA, voffA); PG8_STAGE(PG8_SB(0, 1), cB + hstep, voffB); PG8_STAGE(PG8_SA(0, 1), cA + hstep, voffA);
        if (wr == 1) PG8_BAR;
        PG8_WAIT_V(4); PG8_BAR;
        PG8_STAGE(PG8_SB(1, 0), cB + kstep, voffB); PG8_STAGE(PG8_SA(1, 0), cA + kstep, voffA); PG8_STAGE(PG8_SB(1, 1), cB + hstep + kstep, voffB);
        PG8_WAIT_V(6); PG8_BAR;
    }
    for (;;) {
        const bool has_next = S.next(ui + 1, nxt);
        const char* nA = has_next ? (const char*)g.A + (size_t)nxt.pm * tstep + nxt.ko : cA; const char* nB = has_next ? (const char*)g.Bt + (size_t)nxt.pn * tstep + nxt.ko : cB;
        for (int t = 0; t < nt; t += 2) {
            const bool last = (t == nt - 2);
            const char* a1 = cA + (size_t)(t + 1) * kstep;
            const char* a2 = last ? nA : cA + (size_t)(t + 2) * kstep; const char* b2 = last ? nB : cB + (size_t)(t + 2) * kstep;
            const char* a3 = a2 + kstep; const char* b3 = b2 + kstep;
            if (last && has_next) S.a_ready(nxt);
            if constexpr (SP2) {
            PG8_LDB(B0, 0, 0); PG8_LDB(B1, 0, 1); PG8_SCHED; PG8_LDA(At, 0, 0); PG8_STAGE(PG8_SA(1, 1), a1 + hstep, voffA);
            PG8_WAIT_V(8); PG8_WAIT_L(0); PG8_BAR; PG8_MMA(0, 0, At, B0); PG8_MMA(0, 1, At, B1); PG8_BAR; PG8_SCHED;
            PG8_LDA(At, 0, 1); PG8_STAGE(PG8_SB(0, 0), b2, voffB); PG8_STAGE(PG8_SB(0, 1), b2 + hstep, voffB); PG8_STAGE(PG8_SA(0, 0), a2, voffA);
            PG8_WAIT_V(8); PG8_WAIT_L(0); PG8_BAR; PG8_MMA(1, 0, At, B0); PG8_MMA(1, 1, At, B1); PG8_BAR; PG8_SCHED;
            PG8_LDB(B0, 1, 0); PG8_LDB(B1, 1, 1); PG8_SCHED; PG8_LDA(At, 1, 0); PG8_STAGE(PG8_SA(0, 1), a2 + hstep, voffA);
            PG8_WAIT_V(8); PG8_WAIT_L(0); PG8_BAR; PG8_MMA(0, 0, At, B0); PG8_MMA(0, 1, At, B1); PG8_BAR; PG8_SCHED;
            PG8_LDA(At, 1, 1); PG8_STAGE(PG8_SB(1, 0), b3, voffB); PG8_STAGE(PG8_SB(1, 1), b3 + hstep, voffB); PG8_STAGE(PG8_SA(1, 0), a3, voffA);
            PG8_WAIT_V(8); PG8_WAIT_L(0); PG8_BAR; PG8_MMA(1, 0, At, B0); PG8_MMA(1, 1, At, B1); PG8_BAR; PG8_SCHED;
            } else {
            PG8_LDB(B0, 0, 0); PG8_SCHED; PG8_LDA(At, 0, 0); PG8_STAGE(PG8_SA(1, 1), a1 + hstep, voffA);
            PG8_WAIT_L(8); PG8_BAR; PG8_WAIT_L(0); PG8_MMA(0, 0, At, B0); PG8_BAR; PG8_SCHED;
            PG8_LDB(B1, 0, 1); PG8_STAGE(PG8_SB(0, 0), b2, voffB);
            PG8_BAR; PG8_WAIT_L(0); PG8_MMA(0, 1, At, B1); PG8_BAR;
            PG8_LDA(At, 0, 1); PG8_STAGE(PG8_SA(0, 0), a2, voffA);
            PG8_BAR; PG8_WAIT_L(0); PG8_MMA(1, 0, At, B0); PG8_BAR; PG8_SCHED;
            PG8_STAGE(PG8_SB(0, 1), b2 + hstep, voffB);
            PG8_WAIT_V(6); PG8_BAR; PG8_MMA(1, 1, At, B1); PG8_BAR;
            PG8_LDB(B0, 1, 0); PG8_SCHED; PG8_LDA(At, 1, 0); PG8_STAGE(PG8_SA(0, 1), a2 + hstep, voffA);
            PG8_WAIT_L(8); PG8_BAR; PG8_WAIT_L(0); PG8_MMA(0, 0, At, B0); PG8_BAR; PG8_SCHED;
            PG8_LDB(B1, 1, 1); PG8_STAGE(PG8_SB(1, 0), b3, voffB);
            PG8_BAR; PG8_WAIT_L(0); PG8_MMA(0, 1, At, B1); PG8_BAR;
            PG8_LDA(At, 1, 1); PG8_STAGE(PG8_SA(1, 0), a3, voffA);
            PG8_BAR; PG8_WAIT_L(0); PG8_MMA(1, 0, At, B0); PG8_BAR; PG8_SCHED;
            PG8_STAGE(PG8_SB(1, 1), b3 + hstep, voffB);
            PG8_WAIT_V(6); PG8_BAR; PG8_MMA(1, 1, At, B1); PG8_BAR;
            }
        }
        if constexpr (ALIGN_EPI) { if (wr == 0) PG8_BAR; }
        if constexpr (F8) asm volatile("s_nop 15\n\ts_nop 15" ::: "memory");
        if constexpr (!Epi::AFTER_DRAIN) { int fr_ = fr, fq_ = fq; asm volatile("" : "+v"(fr_), "+v"(fq_)); E(acc, cur, wr, wc, fr_, fq_); S.done(cur); }
        if (!has_next) break;
#pragma unroll
        for (int a = 0; a < 2; ++a)
#pragma unroll
            for (int b = 0; b < 2; ++b)
#pragma unroll
                for (int m = 0; m < 4; ++m)
#pragma unroll
                    for (int n = 0; n < 2; ++n) acc[a][b][m][n] = (f32x4){0.f, 0.f, 0.f, 0.f};
        cur = nxt; cA = nA; cB = nB; ++ui;
        if constexpr (ALIGN_EPI) { if (wr == 1) PG8_BAR; }
    }
    PG8_WAIT_V(0);
    if constexpr (!ALIGN_EPI) { if (wr == 0) PG8_BAR; }
    PG8_BAR;
    if constexpr (Epi::AFTER_DRAIN) { E.fused(acc, cur, wr, wc, fr, fq, lds, wid, lane); S.done(cur); }
#undef PG8_SA
#undef PG8_SB
#undef PG8_STAGE
#undef PG8_LDA
#undef PG8_LDB
#undef PG8_MMA
#undef PG8_CAT8
#undef PG8_WAIT_V
#undef PG8_WAIT_L
#undef PG8_BAR
#undef PG8_SCHED
}
}
#define GAS __attribute__((address_space(1)))
#define LAS __attribute__((address_space(3)))
typedef unsigned short bf16;
typedef unsigned v4u __attribute__((ext_vector_type(4)));
typedef float f32x4 __attribute__((ext_vector_type(4)));
typedef short bf16x8 __attribute__((ext_vector_type(8)));
typedef GAS unsigned gu32;
typedef GAS unsigned long long gu64;
#define RLX_AGENT __ATOMIC_RELAXED, __HIP_MEMORY_SCOPE_AGENT
#define LDS_WAIT() asm volatile("s_waitcnt lgkmcnt(0)" ::: "memory")
#define VM_WAIT() asm volatile("s_waitcnt vmcnt(0)" ::: "memory")
__device__ __forceinline__ unsigned long long rt() { return __builtin_amdgcn_s_memrealtime(); }
__device__ __forceinline__ unsigned f2bf(float f) { unsigned u = __builtin_bit_cast(unsigned, f); return (u + 0x7fffu + ((u >> 16) & 1u)) >> 16; }
__device__ __forceinline__ unsigned pk2(float lo, float hi) { return f2bf(lo) | (f2bf(hi) << 16); }
#define XB_TMO      128
#define XB_XCNT(j)  (256  + 64 * (j))
#define XB_XSUB(j)  (1280 + 64 * (j))
#define XB_XGEN(j)  (2304 + 64 * (j))
#define XB_TOP      3328
#define XB_TOPGEN   3392
#define XCD_BAR_WORDS 3456
#define XB_SPIN_CAP (1u << 18)

__device__ __forceinline__ unsigned xb_ld(unsigned* p)              { return __hip_atomic_load(p, __ATOMIC_RELAXED, __HIP_MEMORY_SCOPE_AGENT); }
__device__ __forceinline__ unsigned xb_add(unsigned* p, unsigned v) { return __hip_atomic_fetch_add(p, v, __ATOMIC_RELAXED, __HIP_MEMORY_SCOPE_AGENT); }
__device__ __forceinline__ unsigned xb_xcc_id() { return (unsigned)__builtin_amdgcn_s_getreg((3 << 11) | 20) & 0xFu; }
#define XB_SPIN(cond, bar) do { unsigned _sp = 0; while (cond) { __builtin_amdgcn_s_sleep(1); \
    if ((++_sp & 255u) == 0u) { if (xb_ld(&(bar)[XB_TMO])) break; if (_sp > XB_SPIN_CAP) { atomicAdd(&(bar)[XB_TMO], 1u); break; } } } } while (0)

struct XcdBarrier {
    unsigned* bar; unsigned x;
    volatile LAS unsigned* st;
};

__device__ __forceinline__ XcdBarrier xcd_barrier_post(unsigned* bar, volatile LAS unsigned* st) {
    XcdBarrier b; b.bar = bar; b.x = xb_xcc_id(); b.st = st;
    if (threadIdx.x == 0) (void)xb_add(&bar[XB_XCNT(b.x)], 1u);
    return b;
}
__device__ __forceinline__ void xcd_barrier_complete(unsigned* bar, unsigned x, unsigned& nloc, unsigned& nx) {
    const unsigned G = gridDim.x * gridDim.y * gridDim.z;
    unsigned sum, cnt, mine, sp = 0u;
    for (;;) {
        sum = 0u; cnt = 0u; mine = 0u;
#pragma unroll
        for (unsigned j = 0; j < 16; ++j) { const unsigned c = xb_ld(&bar[XB_XCNT(j)]); sum += c; cnt += (c > 0u) ? 1u : 0u; mine = (j == x) ? c : mine; }
        if (sum == G) break;
        __builtin_amdgcn_s_sleep(1);
        if ((++sp & 255u) == 0u) { if (xb_ld(&bar[XB_TMO])) break; if (sp > XB_SPIN_CAP) { atomicAdd(&bar[XB_TMO], 1u); break; } }
    }
    nloc = mine > 0u ? mine : 1u; nx = cnt > 0u ? cnt : 1u;
}

__device__ __forceinline__ void xcd_barrier(const XcdBarrier& b) {
    asm volatile("s_waitcnt vmcnt(0)" ::: "memory");
    __syncthreads();
    if (threadIdx.x == 0) {
        unsigned* bar = b.bar;
        __builtin_amdgcn_s_waitcnt(0);
        unsigned nloc = b.st[0], nx = b.st[1];
        if (nloc == 0u) { xcd_barrier_complete(bar, b.x, nloc, nx); b.st[0] = nloc; b.st[1] = nx; }
        const unsigned old = xb_add(&bar[XB_XSUB(b.x)], 1u);
        const unsigned gen = old / nloc;
        if (old + 1u == (gen + 1u) * nloc) {
            __builtin_amdgcn_fence(__ATOMIC_RELEASE, "agent");
            asm volatile("s_waitcnt vmcnt(0)" ::: "memory");
            const unsigned og = xb_add(&bar[XB_TOP], 1u);
            const unsigned tg = og / nx;
            if (og + 1u == (tg + 1u) * nx) xb_add(&bar[XB_TOPGEN], 1u);
            else XB_SPIN(xb_ld(&bar[XB_TOPGEN]) == tg, bar);
            __builtin_amdgcn_fence(__ATOMIC_ACQUIRE, "agent");
            xb_add(&bar[XB_XGEN(b.x)], 1u);
            asm volatile("s_waitcnt vmcnt(0)" ::: "memory");
        } else {
            XB_SPIN(xb_ld(&bar[XB_XGEN(b.x)]) == gen, bar);
            __builtin_amdgcn_fence(__ATOMIC_ACQUIRE, "agent");
            asm volatile("s_waitcnt vmcnt(0)" ::: "memory");
        }
    }
    __syncthreads();
}
constexpr int NWAVES = 8;
constexpr int BATCH = 4, SEQ = 8192, D = 1024, T = BATCH * SEQ, DEPTH = 4, MEML = 256, MROWS = BATCH * MEML;
constexpr int NPROJ = 2560, FFD = 2816, FFE = 3584, NEXP = 8, XW = 512;
constexpr int MP = 2 * T + NEXP * 256;
constexpr float F8_S1 = 16.0f, F8_S2 = 32.0f, F8_SH = 4.0f;
constexpr int NKEYS = 321;
constexpr int NPH = 1 + 8 + 11 + 8 + 11;
constexpr int PC_Q = 0, PC_K = 512, PC_V = 1024, PC_POOL = 1536, PC_BG = 1792, PC_CG = 2048, PC_HC = 2304;
constexpr size_t MiB = 1u << 20;
constexpr size_t WS_CTL = 0, CTL_ZERO_BYTES = 64 * 1024;
constexpr size_t WS_PWT = 256 * 1024;
constexpr size_t WS_CNT = 1 * MiB, WS_META = 1 * MiB + 64 * 1024;
constexpr size_t WS_TOKE = 1 * MiB + 512 * 1024, WS_TOKG = 2 * MiB, WS_TOKPOS = 2 * MiB + 512 * 1024, WS_ROWGATE = 3 * MiB, WS_ROWRS = 3 * MiB + 512 * 1024;
constexpr size_t WS_SSP = 4 * MiB;
constexpr size_t WS_KVX = 30 * MiB, WS_MEMN = 38 * MiB;
constexpr size_t WS_WIN = 40 * MiB, WS_WOUT = 60 * MiB, WS_WQ = 68 * MiB, WS_WKV = 72 * MiB, WS_WO = 80 * MiB, WS_W13D = 84 * MiB, WS_W2D = 106 * MiB, WS_W13M = 117 * MiB, WS_W2M = 341 * MiB;
constexpr size_t WS_XB = 453 * MiB, WS_QX = 517 * MiB, WS_OX = 549 * MiB, WS_AG = 581 * MiB, WS_YM = 713 * MiB, WS_RA = 977 * MiB, WS_VTX = 1439 * MiB, WS_END = 1443 * MiB;
constexpr size_t WS_PROJ = WS_RA, WS_Y = WS_RA + 160 * MiB, WS_H = WS_RA, WS_VT = WS_RA + 224 * MiB, WS_OPART = WS_RA + 320 * MiB, WS_LSE = WS_RA + 416 * MiB;
constexpr size_t VT_STRIDE = (size_t)T * 512, OP_STRIDE = (size_t)T * 512;
static_assert(WS_AG + (size_t)MP * D * 2 <= WS_YM && WS_YM + (size_t)MP * D * 4 <= WS_RA && WS_RA + (size_t)MP * FFE * 2 <= WS_VTX, "ws map");
constexpr int CW_BAR = 4096, CW_TEAM = 8192;
constexpr size_t WS_XCCTAB = 128 * 1024;
constexpr int RING_BYTES = 131072, LDSCTL_OFF = 159744, MISC_OFF = LDSCTL_OFF + 320, LDS_BYTES = 163840;

__device__ __forceinline__ float shx(float v, int mask, int lane) { return __int_as_float(__builtin_amdgcn_ds_bpermute((lane ^ mask) << 2, __float_as_int(v))); }
__device__ __forceinline__ float xsum32(float v) { const auto rr = __builtin_amdgcn_permlane32_swap(__float_as_uint(v), __float_as_uint(v), false, false); return __uint_as_float(rr[0]) + __uint_as_float(rr[1]); }
__device__ __forceinline__ float xmax32(float v) { const auto rr = __builtin_amdgcn_permlane32_swap(__float_as_uint(v), __float_as_uint(v), false, false); return fmaxf(__uint_as_float(rr[0]), __uint_as_float(rr[1])); }
__device__ __forceinline__ float wave_sum(float v, int lane) {
#pragma unroll
    for (int o = 1; o < 32; o <<= 1) v += shx(v, o, lane);
    return xsum32(v);
}
__device__ __forceinline__ float bflo(unsigned u) { return __uint_as_float(u << 16); }
__device__ __forceinline__ float bfhi(unsigned u) { return __uint_as_float(u & 0xffff0000u); }
__device__ __forceinline__ float bf1(bf16 h) { return __uint_as_float(((unsigned)h) << 16); }
__device__ __forceinline__ float dot8(v4u a, v4u b) {
    return (bflo(a.x) * bflo(b.x) + bfhi(a.x) * bfhi(b.x)) + (bflo(a.y) * bflo(b.y) + bfhi(a.y) * bfhi(b.y)) + (bflo(a.z) * bflo(b.z) + bfhi(a.z) * bfhi(b.z)) + (bflo(a.w) * bflo(b.w) + bfhi(a.w) * bfhi(b.w));
}
__device__ __forceinline__ int key_dist(int i) { return i < 129 ? i : (i < 225 ? 132 + 4 * (i - 129) : 528 + 16 * (i - 225)); }
__device__ __forceinline__ int key_mult(int d) { return d <= 128 ? 1 + ((d & 3) == 0 ? 1 : 0) + ((d & 15) == 0 ? 1 : 0) : (d <= 512 ? 1 + ((d & 15) == 0 ? 1 : 0) : 1); }
__device__ __forceinline__ int t5_bucket(int d) {
    if (d < 16) return d;
    int b = 16 + (int)(logf((float)d / 16.0f) / logf(8.0f) * 16.0f);
    return b < 31 ? b : 31;
}

struct Args { const float* in[21]; float* out; unsigned char* ws; int ph_lo, ph_hi; };

__device__ __forceinline__ void conv_item(const float* W, int K, int N, bf16* WT, const float* gain, int swF, LAS float* scr, int item, int lane) {
    const int nblk = N / 64, kb = item / nblk, nb = item % nblk, k0 = 64 * kb, n0 = 64 * nb;
    float wv[64];
#pragma unroll
    for (int i = 0; i < 64; ++i) wv[i] = W[(size_t)(k0 + i) * N + n0 + lane];
    if (gain) {
#pragma unroll
        for (int i = 0; i < 64; ++i) wv[i] *= gain[k0 + i]; }
#pragma unroll
    for (int i = 0; i < 64; ++i) scr[i * 65 + lane] = wv[i];
    LDS_WAIT(); asm volatile("" ::: "memory");
    int orow0 = n0;
    if (swF) { const int isup = n0 >= swF ? 1 : 0; const int j = n0 - isup * swF; orow0 = (j >> 7) * 256 + isup * 128 + (j & 127); }
    const int c = lane & 7;
#pragma unroll
    for (int j = 0; j < 8; ++j) { const int n = (lane >> 3) + 8 * j; const LAS float* s = scr + (8 * c) * 65 + n;
        v4u o; o.x = pk2(s[0 * 65], s[1 * 65]); o.y = pk2(s[2 * 65], s[3 * 65]); o.z = pk2(s[4 * 65], s[5 * 65]); o.w = pk2(s[6 * 65], s[7 * 65]);
        *(GAS v4u*)(WT + (size_t)(orow0 + n) * K + k0 + 8 * c) = o; }
    LDS_WAIT(); asm volatile("" ::: "memory");
}

typedef unsigned u32x2 __attribute__((ext_vector_type(2)));
__device__ __forceinline__ void conv_item8(const float* W, int K, int N, unsigned char* WT, const float* gain, int swF, float scale, LAS float* scr, int item, int lane) {
    const int nblk = N / 64, kb = item / nblk, nb = item % nblk, k0 = 64 * kb, n0 = 64 * nb;
    float wv[64];
#pragma unroll
    for (int i = 0; i < 64; ++i) wv[i] = W[(size_t)(k0 + i) * N + n0 + lane];
#pragma unroll
    for (int i = 0; i < 64; ++i) wv[i] *= gain ? gain[k0 + i] * scale : scale;
#pragma unroll
    for (int i = 0; i < 64; ++i) scr[i * 65 + lane] = wv[i];
    LDS_WAIT(); asm volatile("" ::: "memory");
    int orow0 = n0;
    if (swF) { const int isup = n0 >= swF ? 1 : 0; const int j = n0 - isup * swF; orow0 = (j >> 7) * 256 + isup * 128 + (j & 127); }
    const int c = lane & 7;
#pragma unroll
    for (int j = 0; j < 8; ++j) { const int n = (lane >> 3) + 8 * j; const LAS float* s = scr + (8 * c) * 65 + n;
        u32x2 o; o.x = pg8::pk4_fp8_w(s[0 * 65], s[1 * 65], s[2 * 65], s[3 * 65]); o.y = pg8::pk4_fp8_w(s[4 * 65], s[5 * 65], s[6 * 65], s[7 * 65]);
        *(GAS u32x2*)(WT + (size_t)(orow0 + n) * K + k0 + 8 * c) = o; }
    LDS_WAIT(); asm volatile("" ::: "memory");
}

typedef float f32x16 __attribute__((ext_vector_type(16)));
typedef float f32x2_t __attribute__((ext_vector_type(2))); typedef __bf16 bf16x2_t __attribute__((ext_vector_type(2)));
__device__ __forceinline__ unsigned cvtpk(float lo, float hi) { f32x2_t v = {lo, hi}; bf16x2_t b = __builtin_convertvector(v, bf16x2_t); return __builtin_bit_cast(unsigned, b); }
__device__ __forceinline__ bf16x8 mk8(unsigned a, unsigned b, unsigned c, unsigned d) { v4u t = {a, b, c, d}; return __builtin_bit_cast(bf16x8, t); }
__device__ __forceinline__ bf16x8 mk8u2(u32x2 lo, u32x2 hi) { v4u t = {lo.x, lo.y, hi.x, hi.y}; return __builtin_bit_cast(bf16x8, t); }
#define NEGINF (-__builtin_inff())
constexpr int BT_LD = 200, BT_OFF = 32;
__device__ __forceinline__ void dil_load_k(bf16x8 (&kf)[4], const bf16* pj, int sh, int b, int h, int r, int k0, int q, int hh) {
    const int sg = (q & ~12) | ((q & 4) << 1) | ((q & 8) >> 1);
    const int tk = b * SEQ + r + ((k0 + sg) << sh);
    const bf16* kp = pj + (size_t)tk * NPROJ + PC_K + h * 64 + 32 * hh;
#pragma unroll
    for (int ks = 0; ks < 4; ++ks) kf[ks] = *(const GAS bf16x8*)(kp + 8 * ks);
}
__device__ __forceinline__ void dil_load_v(bf16x8 (&vf)[2][2], const bf16* vrow, int sh, int k0) {
#pragma unroll
    for (int db = 0; db < 2; ++db)
#pragma unroll
        for (int s2 = 0; s2 < 2; ++s2) { const bf16* vp = vrow + (size_t)db * 32 * SEQ + (sh == 4 ? ((k0 >> 4) + s2) * 256 : k0 + 16 * s2); vf[db][s2] = *(const GAS bf16x8*)vp; }
}
__device__ __forceinline__ void dil_blk(const bf16x8 (&kf)[4], const bf16x8 (&vf)[2][2], const bf16x8 (&qf)[4], f32x16& O0, f32x16& O1, float& m, float& l, const LAS float* btl) {
    f32x16 st;
#pragma unroll
    for (int i = 0; i < 16; ++i) st[i] = 0.f;
#pragma unroll
    for (int ks = 0; ks < 4; ++ks) st = __builtin_amdgcn_mfma_f32_32x32x16_bf16(kf[ks], qf[ks], st, 0, 0, 0);
    float mx = NEGINF;
#pragma unroll
    for (int i = 0; i < 16; ++i) { st[i] = st[i] * 0.18033688011112042f + btl[23 - (16 * (i >> 3) + 4 * ((i >> 2) & 1) + (i & 3))]; mx = fmaxf(mx, st[i]); }
    { const auto rr = __builtin_amdgcn_permlane32_swap(__float_as_uint(mx), __float_as_uint(mx), false, false); mx = fmaxf(__uint_as_float(rr[0]), __uint_as_float(rr[1])); }
    const float mn = fmaxf(m, mx), ms = mn == NEGINF ? 0.f : mn, alpha = __builtin_amdgcn_exp2f(m - ms);
    float ls = 0.f;
#pragma unroll
    for (int i = 0; i < 16; ++i) { st[i] = __builtin_amdgcn_exp2f(st[i] - ms); ls += st[i]; }
    l = l * alpha + ls; m = mn;
#pragma unroll
    for (int i = 0; i < 16; ++i) { O0[i] *= alpha; O1[i] *= alpha; }
    const bf16x8 p0 = mk8(cvtpk(st[0], st[1]), cvtpk(st[2], st[3]), cvtpk(st[4], st[5]), cvtpk(st[6], st[7]));
    const bf16x8 p1 = mk8(cvtpk(st[8], st[9]), cvtpk(st[10], st[11]), cvtpk(st[12], st[13]), cvtpk(st[14], st[15]));
    O0 = __builtin_amdgcn_mfma_f32_32x32x16_bf16(vf[0][0], p0, O0, 0, 0, 0); O0 = __builtin_amdgcn_mfma_f32_32x32x16_bf16(vf[0][1], p1, O0, 0, 0, 0);
    O1 = __builtin_amdgcn_mfma_f32_32x32x16_bf16(vf[1][0], p0, O1, 0, 0, 0); O1 = __builtin_amdgcn_mfma_f32_32x32x16_bf16(vf[1][1], p1, O1, 0, 0, 0);
}
__device__ __forceinline__ void dil_store(const f32x16& O0, const f32x16& O1, float m, float l, bf16* opart, float* lsep, int tq, int h, int hh) {
    l = xsum32(l);
    const float inv = l > 0.f ? 1.0f / l : 0.f;
    bf16* op = opart + (size_t)tq * 512 + h * 64 + 4 * hh;
#pragma unroll
    for (int g4 = 0; g4 < 4; ++g4) {
        u32x2 w0, w1; w0.x = cvtpk(O0[4 * g4] * inv, O0[4 * g4 + 1] * inv); w0.y = cvtpk(O0[4 * g4 + 2] * inv, O0[4 * g4 + 3] * inv);
        w1.x = cvtpk(O1[4 * g4] * inv, O1[4 * g4 + 1] * inv); w1.y = cvtpk(O1[4 * g4 + 2] * inv, O1[4 * g4 + 3] * inv);
        *(GAS u32x2*)(op + 8 * g4) = w0; *(GAS u32x2*)(op + 32 + 8 * g4) = w1; }
    if (hh == 0) lsep[(size_t)tq * 8 + h] = l > 0.f ? (m + __builtin_amdgcn_logf(l)) * 0.6931471805599453f : NEGINF;
}
__device__ __forceinline__ void dil_store_t(const f32x16& O0, const f32x16& O1, float m, float l, bf16* opart, float* lsep, int tq, int h, int lane, int sh, LAS unsigned char* st) {
    const int q = lane & 31, hh = lane >> 5;
    l = xsum32(l);
    const float inv = l > 0.f ? 1.0f / l : 0.f;
    LAS unsigned char* wp = st + q * 136 + 8 * hh;
#pragma unroll
    for (int g4 = 0; g4 < 4; ++g4) {
        u32x2 w0, w1; w0.x = cvtpk(O0[4 * g4] * inv, O0[4 * g4 + 1] * inv); w0.y = cvtpk(O0[4 * g4 + 2] * inv, O0[4 * g4 + 3] * inv);
        w1.x = cvtpk(O1[4 * g4] * inv, O1[4 * g4 + 1] * inv); w1.y = cvtpk(O1[4 * g4 + 2] * inv, O1[4 * g4 + 3] * inv);
        *(LAS u32x2*)(wp + 16 * g4) = w0; *(LAS u32x2*)(wp + 64 + 16 * g4) = w1; }
    if (hh == 0) lsep[(size_t)tq * 8 + h] = l > 0.f ? (m + __builtin_amdgcn_logf(l)) * 0.6931471805599453f : NEGINF;
    const int tq0 = tq - (q << sh), j = lane & 7;
#pragma unroll
    for (int k = 0; k < 4; ++k) { const int R = (lane >> 3) + 8 * k;
        const u32x2 a = *(const LAS u32x2*)(st + R * 136 + 16 * j), c = *(const LAS u32x2*)(st + R * 136 + 16 * j + 8);
        v4u o; o.x = a.x; o.y = a.y; o.z = c.x; o.w = c.y;
        *(GAS v4u*)(opart + (size_t)(tq0 + (R << sh)) * 512 + h * 64 + 8 * j) = o; }
}
template <int JLO>
__device__ __forceinline__ void dil_unit32(const bf16* pj, const bf16* vt, bf16* opart, float* lsep, const LAS float* bt, int sh, int b, int h, int r, int n0, bool do_store) {
    constexpr int NT = JLO == 0 ? 5 : 4;
    int lane; asm volatile("v_mbcnt_lo_u32_b32 %0, -1, 0\n\tv_mbcnt_hi_u32_b32 %0, -1, %0" : "=v"(lane));
    const int q = lane & 31, hh = lane >> 5;
    const int L = SEQ >> sh;
    const int tq = b * SEQ + r + ((n0 + q) << sh);
    bf16x8 qf[4];
    { const bf16* qp = pj + (size_t)tq * NPROJ + PC_Q + h * 64 + 32 * hh;
#pragma unroll
      for (int ks = 0; ks < 4; ++ks) qf[ks] = *(const GAS bf16x8*)(qp + 8 * ks); }
    f32x16 O0, O1;
#pragma unroll
    for (int i = 0; i < 16; ++i) { O0[i] = 0.f; O1[i] = 0.f; }
    float m = NEGINF, l = 0.f;
    const bf16* vrow = vt + ((size_t)((b * 8 + h) * 64 + q) * SEQ) + (sh == 4 ? r * 16 : r * L) + 8 * hh;
    bf16x8 kf[2][4], vf[2][2][2];
    { const int k0 = n0 - 128 < 0 ? 0 : n0 - 128; dil_load_k(kf[0], pj, sh, b, h, r, k0, q, hh); dil_load_v(vf[0], vrow, sh, k0); }
#pragma unroll
    for (int t = 0; t < NT; ++t) {
        const int k0 = n0 - 128 + 32 * t;
        if (t + 1 < NT) { const int k1 = k0 + 32 < 0 ? 0 : k0 + 32; dil_load_k(kf[(t + 1) & 1], pj, sh, b, h, r, k1, q, hh); dil_load_v(vf[(t + 1) & 1], vrow, sh, k1); }
        const int jq = k0 < 0 ? 160 : q - 8 * hh + 128 - 32 * t;
        dil_blk(kf[t & 1], vf[t & 1], qf, O0, O1, m, l, bt + jq + BT_OFF - 23);
    }
    if (do_store) dil_store(O0, O1, m, l, opart, lsep, tq, h, hh);
}

constexpr int DIL_WIN = 19200;
constexpr int DK_PITCH = 144, DV_PITCH = 784, DK_BYTES = 384 * DK_PITCH, DV_BYTES = 64 * DV_PITCH;
__device__ __forceinline__ void dil_stage_load_k(v4u (&sk)[6], const bf16* pj, int sh, int b, int h, int r, int n0, int tid) {
    const int ws = n0 - 128;
#pragma unroll
    for (int k = 0; k < 6; ++k) { const int idx = tid + 512 * k, row = idx >> 3, ch = idx & 7; int kk = ws + row; kk = kk < 0 ? 0 : kk;
        sk[k] = *(const GAS v4u*)(pj + (size_t)(b * SEQ + r + (kk << sh)) * NPROJ + PC_K + h * 64 + ch * 8); }
}
__device__ __forceinline__ void dil_stage_load_v(v4u (&sv)[6], const bf16* pj, int sh, int b, int h, int r, int n0, int tid) {
    const int ws = n0 - 128;
#pragma unroll
    for (int k = 0; k < 6; ++k) { const int idx = tid + 512 * k, row = idx >> 3, ch = idx & 7; int kk = ws + row; kk = kk < 0 ? 0 : kk;
        sv[k] = *(const GAS v4u*)(pj + (size_t)(b * SEQ + r + (kk << sh)) * NPROJ + PC_V + h * 64 + ch * 8); }
}
__device__ __forceinline__ void dil_stage_write_k(LAS unsigned char* lds, const v4u (&sk)[6], int tid) {
#pragma unroll
    for (int k = 0; k < 6; ++k) { const int idx = tid + 512 * k, row = idx >> 3, ch = idx & 7; *(LAS v4u*)(lds + row * DK_PITCH + ch * 16) = sk[k]; }
}
__device__ __forceinline__ void dil_stage_write_v(LAS unsigned char* lds, const v4u (&sv)[6], int tid) {
#pragma unroll
    for (int k = 0; k < 6; ++k) { const int idx = tid + 512 * k, row = idx >> 3, ch = idx & 7;
        LAS unsigned short* d = (LAS unsigned short*)(lds + DK_BYTES + (8 * ch) * DV_PITCH + ((((row >> 3) ^ ch) << 3) | (row & 7)) * 2);
        d[0] = (unsigned short)(sv[k].x & 0xffffu); d[DV_PITCH / 2] = (unsigned short)(sv[k].x >> 16); d[2 * (DV_PITCH / 2)] = (unsigned short)(sv[k].y & 0xffffu); d[3 * (DV_PITCH / 2)] = (unsigned short)(sv[k].y >> 16);
        d[4 * (DV_PITCH / 2)] = (unsigned short)(sv[k].z & 0xffffu); d[5 * (DV_PITCH / 2)] = (unsigned short)(sv[k].z >> 16); d[6 * (DV_PITCH / 2)] = (unsigned short)(sv[k].w & 0xffffu); d[7 * (DV_PITCH / 2)] = (unsigned short)(sv[k].w >> 16); }
}
template <int JLO>
__device__ __forceinline__ void dil_wg_compute(LAS unsigned char* lds, const bf16x8 (&qf)[4], bf16* opart, float* lsep, const LAS float* bt, int tq, int h, int k00, int lane, int wave, bool do_store, int sh) {
    constexpr int NT = JLO == 0 ? 5 : 4;
    asm volatile("" : "+v"(lane));
    const int q = lane & 31, hh = lane >> 5;
    f32x16 O0, O1;
#pragma unroll
    for (int i = 0; i < 16; ++i) { O0[i] = 0.f; O1[i] = 0.f; }
    float m = NEGINF, l = 0.f;
    const int sg = (q & ~12) | ((q & 4) << 1) | ((q & 8) >> 1);
    const LAS unsigned char* kl = lds + (32 * wave + sg) * DK_PITCH + 64 * hh;
    const LAS unsigned char* vl = lds + DK_BYTES + q * DV_PITCH;
    bf16x8 kf[2][4], vf[2][2][2];
#define DIL_LDFRAG(t_) do { _Pragma("unroll") for (int ks = 0; ks < 4; ++ks) kf[(t_) & 1][ks] = *(const LAS bf16x8*)(kl + (t_) * 32 * DK_PITCH + 16 * ks); \
        _Pragma("unroll") for (int db = 0; db < 2; ++db) _Pragma("unroll") for (int s2 = 0; s2 < 2; ++s2) \
            vf[(t_) & 1][db][s2] = *(const LAS bf16x8*)(vl + db * 32 * DV_PITCH + (((4 * wave + 4 * (t_) + 2 * s2 + hh) ^ (((32 * db + q) >> 3) & 7)) << 4)); } while (0)
    DIL_LDFRAG(0);
#pragma unroll
    for (int t = 0; t < NT; ++t) {
        if (t + 1 < NT) DIL_LDFRAG(t + 1);
        const int jq = k00 + 32 * t < 0 ? 160 : q - 8 * hh + 128 - 32 * t;
        dil_blk(kf[t & 1], vf[t & 1], qf, O0, O1, m, l, bt + jq + BT_OFF - 23);
        __builtin_amdgcn_sched_barrier(0);
    }
#undef DIL_LDFRAG
    if (do_store) dil_store_t(O0, O1, m, l, opart, lsep, tq, h, lane, sh, lds + DK_BYTES + DV_BYTES + wave * 4352);
}

__device__ __forceinline__ void xat_unit(const bf16* qxp, const bf16* kb, const bf16* vtb, bf16* oxp, int t0, int h, int lane) {
    const int q = lane & 31, hh = lane >> 5;
    bf16x8 qf[8];
    { const bf16* qp = qxp + (size_t)(t0 + q) * XW + h * 128 + 64 * hh;
#pragma unroll
      for (int ks = 0; ks < 8; ++ks) qf[ks] = *(const GAS bf16x8*)(qp + 8 * ks); }
    f32x16 O[4];
#pragma unroll
    for (int d = 0; d < 4; ++d)
#pragma unroll
        for (int i = 0; i < 16; ++i) O[d][i] = 0.f;
    float m = NEGINF, l = 0.f;
    const bf16* vrow = vtb + (size_t)(h * 128 + q) * MEML + 4 * hh;
    for (int k0 = 0; k0 < MEML; k0 += 32) {
        const bf16* kp = kb + (size_t)(k0 + q) * 4096 + h * 128 + 64 * hh;
        f32x16 st;
#pragma unroll
        for (int i = 0; i < 16; ++i) st[i] = 0.f;
#pragma unroll
        for (int ks = 0; ks < 8; ++ks) st = __builtin_amdgcn_mfma_f32_32x32x16_bf16(*(const GAS bf16x8*)(kp + 8 * ks), qf[ks], st, 0, 0, 0);
        bf16x8 vf[4][2];
#pragma unroll
        for (int db = 0; db < 4; ++db)
#pragma unroll
            for (int s2 = 0; s2 < 2; ++s2) { const bf16* vp = vrow + (size_t)db * 32 * MEML + k0 + 16 * s2; vf[db][s2] = mk8u2(*(const GAS u32x2*)vp, *(const GAS u32x2*)(vp + 8)); }
        float mx = st[0];
#pragma unroll
        for (int i = 1; i < 16; ++i) mx = fmaxf(mx, st[i]);
        mx = xmax32(mx);
        const float mn = fmaxf(m, mx), alpha = __expf(m - mn);
        float ls = 0.f;
#pragma unroll
        for (int i = 0; i < 16; ++i) { st[i] = __expf(st[i] - mn); ls += st[i]; }
        l = l * alpha + ls; m = mn;
#pragma unroll
        for (int d = 0; d < 4; ++d)
#pragma unroll
            for (int i = 0; i < 16; ++i) O[d][i] *= alpha;
        const bf16x8 p0 = mk8(cvtpk(st[0], st[1]), cvtpk(st[2], st[3]), cvtpk(st[4], st[5]), cvtpk(st[6], st[7]));
        const bf16x8 p1 = mk8(cvtpk(st[8], st[9]), cvtpk(st[10], st[11]), cvtpk(st[12], st[13]), cvtpk(st[14], st[15]));
#pragma unroll
        for (int d = 0; d < 4; ++d) { O[d] = __builtin_amdgcn_mfma_f32_32x32x16_bf16(vf[d][0], p0, O[d], 0, 0, 0); O[d] = __builtin_amdgcn_mfma_f32_32x32x16_bf16(vf[d][1], p1, O[d], 0, 0, 0); }
    }
    l = xsum32(l);
    const float inv = 1.0f / l;
    bf16* op = oxp + (size_t)(t0 + q) * XW + h * 128 + 4 * hh;
#pragma unroll
    for (int d = 0; d < 4; ++d)
#pragma unroll
        for (int g4 = 0; g4 < 4; ++g4) { u32x2 w; w.x = cvtpk(O[d][4 * g4] * inv, O[d][4 * g4 + 1] * inv); w.y = cvtpk(O[d][4 * g4 + 2] * inv, O[d][4 * g4 + 3] * inv); *(GAS u32x2*)(op + 32 * d + 8 * g4) = w; }
}

constexpr int XK_PITCH = 272, XV_PITCH = 528, XK_BYTES = 256 * XK_PITCH, XV_BYTES = 128 * XV_PITCH;
__device__ __forceinline__ void xat_wg_unit(LAS unsigned char* lds, const bf16* qxp, const bf16* kb, const bf16* vtb, bf16* oxp, int t0, int h, int tid) {
    const int lane = tid & 63, q = lane & 31, hh = lane >> 5;
    __syncthreads();
#pragma unroll
    for (int k = 0; k < 8; ++k) { const int idx = tid + 512 * k, row = idx >> 4, ch = idx & 15;
        const v4u x = *(const GAS v4u*)(kb + (size_t)row * 4096 + h * 128 + ch * 8); *(LAS v4u*)(lds + row * XK_PITCH + ch * 16) = x; }
#pragma unroll
    for (int k = 0; k < 8; ++k) { const int idx = tid + 512 * k, row = idx >> 5, ch = idx & 31;
        const v4u x = *(const GAS v4u*)(vtb + (size_t)(h * 128 + row) * MEML + ch * 8); *(LAS v4u*)(lds + XK_BYTES + row * XV_PITCH + ch * 16) = x; }
    bf16x8 qf[8];
    { const bf16* qp = qxp + (size_t)(t0 + q) * XW + h * 128 + 64 * hh;
#pragma unroll
      for (int ks = 0; ks < 8; ++ks) qf[ks] = *(const GAS bf16x8*)(qp + 8 * ks); }
    __syncthreads();
    f32x16 O[4];
#pragma unroll
    for (int d = 0; d < 4; ++d)
#pragma unroll
        for (int i = 0; i < 16; ++i) O[d][i] = 0.f;
    float m = NEGINF, l = 0.f;
    const int sg = (q & ~12) | ((q & 4) << 1) | ((q & 8) >> 1);
    const LAS unsigned char* kl = lds + sg * XK_PITCH + 128 * hh;
    const LAS unsigned char* vl = lds + XK_BYTES + q * XV_PITCH + 16 * hh;
#pragma unroll
    for (int kt = 0; kt < 8; ++kt) {
        f32x16 st;
#pragma unroll
        for (int i = 0; i < 16; ++i) st[i] = 0.f;
#pragma unroll
        for (int ks = 0; ks < 8; ++ks) st = __builtin_amdgcn_mfma_f32_32x32x16_bf16(*(const LAS bf16x8*)(kl + kt * 32 * XK_PITCH + ks * 16), qf[ks], st, 0, 0, 0);
        float mx = st[0];
#pragma unroll
        for (int i = 1; i < 16; ++i) mx = fmaxf(mx, st[i]);
        mx = xmax32(mx);
        const float mn = fmaxf(m, mx), alpha = __builtin_amdgcn_exp2f((m - mn) * 1.4426950408889634f);
        float ls = 0.f;
#pragma unroll
        for (int i = 0; i < 16; ++i) { st[i] = __builtin_amdgcn_exp2f((st[i] - mn) * 1.4426950408889634f); ls += st[i]; }
        l = l * alpha + ls; m = mn;
#pragma unroll
        for (int d = 0; d < 4; ++d)
#pragma unroll
            for (int i = 0; i < 16; ++i) O[d][i] *= alpha;
        const bf16x8 p0 = mk8(cvtpk(st[0], st[1]), cvtpk(st[2], st[3]), cvtpk(st[4], st[5]), cvtpk(st[6], st[7]));
        const bf16x8 p1 = mk8(cvtpk(st[8], st[9]), cvtpk(st[10], st[11]), cvtpk(st[12], st[13]), cvtpk(st[14], st[15]));
#pragma unroll
        for (int d = 0; d < 4; ++d) { const LAS unsigned char* vp = vl + d * 32 * XV_PITCH + kt * 64;
            O[d] = __builtin_amdgcn_mfma_f32_32x32x16_bf16(*(const LAS bf16x8*)vp, p0, O[d], 0, 0, 0); O[d] = __builtin_amdgcn_mfma_f32_32x32x16_bf16(*(const LAS bf16x8*)(vp + 32), p1, O[d], 0, 0, 0); }
    }
    l = xsum32(l);
    const float inv = 1.0f / l;
    bf16* op = oxp + (size_t)(t0 + q) * XW + h * 128 + 4 * hh;
#pragma unroll
    for (int d = 0; d < 4; ++d)
#pragma unroll
        for (int g4 = 0; g4 < 4; ++g4) { u32x2 w; w.x = cvtpk(O[d][4 * g4] * inv, O[d][4 * g4 + 1] * inv); w.y = cvtpk(O[d][4 * g4 + 2] * inv, O[d][4 * g4 + 3] * inv); *(GAS u32x2*)(op + 32 * d + 8 * g4) = w; }
}

__device__ __forceinline__ void pool_unit(const bf16* pj, const bf16* pwT, const float* psc, bf16* ymixp, int t0, int lane) {
    const int q = lane & 31, hh = lane >> 5; const int t = t0 + q, pos = t & (SEQ - 1);
    const bf16* prow = pj + (size_t)t * NPROJ + PC_POOL + 8 * hh;
#pragma unroll
    for (int g = 0; g < 4; ++g) {
        const int w = 2 << g; const float rn = 1.0f / (float)(pos + 1 < w ? pos + 1 : w);
        f32x16 D0, D1;
#pragma unroll
        for (int i = 0; i < 16; ++i) { D0[i] = 0.f; D1[i] = 0.f; }
#pragma unroll
        for (int ks = 0; ks < 4; ++ks) {
            const bf16* p0 = prow + g * 64 + 16 * ks;
            const v4u x0 = *(const GAS v4u*)p0;
            float a0 = bflo(x0.x), a1 = bfhi(x0.x), a2 = bflo(x0.y), a3 = bfhi(x0.y), a4 = bflo(x0.z), a5 = bfhi(x0.z), a6 = bflo(x0.w), a7 = bfhi(x0.w);
#pragma unroll
            for (int i = 1; i < w; ++i) if (pos - i >= 0) { const v4u xi = *(const GAS v4u*)(p0 - (size_t)i * NPROJ);
                a0 += bflo(xi.x); a1 += bfhi(xi.x); a2 += bflo(xi.y); a3 += bfhi(xi.y); a4 += bflo(xi.z); a5 += bfhi(xi.z); a6 += bflo(xi.w); a7 += bfhi(xi.w); }
            const bf16x8 bfr = mk8(cvtpk(a0 * rn - bflo(x0.x), a1 * rn - bfhi(x0.x)), cvtpk(a2 * rn - bflo(x0.y), a3 * rn - bfhi(x0.y)), cvtpk(a4 * rn - bflo(x0.z), a5 * rn - bfhi(x0.z)), cvtpk(a6 * rn - bflo(x0.w), a7 * rn - bfhi(x0.w)));
            const bf16* wp = pwT + (size_t)(g * 64 + q) * 64 + 16 * ks + 8 * hh;
            D0 = __builtin_amdgcn_mfma_f32_32x32x16_bf16(*(const GAS bf16x8*)wp, bfr, D0, 0, 0, 0);
            D1 = __builtin_amdgcn_mfma_f32_32x32x16_bf16(*(const GAS bf16x8*)(wp + 32 * 64), bfr, D1, 0, 0, 0);
        }
        bf16* op = ymixp + (size_t)t * D + 512 + g * 64 + 4 * hh; const float* sp = psc + g * 64 + 4 * hh;
#pragma unroll
        for (int k = 0; k < 4; ++k) { const f32x4 s0 = *(const GAS f32x4*)(sp + 8 * k), s1 = *(const GAS f32x4*)(sp + 32 + 8 * k);
            u32x2 w0, w1; w0.x = cvtpk(D0[4 * k] * s0[0], D0[4 * k + 1] * s0[1]); w0.y = cvtpk(D0[4 * k + 2] * s0[2], D0[4 * k + 3] * s0[3]);
            w1.x = cvtpk(D1[4 * k] * s1[0], D1[4 * k + 1] * s1[1]); w1.y = cvtpk(D1[4 * k + 2] * s1[2], D1[4 * k + 3] * s1[3]);
            *(GAS u32x2*)(op + 8 * k) = w0; *(GAS u32x2*)(op + 32 + 8 * k) = w1; }
    }
}
__device__ __forceinline__ void mergeconv_unit(const bf16* pj, const bf16* opartp, const float* lsepp, const float* cw, bf16* ymixp, int t0, int lane) {
    const int c4 = 4 * lane, h = lane >> 3;
    const f32x4 w0 = *(const GAS f32x4*)(cw + c4), w1 = *(const GAS f32x4*)(cw + 256 + c4), w2 = *(const GAS f32x4*)(cw + 512 + c4);
    f32x4 u1 = {0.f, 0.f, 0.f, 0.f}, u2 = {0.f, 0.f, 0.f, 0.f};
    const int pos0 = t0 & (SEQ - 1);
    if (pos0 >= 2) {
        const bf16* r1 = pj + (size_t)(t0 - 1) * NPROJ; const bf16* r2 = r1 - NPROJ;
        const u32x2 c1 = *(const GAS u32x2*)(r1 + PC_CG + c4), h1 = *(const GAS u32x2*)(r1 + PC_HC + c4), c2 = *(const GAS u32x2*)(r2 + PC_CG + c4), h2 = *(const GAS u32x2*)(r2 + PC_HC + c4);
        u1 = (f32x4){bflo(c1.x) * bflo(h1.x), bfhi(c1.x) * bfhi(h1.x), bflo(c1.y) * bflo(h1.y), bfhi(c1.y) * bfhi(h1.y)};
        u2 = (f32x4){bflo(c2.x) * bflo(h2.x), bfhi(c2.x) * bfhi(h2.x), bflo(c2.y) * bflo(h2.y), bfhi(c2.y) * bfhi(h2.y)};
    }
#pragma unroll 4
    for (int j = 0; j < 32; ++j) { const int t = t0 + j; const bf16* row = pj + (size_t)t * NPROJ;
        const u32x2 cg = *(const GAS u32x2*)(row + PC_CG + c4), hc = *(const GAS u32x2*)(row + PC_HC + c4), bg = *(const GAS u32x2*)(row + PC_BG + c4);
        const f32x4 u0 = {bflo(cg.x) * bflo(hc.x), bfhi(cg.x) * bfhi(hc.x), bflo(cg.y) * bflo(hc.y), bfhi(cg.y) * bfhi(hc.y)};
        const f32x4 y = (f32x4){bflo(bg.x), bfhi(bg.x), bflo(bg.y), bfhi(bg.y)} * (w0 * u0 + w1 * u1 + w2 * u2);
        u32x2 yo; yo.x = cvtpk(y[0], y[1]); yo.y = cvtpk(y[2], y[3]);
        *(GAS u32x2*)(ymixp + (size_t)t * D + 768 + c4) = yo;
        u2 = u1; u1 = u0;
        const float l0 = lsepp[(size_t)t * 8 + h], l1 = lsepp[(size_t)T * 8 + (size_t)t * 8 + h], l2 = lsepp[(size_t)2 * T * 8 + (size_t)t * 8 + h];
        const float M = fmaxf(l0, fmaxf(l1, l2)); float e0 = __expf(l0 - M), e1 = __expf(l1 - M), e2 = __expf(l2 - M); const float inv = 1.0f / (e0 + e1 + e2); e0 *= inv; e1 *= inv; e2 *= inv;
        const v4u a = *(const GAS v4u*)(opartp + (size_t)t * 512 + 8 * lane), bq = *(const GAS v4u*)(opartp + OP_STRIDE + (size_t)t * 512 + 8 * lane), c = *(const GAS v4u*)(opartp + 2 * OP_STRIDE + (size_t)t * 512 + 8 * lane);
        v4u o; o.x = cvtpk(e0 * bflo(a.x) + e1 * bflo(bq.x) + e2 * bflo(c.x), e0 * bfhi(a.x) + e1 * bfhi(bq.x) + e2 * bfhi(c.x));
        o.y = cvtpk(e0 * bflo(a.y) + e1 * bflo(bq.y) + e2 * bflo(c.y), e0 * bfhi(a.y) + e1 * bfhi(bq.y) + e2 * bfhi(c.y));
        o.z = cvtpk(e0 * bflo(a.z) + e1 * bflo(bq.z) + e2 * bflo(c.z), e0 * bfhi(a.z) + e1 * bfhi(bq.z) + e2 * bfhi(c.z));
        o.w = cvtpk(e0 * bflo(a.w) + e1 * bflo(bq.w) + e2 * bflo(c.w), e0 * bfhi(a.w) + e1 * bfhi(bq.w) + e2 * bfhi(c.w));
        *(GAS v4u*)(ymixp + (size_t)t * D + 8 * lane) = o; }
}

__device__ __forceinline__ void vt_transpose_tile(LAS unsigned char* lds, const bf16* pj, bf16* vt, int pm, int vh, int tid) {
    constexpr int PW = 65;
    LAS unsigned* img = (LAS unsigned*)lds;
    const int row0 = pm * 256, b = row0 >> 13, tt = row0 & 8191;
    for (int hf = 0; hf < 2; ++hf) {
        __syncthreads();
        { const int r = tid >> 1, hc = tid & 1;
            const bf16* src = pj + (size_t)(row0 + r) * NPROJ + PC_V + vh * 256 + hf * 128 + hc * 64;
#pragma unroll
            for (int k = 0; k < 8; ++k) { const v4u x = *(const GAS v4u*)(src + 8 * k); LAS unsigned* d = img + r * PW + hc * 32 + 4 * k; d[0] = x.x; d[1] = x.y; d[2] = x.z; d[3] = x.w; } }
        __syncthreads();
        const LAS unsigned short* im16 = (const LAS unsigned short*)lds;
        bf16* vcol = vt + (size_t)(b * 512 + vh * 256 + hf * 128) * SEQ;
#pragma unroll 2
        for (int k = 0; k < 8; ++k) { const int id = tid + 512 * k, d = id >> 5, c = id & 31;
            {
#define RD16(j) ((unsigned)im16[(8 * c + (j)) * (2 * PW) + d])
              v4u o; o.x = RD16(0) | (RD16(1) << 16); o.y = RD16(2) | (RD16(3) << 16); o.z = RD16(4) | (RD16(5) << 16); o.w = RD16(6) | (RD16(7) << 16);
#undef RD16
              *(GAS v4u*)(vcol + (size_t)d * SEQ + tt + 8 * c) = o; }
            { const int r = c >> 3, n0 = 8 * (c & 7);
#define RD16(j) ((unsigned)im16[(4 * (n0 + (j)) + r) * (2 * PW) + d])
              v4u o; o.x = RD16(0) | (RD16(1) << 16); o.y = RD16(2) | (RD16(3) << 16); o.z = RD16(4) | (RD16(5) << 16); o.w = RD16(6) | (RD16(7) << 16);
#undef RD16
              *(GAS v4u*)(vcol + VT_STRIDE + (size_t)d * SEQ + r * 2048 + (tt >> 2) + n0) = o; }
            { const int r = c >> 1, n0 = 8 * (c & 1);
#define RD16(j) ((unsigned)im16[(16 * (n0 + (j)) + r) * (2 * PW) + d])
              v4u o; o.x = RD16(0) | (RD16(1) << 16); o.y = RD16(2) | (RD16(3) << 16); o.z = RD16(4) | (RD16(5) << 16); o.w = RD16(6) | (RD16(7) << 16);
#undef RD16
              *(GAS v4u*)(vcol + 2 * VT_STRIDE + (size_t)d * SEQ + (tt >> 8) * 256 + r * 16 + n0) = o; }
        }
    }
    __syncthreads();
}

#define x_in (args.in[0])
#define mem_in (args.in[1])
#define rel_bias (args.in[2])
#define mem_g (args.in[3])
#define mix_g (args.in[4])
#define w_in (args.in[5])
#define conv_w (args.in[6])
#define pool_w (args.in[7])
#define pool_scale (args.in[8])
#define w_out (args.in[9])
#define xat_g (args.in[10])
#define wq_x (args.in[11])
#define wkv_x (args.in[12])
#define wo_x (args.in[13])
#define ffn_g (args.in[14])
#define w13_d (args.in[15])
#define w2_d (args.in[16])
#define router_w (args.in[17])
#define w13_m (args.in[18])
#define w2_m (args.in[19])
#define fin_g (args.in[20])
#define out (args.out)
#define Win_t ((bf16*)(ws + WS_WIN))
#define Wout_t ((bf16*)(ws + WS_WOUT))
#define Wq_t ((bf16*)(ws + WS_WQ))
#define Wkv_t ((bf16*)(ws + WS_WKV))
#define Wo_t ((bf16*)(ws + WS_WO))
#define W13d_t ((bf16*)(ws + WS_W13D))
#define W2d_t ((bf16*)(ws + WS_W2D))
#define W13m_t ((bf16*)(ws + WS_W13M))
#define W2m_t ((bf16*)(ws + WS_W2M))
#define xb ((bf16*)(ws + WS_XB))
#define qx ((bf16*)(ws + WS_QX))
#define ox ((bf16*)(ws + WS_OX))
#define Ag ((bf16*)(ws + WS_AG))
#define ym ((bf16*)(ws + WS_YM))
#define ypart ((bf16*)(ws + WS_YM + 136 * MiB))
#define proj ((bf16*)(ws + WS_PROJ))
#define ymix ((bf16*)(ws + WS_Y))
#define hbuf ((bf16*)(ws + WS_H))
#define kvx ((bf16*)(ws + WS_KVX))
#define memn ((bf16*)(ws + WS_MEMN))
#define vtb ((bf16*)(ws + WS_VT))
#define opart ((bf16*)(ws + WS_OPART))
#define lsep ((float*)(ws + WS_LSE))
#define vtx ((bf16*)(ws + WS_VTX))
#define ssp ((float*)(ws + WS_SSP))
#define cnts ((int*)(ws + WS_CNT))
#define meta ((int*)(ws + WS_META))
#define tok_e ((int*)(ws + WS_TOKE))
#define tok_g ((float*)(ws + WS_TOKG))
#define tok_pos ((int*)(ws + WS_TOKPOS))
#define row_gate ((float*)(ws + WS_ROWGATE))
#define row_rs ((float*)(ws + WS_ROWRS))
#ifndef PROBE
#define PROBE 0
#endif
#ifndef N_LAUNCH_MODE
#define N_LAUNCH_MODE 0
#endif

__device__ __forceinline__ void pair_barrier(unsigned* cnt, unsigned target, bool same_xcc, unsigned* tmo, int wave0) {
    asm volatile("s_waitcnt vmcnt(0)" ::: "memory");
    __syncthreads();
    int ln; asm volatile("v_mbcnt_lo_u32_b32 %0, -1, 0\n\tv_mbcnt_hi_u32_b32 %0, -1, %0" : "=v"(ln));
    if (wave0 == 0 && ln == 0) {
        if (!same_xcc) { __builtin_amdgcn_fence(__ATOMIC_RELEASE, "agent"); asm volatile("s_waitcnt vmcnt(0)" ::: "memory"); }
        (void)xb_add(cnt, 1u);
        unsigned sp = 0u;
        while (xb_ld(cnt) < target) { __builtin_amdgcn_s_sleep(1); if ((++sp & 255u) == 0u) { if (xb_ld(tmo)) break; if (sp > XB_SPIN_CAP) { atomicAdd(tmo, 1u); break; } } }
        __builtin_amdgcn_fence(__ATOMIC_ACQUIRE, "agent");
        asm volatile("s_waitcnt vmcnt(0)" ::: "memory");
    }
    __syncthreads();
}
__global__ void __launch_bounds__(NWAVES * 64, 2) trunk_fwd(Args args) {
    extern __shared__ __attribute__((aligned(16))) unsigned char lds_raw[];
    LAS unsigned char* lds = (LAS unsigned char*)lds_raw;
    volatile LAS unsigned* MISC = (volatile LAS unsigned*)(lds + MISC_OFF);
    const int tid0 = threadIdx.x;
    const int G0 = gridDim.x, blk0 = blockIdx.x, wave0 = __builtin_amdgcn_readfirstlane(tid0 >> 6);
    unsigned char* ws0 = args.ws;
    gu32* ctl = (gu32*)(ws0 + WS_CTL);
#define PH_VARS int lane_; asm volatile("v_mbcnt_lo_u32_b32 %0, -1, 0\n\tv_mbcnt_hi_u32_b32 %0, -1, %0" : "=v"(lane_)); int wv_ = wave0; asm volatile("" : "+s"(wv_)); int blk = blk0; asm volatile("" : "+s"(blk)); int G = G0; asm volatile("" : "+s"(G)); \
    unsigned char* ws = ws0; asm volatile("" : "+s"(ws)); const int lane = lane_, wave = wv_, tid = wv_ * 64 + lane_; const int gw = blk * NWAVES + wave, NGW = G * NWAVES; (void)lane; (void)gw; (void)NGW; (void)ws; (void)tid
    for (int u = tid0; u < (LDS_BYTES - LDSCTL_OFF) / 4; u += NWAVES * 64) ((LAS unsigned*)(lds + LDSCTL_OFF))[u] = 0u;
    __syncthreads();
    XcdBarrier bar = xcd_barrier_post((unsigned*)(ctl + CW_BAR), MISC + 8);
    bar.x = __builtin_amdgcn_readfirstlane(bar.x);
    if (tid0 == 0) __hip_atomic_store((unsigned*)(ws0 + WS_XCCTAB) + blk0, bar.x, __ATOMIC_RELAXED, __HIP_MEMORY_SCOPE_AGENT);
    const int tpm0 = (blk0 & 7) + 8 * (blk0 >> 4), tmb0 = (blk0 >> 3) & 1;
    unsigned pepoch = 0u; bool same_xcc = false;
#define PAIR_BAR do { pepoch += 2u; unsigned* tc_ = (unsigned*)(ctl + CW_TEAM) + 64 * tpm0; asm volatile("" : "+s"(tc_)); pair_barrier(tc_, pepoch, same_xcc, (unsigned*)(ctl + CW_BAR) + XB_TMO, wave0); } while (0)
#if N_LAUNCH_MODE == 0
#define PH_ON true
#define PH_END do { for (int br_ = 0; br_ < ((PROBE & 1024) ? 3 : 1); ++br_) { XcdBarrier b_ = bar; asm volatile("" : "+s"(b_.x)); asm volatile("" : "+s"(b_.bar)); xcd_barrier(b_); } } while (0)
#else
    const int lo = args.ph_lo, hi = args.ph_hi;
    int ph = 0;
#define PH_ON (ph >= lo && ph < hi)
#define PH_END do { if (ph >= lo && ph + 1 < hi) { XcdBarrier b_ = bar; asm volatile("" : "+s"(b_.x)); asm volatile("" : "+s"(b_.bar)); xcd_barrier(b_); } ++ph; } while (0)
#endif

    constexpr size_t SSP_STRIDE = (size_t)T * 16;

    if (PH_ON) { PH_VARS;
        LAS float* scr = (LAS float*)(lds + wave * 16896);
        constexpr int I_IN = 16 * 40, I_OUT = 16 * 16, I_Q = 16 * 8, I_KV = 16 * 16, I_O = 8 * 16, I_13D = 16 * 88, I_2D = 44 * 16, I_13M = 16 * 112, I_2M = 56 * 16;
        constexpr int C0 = 4 * I_IN, C1 = C0 + 4 * I_OUT, C2 = C1 + 4 * I_Q, C3 = C2 + 4 * I_KV, C4 = C3 + 4 * I_O, C5 = C4 + 2 * I_13D, C6 = C5 + 2 * I_2D, C7 = C6 + 16 * I_13M, C8 = C7 + 16 * I_2M;
        for (int rep = 0; rep < ((PROBE & 16) ? 2 : 1); ++rep)
        for (int it = gw; it < C8; it += NGW) {
            if (it < C0) { const int m = it / I_IN, r = it % I_IN; if (m < 2) conv_item(w_in + (size_t)m * D * NPROJ, D, NPROJ, Win_t + (size_t)m * NPROJ * D, mix_g + m * D, 0, scr, r, lane);
                else conv_item8(w_in + (size_t)m * D * NPROJ, D, NPROJ, (unsigned char*)(Win_t + (size_t)m * NPROJ * D), mix_g + m * D, 0, F8_S1, scr, r, lane); }
            else if (it < C1) { const int q = it - C0, m = q / I_OUT, r = q % I_OUT; conv_item(w_out + (size_t)m * D * D, D, D, Wout_t + (size_t)m * D * D, nullptr, 0, scr, r, lane); }
            else if (it < C2) { const int q = it - C1, m = q / I_Q, r = q % I_Q; conv_item(wq_x + (size_t)m * D * XW, D, XW, Wq_t + (size_t)m * XW * D, xat_g + m * D, 0, scr, r, lane); }
            else if (it < C3) { const int q = it - C2, m = q / I_KV, r = q % I_KV; conv_item(wkv_x + (size_t)m * D * 1024, D, 1024, Wkv_t + (size_t)m * 1024 * D, nullptr, 0, scr, r, lane); }
            else if (it < C4) { const int q = it - C3, m = q / I_O, r = q % I_O; conv_item(wo_x + (size_t)m * XW * D, XW, D, Wo_t + (size_t)m * D * XW, nullptr, 0, scr, r, lane); }
            else if (it < C5) { const int q = it - C4, m = q / I_13D, r = q % I_13D; if (m == 0) conv_item(w13_d, D, 2 * FFD, W13d_t, ffn_g, FFD, scr, r, lane); else conv_item8(w13_d + (size_t)D * 2 * FFD, D, 2 * FFD, (unsigned char*)(W13d_t + (size_t)2 * FFD * D), ffn_g + 2 * D, FFD, F8_S1, scr, r, lane); }
            else if (it < C6) { const int q = it - C5, m = q / I_2D, r = q % I_2D; if (m == 0) conv_item(w2_d, FFD, D, W2d_t, nullptr, 0, scr, r, lane); else conv_item8(w2_d + (size_t)FFD * D, FFD, D, (unsigned char*)(W2d_t + (size_t)D * FFD), nullptr, 0, F8_S2, scr, r, lane); }
            else if (it < C7) { const int q = it - C6, m = q / I_13M, r = q % I_13M; conv_item8(w13_m + (size_t)m * D * 2 * FFE, D, 2 * FFE, (unsigned char*)W13m_t + (size_t)m * 2 * FFE * D, ffn_g + (2 * (m >> 3) + 1) * D, FFE, F8_S1, scr, r, lane); }
            else { const int q = it - C7, m = q / I_2M, r = q % I_2M; conv_item8(w2_m + (size_t)m * FFE * D, FFE, D, (unsigned char*)W2m_t + (size_t)m * D * FFE, nullptr, 0, F8_S2, scr, r, lane); }
        }
        for (int idx = gw * 64 + lane; idx < DEPTH * 4 * 64 * 64; idx += NGW * 64) { const int c = idx & 63, dp = (idx >> 6) & 63, lg = idx >> 12;
            ((bf16*)(ws + WS_PWT))[idx] = (bf16)f2bf(pool_w[(size_t)(lg * 64 + c) * 64 + dp]); }
        for (int m = gw; m < T; m += NGW) {
            const GAS f32x4* xr = (const GAS f32x4*)(x_in + (size_t)m * D) + lane; f32x4 v[4]; float s = 0.f;
#pragma unroll
            for (int j = 0; j < 4; ++j) { v[j] = xr[64 * j]; s += (v[j].x * v[j].x + v[j].y * v[j].y) + (v[j].z * v[j].z + v[j].w * v[j].w); }
            s = wave_sum(s, lane);
            GAS unsigned long long* o8 = (GAS unsigned long long*)(xb + (size_t)m * D) + lane;
#pragma unroll
            for (int j = 0; j < 4; ++j) o8[64 * j] = (unsigned long long)pk2(v[j].x, v[j].y) | ((unsigned long long)pk2(v[j].z, v[j].w) << 32);
            if (lane < 16) ssp[(size_t)m * 16 + lane] = lane == 0 ? s : 0.f;
        }
        for (int m = gw; m < MROWS; m += NGW) {
            const GAS f32x4* xr = (const GAS f32x4*)(mem_in + (size_t)m * D) + lane; const GAS f32x4* gr = (const GAS f32x4*)mem_g + lane; f32x4 v[4]; float s = 0.f;
#pragma unroll
            for (int j = 0; j < 4; ++j) { v[j] = xr[64 * j]; s += (v[j].x * v[j].x + v[j].y * v[j].y) + (v[j].z * v[j].z + v[j].w * v[j].w); }
            const float r = 1.0f / sqrtf(wave_sum(s, lane) * (1.0f / D) + 1e-6f);
            GAS unsigned long long* o8 = (GAS unsigned long long*)(memn + (size_t)m * D) + lane;
#pragma unroll
            for (int j = 0; j < 4; ++j) { const f32x4 g = gr[64 * j]; o8[64 * j] = (unsigned long long)pk2(v[j].x * r * g.x, v[j].y * r * g.y) | ((unsigned long long)pk2(v[j].z * r * g.z, v[j].w * r * g.w) << 32); }
        }
    }
    PH_END;
    same_xcc = (unsigned)__builtin_amdgcn_readfirstlane((int)xb_ld((unsigned*)(ws0 + WS_XCCTAB) + (blk0 ^ 8))) == bar.x;

    for (int l = 0; l < DEPTH; ++l) {
#define ssp_a (ssp + (size_t)(3 * l) * SSP_STRIDE)
#define ssp_b (ssp + (size_t)(3 * l + 1) * SSP_STRIDE)
#define ssp_c (ssp + (size_t)(3 * l + 2) * SSP_STRIDE)
#define ssp_d (ssp + (size_t)(3 * l + 3) * SSP_STRIDE)
        if (PH_ON) { PH_VARS;
            if (l == 0) {
                pg8::Gemm g{memn, Wkv_t, MROWS, 4096, D}; pg8::StaticOrder S; S.init(MROWS, 4096, G, blk);
                pg8::EpiKV E{kvx, vtx};
                pg8::gemm_phase<pg8::EpiKV, pg8::StaticOrder, true, true>(lds, g, S, E, tid);
#if PROBE & (1 | 64)
                pg8::gemm_phase<pg8::EpiKV, pg8::StaticOrder, true, true>(lds, g, S, E, tid);
#endif
            }
        }
        if (PH_ON) {
            if (l >= 2) { PH_VARS;
                pg8::Gemm g{Ag, Win_t + (size_t)l * NPROJ * D, T, NPROJ, D / 2}; pg8::StaticOrder S; S.init(T, NPROJ, G, blk);
                pg8::EpiRowScale E{proj, NPROJ, ssp_a, 1.0f / F8_S1};
                pg8::gemm_phase<pg8::EpiRowScale, pg8::StaticOrder, true, true, true>(lds, g, S, E, tid);
            } else { PH_VARS;
                pg8::Gemm g{xb, Win_t + (size_t)l * NPROJ * D, T, NPROJ, D}; pg8::StaticOrder S; S.init(T, NPROJ, G, blk);
                pg8::EpiRowScale E{proj, NPROJ, ssp_a, 1.0f};
                pg8::gemm_phase<pg8::EpiRowScale, pg8::StaticOrder, true, true>(lds, g, S, E, tid);
            }
        }
        PH_END;
        if (PH_ON) { PH_VARS;
            LAS float* bt = (LAS float*)lds;
            for (int idx = tid; idx < 3 * 8 * BT_LD; idx += NWAVES * 64) { const int part = idx / (8 * BT_LD), rem = idx % (8 * BT_LD), h = rem / BT_LD, j = rem % BT_LD - BT_OFF, sh = 2 * part, jlo = part ? 33 : 0;
                float v = NEGINF; if (j <= 128 && j >= jlo) { const int d = j << sh; v = (rel_bias[t5_bucket(d) * 8 + h] + logf((float)key_mult(d))) * 1.4426950408889634f; } bt[idx] = v; }
            __syncthreads();
            for (int rep = 0; rep < ((PROBE & (2 | 2048)) ? 2 : 1); ++rep) {
            v4u sk[6], sv[6];
#define DIL_DEC(u_) const int part = (u_) >> 10, v_ = (u_) & 1023, sh = 2 * part, b = v_ >> 8, h = (v_ >> 5) & 7, w5 = v_ & 31, nbs = 5 - sh, r = w5 >> nbs, n0 = 256 * (w5 & ((1 << nbs) - 1))
            { const int u0 = blk < 3 * 1024 ? blk : 0; DIL_DEC(u0); dil_stage_load_k(sk, proj, sh, b, h, r, n0, tid); dil_stage_load_v(sv, proj, sh, b, h, r, n0, tid); }
            for (int u = blk; u < 3 * 1024; u += G) {
                DIL_DEC(u);
                const bool dst = !((PROBE & 2048) && rep == 1);
                __syncthreads();
                dil_stage_write_k(lds + DIL_WIN, sk, tid); dil_stage_write_v(lds + DIL_WIN, sv, tid);
                const int tq = b * SEQ + r + ((n0 + 32 * wave + (lane & 31)) << sh);
                bf16x8 qf[4];
                { const bf16* qp = proj + (size_t)tq * NPROJ + PC_Q + h * 64 + 32 * (lane >> 5);
#pragma unroll
                  for (int ks = 0; ks < 4; ++ks) qf[ks] = *(const GAS bf16x8*)(qp + 8 * ks); }
                __syncthreads();
                { const int un = u + G < 3 * 1024 ? u + G : u, part2 = un >> 10, v2 = un & 1023, sh2 = 2 * part2, nbs2 = 5 - sh2, w52 = v2 & 31, b2 = v2 >> 8, h2 = (v2 >> 5) & 7, r2 = w52 >> nbs2, n02 = 256 * (w52 & ((1 << nbs2) - 1));
                    dil_stage_load_k(sk, proj, sh2, b2, h2, r2, n02, tid); dil_stage_load_v(sv, proj, sh2, b2, h2, r2, n02, tid); }
                if (part == 0) dil_wg_compute<0>(lds + DIL_WIN, qf, opart, lsep, bt + h * BT_LD, tq, h, n0 + 32 * wave - 128, lane, wave, dst, sh);
                else dil_wg_compute<33>(lds + DIL_WIN, qf, opart + (size_t)part * OP_STRIDE, lsep + (size_t)part * T * 8, bt + (part * 8 + h) * BT_LD, tq, h, n0 + 32 * wave - 128, lane, wave, dst, sh);
            }
#undef DIL_DEC
            }
            __syncthreads();
        }
        PH_END;
        if (PH_ON) { PH_VARS;
            const bf16* pwT = (const bf16*)(ws + WS_PWT) + (size_t)l * 4 * 64 * 64;
            const int t0 = 32 * (tpm0 * 8 + 4 * tmb0 + (wave >> 1));
            if ((wave & 1) == 0) pool_unit(proj, pwT, pool_scale + (size_t)l * 256, ymix, t0, lane);
            else mergeconv_unit(proj, opart, lsep, conv_w + (size_t)l * 768, ymix, t0, lane);
        }
        PAIR_BAR;
        if (PH_ON) { PH_VARS;
            pg8::Gemm g{ymix, Wout_t + (size_t)l * D * D, T, D, D}; pg8::TeamOrder S{tpm0, 2 * tmb0, 2};
            pg8::EpiResid E{l == 0 ? x_in : (const float*)nullptr, xb, ssp_b, nullptr, 1.0f, 0};
            pg8::gemm_phase<pg8::EpiResid, pg8::TeamOrder, true, true>(lds, g, S, E, tid);
        }
        PAIR_BAR;
        if (PH_ON) { PH_VARS;
            pg8::Gemm g{xb, Wq_t + (size_t)l * XW * D, T, XW, D}; pg8::TeamOrder S{tpm0, tmb0, 1};
            pg8::EpiRowScale E{qx, XW, ssp_b, 0.08838834764831845f};
            pg8::gemm_phase<pg8::EpiRowScale, pg8::TeamOrder, true, true>(lds, g, S, E, tid);
            { const int b = (tpm0 * 256) / SEQ;
              for (int h2 = 0; h2 < 2; ++h2) xat_wg_unit(lds, qx, kvx + (size_t)(b * MEML) * 4096 + l * 1024, vtx + (size_t)((l * 4 + b) * 512) * MEML, ox, tpm0 * 256 + wave * 32, 2 * tmb0 + h2, tid); }
            __syncthreads();
        }
        PAIR_BAR;
        if (PH_ON) { PH_VARS;
            pg8::Gemm g{ox, Wo_t + (size_t)l * D * XW, T, D, XW}; pg8::TeamOrder S{tpm0, 2 * tmb0, 2};
            pg8::EpiResid E{nullptr, xb, ssp_c, (unsigned char*)Ag, 1.0f, l == 2 ? 1 : 0};
            pg8::gemm_phase<pg8::EpiResid, pg8::TeamOrder, true, true>(lds, g, S, E, tid);
        }
        PH_END;
        if ((l & 1) == 0) {
            if (PH_ON) { PH_VARS;
                pg8::StaticOrder S; S.init(T, 2 * FFD, G, blk);
                if (l == 2) {
                    pg8::Gemm g{Ag, W13d_t + (size_t)2 * FFD * D, T, 2 * FFD, D / 2};
                    pg8::EpiSwiGLU8 E{(unsigned char*)hbuf, FFD, nullptr, 0, 1.0f / F8_S1, F8_SH, ssp_c};
                    pg8::gemm_phase<pg8::EpiSwiGLU8, pg8::StaticOrder, true, true, true>(lds, g, S, E, tid);
                } else {
                    pg8::Gemm g{xb, W13d_t, T, 2 * FFD, D};
                    pg8::EpiSwiGLU E{hbuf, FFD, ssp_c, nullptr, 0};
                    pg8::gemm_phase<pg8::EpiSwiGLU, pg8::StaticOrder, true, true>(lds, g, S, E, tid);
                }
            }
            PH_END;
            if (PH_ON) { PH_VARS;
                pg8::StaticOrder S; S.init(T, D, G, blk);
                if (l == 2) {
                    pg8::Gemm g{hbuf, W2d_t + (size_t)D * FFD, T, D, FFD / 2};
                    pg8::EpiResid E{nullptr, xb, ssp_d, (unsigned char*)Ag, 1.0f / (F8_S2 * F8_SH), 1};
                    pg8::gemm_phase<pg8::EpiResid, pg8::StaticOrder, true, true, true>(lds, g, S, E, tid);
                } else {
                    pg8::Gemm g{hbuf, W2d_t, T, D, FFD};
                    pg8::EpiResid E{nullptr, xb, ssp_d, nullptr, 1.0f, 0};
                    pg8::gemm_phase<pg8::EpiResid, pg8::StaticOrder, true, true>(lds, g, S, E, tid);
                }
            }
            PH_END;
        } else {
#define chunk ((T + G - 1) / G)
            if (PH_ON) { PH_VARS;
                LAS int* lcnt = (LAS int*)lds; const float* rw = router_w + (size_t)(l >> 1) * D * NEXP; const float* fg = ffn_g + (size_t)l * D;
                if (tid < NEXP) lcnt[tid] = 0;
                __syncthreads();
                for (int i = wave; i < chunk; i += NWAVES) { const int t = blk * chunk + i; if (t >= T) break;
                    const float r = pg8::row_rs16(ssp_c, t);
                    float lg[8];
#pragma unroll
                    for (int e = 0; e < 8; ++e) lg[e] = 0.f;
#pragma unroll
                    for (int j = 0; j < 4; ++j) { const u32x2 xw = *((const GAS u32x2*)(xb + (size_t)t * D) + lane + 64 * j); const f32x4 xv = {bflo(xw.x), bfhi(xw.x), bflo(xw.y), bfhi(xw.y)}; const f32x4 gv = *((const GAS f32x4*)fg + lane + 64 * j);
#pragma unroll
                        for (int c = 0; c < 4; ++c) { const float hn = xv[c] * r * gv[c]; const int k = 4 * (lane + 64 * j) + c; const f32x4 w0 = *(const GAS f32x4*)(rw + (size_t)k * 8), w1 = *(const GAS f32x4*)(rw + (size_t)k * 8 + 4);
                            lg[0] += hn * w0[0]; lg[1] += hn * w0[1]; lg[2] += hn * w0[2]; lg[3] += hn * w0[3]; lg[4] += hn * w1[0]; lg[5] += hn * w1[1]; lg[6] += hn * w1[2]; lg[7] += hn * w1[3]; } }
#pragma unroll
                    for (int e = 0; e < 8; ++e) lg[e] = wave_sum(lg[e], lane);
                    int e0 = 0; float v0 = lg[0];
#pragma unroll
                    for (int e = 1; e < 8; ++e) if (lg[e] > v0) { v0 = lg[e]; e0 = e; }
                    int e1 = -1; float v1 = -3.0e38f;
#pragma unroll
                    for (int e = 0; e < 8; ++e) if (e != e0 && lg[e] > v1) { v1 = lg[e]; e1 = e; }
                    const float p0 = 1.0f / (1.0f + __expf(v1 - v0)), p1 = 1.0f - p0;
                    if (lane == 0) { tok_e[2 * t] = e0; tok_e[2 * t + 1] = e1; tok_g[2 * t] = p0; tok_g[2 * t + 1] = p1; atomicAdd((int*)&lcnt[e0], 1); atomicAdd((int*)&lcnt[e1], 1); }
                }
                __syncthreads();
                if (tid < NEXP) cnts[blk * NEXP + tid] = lcnt[tid];
                __syncthreads();
            }
            PH_END;
            if (PH_ON) { PH_VARS;
                LAS int* lc = (LAS int*)lds;
                LAS int* lbase = (LAS int*)(lds + 32768);
                LAS int* lseg = (LAS int*)(lds + 32768 + 64);
                LAS int* lpos = (LAS int*)(lds + 36864);
                for (int i = tid; i < G * NEXP; i += NWAVES * 64) lc[i] = cnts[i];
                __syncthreads();
                { int base = 0, tot = 0;
                  for (int b2 = lane; b2 < G; b2 += 64) { const int c = lc[b2 * NEXP + wave]; tot += c; base += b2 < blk ? c : 0; }
                  for (int o = 1; o < 32; o <<= 1) { tot += __builtin_amdgcn_ds_bpermute((lane ^ o) << 2, tot); base += __builtin_amdgcn_ds_bpermute((lane ^ o) << 2, base); }
                  tot += __builtin_amdgcn_ds_bpermute((lane ^ 32) << 2, tot); base += __builtin_amdgcn_ds_bpermute((lane ^ 32) << 2, base);
                  if (lane == 0) { lbase[wave] = base; lseg[8 + wave] = tot; } }
                __syncthreads();
                if (tid == 0) { int s = 0; for (int e = 0; e < NEXP; ++e) { lseg[e] = s; lbase[e] += s; s += (lseg[8 + e] + 255) & ~255; lseg[16 + e] = s; if (blk == 0) meta[e] = s >> 8; } }
                __syncthreads();
                if (wave == 0) {
                    int run[8];
#pragma unroll
                    for (int e = 0; e < 8; ++e) run[e] = lbase[e];
                    const int nent = 2 * chunk;
                    for (int r0 = 0; r0 < nent; r0 += 64) { const int idx = r0 + lane; const int t = blk * chunk + (idx >> 1); const bool ok = idx < nent && t < T;
                        const int e = ok ? tok_e[2 * t + (idx & 1)] : -1; int pos = 0;
#pragma unroll
                        for (int ee = 0; ee < 8; ++ee) { const unsigned long long mk = __ballot(e == ee); if (e == ee) pos = run[ee] + __popcll(mk & ((1ull << lane) - 1ull)); run[ee] += __popcll(mk); }
                        if (ok) { tok_pos[2 * t + (idx & 1)] = pos; row_gate[pos] = tok_g[2 * t + (idx & 1)]; row_rs[pos] = pg8::row_rs16(ssp_c, t); lpos[idx] = pos; } }
                }
                __syncthreads();
                for (int idx = wave; idx < 2 * chunk; idx += NWAVES) { const int t = blk * chunk + (idx >> 1); if (t >= T) break; const int pos = lpos[idx];
                    const GAS v4u* src = (const GAS v4u*)(xb + (size_t)t * D); const v4u a = src[2 * lane], c = src[2 * lane + 1];
                    v4u o; o.x = pg8::pk4_fp8(bflo(a.x), bfhi(a.x), bflo(a.y), bfhi(a.y)); o.y = pg8::pk4_fp8(bflo(a.z), bfhi(a.z), bflo(a.w), bfhi(a.w));
                    o.z = pg8::pk4_fp8(bflo(c.x), bfhi(c.x), bflo(c.y), bfhi(c.y)); o.w = pg8::pk4_fp8(bflo(c.z), bfhi(c.z), bflo(c.w), bfhi(c.w));
                    *((GAS v4u*)((unsigned char*)Ag + (size_t)pos * D) + lane) = o; }
                if (blk < NEXP) { const int r0 = lseg[blk] + lseg[8 + blk], r1 = lseg[16 + blk];
                    for (int r = r0 + wave; r < r1; r += NWAVES) { GAS v4u* dst = (GAS v4u*)((unsigned char*)Ag + (size_t)r * D); unsigned z0; asm volatile("v_mov_b32 %0, 0" : "=v"(z0)); const v4u z = {z0, z0, z0, z0}; dst[lane] = z; if (lane == 0) { row_gate[r] = 0.f; row_rs[r] = 0.f; } } }
                __syncthreads();
            }
            PH_END;
            if (PH_ON) { PH_VARS;
                pg8::MoeOrder S;
#pragma unroll
                for (int e = 0; e < 8; ++e) S.te[e] = __builtin_amdgcn_readfirstlane(meta[e]);
                S.nNl = 2 * FFE / 256; S.so.init(S.te[7] * 256, 2 * FFE, G, blk);
                pg8::Gemm g{Ag, W13m_t + (size_t)(l >> 1) * NEXP * 2 * FFE * (D / 2), MP, NEXP * 2 * FFE, D / 2};
                pg8::EpiSwiGLU8 E{(unsigned char*)hbuf, FFE, row_rs, 2 * FFE / 256, 1.0f / F8_S1, F8_SH, nullptr};
                pg8::gemm_phase<pg8::EpiSwiGLU8, pg8::MoeOrder, true, true, true>(lds, g, S, E, tid);
#if PROBE & (1 | 512)
                pg8::gemm_phase<pg8::EpiSwiGLU8, pg8::MoeOrder, true, true, true>(lds, g, S, E, tid);
#endif
            }
            PH_END;
            if (PH_ON) { PH_VARS;
                pg8::MoeOrder S;
#pragma unroll
                for (int e = 0; e < 8; ++e) S.te[e] = __builtin_amdgcn_readfirstlane(meta[e]);
                const int ntile = S.te[7], nmain = ntile < 256 ? ntile : 256;
                S.nNl = D / 256; S.so.init(nmain * 256, D, G, blk);
                pg8::Gemm g{hbuf, W2m_t + (size_t)(l >> 1) * NEXP * D * (FFE / 2), MP, NEXP * D, FFE / 2};
                pg8::EpiMoeOut E{ym, row_gate, 1.0f / (F8_S2 * F8_SH)};
                pg8::gemm_phase<pg8::EpiMoeOut, pg8::MoeOrder, true, true, true>(lds, g, S, E, tid);
#if PROBE & (1 | 512)
                pg8::gemm_phase<pg8::EpiMoeOut, pg8::MoeOrder, true, true, true>(lds, g, S, E, tid);
#endif
                if (ntile > 256) {
                    pg8::MoeTailOrder ST; ST.npieces = (ntile - 256) * 4 * 7; ST.G = G; ST.c = blk; ST.kstep = 512;
#pragma unroll
                    for (int e = 0; e < 8; ++e) ST.te[e] = S.te[e];
                    pg8::Gemm g2{hbuf, W2m_t + (size_t)(l >> 1) * NEXP * D * (FFE / 2), MP, NEXP * D, 256, FFE / 2};
                    pg8::EpiMoePart EP{ypart, row_gate, 1.0f / (F8_S2 * F8_SH), 9};
                    pg8::gemm_phase<pg8::EpiMoePart, pg8::MoeTailOrder, true, true, true>(lds, g2, ST, EP, tid);
                }
            }
            PH_END;
            if (PH_ON) { PH_VARS;
                const bool last = (l == DEPTH - 1);
                for (int t = gw; t < T; t += NGW) {
                    const int p0 = tok_pos[2 * t], p1 = tok_pos[2 * t + 1];
                    const GAS u32x2* xr = (const GAS u32x2*)(xb + (size_t)t * D) + lane; const GAS u32x2* y0 = (const GAS u32x2*)(ym + (size_t)p0 * D) + lane; const GAS u32x2* y1 = (const GAS u32x2*)(ym + (size_t)p1 * D) + lane;
                    f32x4 v[4]; float s = 0.f;
#pragma unroll
                    for (int j = 0; j < 4; ++j) { const u32x2 a = xr[64 * j]; f32x4 e0, e1;
                        if (p0 < 65536) { const u32x2 b0 = y0[64 * j]; e0 = (f32x4){bflo(b0.x), bfhi(b0.x), bflo(b0.y), bfhi(b0.y)}; }
                        else { e0 = (f32x4){0.f, 0.f, 0.f, 0.f};
                            for (int kp = 0; kp < 7; ++kp) { const u32x2 b0 = *((const GAS u32x2*)(ypart + ((size_t)kp * 2048 + (p0 - 65536)) * D) + lane + 64 * j); e0 += (f32x4){bflo(b0.x), bfhi(b0.x), bflo(b0.y), bfhi(b0.y)}; } }
                        if (p1 < 65536) { const u32x2 b1 = y1[64 * j]; e1 = (f32x4){bflo(b1.x), bfhi(b1.x), bflo(b1.y), bfhi(b1.y)}; }
                        else { e1 = (f32x4){0.f, 0.f, 0.f, 0.f};
                            for (int kp = 0; kp < 7; ++kp) { const u32x2 b1 = *((const GAS u32x2*)(ypart + ((size_t)kp * 2048 + (p1 - 65536)) * D) + lane + 64 * j); e1 += (f32x4){bflo(b1.x), bfhi(b1.x), bflo(b1.y), bfhi(b1.y)}; } }
                        v[j] = ((f32x4){bflo(a.x), bfhi(a.x), bflo(a.y), bfhi(a.y)} + e0) + e1;
                        s += (v[j].x * v[j].x + v[j].y * v[j].y) + (v[j].z * v[j].z + v[j].w * v[j].w); }
                    s = wave_sum(s, lane);
                    GAS f32x4* orow = (GAS f32x4*)(out + (size_t)t * D) + lane;
                    if (last) { const float r = 1.0f / sqrtf(s * (1.0f / D) + 1e-6f); const GAS f32x4* gr = (const GAS f32x4*)fin_g + lane;
#pragma unroll
                        for (int j = 0; j < 4; ++j) orow[64 * j] = v[j] * r * gr[64 * j]; }
                    else { GAS unsigned long long* o8 = (GAS unsigned long long*)(xb + (size_t)t * D) + lane;
#pragma unroll
                        for (int j = 0; j < 4; ++j) o8[64 * j] = (unsigned long long)pk2(v[j].x, v[j].y) | ((unsigned long long)pk2(v[j].z, v[j].w) << 32);
                        { GAS unsigned* o4 = (GAS unsigned*)((unsigned char*)Ag + (size_t)t * D) + lane;
#pragma unroll
                          for (int j = 0; j < 4; ++j) o4[64 * j] = pg8::pk4_fp8(v[j].x, v[j].y, v[j].z, v[j].w); }
                        if (lane < 16) ssp_d[(size_t)t * 16 + lane] = lane == 0 ? s : 0.f; }
                }
            }
            if (l != DEPTH - 1) { PH_END; }
        }
    }
#undef PH_ON
#undef PH_END
}
#undef x_in
#undef mem_in
#undef rel_bias
#undef mem_g
#undef mix_g
#undef w_in
#undef conv_w
#undef pool_w
#undef pool_scale
#undef w_out
#undef xat_g
#undef wq_x
#undef wkv_x
#undef wo_x
#undef ffn_g
#undef w13_d
#undef w2_d
#undef router_w
#undef w13_m
#undef w2_m
#undef fin_g
#undef out
#undef Win_t
#undef Wout_t
#undef Wq_t
#undef Wkv_t
#undef Wo_t
#undef W13d_t
#undef W2d_t
#undef W13m_t
#undef W2m_t
#undef xb
#undef qx
#undef ox
#undef Ag
#undef ym
#undef proj
#undef ymix
#undef hbuf
#undef kvx
#undef memn
#undef ssp
#undef cnts
#undef meta
#undef tok_e
#undef tok_g
#undef tok_pos
#undef row_gate
#undef row_rs
#undef ssp_a
#undef ssp_b
#undef ssp_c
#undef ssp_d
#undef PH_VARS
#undef ypart
#undef chunk
#undef vtb
#undef opart
#undef lsep
#undef vtx

extern "C" void kernel_launch(void* const* d_in, const int* in_sizes, int n_in, void* d_out, int out_size, void* d_ws, size_t ws_size, hipStream_t stream) {
    static int grid = 0;
    if (grid == 0) {
        if (n_in != 21 || in_sizes[0] != T * D || out_size != T * D || ws_size < WS_END) { fprintf(stderr, "kernel_launch: unexpected shapes: n_in %d in0 %d out %d ws %zu (need %zu)\n", n_in, n_in > 0 ? in_sizes[0] : -1, out_size, ws_size, (size_t)WS_END); grid = -1; return; }
        int dev = 0, cus = 0, per_cu = 0;
        if (hipGetDevice(&dev) != hipSuccess || hipDeviceGetAttribute(&cus, hipDeviceAttributeMultiprocessorCount, dev) != hipSuccess) { fprintf(stderr, "kernel_launch: device query failed\n"); grid = -1; return; }
        if (hipFuncSetAttribute((const void*)trunk_fwd, hipFuncAttributeMaxDynamicSharedMemorySize, LDS_BYTES) != hipSuccess) { fprintf(stderr, "kernel_launch: hipFuncSetAttribute failed\n"); grid = -1; return; }
        if (hipOccupancyMaxActiveBlocksPerMultiprocessor(&per_cu, (const void*)trunk_fwd, NWAVES * 64, LDS_BYTES) != hipSuccess || per_cu < 1) fprintf(stderr, "kernel_launch: occupancy query reports %d\n", per_cu);
        (void)hipGetLastError();
        if (cus != T / 256 * 2) { fprintf(stderr, "kernel_launch: the team mapping needs %d CUs, device has %d\n", T / 256 * 2, cus); grid = -1; return; }
        grid = cus;
    }
    if (grid < 0) return;
    if (hipMemsetAsync((char*)d_ws + WS_CTL, 0, CTL_ZERO_BYTES, stream) != hipSuccess) { fprintf(stderr, "kernel_launch: memset failed\n"); return; }
    Args a{};
    for (int i = 0; i < 21; ++i) a.in[i] = (const float*)d_in[i];
    a.out = (float*)d_out; a.ws = (unsigned char*)d_ws;
#if N_LAUNCH_MODE == 0
    a.ph_lo = 0; a.ph_hi = NPH;
    hipLaunchKernelGGL(trunk_fwd, dim3(grid), dim3(NWAVES * 64), LDS_BYTES, stream, a);
#else
    for (int p = 0; p < NPH; ++p) { a.ph_lo = p; a.ph_hi = p + 1; hipLaunchKernelGGL(trunk_fwd, dim3(grid), dim3(NWAVES * 64), LDS_BYTES, stream, a); }
#endif
    const hipError_t le = hipPeekAtLastError();
    if (le != hipSuccess) fprintf(stderr, "kernel_launch: launch failed: %s\n", hipGetErrorName(le));
}
```

```cpp
#define PROBE 0
#include <hip/hip_runtime.h>
#include <cstdio>
#include <cstdint>
namespace pg8 {
#define PG8_LAS __attribute__((address_space(3)))
typedef unsigned short bf16_t;
typedef short bf16x8 __attribute__((ext_vector_type(8)));
typedef float f32x4 __attribute__((ext_vector_type(4)));
typedef unsigned u32x4 __attribute__((ext_vector_type(4)));
typedef int v4i_t __attribute__((ext_vector_type(4)));
typedef long v2l_t __attribute__((ext_vector_type(2)));
typedef int v8i_t __attribute__((ext_vector_type(8)));
constexpr int BM = 256, BK = 64, HALF = 128, HTB = HALF * BK * 2  , STAGE_BYTES = 8 * HTB, NXCD = 8, WGM = 8;

__host__ __device__ __forceinline__ int lds_byte(int r, int c) { const int st = (r >> 4) * 2 + (c >> 5), rr = r & 15, cc = c & 31, ob = rr * 64 + cc * 2; return st * 1024 + (ob ^ (((ob >> 9) & 1) << 5)); }
__host__ __device__ __forceinline__ void stage_rc(int b, int& R, int& C) { const int st = b / 1024, sb = b % 1024, swz = sb ^ (((sb >> 9) & 1) << 5); R = (st >> 1) * 16 + swz / 64; C = (st & 1) * 32 + (swz % 64) / 2; }
__host__ __device__ __forceinline__ int perm32(int rho) { const int n = rho >> 4, i = rho & 15; return 8 * (i >> 2) + 4 * n + (i & 3); }

struct Unit { int pm, pn; int ko = 0; };
struct Gemm { const bf16_t* A; const bf16_t* Bt; int M, N, K; int ld = 0; };

struct StaticOrder {
    int nM, nN, nwg, G, c;
    __host__ __device__ void init(int M, int N, int G_, int c_) { nM = M / BM; nN = N / BM; nwg = nM * nN; G = G_; c = c_; }
    __host__ __device__ __forceinline__ bool next(int i, Unit& u) const {
        const long L = (long)i * G + c; if (L >= nwg) return false;
        int wgid = (int)L; { const int q = nwg / NXCD, r = nwg % NXCD, xcd = wgid % NXCD, off = wgid / NXCD; wgid = (xcd < r ? xcd * (q + 1) : r * (q + 1) + (xcd - r) * q) + off; }
        const int nig = WGM * nN, gid = wgid / nig, fm = gid * WGM, gsz = (nM - fm) < WGM ? (nM - fm) : WGM;
        u.pm = fm + ((wgid % nig) % gsz); u.pn = (wgid % nig) / gsz; return true;
    }
    __device__ __forceinline__ void a_ready(const Unit&) const {}
    __device__ __forceinline__ void done(const Unit&) const {}
};

__device__ __forceinline__ unsigned cvt_pk_bf16(float lo, float hi) { unsigned r; asm volatile("v_cvt_pk_bf16_f32 %0, %1, %2" : "=v"(r) : "v"(lo), "v"(hi)); return r; }
typedef float f32x2 __attribute__((ext_vector_type(2)));
__device__ __forceinline__ float row_rs16(const float* ssp, int row) {
    const f32x4* sp = (const f32x4*)(ssp + (size_t)row * 16); const f32x4 s0 = sp[0], s1 = sp[1], s2 = sp[2], s3 = sp[3];
    const float s = (((s0[0] + s0[1]) + (s0[2] + s0[3])) + ((s1[0] + s1[1]) + (s1[2] + s1[3]))) + (((s2[0] + s2[1]) + (s2[2] + s2[3])) + ((s3[0] + s3[1]) + (s3[2] + s3[3])));
    return __builtin_amdgcn_rsqf(s * (1.0f / 1024.0f) + 1e-6f);
}
__device__ __forceinline__ void row_rs16x8(float (&r)[8], const float* ssp, int row0, int fr, int fq) {
    f32x4 c[8];
#pragma unroll
    for (int k = 0; k < 8; ++k) c[k] = *(const f32x4*)(ssp + (size_t)(row0 + (k >> 2) * HALF + (k & 3) * 16) * 16 + 4 * fq);
#pragma unroll
    for (int k = 0; k < 8; ++k) { float s = (c[k][0] + c[k][1]) + (c[k][2] + c[k][3]);
        s += __int_as_float(__builtin_amdgcn_ds_bpermute((((fq * 16 + fr) ^ 16) << 2), __float_as_int(s)));
        { const auto rr = __builtin_amdgcn_permlane32_swap(__float_as_uint(s), __float_as_uint(s), false, false); s = __uint_as_float(rr[0]) + __uint_as_float(rr[1]); }
        r[k] = __builtin_amdgcn_rsqf(s * (1.0f / 1024.0f) + 1e-6f); }
}
struct EpiRowScale {
    static constexpr bool PERM = true, AFTER_DRAIN = false;
    bf16_t* O; int ldc; const float* ssp; float cs;
    __device__ __forceinline__ void operator()(const f32x4 (&acc)[2][2][4][2], const Unit& u, int wr, int wc, int fr, int fq) const {
        const int row0 = u.pm * BM + wr * 64 + fr, col0 = u.pn * BM + wc * 32 + 8 * fq;
        float rr8[8];
        if (ssp) row_rs16x8(rr8, ssp, row0, fr, fq); else {
#pragma unroll
            for (int k = 0; k < 8; ++k) rr8[k] = 1.0f; }
#pragma unroll
        for (int ai = 0; ai < 2; ++ai)
#pragma unroll
            for (int m = 0; m < 4; ++m) { const int row = row0 + ai * HALF + m * 16; const float r = rr8[ai * 4 + m] * cs; bf16_t* rowp = O + (size_t)row * ldc + col0;
#pragma unroll
                for (int bj = 0; bj < 2; ++bj) { const f32x4 v0 = acc[ai][bj][m][0] * r, v1 = acc[ai][bj][m][1] * r;
                    u32x4 w; w.x = cvt_pk_bf16(v0[0], v0[1]); w.y = cvt_pk_bf16(v0[2], v0[3]); w.z = cvt_pk_bf16(v1[0], v1[1]); w.w = cvt_pk_bf16(v1[2], v1[3]);
                    *(u32x4*)(rowp + bj * HALF) = w; } }
    }
};
struct EpiInProj {
    static constexpr bool PERM = true, AFTER_DRAIN = false;
    bf16_t* O; const float* ssp; bf16_t* vt;
    __device__ __forceinline__ void operator()(const f32x4 (&acc)[2][2][4][2], const Unit& u, int wr, int wc, int fr, int fq) const {
        const int row0 = u.pm * BM + wr * 64 + fr;
        if (u.pn == 4 || u.pn == 5) {
            const int cv0 = (u.pn - 4) * BM + wc * 32 + 8 * fq; constexpr size_t CS = (size_t)32768 * 512;
#pragma unroll
            for (int ai = 0; ai < 2; ++ai)
#pragma unroll
                for (int m = 0; m < 4; ++m) { const int row = row0 + ai * HALF + m * 16; const float r = row_rs16(ssp, row); const int b = row >> 13, t = row & 8191;
                    const size_t o0 = (size_t)t, o1 = CS + (size_t)(t & 3) * 2048 + (t >> 2), o2 = 2 * CS + (size_t)(t & 15) * 512 + (t >> 4);
#pragma unroll
                    for (int bj = 0; bj < 2; ++bj)
#pragma unroll
                        for (int n = 0; n < 2; ++n) { const f32x4 v = acc[ai][bj][m][n] * r; const unsigned w01 = cvt_pk_bf16(v[0], v[1]), w23 = cvt_pk_bf16(v[2], v[3]);
                            bf16_t* p = vt + (size_t)(b * 512 + cv0 + bj * HALF + 4 * n) * 8192;
                            const bf16_t e0 = (bf16_t)(w01 & 0xffffu), e1 = (bf16_t)(w01 >> 16), e2 = (bf16_t)(w23 & 0xffffu), e3 = (bf16_t)(w23 >> 16);
                            p[o0] = e0; p[o1] = e0; p[o2] = e0; p[8192 + o0] = e1; p[8192 + o1] = e1; p[8192 + o2] = e1;
                            p[2 * 8192 + o0] = e2; p[2 * 8192 + o1] = e2; p[2 * 8192 + o2] = e2; p[3 * 8192 + o0] = e3; p[3 * 8192 + o1] = e3; p[3 * 8192 + o2] = e3; } }
        } else {
            const int col0 = u.pn * BM + wc * 32 + 8 * fq;
#pragma unroll
            for (int ai = 0; ai < 2; ++ai)
#pragma unroll
                for (int m = 0; m < 4; ++m) { const int row = row0 + ai * HALF + m * 16; const float r = row_rs16(ssp, row); bf16_t* rowp = O + (size_t)row * 2560 + col0;
#pragma unroll
                    for (int bj = 0; bj < 2; ++bj) { const f32x4 v0 = acc[ai][bj][m][0] * r, v1 = acc[ai][bj][m][1] * r;
                        u32x4 w; w.x = cvt_pk_bf16(v0[0], v0[1]); w.y = cvt_pk_bf16(v0[2], v0[3]); w.z = cvt_pk_bf16(v1[0], v1[1]); w.w = cvt_pk_bf16(v1[2], v1[3]);
                        *(u32x4*)(rowp + bj * HALF) = w; } }
        }
    }
};
struct EpiKV {
    static constexpr bool PERM = true, AFTER_DRAIN = false;
    bf16_t* kvx; bf16_t* vtx;
    __device__ __forceinline__ void operator()(const f32x4 (&acc)[2][2][4][2], const Unit& u, int wr, int wc, int fr, int fq) const {
        const int row0 = u.pm * BM + wr * 64 + fr, col0 = u.pn * BM + wc * 32 + 8 * fq;
        if ((u.pn & 3) >= 2) {
            const int lx = u.pn >> 2, dv0 = (col0 & 1023) - 512;
#pragma unroll
            for (int ai = 0; ai < 2; ++ai)
#pragma unroll
                for (int m = 0; m < 4; ++m) { const int row = row0 + ai * HALF + m * 16; const int b = row >> 8, key = row & 255;
#pragma unroll
                    for (int bj = 0; bj < 2; ++bj)
#pragma unroll
                        for (int n = 0; n < 2; ++n) { const f32x4 v = acc[ai][bj][m][n]; const unsigned w01 = cvt_pk_bf16(v[0], v[1]), w23 = cvt_pk_bf16(v[2], v[3]);
                            bf16_t* p = vtx + ((size_t)((lx * 4 + b) * 512 + dv0 + bj * HALF + 4 * n)) * 256 + key;
                            p[0] = (bf16_t)(w01 & 0xffffu); p[256] = (bf16_t)(w01 >> 16); p[512] = (bf16_t)(w23 & 0xffffu); p[768] = (bf16_t)(w23 >> 16); } }
        } else {
#pragma unroll
            for (int ai = 0; ai < 2; ++ai)
#pragma unroll
                for (int m = 0; m < 4; ++m) { const int row = row0 + ai * HALF + m * 16; bf16_t* rowp = kvx + (size_t)row * 4096 + col0;
#pragma unroll
                    for (int bj = 0; bj < 2; ++bj) { const f32x4 v0 = acc[ai][bj][m][0], v1 = acc[ai][bj][m][1];
                        u32x4 w; w.x = cvt_pk_bf16(v0[0], v0[1]); w.y = cvt_pk_bf16(v0[2], v0[3]); w.z = cvt_pk_bf16(v1[0], v1[1]); w.w = cvt_pk_bf16(v1[2], v1[3]);
                        *(u32x4*)(rowp + bj * HALF) = w; } }
        }
    }
};
__device__ __forceinline__ float silu_mul(float g, float u) { return g * u * __builtin_amdgcn_rcpf(1.0f + __expf(-g)); }
struct EpiSwiGLU {
    static constexpr bool PERM = true, AFTER_DRAIN = false;
    bf16_t* O; int ldc; const float* ssp; const float* rmul; int pn_mod;
    __device__ __forceinline__ void operator()(const f32x4 (&acc)[2][2][4][2], const Unit& u, int wr, int wc, int fr, int fq) const {
        const int pnl = pn_mod ? (u.pn % pn_mod) : u.pn;
        const int row0 = u.pm * BM + wr * 64 + fr, col0 = pnl * HALF + wc * 32 + 8 * fq;
        float rr8[8];
        if (ssp) row_rs16x8(rr8, ssp, row0, fr, fq); else {
#pragma unroll
            for (int k = 0; k < 8; ++k) rr8[k] = rmul[row0 + (k >> 2) * HALF + (k & 3) * 16]; }
#pragma unroll
        for (int ai = 0; ai < 2; ++ai)
#pragma unroll
            for (int m = 0; m < 4; ++m) { const int row = row0 + ai * HALF + m * 16; const float r = rr8[ai * 4 + m];
                const f32x4 g0 = acc[ai][0][m][0] * r, g1 = acc[ai][0][m][1] * r, u0 = acc[ai][1][m][0] * r, u1 = acc[ai][1][m][1] * r;
                u32x4 w; w.x = cvt_pk_bf16(silu_mul(g0[0], u0[0]), silu_mul(g0[1], u0[1])); w.y = cvt_pk_bf16(silu_mul(g0[2], u0[2]), silu_mul(g0[3], u0[3]));
                w.z = cvt_pk_bf16(silu_mul(g1[0], u1[0]), silu_mul(g1[1], u1[1])); w.w = cvt_pk_bf16(silu_mul(g1[2], u1[2]), silu_mul(g1[3], u1[3]));
                *(u32x4*)(O + (size_t)row * ldc + col0) = w; }
    }
};
__device__ __forceinline__ float sat8(float v) { return __builtin_amdgcn_fmed3f(v, -448.0f, 448.0f); }
__device__ __forceinline__ unsigned pk4_fp8_w(float a, float b, float c, float d) { int r = __builtin_amdgcn_cvt_pk_fp8_f32(a, b, 0, false); r = __builtin_amdgcn_cvt_pk_fp8_f32(c, d, r, true); return (unsigned)r; }
__device__ __forceinline__ unsigned pk4_fp8(float a, float b, float c, float d) { int r = __builtin_amdgcn_cvt_pk_fp8_f32(sat8(a), sat8(b), 0, false); r = __builtin_amdgcn_cvt_pk_fp8_f32(sat8(c), sat8(d), r, true); return (unsigned)r; }
struct EpiSwiGLU8 {
    static constexpr bool PERM = true, AFTER_DRAIN = false;
    unsigned char* O; int ldc; const float* rmul; int pn_mod; float cs, hs; const float* ssp;
    __device__ __forceinline__ void operator()(const f32x4 (&acc)[2][2][4][2], const Unit& u, int wr, int wc, int fr, int fq) const {
        const int pnl = pn_mod ? (u.pn % pn_mod) : u.pn;
        const int row0 = u.pm * BM + wr * 64 + fr, col0 = pnl * HALF + wc * 32 + 8 * fq;
        float rr8[8];
        if (ssp) row_rs16x8(rr8, ssp, row0, fr, fq); else {
#pragma unroll
            for (int k = 0; k < 8; ++k) rr8[k] = rmul[row0 + (k >> 2) * HALF + (k & 3) * 16]; }
#pragma unroll
        for (int ai = 0; ai < 2; ++ai)
#pragma unroll
            for (int m = 0; m < 4; ++m) { const int row = row0 + ai * HALF + m * 16; const float r = rr8[ai * 4 + m] * cs, r2 = r * -1.4426950408889634f, rrh = r * r * hs;
                unsigned w[2];
#pragma unroll
                for (int n = 0; n < 2; ++n) { const f32x4 ag = acc[ai][0][m][n], au = acc[ai][1][m][n]; const f32x4 t = ag * r2;
                    f32x4 d; d[0] = __builtin_amdgcn_exp2f(t[0]); d[1] = __builtin_amdgcn_exp2f(t[1]); d[2] = __builtin_amdgcn_exp2f(t[2]); d[3] = __builtin_amdgcn_exp2f(t[3]);
                    d = d + 1.0f;
                    f32x4 iv; iv[0] = __builtin_amdgcn_rcpf(d[0]); iv[1] = __builtin_amdgcn_rcpf(d[1]); iv[2] = __builtin_amdgcn_rcpf(d[2]); iv[3] = __builtin_amdgcn_rcpf(d[3]);
                    const f32x4 hv = ((ag * au) * rrh) * iv;
                    w[n] = pk4_fp8(hv[0], hv[1], hv[2], hv[3]); }
                typedef unsigned u32x2_t __attribute__((ext_vector_type(2)));
                *(u32x2_t*)(O + (size_t)row * ldc + col0) = (u32x2_t){w[0], w[1]}; }
    }
};
struct EpiResid {
    static constexpr bool PERM = true, AFTER_DRAIN = false;
    const float* base32; bf16_t* xb; float* ssp_out; unsigned char* xb8; float cs; int w8;
    __device__ __forceinline__ void operator()(const f32x4 (&acc)[2][2][4][2], const Unit& u, int wr, int wc, int fr, int fq) const {
        const int row0 = u.pm * BM + wr * 64 + fr, col0 = u.pn * BM + wc * 32 + 8 * fq;
        u32x4 xw[2][4][2];
        if (!base32) {
#pragma unroll
            for (int ai = 0; ai < 2; ++ai)
#pragma unroll
                for (int m = 0; m < 4; ++m)
#pragma unroll
                    for (int bj = 0; bj < 2; ++bj) xw[ai][m][bj] = *(const u32x4*)(xb + (size_t)(row0 + ai * HALF + m * 16) * 1024 + col0 + bj * HALF);
        }
#pragma unroll
        for (int ai = 0; ai < 2; ++ai)
#pragma unroll
            for (int m = 0; m < 4; ++m) { const int row = row0 + ai * HALF + m * 16; const size_t off = (size_t)row * 1024 + col0; float q = 0.f;
#pragma unroll
                for (int bj = 0; bj < 2; ++bj) { f32x4 b0, b1;
                    if (base32) { b0 = *(const f32x4*)(base32 + off + bj * HALF); b1 = *(const f32x4*)(base32 + off + bj * HALF + 4); }
                    else { const u32x4 w4 = xw[ai][m][bj];
                        b0 = (f32x4){__uint_as_float(w4.x << 16), __uint_as_float(w4.x & 0xffff0000u), __uint_as_float(w4.y << 16), __uint_as_float(w4.y & 0xffff0000u)};
                        b1 = (f32x4){__uint_as_float(w4.z << 16), __uint_as_float(w4.z & 0xffff0000u), __uint_as_float(w4.w << 16), __uint_as_float(w4.w & 0xffff0000u)}; }
                    const f32x4 v0 = b0 + acc[ai][bj][m][0] * cs, v1 = b1 + acc[ai][bj][m][1] * cs;
                    u32x4 w; w.x = cvt_pk_bf16(v0[0], v0[1]); w.y = cvt_pk_bf16(v0[2], v0[3]); w.z = cvt_pk_bf16(v1[0], v1[1]); w.w = cvt_pk_bf16(v1[2], v1[3]);
                    *(u32x4*)(xb + off + bj * HALF) = w;
                    if (w8) { typedef unsigned u32x2_t __attribute__((ext_vector_type(2))); *(u32x2_t*)(xb8 + off + bj * HALF) = (u32x2_t){pk4_fp8(v0[0], v0[1], v0[2], v0[3]), pk4_fp8(v1[0], v1[1], v1[2], v1[3])}; }
                    q += ((v0[0] * v0[0] + v0[1] * v0[1]) + (v0[2] * v0[2] + v0[3] * v0[3])) + ((v1[0] * v1[0] + v1[1] * v1[1]) + (v1[2] * v1[2] + v1[3] * v1[3])); }
                q += __int_as_float(__builtin_amdgcn_ds_bpermute((((fq * 16 + fr) ^ 16) << 2), __float_as_int(q)));
                { const auto rr = __builtin_amdgcn_permlane32_swap(__float_as_uint(q), __float_as_uint(q), false, false); q = __uint_as_float(rr[0]) + __uint_as_float(rr[1]); }
                if (fq == 0) ssp_out[(size_t)row * 16 + u.pn * 4 + wc] = q;
                if (base32 && (m & 1)) asm volatile("" ::: "memory"); }
    }
};
struct EpiMoeOut {
    static constexpr bool PERM = true, AFTER_DRAIN = false;
    bf16_t* Y; const float* gate; float cs = 1.0f;
    __device__ __forceinline__ void operator()(const f32x4 (&acc)[2][2][4][2], const Unit& u, int wr, int wc, int fr, int fq) const {
        const int row0 = u.pm * BM + wr * 64 + fr, col0 = (u.pn & 3) * BM + wc * 32 + 8 * fq;
#pragma unroll
        for (int ai = 0; ai < 2; ++ai)
#pragma unroll
            for (int m = 0; m < 4; ++m) { const int row = row0 + ai * HALF + m * 16; const float gt = gate[row] * cs; bf16_t* rowp = Y + (size_t)row * 1024 + col0;
#pragma unroll
                for (int bj = 0; bj < 2; ++bj) { const f32x4 v0 = acc[ai][bj][m][0] * gt, v1 = acc[ai][bj][m][1] * gt;
                    u32x4 w; w.x = cvt_pk_bf16(v0[0], v0[1]); w.y = cvt_pk_bf16(v0[2], v0[3]); w.z = cvt_pk_bf16(v1[0], v1[1]); w.w = cvt_pk_bf16(v1[2], v1[3]);
                    *(u32x4*)(rowp + bj * HALF) = w; } }
    }
};
struct EpiNull {
    static constexpr bool PERM = true, AFTER_DRAIN = false;
    float* sink;
    __device__ __forceinline__ void operator()(const f32x4 (&acc)[2][2][4][2], const Unit& u, int wr, int wc, int fr, int fq) const {
        float s = 0.f;
#pragma unroll
        for (int ai = 0; ai < 2; ++ai)
#pragma unroll
            for (int bj = 0; bj < 2; ++bj)
#pragma unroll
                for (int m = 0; m < 4; ++m)
#pragma unroll
                    for (int n = 0; n < 2; ++n) s += (acc[ai][bj][m][n][0] + acc[ai][bj][m][n][1]) + (acc[ai][bj][m][n][2] + acc[ai][bj][m][n][3]);
        if (s == 12345.6789f) sink[u.pm * 4 + wr] = s;
    }
};
struct EpiMoePart {
    static constexpr bool PERM = true, AFTER_DRAIN = false;
    bf16_t* P; const float* gate; float cs = 1.0f; int kshift = 10;
    __device__ __forceinline__ void operator()(const f32x4 (&acc)[2][2][4][2], const Unit& u, int wr, int wc, int fr, int fq) const {
        const int row0 = u.pm * BM + wr * 64 + fr, col0 = (u.pn & 3) * BM + wc * 32 + 8 * fq; bf16_t* base = P + (size_t)(u.ko >> kshift) * (2048 * 1024);
#pragma unroll
        for (int ai = 0; ai < 2; ++ai)
#pragma unroll
            for (int m = 0; m < 4; ++m) { const int row = row0 + ai * HALF + m * 16; const float gt = gate[row] * cs; bf16_t* rowp = base + (size_t)(row - 65536) * 1024 + col0;
#pragma unroll
                for (int bj = 0; bj < 2; ++bj) { const f32x4 v0 = acc[ai][bj][m][0] * gt, v1 = acc[ai][bj][m][1] * gt;
                    u32x4 w; w.x = cvt_pk_bf16(v0[0], v0[1]); w.y = cvt_pk_bf16(v0[2], v0[3]); w.z = cvt_pk_bf16(v1[0], v1[1]); w.w = cvt_pk_bf16(v1[2], v1[3]);
                    *(u32x4*)(rowp + bj * HALF) = w; } }
    }
};
struct MoeTailOrder {
    int npieces, G, c; int te[8]; int kstep = 1024;
    __device__ __forceinline__ bool next(int i, Unit& u) const {
        const int p = i * G + c; if (p >= npieces) return false;
        const int tt = p / 7, kp = p - tt * 7; const int pm = 256 + (tt >> 2);
        int e = 0;
#pragma unroll
        for (int k = 0; k < 7; ++k) e += (pm >= te[k]) ? 1 : 0;
        u.pm = pm; u.pn = e * 4 + (tt & 3); u.ko = kp * kstep; return true;
    }
    __device__ __forceinline__ void a_ready(const Unit&) const {}
    __device__ __forceinline__ void done(const Unit&) const {}
};
struct TeamOrder {
    int pm, pn0, npn;
    __device__ __forceinline__ bool next(int i, Unit& u) const { if (i >= npn) return false; u.pm = pm; u.pn = pn0 + i; return true; }
    __device__ __forceinline__ void a_ready(const Unit&) const {}
    __device__ __forceinline__ void done(const Unit&) const {}
};
struct MoeOrder {
    StaticOrder so; int nNl; int te[8];
    __device__ __forceinline__ bool next(int i, Unit& u) const {
        if (!so.next(i, u)) return false;
        int e = 0;
#pragma unroll
        for (int k = 0; k < 7; ++k) e += (u.pm >= te[k]) ? 1 : 0;
        u.pn += e * nNl; return true;
    }
    __device__ __forceinline__ void a_ready(const Unit&) const {}
    __device__ __forceinline__ void done(const Unit&) const {}
};

template <class Epi, class Sched, bool ALIGN_EPI = false, bool SP2 = false, bool F8 = false>
__device__ __forceinline__ void gemm_phase(PG8_LAS unsigned char* lds, const Gemm g, const Sched& S, const Epi& E, const int tid) {
    const int wid = __builtin_amdgcn_readfirstlane(tid >> 6), lane = tid & 63, wr = wid >> 2, wc = wid & 3, fr = lane & 15, fq = lane >> 4;
    const int K = g.K, nt = K / BK, LD = g.ld ? g.ld : K;
    unsigned voffA[2], voffB[2];
#pragma unroll
    for (int i = 0; i < 2; ++i) { int R, C; stage_rc(tid * 16 + i * 8192, R, C); const int Rb = Epi::PERM ? ((R & ~31) + perm32(R & 31)) : R;
        voffA[i] = (unsigned)(R * LD + C) * 2u; voffB[i] = (unsigned)(Rb * LD + C) * 2u; }
    const size_t kstep = (size_t)(BK * 2);
    const size_t hstep = (size_t)HALF * LD * 2;
    const size_t tstep = 2 * hstep;
    const unsigned ldsw = (unsigned)wid * 1024u;
    const int aoff = lds_byte(wr * 64 + fr, fq * 8), boff = lds_byte(wc * 32 + fr, fq * 8);
#define PG8_SA(b, h) (((b) * 2 + (h)) * HTB)
#define PG8_SB(b, h) ((4 + (b) * 2 + (h)) * HTB)
#define PG8_STAGE(bufoff, gbase, voff) do { _Pragma("unroll") for (int _i = 0; _i < 2; ++_i) \
        __builtin_amdgcn_global_load_lds((const unsigned*)((const char*)(gbase) + (voff)[_i]), (PG8_LAS unsigned*)(lds + (bufoff) + ldsw + _i * 8192), 16, 0, 0); } while (0)
#define PG8_CAT8(x, y) __builtin_shufflevector(__builtin_bit_cast(v4i_t, x), __builtin_bit_cast(v4i_t, y), 0, 1, 2, 3, 4, 5, 6, 7)
#define PG8_LDA(dst, b, h) do { _Pragma("unroll") for (int m = 0; m < 4; ++m) { if constexpr (F8) dst##8[m] = PG8_CAT8(*(const PG8_LAS bf16x8*)(lds + PG8_SA(b, h) + aoff + m * 2048), *(const PG8_LAS bf16x8*)(lds + PG8_SA(b, h) + aoff + m * 2048 + 1024)); \
        else { _Pragma("unroll") for (int k = 0; k < 2; ++k) dst[m][k] = *(const PG8_LAS bf16x8*)(lds + PG8_SA(b, h) + aoff + m * 2048 + k * 1024); } } } while (0)
#define PG8_LDB(dst, b, h) do { _Pragma("unroll") for (int n = 0; n < 2; ++n) { if constexpr (F8) dst##8[n] = PG8_CAT8(*(const PG8_LAS bf16x8*)(lds + PG8_SB(b, h) + boff + n * 2048), *(const PG8_LAS bf16x8*)(lds + PG8_SB(b, h) + boff + n * 2048 + 1024)); \
        else { _Pragma("unroll") for (int k = 0; k < 2; ++k) dst[n][k] = *(const PG8_LAS bf16x8*)(lds + PG8_SB(b, h) + boff + n * 2048 + k * 1024); } } } while (0)
#define PG8_MMA(ai, bj, At, Bt) do { __builtin_amdgcn_s_setprio(1); _Pragma("unroll") for (int m = 0; m < 4; ++m) _Pragma("unroll") for (int n = 0; n < 2; ++n) { \
        if constexpr (F8) asm volatile("v_mfma_scale_f32_16x16x128_f8f6f4 %0, %1, %2, %0, %3, %3 op_sel_hi:[0,0,0]" : "+v"(acc[ai][bj][m][n]) : "v"(Bt##8[n]), "v"(At##8[m]), "v"(f8scale)); \
        else { _Pragma("unroll") for (int k = 0; k < 2; ++k) acc[ai][bj][m][n] = __builtin_amdgcn_mfma_f32_16x16x32_bf16(Bt[n][k], At[m][k], acc[ai][bj][m][n], 0, 0, 0); } } __builtin_amdgcn_s_setprio(0); } while (0)
#define PG8_WAIT_V(n) asm volatile("s_waitcnt vmcnt(" #n ")" ::: "memory")
#define PG8_WAIT_L(n) asm volatile("s_waitcnt lgkmcnt(" #n ")" ::: "memory")
#define PG8_BAR __builtin_amdgcn_s_barrier()
#define PG8_SCHED __builtin_amdgcn_sched_barrier(0)
    Unit cur, nxt; int ui = 0;
    if (!S.next(0, cur)) return;
    f32x4 acc[2][2][4][2];
#pragma unroll
    for (int a = 0; a < 2; ++a)
#pragma unroll
        for (int b = 0; b < 2; ++b)
#pragma unroll
            for (int m = 0; m < 4; ++m)
#pragma unroll
                for (int n = 0; n < 2; ++n) acc[a][b][m][n] = (f32x4){0.f, 0.f, 0.f, 0.f};
    const int f8scale = 0x7f7f7f7f;
    bf16x8 At[4][2], B0[2][2], B1[2][2]; v8i_t At8[4], B08[2], B18[2];
    const char* cA = (const char*)g.A + (size_t)cur.pm * tstep + cur.ko; const char* cB = (const char*)g.Bt + (size_t)cur.pn * tstep + cur.ko;
    S.a_ready(cur);
    if constexpr (SP2) {
        PG8_STAGE(PG8_SB(0, 0), cB, voffB); PG8_STAGE(PG8_SB(0, 1), cB + hstep, voffB); PG8_STAGE(PG8_SA(0, 0), cA, voffA); PG8_STAGE(PG8_SA(0, 1), cA + hstep, voffA);
        if (wr == 1) PG8_BAR;
        PG8_WAIT_V(2); PG8_BAR;
        PG8_STAGE(PG8_SB(1, 0), cB + kstep, voffB); PG8_STAGE(PG8_SA(1, 0), cA + kstep, voffA); PG8_STAGE(PG8_SB(1, 1), cB + hstep + kstep, voffB);
        PG8_WAIT_V(6); PG8_BAR;
    } else {
        PG8_STAGE(PG8_SB(0, 0), cB, voffB); PG8_STAGE(PG8_SA(0, 0), cA, voffA); PG8_STAGE(PG8_SB(0, 1), cB + hstep, voffB); PG8_STAGE(PG8_SA(0, 1), cA + hstep, voffA);
        if (wr == 1) PG8_BAR;
        PG8_WAIT_V(4); PG8_BAR;
        PG8_STAGE(PG8_SB(1, 0), cB + kstep, voffB); PG8_STAGE(PG8_SA(1, 0), cA + kstep, voffA); PG8_STAGE(PG8_SB(1, 1), cB + hstep + kstep, voffB);
        PG8_WAIT_V(6); PG8_BAR;
    }
    for (;;) {
        const bool has_next = S.next(ui + 1, nxt);
        const char* nA = has_next ? (const char*)g.A + (size_t)nxt.pm * tstep + nxt.ko : cA; const char* nB = has_next ? (const char*)g.Bt + (size_t)nxt.pn * tstep + nxt.ko : cB;
        for (int t = 0; t < nt; t += 2) {
            const bool last = (t == nt - 2);
            const char* a1 = cA + (size_t)(t + 1) * kstep;
            const char* a2 = last ? nA : cA + (size_t)(t + 2) * kstep; const char* b2 = last ? nB : cB + (size_t)(t + 2) * kstep;
            const char* a3 = a2 + kstep; const char* b3 = b2 + kstep;
            if (last && has_next) S.a_ready(nxt);
            if constexpr (SP2) {
            PG8_LDB(B0, 0, 0); PG8_LDB(B1, 0, 1); PG8_SCHED; PG8_LDA(At, 0, 0); PG8_STAGE(PG8_SA(1, 1), a1 + hstep, voffA);
            PG8_WAIT_V(8); PG8_WAIT_L(0); PG8_BAR; PG8_MMA(0, 0, At, B0); PG8_MMA(0, 1, At, B1); PG8_BAR; PG8_SCHED;
            PG8_LDA(At, 0, 1); PG8_STAGE(PG8_SB(0, 0), b2, voffB); PG8_STAGE(PG8_SB(0, 1), b2 + hstep, voffB); PG8_STAGE(PG8_SA(0, 0), a2, voffA);
            PG8_WAIT_V(8); PG8_WAIT_L(0); PG8_BAR; PG8_MMA(1, 0, At, B0); PG8_MMA(1, 1, At, B1); PG8_BAR; PG8_SCHED;
            PG8_LDB(B0, 1, 0); PG8_LDB(B1, 1, 1); PG8_SCHED; PG8_LDA(At, 1, 0); PG8_STAGE(PG8_SA(0, 1), a2 + hstep, voffA);
            PG8_WAIT_V(8); PG8_WAIT_L(0); PG8_BAR; PG8_MMA(0, 0, At, B0); PG8_MMA(0, 1, At, B1); PG8_BAR; PG8_SCHED;
            PG8_LDA(At, 1, 1); PG8_STAGE(PG8_SB(1, 0), b3, voffB); PG8_STAGE(PG8_SB(1, 1), b3 + hstep, voffB); PG8_STAGE(PG8_SA(1, 0), a3, voffA);
            PG8_WAIT_V(8); PG8_WAIT_L(0); PG8_BAR; PG8_MMA(1, 0, At, B0); PG8_MMA(1, 1, At, B1); PG8_BAR; PG8_SCHED;
            } else {
            PG8_LDB(B0, 0, 0); PG8_SCHED; PG8_LDA(At, 0, 0); PG8_STAGE(PG8_SA(1, 1), a1 + hstep, voffA);
            PG8_WAIT_L(8); PG8_BAR; PG8_WAIT_L(0); PG8_MMA(0, 0, At, B0); PG8_BAR; PG8_SCHED;
            PG8_LDB(B1, 0, 1); PG8_STAGE(PG8_SB(0, 0), b2, voffB);
            PG8_BAR; PG8_WAIT_L(0); PG8_MMA(0, 1, At, B1); PG8_BAR;
            PG8_LDA(At, 0, 1); PG8_STAGE(PG8_SA(0, 0), a2, voffA);
            PG8_BAR; PG8_WAIT_L(0); PG8_MMA(1, 0, At, B0); PG8_BAR; PG8_SCHED;
            PG8_STAGE(PG8_SB(0, 1), b2 + hstep, voffB);
            PG8_WAIT_V(6); PG8_BAR; PG8_MMA(1, 1, At, B1); PG8_BAR;
            PG8_LDB(B0, 1, 0); PG8_SCHED; PG8_LDA(At, 1, 0); PG8_STAGE(PG8_SA(0, 1), a2 + hstep, voffA);
            PG8_WAIT_L(8); PG8_BAR; PG8_WAIT_L(0); PG8_MMA(0, 0, At, B0); PG8_BAR; PG8_SCHED;
            PG8_LDB(B1, 1, 1); PG8_STAGE(PG8_SB(1, 0), b3, voffB);
            PG8_BAR; PG8_WAIT_L(0); PG8_MMA(0, 1, At, B1); PG8_BAR;
            PG8_LDA(At, 1, 1); PG8_STAGE(PG8_SA(1, 0), a3, voffA);
            PG8_BAR; PG8_WAIT_L(0); PG8_MMA(1, 0, At, B0); PG8_BAR; PG8_SCHED;
            PG8_STAGE(PG8_SB(1, 1), b3 + hstep, voffB);
            PG8_WAIT_V(6); PG8_BAR; PG8_MMA(1, 1, At, B1); PG8_BAR;
            }
        }
        if constexpr (ALIGN_EPI) { if (wr == 0) PG8_BAR; }
        if constexpr (F8) asm volatile("s_nop 15\n\ts_nop 15" ::: "memory");
        if constexpr (!Epi::AFTER_DRAIN) { int fr_ = fr, fq_ = fq; asm volatile("" : "+v"(fr_), "+v"(fq_)); E(acc, cur, wr, wc, fr_, fq_); S.done(cur); }
        if (!has_next) break;
#pragma unroll
        for (int a = 0; a < 2; ++a)
#pragma unroll
            for (int b = 0; b < 2; ++b)
#pragma unroll
                for (int m = 0; m < 4; ++m)
#pragma unroll
                    for (int n = 0; n < 2; ++n) acc[a][b][m][n] = (f32x4){0.f, 0.f, 0.f, 0.f};
        cur = nxt; cA = nA; cB = nB; ++ui;
        if constexpr (ALIGN_EPI) { if (wr == 1) PG8_BAR; }
    }
    PG8_WAIT_V(0);
    if constexpr (!ALIGN_EPI) { if (wr == 0) PG8_BAR; }
    PG8_BAR;
    if constexpr (Epi::AFTER_DRAIN) { E.fused(acc, cur, wr, wc, fr, fq, lds, wid, lane); S.done(cur); }
#undef PG8_SA
#undef PG8_SB
#undef PG8_STAGE
#undef PG8_LDA
#undef PG8_LDB
#undef PG8_MMA
#undef PG8_CAT8
#undef PG8_WAIT_V
#undef PG8_WAIT_L
#undef PG8_BAR
#undef PG8_SCHED
}
}
#define GAS __attribute__((address_space(1)))
#define LAS __attribute__((address_space(3)))
typedef unsigned short bf16;
typedef unsigned v4u __attribute__((ext_vector_type(4)));
typedef float f32x4 __attribute__((ext_vector_type(4)));
typedef short bf16x8 __attribute__((ext_vector_type(8)));
typedef GAS unsigned gu32;
typedef GAS unsigned long long gu64;
#define RLX_AGENT __ATOMIC_RELAXED, __HIP_MEMORY_SCOPE_AGENT
#define LDS_WAIT() asm volatile("s_waitcnt lgkmcnt(0)" ::: "memory")
#define VM_WAIT() asm volatile("s_waitcnt vmcnt(0)" ::: "memory")
__device__ __forceinline__ unsigned long long rt() { return __builtin_amdgcn_s_memrealtime(); }
__device__ __forceinline__ unsigned f2bf(float f) { unsigned u = __builtin_bit_cast(unsigned, f); return (u + 0x7fffu + ((u >> 16) & 1u)) >> 16; }
__device__ __forceinline__ unsigned pk2(float lo, float hi) { return f2bf(lo) | (f2bf(hi) << 16); }
#define XB_TMO      128
#define XB_XCNT(j)  (256  + 64 * (j))
#define XB_XSUB(j)  (1280 + 64 * (j))
#define XB_XGEN(j)  (2304 + 64 * (j))
#define XB_TOP      3328
#define XB_TOPGEN   3392
#define XCD_BAR_WORDS 3456
#define XB_SPIN_CAP (1u << 18)

__device__ __forceinline__ unsigned xb_ld(unsigned* p)              { return __hip_atomic_load(p, __ATOMIC_RELAXED, __HIP_MEMORY_SCOPE_AGENT); }
__device__ __forceinline__ unsigned xb_add(unsigned* p, unsigned v) { return __hip_atomic_fetch_add(p, v, __ATOMIC_RELAXED, __HIP_MEMORY_SCOPE_AGENT); }
__device__ __forceinline__ unsigned xb_xcc_id() { return (unsigned)__builtin_amdgcn_s_getreg((3 << 11) | 20) & 0xFu; }
#define XB_SPIN(cond, bar) do { unsigned _sp = 0; while (cond) { __builtin_amdgcn_s_sleep(1); \
    if ((++_sp & 255u) == 0u) { if (xb_ld(&(bar)[XB_TMO])) break; if (_sp > XB_SPIN_CAP) { atomicAdd(&(bar)[XB_TMO], 1u); break; } } } } while (0)

struct XcdBarrier {
    unsigned* bar; unsigned x;
    volatile LAS unsigned* st;
};

__device__ __forceinline__ XcdBarrier xcd_barrier_post(unsigned* bar, volatile LAS unsigned* st) {
    XcdBarrier b; b.bar = bar; b.x = xb_xcc_id(); b.st = st;
    if (threadIdx.x == 0) (void)xb_add(&bar[XB_XCNT(b.x)], 1u);
    return b;
}
__device__ __forceinline__ void xcd_barrier_complete(unsigned* bar, unsigned x, unsigned& nloc, unsigned& nx) {
    const unsigned G = gridDim.x * gridDim.y * gridDim.z;
    unsigned sum, cnt, mine, sp = 0u;
    for (;;) {
        sum = 0u; cnt = 0u; mine = 0u;
#pragma unroll
        for (unsigned j = 0; j < 16; ++j) { const unsigned c = xb_ld(&bar[XB_XCNT(j)]); sum += c; cnt += (c > 0u) ? 1u : 0u; mine = (j == x) ? c : mine; }
        if (sum == G) break;
        __builtin_amdgcn_s_sleep(1);
        if ((++sp & 255u) == 0u) { if (xb_ld(&bar[XB_TMO])) break; if (sp > XB_SPIN_CAP) { atomicAdd(&bar[XB_TMO], 1u); break; } }
    }
    nloc = mine > 0u ? mine : 1u; nx = cnt > 0u ? cnt : 1u;
}

__device__ __forceinline__ void xcd_barrier(const XcdBarrier& b) {
    asm volatile("s_waitcnt vmcnt(0)" ::: "memory");
    __syncthreads();
    if (threadIdx.x == 0) {
        unsigned* bar = b.bar;
        __builtin_amdgcn_s_waitcnt(0);
        unsigned nloc = b.st[0], nx = b.st[1];
        if (nloc == 0u) { xcd_barrier_complete(bar, b.x, nloc, nx); b.st[0] = nloc; b.st[1] = nx; }
        const unsigned old = xb_add(&bar[XB_XSUB(b.x)], 1u);
        const unsigned gen = old / nloc;
        if (old + 1u == (gen + 1u) * nloc) {
            __builtin_amdgcn_fence(__ATOMIC_RELEASE, "agent");
            asm volatile("s_waitcnt vmcnt(0)" ::: "memory");
            const unsigned og = xb_add(&bar[XB_TOP], 1u);
            const unsigned tg = og / nx;
            if (og + 1u == (tg + 1u) * nx) xb_add(&bar[XB_TOPGEN], 1u);
            else XB_SPIN(xb_ld(&bar[XB_TOPGEN]) == tg, bar);
            __builtin_amdgcn_fence(__ATOMIC_ACQUIRE, "agent");
            xb_add(&bar[XB_XGEN(b.x)], 1u);
            asm volatile("s_waitcnt vmcnt(0)" ::: "memory");
        } else {
            XB_SPIN(xb_ld(&bar[XB_XGEN(b.x)]) == gen, bar);
            __builtin_amdgcn_fence(__ATOMIC_ACQUIRE, "agent");
            asm volatile("s_waitcnt vmcnt(0)" ::: "memory");
        }
    }
    __syncthreads();
}
constexpr int NWAVES = 8;
constexpr int BATCH = 4, SEQ = 8192, D = 1024, T = BATCH * SEQ, DEPTH = 4, MEML = 256, MROWS = BATCH * MEML;
constexpr int NPROJ = 2560, FFD = 2816, FFE = 3584, NEXP = 8, XW = 512;
constexpr int MP = 2 * T + NEXP * 256;
constexpr float F8_S1 = 16.0f, F8_S2 = 32.0f, F8_SH = 4.0f;
constexpr int NKEYS = 321;
constexpr int NPH = 1 + 8 + 11 + 8 + 11;
constexpr int PC_Q = 0, PC_K = 512, PC_V = 1024, PC_POOL = 1536, PC_BG = 1792, PC_CG = 2048, PC_HC = 2304;
constexpr size_t MiB = 1u << 20;
constexpr size_t WS_CTL = 0, CTL_ZERO_BYTES = 64 * 1024;
constexpr size_t WS_PWT = 256 * 1024;
constexpr size_t WS_CNT = 1 * MiB, WS_META = 1 * MiB + 64 * 1024;
constexpr size_t WS_TOKE = 1 * MiB + 512 * 1024, WS_TOKG = 2 * MiB, WS_TOKPOS = 2 * MiB + 512 * 1024, WS_ROWGATE = 3 * MiB, WS_ROWRS = 3 * MiB + 512 * 1024;
constexpr size_t WS_SSP = 4 * MiB;
constexpr size_t WS_KVX = 30 * MiB, WS_MEMN = 38 * MiB;
constexpr size_t WS_WIN = 40 * MiB, WS_WOUT = 60 * MiB, WS_WQ = 68 * MiB, WS_WKV = 72 * MiB, WS_WO = 80 * MiB, WS_W13D = 84 * MiB, WS_W2D = 106 * MiB, WS_W13M = 117 * MiB, WS_W2M = 341 * MiB;
constexpr size_t WS_XB = 453 * MiB, WS_QX = 517 * MiB, WS_OX = 549 * MiB, WS_AG = 581 * MiB, WS_YM = 713 * MiB, WS_RA = 977 * MiB, WS_VTX = 1439 * MiB, WS_END = 1443 * MiB;
constexpr size_t WS_PROJ = WS_RA, WS_Y = WS_RA + 160 * MiB, WS_H = WS_RA, WS_VT = WS_RA + 224 * MiB, WS_OPART = WS_RA + 320 * MiB, WS_LSE = WS_RA + 416 * MiB;
constexpr size_t VT_STRIDE = (size_t)T * 512, OP_STRIDE = (size_t)T * 512;
static_assert(WS_AG + (size_t)MP * D * 2 <= WS_YM && WS_YM + (size_t)MP * D * 4 <= WS_RA && WS_RA + (size_t)MP * FFE * 2 <= WS_VTX, "ws map");
constexpr int CW_BAR = 4096, CW_TEAM = 8192;
constexpr size_t WS_XCCTAB = 128 * 1024;
constexpr int RING_BYTES = 131072, LDSCTL_OFF = 159744, MISC_OFF = LDSCTL_OFF + 320, LDS_BYTES = 163840;

__device__ __forceinline__ float shx(float v, int mask, int lane) { return __int_as_float(__builtin_amdgcn_ds_bpermute((lane ^ mask) << 2, __float_as_int(v))); }
__device__ __forceinline__ float xsum32(float v) { const auto rr = __builtin_amdgcn_permlane32_swap(__float_as_uint(v), __float_as_uint(v), false, false); return __uint_as_float(rr[0]) + __uint_as_float(rr[1]); }
__device__ __forceinline__ float xmax32(float v) { const auto rr = __builtin_amdgcn_permlane32_swap(__float_as_uint(v), __float_as_uint(v), false, false); return fmaxf(__uint_as_float(rr[0]), __uint_as_float(rr[1])); }
__device__ __forceinline__ float wave_sum(float v, int lane) {
#pragma unroll
    for (int o = 1; o < 32; o <<= 1) v += shx(v, o, lane);
    return xsum32(v);
}
__device__ __forceinline__ float bflo(unsigned u) { return __uint_as_float(u << 16); }
__device__ __forceinline__ float bfhi(unsigned u) { return __uint_as_float(u & 0xffff0000u); }
__device__ __forceinline__ float bf1(bf16 h) { return __uint_as_float(((unsigned)h) << 16); }
__device__ __forceinline__ float dot8(v4u a, v4u b) {
    return (bflo(a.x) * bflo(b.x) + bfhi(a.x) * bfhi(b.x)) + (bflo(a.y) * bflo(b.y) + bfhi(a.y) * bfhi(b.y)) + (bflo(a.z) * bflo(b.z) + bfhi(a.z) * bfhi(b.z)) + (bflo(a.w) * bflo(b.w) + bfhi(a.w) * bfhi(b.w));
}
__device__ __forceinline__ int key_dist(int i) { return i < 129 ? i : (i < 225 ? 132 + 4 * (i - 129) : 528 + 16 * (i - 225)); }
__device__ __forceinline__ int key_mult(int d) { return d <= 128 ? 1 + ((d & 3) == 0 ? 1 : 0) + ((d & 15) == 0 ? 1 : 0) : (d <= 512 ? 1 + ((d & 15) == 0 ? 1 : 0) : 1); }
__device__ __forceinline__ int t5_bucket(int d) {
    if (d < 16) return d;
    int b = 16 + (int)(logf((float)d / 16.0f) / logf(8.0f) * 16.0f);
    return b < 31 ? b : 31;
}

struct Args { const float* in[21]; float* out; unsigned char* ws; int ph_lo, ph_hi; };

__device__ __forceinline__ void conv_item(const float* W, int K, int N, bf16* WT, const float* gain, int swF, LAS float* scr, int item, int lane) {
    const int nblk = N / 64, kb = item / nblk, nb = item % nblk, k0 = 64 * kb, n0 = 64 * nb;
    float wv[64];
#pragma unroll
    for (int i = 0; i < 64; ++i) wv[i] = W[(size_t)(k0 + i) * N + n0 + lane];
    if (gain) {
#pragma unroll
        for (int i = 0; i < 64; ++i) wv[i] *= gain[k0 + i]; }
#pragma unroll
    for (int i = 0; i < 64; ++i) scr[i * 65 + lane] = wv[i];
    LDS_WAIT(); asm volatile("" ::: "memory");
    int orow0 = n0;
    if (swF) { const int isup = n0 >= swF ? 1 : 0; const int j = n0 - isup * swF; orow0 = (j >> 7) * 256 + isup * 128 + (j & 127); }
    const int c = lane & 7;
#pragma unroll
    for (int j = 0; j < 8; ++j) { const int n = (lane >> 3) + 8 * j; const LAS float* s = scr + (8 * c) * 65 + n;
        v4u o; o.x = pk2(s[0 * 65], s[1 * 65]); o.y = pk2(s[2 * 65], s[3 * 65]); o.z = pk2(s[4 * 65], s[5 * 65]); o.w = pk2(s[6 * 65], s[7 * 65]);
        *(GAS v4u*)(WT + (size_t)(orow0 + n) * K + k0 + 8 * c) = o; }
    LDS_WAIT(); asm volatile("" ::: "memory");
}

typedef unsigned u32x2 __attribute__((ext_vector_type(2)));
__device__ __forceinline__ void conv_item8(const float* W, int K, int N, unsigned char* WT, const float* gain, int swF, float scale, LAS float* scr, int item, int lane) {
    const int nblk = N / 64, kb = item / nblk, nb = item % nblk, k0 = 64 * kb, n0 = 64 * nb;
    float wv[64];
#pragma unroll
    for (int i = 0; i < 64; ++i) wv[i] = W[(size_t)(k0 + i) * N + n0 + lane];
#pragma unroll
    for (int i = 0; i < 64; ++i) wv[i] *= gain ? gain[k0 + i] * scale : scale;
#pragma unroll
    for (int i = 0; i < 64; ++i) scr[i * 65 + lane] = wv[i];
    LDS_WAIT(); asm volatile("" ::: "memory");
    int orow0 = n0;
    if (swF) { const int isup = n0 >= swF ? 1 : 0; const int j = n0 - isup * swF; orow0 = (j >> 7) * 256 + isup * 128 + (j & 127); }
    const int c = lane & 7;
#pragma unroll
    for (int j = 0; j < 8; ++j) { const int n = (lane >> 3) + 8 * j; const LAS float* s = scr + (8 * c) * 65 + n;
        u32x2 o; o.x = pg8::pk4_fp8_w(s[0 * 65], s[1 * 65], s[2 * 65], s[3 * 65]); o.y = pg8::pk4_fp8_w(s[4 * 65], s[5 * 65], s[6 * 65], s[7 * 65]);
        *(GAS u32x2*)(WT + (size_t)(orow0 + n) * K + k0 + 8 * c) = o; }
    LDS_WAIT(); asm volatile("" ::: "memory");
}

typedef float f32x16 __attribute__((ext_vector_type(16)));
typedef float f32x2_t __attribute__((ext_vector_type(2))); typedef __bf16 bf16x2_t __attribute__((ext_vector_type(2)));
__device__ __forceinline__ unsigned cvtpk(float lo, float hi) { f32x2_t v = {lo, hi}; bf16x2_t b = __builtin_convertvector(v, bf16x2_t); return __builtin_bit_cast(unsigned, b); }
__device__ __forceinline__ bf16x8 mk8(unsigned a, unsigned b, unsigned c, unsigned d) { v4u t = {a, b, c, d}; return __builtin_bit_cast(bf16x8, t); }
__device__ __forceinline__ bf16x8 mk8u2(u32x2 lo, u32x2 hi) { v4u t = {lo.x, lo.y, hi.x, hi.y}; return __builtin_bit_cast(bf16x8, t); }
#define NEGINF (-__builtin_inff())
constexpr int BT_LD = 200, BT_OFF = 32;
__device__ __forceinline__ void dil_load_k(bf16x8 (&kf)[4], const bf16* pj, int sh, int b, int h, int r, int k0, int q, int hh) {
    const int sg = (q & ~12) | ((q & 4) << 1) | ((q & 8) >> 1);
    const int tk = b * SEQ + r + ((k0 + sg) << sh);
    const bf16* kp = pj + (size_t)tk * NPROJ + PC_K + h * 64 + 32 * hh;
#pragma unroll
    for (int ks = 0; ks < 4; ++ks) kf[ks] = *(const GAS bf16x8*)(kp + 8 * ks);
}
__device__ __forceinline__ void dil_load_v(bf16x8 (&vf)[2][2], const bf16* vrow, int sh, int k0) {
#pragma unroll
    for (int db = 0; db < 2; ++db)
#pragma unroll
        for (int s2 = 0; s2 < 2; ++s2) { const bf16* vp = vrow + (size_t)db * 32 * SEQ + (sh == 4 ? ((k0 >> 4) + s2) * 256 : k0 + 16 * s2); vf[db][s2] = *(const GAS bf16x8*)vp; }
}
__device__ __forceinline__ void dil_blk(const bf16x8 (&kf)[4], const bf16x8 (&vf)[2][2], const bf16x8 (&qf)[4], f32x16& O0, f32x16& O1, float& m, float& l, const LAS float* btl) {
    f32x16 st;
#pragma unroll
    for (int i = 0; i < 16; ++i) st[i] = 0.f;
#pragma unroll
    for (int ks = 0; ks < 4; ++ks) st = __builtin_amdgcn_mfma_f32_32x32x16_bf16(kf[ks], qf[ks], st, 0, 0, 0);
    float mx = NEGINF;
#pragma unroll
    for (int i = 0; i < 16; ++i) { st[i] = st[i] * 0.18033688011112042f + btl[23 - (16 * (i >> 3) + 4 * ((i >> 2) & 1) + (i & 3))]; mx = fmaxf(mx, st[i]); }
    { const auto rr = __builtin_amdgcn_permlane32_swap(__float_as_uint(mx), __float_as_uint(mx), false, false); mx = fmaxf(__uint_as_float(rr[0]), __uint_as_float(rr[1])); }
    const float mn = fmaxf(m, mx), ms = mn == NEGINF ? 0.f : mn, alpha = __builtin_amdgcn_exp2f(m - ms);
    float ls = 0.f;
#pragma unroll
    for (int i = 0; i < 16; ++i) { st[i] = __builtin_amdgcn_exp2f(st[i] - ms); ls += st[i]; }
    l = l * alpha + ls; m = mn;
#pragma unroll
    for (int i = 0; i < 16; ++i) { O0[i] *= alpha; O1[i] *= alpha; }
    const bf16x8 p0 = mk8(cvtpk(st[0], st[1]), cvtpk(st[2], st[3]), cvtpk(st[4], st[5]), cvtpk(st[6], st[7]));
    const bf16x8 p1 = mk8(cvtpk(st[8], st[9]), cvtpk(st[10], st[11]), cvtpk(st[12], st[13]), cvtpk(st[14], st[15]));
    O0 = __builtin_amdgcn_mfma_f32_32x32x16_bf16(vf[0][0], p0, O0, 0, 0, 0); O0 = __builtin_amdgcn_mfma_f32_32x32x16_bf16(vf[0][1], p1, O0, 0, 0, 0);
    O1 = __builtin_amdgcn_mfma_f32_32x32x16_bf16(vf[1][0], p0, O1, 0, 0, 0); O1 = __builtin_amdgcn_mfma_f32_32x32x16_bf16(vf[1][1], p1, O1, 0, 0, 0);
}
__device__ __forceinline__ void dil_store(const f32x16& O0, const f32x16& O1, float m, float l, bf16* opart, float* lsep, int tq, int h, int hh) {
    l = xsum32(l);
    const float inv = l > 0.f ? 1.0f / l : 0.f;
    bf16* op = opart + (size_t)tq * 512 + h * 64 + 4 * hh;
#pragma unroll
    for (int g4 = 0; g4 < 4; ++g4) {
        u32x2 w0, w1; w0.x = cvtpk(O0[4 * g4] * inv, O0[4 * g4 + 1] * inv); w0.y = cvtpk(O0[4 * g4 + 2] * inv, O0[4 * g4 + 3] * inv);
        w1.x = cvtpk(O1[4 * g4] * inv, O1[4 * g4 + 1] * inv); w1.y = cvtpk(O1[4 * g4 + 2] * inv, O1[4 * g4 + 3] * inv);
        *(GAS u32x2*)(op + 8 * g4) = w0; *(GAS u32x2*)(op + 32 + 8 * g4) = w1; }
    if (hh == 0) lsep[(size_t)tq * 8 + h] = l > 0.f ? (m + __builtin_amdgcn_logf(l)) * 0.6931471805599453f : NEGINF;
}
template <int JLO>
__device__ __forceinline__ void dil_unit32(const bf16* pj, const bf16* vt, bf16* opart, float* lsep, const LAS float* bt, int sh, int b, int h, int r, int n0, bool do_store) {
    constexpr int NT = JLO == 0 ? 5 : 4;
    int lane; asm volatile("v_mbcnt_lo_u32_b32 %0, -1, 0\n\tv_mbcnt_hi_u32_b32 %0, -1, %0" : "=v"(lane));
    const int q = lane & 31, hh = lane >> 5;
    const int L = SEQ >> sh;
    const int tq = b * SEQ + r + ((n0 + q) << sh);
    bf16x8 qf[4];
    { const bf16* qp = pj + (size_t)tq * NPROJ + PC_Q + h * 64 + 32 * hh;
#pragma unroll
      for (int ks = 0; ks < 4; ++ks) qf[ks] = *(const GAS bf16x8*)(qp + 8 * ks); }
    f32x16 O0, O1;
#pragma unroll
    for (int i = 0; i < 16; ++i) { O0[i] = 0.f; O1[i] = 0.f; }
    float m = NEGINF, l = 0.f;
    const bf16* vrow = vt + ((size_t)((b * 8 + h) * 64 + q) * SEQ) + (sh == 4 ? r * 16 : r * L) + 8 * hh;
    bf16x8 kf[2][4], vf[2][2][2];
    { const int k0 = n0 - 128 < 0 ? 0 : n0 - 128; dil_load_k(kf[0], pj, sh, b, h, r, k0, q, hh); dil_load_v(vf[0], vrow, sh, k0); }
#pragma unroll
    for (int t = 0; t < NT; ++t) {
        const int k0 = n0 - 128 + 32 * t;
        if (t + 1 < NT) { const int k1 = k0 + 32 < 0 ? 0 : k0 + 32; dil_load_k(kf[(t + 1) & 1], pj, sh, b, h, r, k1, q, hh); dil_load_v(vf[(t + 1) & 1], vrow, sh, k1); }
        const int jq = k0 < 0 ? 160 : q - 8 * hh + 128 - 32 * t;
        dil_blk(kf[t & 1], vf[t & 1], qf, O0, O1, m, l, bt + jq + BT_OFF - 23);
    }
    if (do_store) dil_store(O0, O1, m, l, opart, lsep, tq, h, hh);
}

constexpr int DK_PITCH = 144, DK_BYTES = 384 * DK_PITCH, DV_BYTES = 384 * 128;
typedef short v4i16_t __attribute__((ext_vector_type(4)));
__device__ __forceinline__ int dv_off(int key, int dim) { return 128 * key + 64 * ((dim >> 5) ^ ((key >> 1) & 1)) + 2 * (dim & 31); }
__device__ __forceinline__ void dil_stage_load_k(v4u (&sk)[6], const bf16* pj, int sh, int b, int h, int r, int n0, int tid) {
    const int ws = n0 - 128;
#pragma unroll
    for (int k = 0; k < 6; ++k) { const int idx = tid + 512 * k, row = idx >> 3, ch = idx & 7; int kk = ws + row; kk = kk < 0 ? 0 : kk;
        sk[k] = *(const GAS v4u*)(pj + (size_t)(b * SEQ + r + (kk << sh)) * NPROJ + PC_K + h * 64 + ch * 8); }
}
__device__ __forceinline__ void dil_stage_load_v(v4u (&sv)[6], const bf16* pj, int sh, int b, int h, int r, int n0, int tid) {
    const int ws = n0 - 128;
#pragma unroll
    for (int k = 0; k < 6; ++k) { const int idx = tid + 512 * k, row = idx >> 3, ch = idx & 7; int kk = ws + row; kk = kk < 0 ? 0 : kk;
        sv[k] = *(const GAS v4u*)(pj + (size_t)(b * SEQ + r + (kk << sh)) * NPROJ + PC_V + h * 64 + ch * 8); }
}
__device__ __forceinline__ void dil_stage_write_k(LAS unsigned char* lds, const v4u (&sk)[6], int tid) {
#pragma unroll
    for (int k = 0; k < 6; ++k) { const int idx = tid + 512 * k, row = idx >> 3, ch = idx & 7; *(LAS v4u*)(lds + row * DK_PITCH + ch * 16) = sk[k]; }
}
__device__ __forceinline__ void dil_stage_write_v(LAS unsigned char* lds, const v4u (&sv)[6], int tid) {
#pragma unroll
    for (int k = 0; k < 6; ++k) { const int idx = tid + 512 * k, row = idx >> 3, ch = idx & 7; *(LAS v4u*)(lds + DK_BYTES + dv_off(row, 8 * ch)) = sv[k]; }
}
template <int JLO>
__device__ __forceinline__ void dil_wg_compute(const LAS unsigned char* lds, const bf16x8 (&qf)[4], bf16* opart, float* lsep, const LAS float* bt, int tq, int h, int k00, int lane, int wave, bool do_store) {
    constexpr int NT = JLO == 0 ? 5 : 4;
    asm volatile("" : "+v"(lane));
    const int q = lane & 31, hh = lane >> 5;
    f32x16 O0, O1;
#pragma unroll
    for (int i = 0; i < 16; ++i) { O0[i] = 0.f; O1[i] = 0.f; }
    float m = NEGINF, l = 0.f;
    const int sg = (q & ~12) | ((q & 4) << 1) | ((q & 8) >> 1);
    const LAS unsigned char* kl = lds + (32 * wave + sg) * DK_PITCH + 64 * hh;
    const int qq = (lane >> 2) & 3, kr = 32 * wave + 8 * hh + qq, d0 = 16 * ((lane >> 4) & 1) + 4 * (lane & 3);
    const LAS unsigned char* vl0 = lds + DK_BYTES + dv_off(kr, d0);
    const LAS unsigned char* vl1 = lds + DK_BYTES + dv_off(kr, 32 + d0);
#pragma unroll
    for (int t = 0; t < NT; ++t) {
        bf16x8 kf[4], vf[2][2];
#pragma unroll
        for (int ks = 0; ks < 4; ++ks) kf[ks] = *(const LAS bf16x8*)(kl + t * 32 * DK_PITCH + 16 * ks);
#pragma unroll
        for (int db = 0; db < 2; ++db)
#pragma unroll
            for (int s2 = 0; s2 < 2; ++s2) { const LAS unsigned char* vp_ = (db ? vl1 : vl0) + 128 * (32 * t + 16 * s2);
                vf[db][s2] = __builtin_shufflevector(__builtin_amdgcn_ds_read_tr16_b64_v4i16((LAS v4i16_t*)vp_), __builtin_amdgcn_ds_read_tr16_b64_v4i16((LAS v4i16_t*)(vp_ + 512)), 0, 1, 2, 3, 4, 5, 6, 7); }
        const int jq = k00 + 32 * t < 0 ? 160 : q - 8 * hh + 128 - 32 * t;
        dil_blk(kf, vf, qf, O0, O1, m, l, bt + jq + BT_OFF - 23);
        __builtin_amdgcn_sched_barrier(0);
    }
    if (do_store) dil_store(O0, O1, m, l, opart, lsep, tq, h, hh);
}

__device__ __forceinline__ void xat_unit(const bf16* qxp, const bf16* kb, const bf16* vtb, bf16* oxp, int t0, int h, int lane) {
    const int q = lane & 31, hh = lane >> 5;
    bf16x8 qf[8];
    { const bf16* qp = qxp + (size_t)(t0 + q) * XW + h * 128 + 64 * hh;
#pragma unroll
      for (int ks = 0; ks < 8; ++ks) qf[ks] = *(const GAS bf16x8*)(qp + 8 * ks); }
    f32x16 O[4];
#pragma unroll
    for (int d = 0; d < 4; ++d)
#pragma unroll
        for (int i = 0; i < 16; ++i) O[d][i] = 0.f;
    float m = NEGINF, l = 0.f;
    const bf16* vrow = vtb + (size_t)(h * 128 + q) * MEML + 4 * hh;
    for (int k0 = 0; k0 < MEML; k0 += 32) {
        const bf16* kp = kb + (size_t)(k0 + q) * 4096 + h * 128 + 64 * hh;
        f32x16 st;
#pragma unroll
        for (int i = 0; i < 16; ++i) st[i] = 0.f;
#pragma unroll
        for (int ks = 0; ks < 8; ++ks) st = __builtin_amdgcn_mfma_f32_32x32x16_bf16(*(const GAS bf16x8*)(kp + 8 * ks), qf[ks], st, 0, 0, 0);
        bf16x8 vf[4][2];
#pragma unroll
        for (int db = 0; db < 4; ++db)
#pragma unroll
            for (int s2 = 0; s2 < 2; ++s2) { const bf16* vp = vrow + (size_t)db * 32 * MEML + k0 + 16 * s2; vf[db][s2] = mk8u2(*(const GAS u32x2*)vp, *(const GAS u32x2*)(vp + 8)); }
        float mx = st[0];
#pragma unroll
        for (int i = 1; i < 16; ++i) mx = fmaxf(mx, st[i]);
        mx = xmax32(mx);
        const float mn = fmaxf(m, mx), alpha = __expf(m - mn);
        float ls = 0.f;
#pragma unroll
        for (int i = 0; i < 16; ++i) { st[i] = __expf(st[i] - mn); ls += st[i]; }
        l = l * alpha + ls; m = mn;
#pragma unroll
        for (int d = 0; d < 4; ++d)
#pragma unroll
            for (int i = 0; i < 16; ++i) O[d][i] *= alpha;
        const bf16x8 p0 = mk8(cvtpk(st[0], st[1]), cvtpk(st[2], st[3]), cvtpk(st[4], st[5]), cvtpk(st[6], st[7]));
        const bf16x8 p1 = mk8(cvtpk(st[8], st[9]), cvtpk(st[10], st[11]), cvtpk(st[12], st[13]), cvtpk(st[14], st[15]));
#pragma unroll
        for (int d = 0; d < 4; ++d) { O[d] = __builtin_amdgcn_mfma_f32_32x32x16_bf16(vf[d][0], p0, O[d], 0, 0, 0); O[d] = __builtin_amdgcn_mfma_f32_32x32x16_bf16(vf[d][1], p1, O[d], 0, 0, 0); }
    }
    l = xsum32(l);
    const float inv = 1.0f / l;
    bf16* op = oxp + (size_t)(t0 + q) * XW + h * 128 + 4 * hh;
#pragma unroll
    for (int d = 0; d < 4; ++d)
#pragma unroll
        for (int g4 = 0; g4 < 4; ++g4) { u32x2 w; w.x = cvtpk(O[d][4 * g4] * inv, O[d][4 * g4 + 1] * inv); w.y = cvtpk(O[d][4 * g4 + 2] * inv, O[d][4 * g4 + 3] * inv); *(GAS u32x2*)(op + 32 * d + 8 * g4) = w; }
}

constexpr int XK_PITCH = 272, XV_PITCH = 528, XK_BYTES = 256 * XK_PITCH, XV_BYTES = 128 * XV_PITCH;
__device__ __forceinline__ void xat_wg_unit(LAS unsigned char* lds, const bf16* qxp, const bf16* kb, const bf16* vtb, bf16* oxp, int t0, int h, int tid) {
    const int lane = tid & 63, q = lane & 31, hh = lane >> 5;
    __syncthreads();
#pragma unroll
    for (int k = 0; k < 8; ++k) { const int idx = tid + 512 * k, row = idx >> 4, ch = idx & 15;
        const v4u x = *(const GAS v4u*)(kb + (size_t)row * 4096 + h * 128 + ch * 8); *(LAS v4u*)(lds + row * XK_PITCH + ch * 16) = x; }
#pragma unroll
    for (int k = 0; k < 8; ++k) { const int idx = tid + 512 * k, row = idx >> 5, ch = idx & 31;
        const v4u x = *(const GAS v4u*)(vtb + (size_t)(h * 128 + row) * MEML + ch * 8); *(LAS v4u*)(lds + XK_BYTES + row * XV_PITCH + ch * 16) = x; }
    bf16x8 qf[8];
    { const bf16* qp = qxp + (size_t)(t0 + q) * XW + h * 128 + 64 * hh;
#pragma unroll
      for (int ks = 0; ks < 8; ++ks) qf[ks] = *(const GAS bf16x8*)(qp + 8 * ks); }
    __syncthreads();
    f32x16 O[4];
#pragma unroll
    for (int d = 0; d < 4; ++d)
#pragma unroll
        for (int i = 0; i < 16; ++i) O[d][i] = 0.f;
    float m = NEGINF, l = 0.f;
    const int sg = (q & ~12) | ((q & 4) << 1) | ((q & 8) >> 1);
    const LAS unsigned char* kl = lds + sg * XK_PITCH + 128 * hh;
    const LAS unsigned char* vl = lds + XK_BYTES + q * XV_PITCH + 16 * hh;
#pragma unroll
    for (int kt = 0; kt < 8; ++kt) {
        f32x16 st;
#pragma unroll
        for (int i = 0; i < 16; ++i) st[i] = 0.f;
#pragma unroll
        for (int ks = 0; ks < 8; ++ks) st = __builtin_amdgcn_mfma_f32_32x32x16_bf16(*(const LAS bf16x8*)(kl + kt * 32 * XK_PITCH + ks * 16), qf[ks], st, 0, 0, 0);
        float mx = st[0];
#pragma unroll
        for (int i = 1; i < 16; ++i) mx = fmaxf(mx, st[i]);
        mx = xmax32(mx);
        const float mn = fmaxf(m, mx), alpha = __builtin_amdgcn_exp2f((m - mn) * 1.4426950408889634f);
        float ls = 0.f;
#pragma unroll
        for (int i = 0; i < 16; ++i) { st[i] = __builtin_amdgcn_exp2f((st[i] - mn) * 1.4426950408889634f); ls += st[i]; }
        l = l * alpha + ls; m = mn;
#pragma unroll
        for (int d = 0; d < 4; ++d)
#pragma unroll
            for (int i = 0; i < 16; ++i) O[d][i] *= alpha;
        const bf16x8 p0 = mk8(cvtpk(st[0], st[1]), cvtpk(st[2], st[3]), cvtpk(st[4], st[5]), cvtpk(st[6], st[7]));
        const bf16x8 p1 = mk8(cvtpk(st[8], st[9]), cvtpk(st[10], st[11]), cvtpk(st[12], st[13]), cvtpk(st[14], st[15]));
#pragma unroll
        for (int d = 0; d < 4; ++d) { const LAS unsigned char* vp = vl + d * 32 * XV_PITCH + kt * 64;
            O[d] = __builtin_amdgcn_mfma_f32_32x32x16_bf16(*(const LAS bf16x8*)vp, p0, O[d], 0, 0, 0); O[d] = __builtin_amdgcn_mfma_f32_32x32x16_bf16(*(const LAS bf16x8*)(vp + 32), p1, O[d], 0, 0, 0); }
    }
    l = xsum32(l);
    const float inv = 1.0f / l;
    bf16* op = oxp + (size_t)(t0 + q) * XW + h * 128 + 4 * hh;
#pragma unroll
    for (int d = 0; d < 4; ++d)
#pragma unroll
        for (int g4 = 0; g4 < 4; ++g4) { u32x2 w; w.x = cvtpk(O[d][4 * g4] * inv, O[d][4 * g4 + 1] * inv); w.y = cvtpk(O[d][4 * g4 + 2] * inv, O[d][4 * g4 + 3] * inv); *(GAS u32x2*)(op + 32 * d + 8 * g4) = w; }
}

__device__ __forceinline__ void pool_unit(const bf16* pj, const bf16* pwT, const float* psc, bf16* ymixp, int t0, int lane) {
    const int q = lane & 31, hh = lane >> 5; const int t = t0 + q, pos = t & (SEQ - 1);
    const bf16* prow = pj + (size_t)t * NPROJ + PC_POOL + 8 * hh;
#pragma unroll
    for (int g = 0; g < 4; ++g) {
        const int w = 2 << g; const float rn = 1.0f / (float)(pos + 1 < w ? pos + 1 : w);
        f32x16 D0, D1;
#pragma unroll
        for (int i = 0; i < 16; ++i) { D0[i] = 0.f; D1[i] = 0.f; }
#pragma unroll
        for (int ks = 0; ks < 4; ++ks) {
            const bf16* p0 = prow + g * 64 + 16 * ks;
            const v4u x0 = *(const GAS v4u*)p0;
            float a0 = bflo(x0.x), a1 = bfhi(x0.x), a2 = bflo(x0.y), a3 = bfhi(x0.y), a4 = bflo(x0.z), a5 = bfhi(x0.z), a6 = bflo(x0.w), a7 = bfhi(x0.w);
#pragma unroll
            for (int i = 1; i < w; ++i) if (pos - i >= 0) { const v4u xi = *(const GAS v4u*)(p0 - (size_t)i * NPROJ);
                a0 += bflo(xi.x); a1 += bfhi(xi.x); a2 += bflo(xi.y); a3 += bfhi(xi.y); a4 += bflo(xi.z); a5 += bfhi(xi.z); a6 += bflo(xi.w); a7 += bfhi(xi.w); }
            const bf16x8 bfr = mk8(cvtpk(a0 * rn - bflo(x0.x), a1 * rn - bfhi(x0.x)), cvtpk(a2 * rn - bflo(x0.y), a3 * rn - bfhi(x0.y)), cvtpk(a4 * rn - bflo(x0.z), a5 * rn - bfhi(x0.z)), cvtpk(a6 * rn - bflo(x0.w), a7 * rn - bfhi(x0.w)));
            const bf16* wp = pwT + (size_t)(g * 64 + q) * 64 + 16 * ks + 8 * hh;
            D0 = __builtin_amdgcn_mfma_f32_32x32x16_bf16(*(const GAS bf16x8*)wp, bfr, D0, 0, 0, 0);
            D1 = __builtin_amdgcn_mfma_f32_32x32x16_bf16(*(const GAS bf16x8*)(wp + 32 * 64), bfr, D1, 0, 0, 0);
        }
        bf16* op = ymixp + (size_t)t * D + 512 + g * 64 + 4 * hh; const float* sp = psc + g * 64 + 4 * hh;
#pragma unroll
        for (int k = 0; k < 4; ++k) { const f32x4 s0 = *(const GAS f32x4*)(sp + 8 * k), s1 = *(const GAS f32x4*)(sp + 32 + 8 * k);
            u32x2 w0, w1; w0.x = cvtpk(D0[4 * k] * s0[0], D0[4 * k + 1] * s0[1]); w0.y = cvtpk(D0[4 * k + 2] * s0[2], D0[4 * k + 3] * s0[3]);
            w1.x = cvtpk(D1[4 * k] * s1[0], D1[4 * k + 1] * s1[1]); w1.y = cvtpk(D1[4 * k + 2] * s1[2], D1[4 * k + 3] * s1[3]);
            *(GAS u32x2*)(op + 8 * k) = w0; *(GAS u32x2*)(op + 32 + 8 * k) = w1; }
    }
}
__device__ __forceinline__ void mergeconv_unit(const bf16* pj, const bf16* opartp, const float* lsepp, const float* cw, bf16* ymixp, int t0, int lane) {
    const int c4 = 4 * lane, h = lane >> 3;
    const f32x4 w0 = *(const GAS f32x4*)(cw + c4), w1 = *(const GAS f32x4*)(cw + 256 + c4), w2 = *(const GAS f32x4*)(cw + 512 + c4);
    f32x4 u1 = {0.f, 0.f, 0.f, 0.f}, u2 = {0.f, 0.f, 0.f, 0.f};
    const int pos0 = t0 & (SEQ - 1);
    if (pos0 >= 2) {
        const bf16* r1 = pj + (size_t)(t0 - 1) * NPROJ; const bf16* r2 = r1 - NPROJ;
        const u32x2 c1 = *(const GAS u32x2*)(r1 + PC_CG + c4), h1 = *(const GAS u32x2*)(r1 + PC_HC + c4), c2 = *(const GAS u32x2*)(r2 + PC_CG + c4), h2 = *(const GAS u32x2*)(r2 + PC_HC + c4);
        u1 = (f32x4){bflo(c1.x) * bflo(h1.x), bfhi(c1.x) * bfhi(h1.x), bflo(c1.y) * bflo(h1.y), bfhi(c1.y) * bfhi(h1.y)};
        u2 = (f32x4){bflo(c2.x) * bflo(h2.x), bfhi(c2.x) * bfhi(h2.x), bflo(c2.y) * bflo(h2.y), bfhi(c2.y) * bfhi(h2.y)};
    }
#pragma unroll 4
    for (int j = 0; j < 32; ++j) { const int t = t0 + j; const bf16* row = pj + (size_t)t * NPROJ;
        const u32x2 cg = *(const GAS u32x2*)(row + PC_CG + c4), hc = *(const GAS u32x2*)(row + PC_HC + c4), bg = *(const GAS u32x2*)(row + PC_BG + c4);
        const f32x4 u0 = {bflo(cg.x) * bflo(hc.x), bfhi(cg.x) * bfhi(hc.x), bflo(cg.y) * bflo(hc.y), bfhi(cg.y) * bfhi(hc.y)};
        const f32x4 y = (f32x4){bflo(bg.x), bfhi(bg.x), bflo(bg.y), bfhi(bg.y)} * (w0 * u0 + w1 * u1 + w2 * u2);
        u32x2 yo; yo.x = cvtpk(y[0], y[1]); yo.y = cvtpk(y[2], y[3]);
        *(GAS u32x2*)(ymixp + (size_t)t * D + 768 + c4) = yo;
        u2 = u1; u1 = u0;
        const float l0 = lsepp[(size_t)t * 8 + h], l1 = lsepp[(size_t)T * 8 + (size_t)t * 8 + h], l2 = lsepp[(size_t)2 * T * 8 + (size_t)t * 8 + h];
        const float M = fmaxf(l0, fmaxf(l1, l2)); float e0 = __expf(l0 - M), e1 = __expf(l1 - M), e2 = __expf(l2 - M); const float inv = 1.0f / (e0 + e1 + e2); e0 *= inv; e1 *= inv; e2 *= inv;
        const v4u a = *(const GAS v4u*)(opartp + (size_t)t * 512 + 8 * lane), bq = *(const GAS v4u*)(opartp + OP_STRIDE + (size_t)t * 512 + 8 * lane), c = *(const GAS v4u*)(opartp + 2 * OP_STRIDE + (size_t)t * 512 + 8 * lane);
        v4u o; o.x = cvtpk(e0 * bflo(a.x) + e1 * bflo(bq.x) + e2 * bflo(c.x), e0 * bfhi(a.x) + e1 * bfhi(bq.x) + e2 * bfhi(c.x));
        o.y = cvtpk(e0 * bflo(a.y) + e1 * bflo(bq.y) + e2 * bflo(c.y), e0 * bfhi(a.y) + e1 * bfhi(bq.y) + e2 * bfhi(c.y));
        o.z = cvtpk(e0 * bflo(a.z) + e1 * bflo(bq.z) + e2 * bflo(c.z), e0 * bfhi(a.z) + e1 * bfhi(bq.z) + e2 * bfhi(c.z));
        o.w = cvtpk(e0 * bflo(a.w) + e1 * bflo(bq.w) + e2 * bflo(c.w), e0 * bfhi(a.w) + e1 * bfhi(bq.w) + e2 * bfhi(c.w));
        *(GAS v4u*)(ymixp + (size_t)t * D + 8 * lane) = o; }
}

__device__ __forceinline__ void vt_transpose_tile(LAS unsigned char* lds, const bf16* pj, bf16* vt, int pm, int vh, int tid) {
    constexpr int PW = 65;
    LAS unsigned* img = (LAS unsigned*)lds;
    const int row0 = pm * 256, b = row0 >> 13, tt = row0 & 8191;
    for (int hf = 0; hf < 2; ++hf) {
        __syncthreads();
        { const int r = tid >> 1, hc = tid & 1;
            const bf16* src = pj + (size_t)(row0 + r) * NPROJ + PC_V + vh * 256 + hf * 128 + hc * 64;
#pragma unroll
            for (int k = 0; k < 8; ++k) { const v4u x = *(const GAS v4u*)(src + 8 * k); LAS unsigned* d = img + r * PW + hc * 32 + 4 * k; d[0] = x.x; d[1] = x.y; d[2] = x.z; d[3] = x.w; } }
        __syncthreads();
        const LAS unsigned short* im16 = (const LAS unsigned short*)lds;
        bf16* vcol = vt + (size_t)(b * 512 + vh * 256 + hf * 128) * SEQ;
#pragma unroll 2
        for (int k = 0; k < 8; ++k) { const int id = tid + 512 * k, d = id >> 5, c = id & 31;
            {
#define RD16(j) ((unsigned)im16[(8 * c + (j)) * (2 * PW) + d])
              v4u o; o.x = RD16(0) | (RD16(1) << 16); o.y = RD16(2) | (RD16(3) << 16); o.z = RD16(4) | (RD16(5) << 16); o.w = RD16(6) | (RD16(7) << 16);
#undef RD16
              *(GAS v4u*)(vcol + (size_t)d * SEQ + tt + 8 * c) = o; }
            { const int r = c >> 3, n0 = 8 * (c & 7);
#define RD16(j) ((unsigned)im16[(4 * (n0 + (j)) + r) * (2 * PW) + d])
              v4u o; o.x = RD16(0) | (RD16(1) << 16); o.y = RD16(2) | (RD16(3) << 16); o.z = RD16(4) | (RD16(5) << 16); o.w = RD16(6) | (RD16(7) << 16);
#undef RD16
              *(GAS v4u*)(vcol + VT_STRIDE + (size_t)d * SEQ + r * 2048 + (tt >> 2) + n0) = o; }
            { const int r = c >> 1, n0 = 8 * (c & 1);
#define RD16(j) ((unsigned)im16[(16 * (n0 + (j)) + r) * (2 * PW) + d])
              v4u o; o.x = RD16(0) | (RD16(1) << 16); o.y = RD16(2) | (RD16(3) << 16); o.z = RD16(4) | (RD16(5) << 16); o.w = RD16(6) | (RD16(7) << 16);
#undef RD16
              *(GAS v4u*)(vcol + 2 * VT_STRIDE + (size_t)d * SEQ + (tt >> 8) * 256 + r * 16 + n0) = o; }
        }
    }
    __syncthreads();
}

#define x_in (args.in[0])
#define mem_in (args.in[1])
#define rel_bias (args.in[2])
#define mem_g (args.in[3])
#define mix_g (args.in[4])
#define w_in (args.in[5])
#define conv_w (args.in[6])
#define pool_w (args.in[7])
#define pool_scale (args.in[8])
#define w_out (args.in[9])
#define xat_g (args.in[10])
#define wq_x (args.in[11])
#define wkv_x (args.in[12])
#define wo_x (args.in[13])
#define ffn_g (args.in[14])
#define w13_d (args.in[15])
#define w2_d (args.in[16])
#define router_w (args.in[17])
#define w13_m (args.in[18])
#define w2_m (args.in[19])
#define fin_g (args.in[20])
#define out (args.out)
#define Win_t ((bf16*)(ws + WS_WIN))
#define Wout_t ((bf16*)(ws + WS_WOUT))
#define Wq_t ((bf16*)(ws + WS_WQ))
#define Wkv_t ((bf16*)(ws + WS_WKV))
#define Wo_t ((bf16*)(ws + WS_WO))
#define W13d_t ((bf16*)(ws + WS_W13D))
#define W2d_t ((bf16*)(ws + WS_W2D))
#define W13m_t ((bf16*)(ws + WS_W13M))
#define W2m_t ((bf16*)(ws + WS_W2M))
#define xb ((bf16*)(ws + WS_XB))
#define qx ((bf16*)(ws + WS_QX))
#define ox ((bf16*)(ws + WS_OX))
#define Ag ((bf16*)(ws + WS_AG))
#define ym ((bf16*)(ws + WS_YM))
#define ypart ((bf16*)(ws + WS_YM + 136 * MiB))
#define proj ((bf16*)(ws + WS_PROJ))
#define ymix ((bf16*)(ws + WS_Y))
#define hbuf ((bf16*)(ws + WS_H))
#define kvx ((bf16*)(ws + WS_KVX))
#define memn ((bf16*)(ws + WS_MEMN))
#define vtb ((bf16*)(ws + WS_VT))
#define opart ((bf16*)(ws + WS_OPART))
#define lsep ((float*)(ws + WS_LSE))
#define vtx ((bf16*)(ws + WS_VTX))
#define ssp ((float*)(ws + WS_SSP))
#define cnts ((int*)(ws + WS_CNT))
#define meta ((int*)(ws + WS_META))
#define tok_e ((int*)(ws + WS_TOKE))
#define tok_g ((float*)(ws + WS_TOKG))
#define tok_pos ((int*)(ws + WS_TOKPOS))
#define row_gate ((float*)(ws + WS_ROWGATE))
#define row_rs ((float*)(ws + WS_ROWRS))
#ifndef PROBE
#define PROBE 0
#endif
#ifndef N_LAUNCH_MODE
#define N_LAUNCH_MODE 0
#endif

__device__ __forceinline__ void pair_barrier(unsigned* cnt, unsigned target, bool same_xcc, unsigned* tmo, int wave0) {
    asm volatile("s_waitcnt vmcnt(0)" ::: "memory");
    __syncthreads();
    int ln; asm volatile("v_mbcnt_lo_u32_b32 %0, -1, 0\n\tv_mbcnt_hi_u32_b32 %0, -1, %0" : "=v"(ln));
    if (wave0 == 0 && ln == 0) {
        if (!same_xcc) { __builtin_amdgcn_fence(__ATOMIC_RELEASE, "agent"); asm volatile("s_waitcnt vmcnt(0)" ::: "memory"); }
        (void)xb_add(cnt, 1u);
        unsigned sp = 0u;
        while (xb_ld(cnt) < target) { __builtin_amdgcn_s_sleep(1); if ((++sp & 255u) == 0u) { if (xb_ld(tmo)) break; if (sp > XB_SPIN_CAP) { atomicAdd(tmo, 1u); break; } } }
        __builtin_amdgcn_fence(__ATOMIC_ACQUIRE, "agent");
        asm volatile("s_waitcnt vmcnt(0)" ::: "memory");
    }
    __syncthreads();
}
__global__ void __launch_bounds__(NWAVES * 64, 2) trunk_fwd(Args args) {
    extern __shared__ __attribute__((aligned(16))) unsigned char lds_raw[];
    LAS unsigned char* lds = (LAS unsigned char*)lds_raw;
    volatile LAS unsigned* MISC = (volatile LAS unsigned*)(lds + MISC_OFF);
    const int tid0 = threadIdx.x;
    const int G0 = gridDim.x, blk0 = blockIdx.x, wave0 = __builtin_amdgcn_readfirstlane(tid0 >> 6);
    unsigned char* ws0 = args.ws;
    gu32* ctl = (gu32*)(ws0 + WS_CTL);
#define PH_VARS int lane_; asm volatile("v_mbcnt_lo_u32_b32 %0, -1, 0\n\tv_mbcnt_hi_u32_b32 %0, -1, %0" : "=v"(lane_)); int wv_ = wave0; asm volatile("" : "+s"(wv_)); int blk = blk0; asm volatile("" : "+s"(blk)); int G = G0; asm volatile("" : "+s"(G)); \
    unsigned char* ws = ws0; asm volatile("" : "+s"(ws)); const int lane = lane_, wave = wv_, tid = wv_ * 64 + lane_; const int gw = blk * NWAVES + wave, NGW = G * NWAVES; (void)lane; (void)gw; (void)NGW; (void)ws; (void)tid
    for (int u = tid0; u < (LDS_BYTES - LDSCTL_OFF) / 4; u += NWAVES * 64) ((LAS unsigned*)(lds + LDSCTL_OFF))[u] = 0u;
    __syncthreads();
    XcdBarrier bar = xcd_barrier_post((unsigned*)(ctl + CW_BAR), MISC + 8);
    bar.x = __builtin_amdgcn_readfirstlane(bar.x);
    if (tid0 == 0) __hip_atomic_store((unsigned*)(ws0 + WS_XCCTAB) + blk0, bar.x, __ATOMIC_RELAXED, __HIP_MEMORY_SCOPE_AGENT);
    const int tpm0 = (blk0 & 7) + 8 * (blk0 >> 4), tmb0 = (blk0 >> 3) & 1;
    unsigned pepoch = 0u; bool same_xcc = false;
#define PAIR_BAR do { pepoch += 2u; unsigned* tc_ = (unsigned*)(ctl + CW_TEAM) + 64 * tpm0; asm volatile("" : "+s"(tc_)); pair_barrier(tc_, pepoch, same_xcc, (unsigned*)(ctl + CW_BAR) + XB_TMO, wave0); } while (0)
#if N_LAUNCH_MODE == 0
#define PH_ON true
#define PH_END do { for (int br_ = 0; br_ < ((PROBE & 1024) ? 3 : 1); ++br_) { XcdBarrier b_ = bar; asm volatile("" : "+s"(b_.x)); asm volatile("" : "+s"(b_.bar)); xcd_barrier(b_); } } while (0)
#else
    const int lo = args.ph_lo, hi = args.ph_hi;
    int ph = 0;
#define PH_ON (ph >= lo && ph < hi)
#define PH_END do { if (ph >= lo && ph + 1 < hi) { XcdBarrier b_ = bar; asm volatile("" : "+s"(b_.x)); asm volatile("" : "+s"(b_.bar)); xcd_barrier(b_); } ++ph; } while (0)
#endif

    constexpr size_t SSP_STRIDE = (size_t)T * 16;

    if (PH_ON) { PH_VARS;
        LAS float* scr = (LAS float*)(lds + wave * 16896);
        constexpr int I_IN = 16 * 40, I_OUT = 16 * 16, I_Q = 16 * 8, I_KV = 16 * 16, I_O = 8 * 16, I_13D = 16 * 88, I_2D = 44 * 16, I_13M = 16 * 112, I_2M = 56 * 16;
        constexpr int C0 = 4 * I_IN, C1 = C0 + 4 * I_OUT, C2 = C1 + 4 * I_Q, C3 = C2 + 4 * I_KV, C4 = C3 + 4 * I_O, C5 = C4 + 2 * I_13D, C6 = C5 + 2 * I_2D, C7 = C6 + 16 * I_13M, C8 = C7 + 16 * I_2M;
        for (int rep = 0; rep < ((PROBE & 16) ? 2 : 1); ++rep)
        for (int it = gw; it < C8; it += NGW) {
            if (it < C0) { const int m = it / I_IN, r = it % I_IN; if (m < 2) conv_item(w_in + (size_t)m * D * NPROJ, D, NPROJ, Win_t + (size_t)m * NPROJ * D, mix_g + m * D, 0, scr, r, lane);
                else conv_item8(w_in + (size_t)m * D * NPROJ, D, NPROJ, (unsigned char*)(Win_t + (size_t)m * NPROJ * D), mix_g + m * D, 0, F8_S1, scr, r, lane); }
            else if (it < C1) { const int q = it - C0, m = q / I_OUT, r = q % I_OUT; conv_item(w_out + (size_t)m * D * D, D, D, Wout_t + (size_t)m * D * D, nullptr, 0, scr, r, lane); }
            else if (it < C2) { const int q = it - C1, m = q / I_Q, r = q % I_Q; conv_item(wq_x + (size_t)m * D * XW, D, XW, Wq_t + (size_t)m * XW * D, xat_g + m * D, 0, scr, r, lane); }
            else if (it < C3) { const int q = it - C2, m = q / I_KV, r = q % I_KV; conv_item(wkv_x + (size_t)m * D * 1024, D, 1024, Wkv_t + (size_t)m * 1024 * D, nullptr, 0, scr, r, lane); }
            else if (it < C4) { const int q = it - C3, m = q / I_O, r = q % I_O; conv_item(wo_x + (size_t)m * XW * D, XW, D, Wo_t + (size_t)m * D * XW, nullptr, 0, scr, r, lane); }
            else if (it < C5) { const int q = it - C4, m = q / I_13D, r = q % I_13D; if (m == 0) conv_item(w13_d, D, 2 * FFD, W13d_t, ffn_g, FFD, scr, r, lane); else conv_item8(w13_d + (size_t)D * 2 * FFD, D, 2 * FFD, (unsigned char*)(W13d_t + (size_t)2 * FFD * D), ffn_g + 2 * D, FFD, F8_S1, scr, r, lane); }
            else if (it < C6) { const int q = it - C5, m = q / I_2D, r = q % I_2D; if (m == 0) conv_item(w2_d, FFD, D, W2d_t, nullptr, 0, scr, r, lane); else conv_item8(w2_d + (size_t)FFD * D, FFD, D, (unsigned char*)(W2d_t + (size_t)D * FFD), nullptr, 0, F8_S2, scr, r, lane); }
            else if (it < C7) { const int q = it - C6, m = q / I_13M, r = q % I_13M; conv_item8(w13_m + (size_t)m * D * 2 * FFE, D, 2 * FFE, (unsigned char*)W13m_t + (size_t)m * 2 * FFE * D, ffn_g + (2 * (m >> 3) + 1) * D, FFE, F8_S1, scr, r, lane); }
            else { const int q = it - C7, m = q / I_2M, r = q % I_2M; conv_item8(w2_m + (size_t)m * FFE * D, FFE, D, (unsigned char*)W2m_t + (size_t)m * D * FFE, nullptr, 0, F8_S2, scr, r, lane); }
        }
        for (int idx = gw * 64 + lane; idx < DEPTH * 4 * 64 * 64; idx += NGW * 64) { const int c = idx & 63, dp = (idx >> 6) & 63, lg = idx >> 12;
            ((bf16*)(ws + WS_PWT))[idx] = (bf16)f2bf(pool_w[(size_t)(lg * 64 + c) * 64 + dp]); }
        for (int m = gw; m < T; m += NGW) {
            const GAS f32x4* xr = (const GAS f32x4*)(x_in + (size_t)m * D) + lane; f32x4 v[4]; float s = 0.f;
#pragma unroll
            for (int j = 0; j < 4; ++j) { v[j] = xr[64 * j]; s += (v[j].x * v[j].x + v[j].y * v[j].y) + (v[j].z * v[j].z + v[j].w * v[j].w); }
            s = wave_sum(s, lane);
            GAS unsigned long long* o8 = (GAS unsigned long long*)(xb + (size_t)m * D) + lane;
#pragma unroll
            for (int j = 0; j < 4; ++j) o8[64 * j] = (unsigned long long)pk2(v[j].x, v[j].y) | ((unsigned long long)pk2(v[j].z, v[j].w) << 32);
            if (lane < 16) ssp[(size_t)m * 16 + lane] = lane == 0 ? s : 0.f;
        }
        for (int m = gw; m < MROWS; m += NGW) {
            const GAS f32x4* xr = (const GAS f32x4*)(mem_in + (size_t)m * D) + lane; const GAS f32x4* gr = (const GAS f32x4*)mem_g + lane; f32x4 v[4]; float s = 0.f;
#pragma unroll
            for (int j = 0; j < 4; ++j) { v[j] = xr[64 * j]; s += (v[j].x * v[j].x + v[j].y * v[j].y) + (v[j].z * v[j].z + v[j].w * v[j].w); }
            const float r = 1.0f / sqrtf(wave_sum(s, lane) * (1.0f / D) + 1e-6f);
            GAS unsigned long long* o8 = (GAS unsigned long long*)(memn + (size_t)m * D) + lane;
#pragma unroll
            for (int j = 0; j < 4; ++j) { const f32x4 g = gr[64 * j]; o8[64 * j] = (unsigned long long)pk2(v[j].x * r * g.x, v[j].y * r * g.y) | ((unsigned long long)pk2(v[j].z * r * g.z, v[j].w * r * g.w) << 32); }
        }
    }
    PH_END;
    same_xcc = (unsigned)__builtin_amdgcn_readfirstlane((int)xb_ld((unsigned*)(ws0 + WS_XCCTAB) + (blk0 ^ 8))) == bar.x;

    for (int l = 0; l < DEPTH; ++l) {
#define ssp_a (ssp + (size_t)(3 * l) * SSP_STRIDE)
#define ssp_b (ssp + (size_t)(3 * l + 1) * SSP_STRIDE)
#define ssp_c (ssp + (size_t)(3 * l + 2) * SSP_STRIDE)
#define ssp_d (ssp + (size_t)(3 * l + 3) * SSP_STRIDE)
        if (PH_ON) { PH_VARS;
            if (l == 0) {
                pg8::Gemm g{memn, Wkv_t, MROWS, 4096, D}; pg8::StaticOrder S; S.init(MROWS, 4096, G, blk);
                pg8::EpiKV E{kvx, vtx};
                pg8::gemm_phase<pg8::EpiKV, pg8::StaticOrder, true, true>(lds, g, S, E, tid);
#if PROBE & (1 | 64)
                pg8::gemm_phase<pg8::EpiKV, pg8::StaticOrder, true, true>(lds, g, S, E, tid);
#endif
            }
        }
        if (PH_ON) {
            if (l >= 2) { PH_VARS;
                pg8::Gemm g{Ag, Win_t + (size_t)l * NPROJ * D, T, NPROJ, D / 2}; pg8::StaticOrder S; S.init(T, NPROJ, G, blk);
                pg8::EpiRowScale E{proj, NPROJ, ssp_a, 1.0f / F8_S1};
                pg8::gemm_phase<pg8::EpiRowScale, pg8::StaticOrder, true, true, true>(lds, g, S, E, tid);
            } else { PH_VARS;
                pg8::Gemm g{xb, Win_t + (size_t)l * NPROJ * D, T, NPROJ, D}; pg8::StaticOrder S; S.init(T, NPROJ, G, blk);
                pg8::EpiRowScale E{proj, NPROJ, ssp_a, 1.0f};
                pg8::gemm_phase<pg8::EpiRowScale, pg8::StaticOrder, true, true>(lds, g, S, E, tid);
            }
        }
        PH_END;
        if (PH_ON) { PH_VARS;
            LAS float* bt = (LAS float*)lds;
            for (int idx = tid; idx < 3 * 8 * BT_LD; idx += NWAVES * 64) { const int part = idx / (8 * BT_LD), rem = idx % (8 * BT_LD), h = rem / BT_LD, j = rem % BT_LD - BT_OFF, sh = 2 * part, jlo = part ? 33 : 0;
                float v = NEGINF; if (j <= 128 && j >= jlo) { const int d = j << sh; v = (rel_bias[t5_bucket(d) * 8 + h] + logf((float)key_mult(d))) * 1.4426950408889634f; } bt[idx] = v; }
            __syncthreads();
            for (int rep = 0; rep < ((PROBE & (2 | 2048 | 16384)) ? 2 : 1); ++rep) {
            v4u sk[6], sv[6];
#define DIL_DEC(u_) const int part = (u_) >> 10, v_ = (u_) & 1023, sh = 2 * part, b = v_ >> 8, h = (v_ >> 5) & 7, w5 = v_ & 31, nbs = 5 - sh, r = w5 >> nbs, n0 = 256 * (w5 & ((1 << nbs) - 1))
            { const int u0 = blk < 3 * 1024 ? blk : 0; DIL_DEC(u0); dil_stage_load_k(sk, proj, sh, b, h, r, n0, tid); dil_stage_load_v(sv, proj, sh, b, h, r, n0, tid); }
            for (int u = blk; u < 3 * 1024; u += G) {
                DIL_DEC(u);
                const bool dst = !((PROBE & 2048) && rep == 1);
                __syncthreads();
                dil_stage_write_k(lds + 20480, sk, tid); dil_stage_write_v(lds + 20480, sv, tid);
                const int tq = b * SEQ + r + ((n0 + 32 * wave + (lane & 31)) << sh);
                bf16x8 qf[4];
                { const bf16* qp = proj + (size_t)tq * NPROJ + PC_Q + h * 64 + 32 * (lane >> 5);
#pragma unroll
                  for (int ks = 0; ks < 4; ++ks) qf[ks] = *(const GAS bf16x8*)(qp + 8 * ks); }
                __syncthreads();
                { const int un = u + G < 3 * 1024 ? u + G : u, part2 = un >> 10, v2 = un & 1023, sh2 = 2 * part2, nbs2 = 5 - sh2, w52 = v2 & 31, b2 = v2 >> 8, h2 = (v2 >> 5) & 7, r2 = w52 >> nbs2, n02 = 256 * (w52 & ((1 << nbs2) - 1));
                    dil_stage_load_k(sk, proj, sh2, b2, h2, r2, n02, tid); dil_stage_load_v(sv, proj, sh2, b2, h2, r2, n02, tid); }
                if ((PROBE & 16384) && rep == 1) continue;
                if (part == 0) dil_wg_compute<0>(lds + 20480, qf, opart, lsep, bt + h * BT_LD, tq, h, n0 + 32 * wave - 128, lane, wave, dst);
                else dil_wg_compute<33>(lds + 20480, qf, opart + (size_t)part * OP_STRIDE, lsep + (size_t)part * T * 8, bt + (part * 8 + h) * BT_LD, tq, h, n0 + 32 * wave - 128, lane, wave, dst);
            }
#undef DIL_DEC
            }
            __syncthreads();
        }
        PH_END;
        if (PH_ON) { PH_VARS;
            const bf16* pwT = (const bf16*)(ws + WS_PWT) + (size_t)l * 4 * 64 * 64;
            const int t0 = 32 * (tpm0 * 8 + 4 * tmb0 + (wave >> 1));
            if ((wave & 1) == 0) pool_unit(proj, pwT, pool_scale + (size_t)l * 256, ymix, t0, lane);
            else mergeconv_unit(proj, opart, lsep, conv_w + (size_t)l * 768, ymix, t0, lane);
        }
        PAIR_BAR;
        if (PH_ON) { PH_VARS;
            pg8::Gemm g{ymix, Wout_t + (size_t)l * D * D, T, D, D}; pg8::TeamOrder S{tpm0, 2 * tmb0, 2};
            pg8::EpiResid E{l == 0 ? x_in : (const float*)nullptr, xb, ssp_b, nullptr, 1.0f, 0};
            pg8::gemm_phase<pg8::EpiResid, pg8::TeamOrder, true, true>(lds, g, S, E, tid);
        }
        PAIR_BAR;
        if (PH_ON) { PH_VARS;
            pg8::Gemm g{xb, Wq_t + (size_t)l * XW * D, T, XW, D}; pg8::TeamOrder S{tpm0, tmb0, 1};
            pg8::EpiRowScale E{qx, XW, ssp_b, 0.08838834764831845f};
            pg8::gemm_phase<pg8::EpiRowScale, pg8::TeamOrder, true, true>(lds, g, S, E, tid);
            { const int b = (tpm0 * 256) / SEQ;
              for (int h2 = 0; h2 < 2; ++h2) xat_wg_unit(lds, qx, kvx + (size_t)(b * MEML) * 4096 + l * 1024, vtx + (size_t)((l * 4 + b) * 512) * MEML, ox, tpm0 * 256 + wave * 32, 2 * tmb0 + h2, tid); }
            __syncthreads();
        }
        PAIR_BAR;
        if (PH_ON) { PH_VARS;
            pg8::Gemm g{ox, Wo_t + (size_t)l * D * XW, T, D, XW}; pg8::TeamOrder S{tpm0, 2 * tmb0, 2};
            pg8::EpiResid E{nullptr, xb, ssp_c, (unsigned char*)Ag, 1.0f, l == 2 ? 1 : 0};
            pg8::gemm_phase<pg8::EpiResid, pg8::TeamOrder, true, true>(lds, g, S, E, tid);
        }
        PH_END;
        if ((l & 1) == 0) {
            if (PH_ON) { PH_VARS;
                pg8::StaticOrder S; S.init(T, 2 * FFD, G, blk);
                if (l == 2) {
                    pg8::Gemm g{Ag, W13d_t + (size_t)2 * FFD * D, T, 2 * FFD, D / 2};
                    pg8::EpiSwiGLU8 E{(unsigned char*)hbuf, FFD, nullptr, 0, 1.0f / F8_S1, F8_SH, ssp_c};
                    pg8::gemm_phase<pg8::EpiSwiGLU8, pg8::StaticOrder, true, true, true>(lds, g, S, E, tid);
                } else {
                    pg8::Gemm g{xb, W13d_t, T, 2 * FFD, D};
                    pg8::EpiSwiGLU E{hbuf, FFD, ssp_c, nullptr, 0};
                    pg8::gemm_phase<pg8::EpiSwiGLU, pg8::StaticOrder, true, true>(lds, g, S, E, tid);
                }
            }
            PH_END;
            if (PH_ON) { PH_VARS;
                pg8::StaticOrder S; S.init(T, D, G, blk);
                if (l == 2) {
                    pg8::Gemm g{hbuf, W2d_t + (size_t)D * FFD, T, D, FFD / 2};
                    pg8::EpiResid E{nullptr, xb, ssp_d, (unsigned char*)Ag, 1.0f / (F8_S2 * F8_SH), 1};
                    pg8::gemm_phase<pg8::EpiResid, pg8::StaticOrder, true, true, true>(lds, g, S, E, tid);
                } else {
                    pg8::Gemm g{hbuf, W2d_t, T, D, FFD};
                    pg8::EpiResid E{nullptr, xb, ssp_d, nullptr, 1.0f, 0};
                    pg8::gemm_phase<pg8::EpiResid, pg8::StaticOrder, true, true>(lds, g, S, E, tid);
                }
            }
            PH_END;
        } else {
#define chunk ((T + G - 1) / G)
            if (PH_ON) { PH_VARS;
                LAS int* lcnt = (LAS int*)lds; const float* rw = router_w + (size_t)(l >> 1) * D * NEXP; const float* fg = ffn_g + (size_t)l * D;
                if (tid < NEXP) lcnt[tid] = 0;
                __syncthreads();
                for (int i = wave; i < chunk; i += NWAVES) { const int t = blk * chunk + i; if (t >= T) break;
                    const float r = pg8::row_rs16(ssp_c, t);
                    float lg[8];
#pragma unroll
                    for (int e = 0; e < 8; ++e) lg[e] = 0.f;
#pragma unroll
                    for (int j = 0; j < 4; ++j) { const u32x2 xw = *((const GAS u32x2*)(xb + (size_t)t * D) + lane + 64 * j); const f32x4 xv = {bflo(xw.x), bfhi(xw.x), bflo(xw.y), bfhi(xw.y)}; const f32x4 gv = *((const GAS f32x4*)fg + lane + 64 * j);
#pragma unroll
                        for (int c = 0; c < 4; ++c) { const float hn = xv[c] * r * gv[c]; const int k = 4 * (lane + 64 * j) + c; const f32x4 w0 = *(const GAS f32x4*)(rw + (size_t)k * 8), w1 = *(const GAS f32x4*)(rw + (size_t)k * 8 + 4);
                            lg[0] += hn * w0[0]; lg[1] += hn * w0[1]; lg[2] += hn * w0[2]; lg[3] += hn * w0[3]; lg[4] += hn * w1[0]; lg[5] += hn * w1[1]; lg[6] += hn * w1[2]; lg[7] += hn * w1[3]; } }
#pragma unroll
                    for (int e = 0; e < 8; ++e) lg[e] = wave_sum(lg[e], lane);
                    int e0 = 0; float v0 = lg[0];
#pragma unroll
                    for (int e = 1; e < 8; ++e) if (lg[e] > v0) { v0 = lg[e]; e0 = e; }
                    int e1 = -1; float v1 = -3.0e38f;
#pragma unroll
                    for (int e = 0; e < 8; ++e) if (e != e0 && lg[e] > v1) { v1 = lg[e]; e1 = e; }
                    const float p0 = 1.0f / (1.0f + __expf(v1 - v0)), p1 = 1.0f - p0;
                    if (lane == 0) { tok_e[2 * t] = e0; tok_e[2 * t + 1] = e1; tok_g[2 * t] = p0; tok_g[2 * t + 1] = p1; atomicAdd((int*)&lcnt[e0], 1); atomicAdd((int*)&lcnt[e1], 1); }
                }
                __syncthreads();
                if (tid < NEXP) cnts[blk * NEXP + tid] = lcnt[tid];
                __syncthreads();
            }
            PH_END;
            if (PH_ON) { PH_VARS;
                LAS int* lc = (LAS int*)lds;
                LAS int* lbase = (LAS int*)(lds + 32768);
                LAS int* lseg = (LAS int*)(lds + 32768 + 64);
                LAS int* lpos = (LAS int*)(lds + 36864);
                for (int i = tid; i < G * NEXP; i += NWAVES * 64) lc[i] = cnts[i];
                __syncthreads();
                { int base = 0, tot = 0;
                  for (int b2 = lane; b2 < G; b2 += 64) { const int c = lc[b2 * NEXP + wave]; tot += c; base += b2 < blk ? c : 0; }
                  for (int o = 1; o < 32; o <<= 1) { tot += __builtin_amdgcn_ds_bpermute((lane ^ o) << 2, tot); base += __builtin_amdgcn_ds_bpermute((lane ^ o) << 2, base); }
                  tot += __builtin_amdgcn_ds_bpermute((lane ^ 32) << 2, tot); base += __builtin_amdgcn_ds_bpermute((lane ^ 32) << 2, base);
                  if (lane == 0) { lbase[wave] = base; lseg[8 + wave] = tot; } }
                __syncthreads();
                if (tid == 0) { int s = 0; for (int e = 0; e < NEXP; ++e) { lseg[e] = s; lbase[e] += s; s += (lseg[8 + e] + 255) & ~255; lseg[16 + e] = s; if (blk == 0) meta[e] = s >> 8; } }
                __syncthreads();
                if (wave == 0) {
                    int run[8];
#pragma unroll
                    for (int e = 0; e < 8; ++e) run[e] = lbase[e];
                    const int nent = 2 * chunk;
                    for (int r0 = 0; r0 < nent; r0 += 64) { const int idx = r0 + lane; const int t = blk * chunk + (idx >> 1); const bool ok = idx < nent && t < T;
                        const int e = ok ? tok_e[2 * t + (idx & 1)] : -1; int pos = 0;
#pragma unroll
                        for (int ee = 0; ee < 8; ++ee) { const unsigned long long mk = __ballot(e == ee); if (e == ee) pos = run[ee] + __popcll(mk & ((1ull << lane) - 1ull)); run[ee] += __popcll(mk); }
                        if (ok) { tok_pos[2 * t + (idx & 1)] = pos; row_gate[pos] = tok_g[2 * t + (idx & 1)]; row_rs[pos] = pg8::row_rs16(ssp_c, t); lpos[idx] = pos; } }
                }
                __syncthreads();
                for (int idx = wave; idx < 2 * chunk; idx += NWAVES) { const int t = blk * chunk + (idx >> 1); if (t >= T) break; const int pos = lpos[idx];
                    const GAS v4u* src = (const GAS v4u*)(xb + (size_t)t * D); const v4u a = src[2 * lane], c = src[2 * lane + 1];
                    v4u o; o.x = pg8::pk4_fp8(bflo(a.x), bfhi(a.x), bflo(a.y), bfhi(a.y)); o.y = pg8::pk4_fp8(bflo(a.z), bfhi(a.z), bflo(a.w), bfhi(a.w));
                    o.z = pg8::pk4_fp8(bflo(c.x), bfhi(c.x), bflo(c.y), bfhi(c.y)); o.w = pg8::pk4_fp8(bflo(c.z), bfhi(c.z), bflo(c.w), bfhi(c.w));
                    *((GAS v4u*)((unsigned char*)Ag + (size_t)pos * D) + lane) = o; }
                if (blk < NEXP) { const int r0 = lseg[blk] + lseg[8 + blk], r1 = lseg[16 + blk];
                    for (int r = r0 + wave; r < r1; r += NWAVES) { GAS v4u* dst = (GAS v4u*)((unsigned char*)Ag + (size_t)r * D); unsigned z0; asm volatile("v_mov_b32 %0, 0" : "=v"(z0)); const v4u z = {z0, z0, z0, z0}; dst[lane] = z; if (lane == 0) { row_gate[r] = 0.f; row_rs[r] = 0.f; } } }
                __syncthreads();
            }
            PH_END;
            if (PH_ON) { PH_VARS;
                pg8::MoeOrder S;
#pragma unroll
                for (int e = 0; e < 8; ++e) S.te[e] = __builtin_amdgcn_readfirstlane(meta[e]);
                S.nNl = 2 * FFE / 256; S.so.init(S.te[7] * 256, 2 * FFE, G, blk);
                pg8::Gemm g{Ag, W13m_t + (size_t)(l >> 1) * NEXP * 2 * FFE * (D / 2), MP, NEXP * 2 * FFE, D / 2};
                pg8::EpiSwiGLU8 E{(unsigned char*)hbuf, FFE, row_rs, 2 * FFE / 256, 1.0f / F8_S1, F8_SH, nullptr};
                pg8::gemm_phase<pg8::EpiSwiGLU8, pg8::MoeOrder, true, true, true>(lds, g, S, E, tid);
#if PROBE & (1 | 512)
                pg8::gemm_phase<pg8::EpiSwiGLU8, pg8::MoeOrder, true, true, true>(lds, g, S, E, tid);
#endif
            }
            PH_END;
            if (PH_ON) { PH_VARS;
                pg8::MoeOrder S;
#pragma unroll
                for (int e = 0; e < 8; ++e) S.te[e] = __builtin_amdgcn_readfirstlane(meta[e]);
                const int ntile = S.te[7], nmain = ntile < 256 ? ntile : 256;
                S.nNl = D / 256; S.so.init(nmain * 256, D, G, blk);
                pg8::Gemm g{hbuf, W2m_t + (size_t)(l >> 1) * NEXP * D * (FFE / 2), MP, NEXP * D, FFE / 2};
                pg8::EpiMoeOut E{ym, row_gate, 1.0f / (F8_S2 * F8_SH)};
                pg8::gemm_phase<pg8::EpiMoeOut, pg8::MoeOrder, true, true, true>(lds, g, S, E, tid);
#if PROBE & (1 | 512)
                pg8::gemm_phase<pg8::EpiMoeOut, pg8::MoeOrder, true, true, true>(lds, g, S, E, tid);
#endif
                if (ntile > 256) {
                    pg8::MoeTailOrder ST; ST.npieces = (ntile - 256) * 4 * 7; ST.G = G; ST.c = blk; ST.kstep = 512;
#pragma unroll
                    for (int e = 0; e < 8; ++e) ST.te[e] = S.te[e];
                    pg8::Gemm g2{hbuf, W2m_t + (size_t)(l >> 1) * NEXP * D * (FFE / 2), MP, NEXP * D, 256, FFE / 2};
                    pg8::EpiMoePart EP{ypart, row_gate, 1.0f / (F8_S2 * F8_SH), 9};
                    pg8::gemm_phase<pg8::EpiMoePart, pg8::MoeTailOrder, true, true, true>(lds, g2, ST, EP, tid);
                }
            }
            PH_END;
            if (PH_ON) { PH_VARS;
                const bool last = (l == DEPTH - 1);
                for (int t = gw; t < T; t += NGW) {
                    const int p0 = tok_pos[2 * t], p1 = tok_pos[2 * t + 1];
                    const GAS u32x2* xr = (const GAS u32x2*)(xb + (size_t)t * D) + lane; const GAS u32x2* y0 = (const GAS u32x2*)(ym + (size_t)p0 * D) + lane; const GAS u32x2* y1 = (const GAS u32x2*)(ym + (size_t)p1 * D) + lane;
                    f32x4 v[4]; float s = 0.f;
#pragma unroll
                    for (int j = 0; j < 4; ++j) { const u32x2 a = xr[64 * j]; f32x4 e0, e1;
                        if (p0 < 65536) { const u32x2 b0 = y0[64 * j]; e0 = (f32x4){bflo(b0.x), bfhi(b0.x), bflo(b0.y), bfhi(b0.y)}; }
                        else { e0 = (f32x4){0.f, 0.f, 0.f, 0.f};
                            for (int kp = 0; kp < 7; ++kp) { const u32x2 b0 = *((const GAS u32x2*)(ypart + ((size_t)kp * 2048 + (p0 - 65536)) * D) + lane + 64 * j); e0 += (f32x4){bflo(b0.x), bfhi(b0.x), bflo(b0.y), bfhi(b0.y)}; } }
                        if (p1 < 65536) { const u32x2 b1 = y1[64 * j]; e1 = (f32x4){bflo(b1.x), bfhi(b1.x), bflo(b1.y), bfhi(b1.y)}; }
                        else { e1 = (f32x4){0.f, 0.f, 0.f, 0.f};
                            for (int kp = 0; kp < 7; ++kp) { const u32x2 b1 = *((const GAS u32x2*)(ypart + ((size_t)kp * 2048 + (p1 - 65536)) * D) + lane + 64 * j); e1 += (f32x4){bflo(b1.x), bfhi(b1.x), bflo(b1.y), bfhi(b1.y)}; } }
                        v[j] = ((f32x4){bflo(a.x), bfhi(a.x), bflo(a.y), bfhi(a.y)} + e0) + e1;
                        s += (v[j].x * v[j].x + v[j].y * v[j].y) + (v[j].z * v[j].z + v[j].w * v[j].w); }
                    s = wave_sum(s, lane);
                    GAS f32x4* orow = (GAS f32x4*)(out + (size_t)t * D) + lane;
                    if (last) { const float r = 1.0f / sqrtf(s * (1.0f / D) + 1e-6f); const GAS f32x4* gr = (const GAS f32x4*)fin_g + lane;
#pragma unroll
                        for (int j = 0; j < 4; ++j) orow[64 * j] = v[j] * r * gr[64 * j]; }
                    else { GAS unsigned long long* o8 = (GAS unsigned long long*)(xb + (size_t)t * D) + lane;
#pragma unroll
                        for (int j = 0; j < 4; ++j) o8[64 * j] = (unsigned long long)pk2(v[j].x, v[j].y) | ((unsigned long long)pk2(v[j].z, v[j].w) << 32);
                        { GAS unsigned* o4 = (GAS unsigned*)((unsigned char*)Ag + (size_t)t * D) + lane;
#pragma unroll
                          for (int j = 0; j < 4; ++j) o4[64 * j] = pg8::pk4_fp8(v[j].x, v[j].y, v[j].z, v[j].w); }
                        if (lane < 16) ssp_d[(size_t)t * 16 + lane] = lane == 0 ? s : 0.f; }
                }
            }
            if (l != DEPTH - 1) { PH_END; }
        }
    }
#undef PH_ON
#undef PH_END
}
#undef x_in
#undef mem_in
#undef rel_bias
#undef mem_g
#undef mix_g
#undef w_in
#undef conv_w
#undef pool_w
#undef pool_scale
#undef w_out
#undef xat_g
#undef wq_x
#undef wkv_x
#undef wo_x
#undef ffn_g
#undef w13_d
#undef w2_d
#undef router_w
#undef w13_m
#undef w2_m
#undef fin_g
#undef out
#undef Win_t
#undef Wout_t
#undef Wq_t
#undef Wkv_t
#undef Wo_t
#undef W13d_t
#undef W2d_t
#undef W13m_t
#undef W2m_t
#undef xb
#undef qx
#undef ox
#undef Ag
#undef ym
#undef proj
#undef ymix
#undef hbuf
#undef kvx
#undef memn
#undef ssp
#undef cnts
#undef meta
#undef tok_e
#undef tok_g
#undef tok_pos
#undef row_gate
#undef row_rs
#undef ssp_a
#undef ssp_b
#undef ssp_c
#undef ssp_d
#undef PH_VARS
#undef ypart
#undef chunk
#undef vtb
#undef opart
#undef lsep
#undef vtx

extern "C" void kernel_launch(void* const* d_in, const int* in_sizes, int n_in, void* d_out, int out_size, void* d_ws, size_t ws_size, hipStream_t stream) {
    static int grid = 0;
    if (grid == 0) {
        if (n_in != 21 || in_sizes[0] != T * D || out_size != T * D || ws_size < WS_END) { fprintf(stderr, "kernel_launch: unexpected shapes: n_in %d in0 %d out %d ws %zu (need %zu)\n", n_in, n_in > 0 ? in_sizes[0] : -1, out_size, ws_size, (size_t)WS_END); grid = -1; return; }
        int dev = 0, cus = 0, per_cu = 0;
        if (hipGetDevice(&dev) != hipSuccess || hipDeviceGetAttribute(&cus, hipDeviceAttributeMultiprocessorCount, dev) != hipSuccess) { fprintf(stderr, "kernel_launch: device query failed\n"); grid = -1; return; }
        if (hipFuncSetAttribute((const void*)trunk_fwd, hipFuncAttributeMaxDynamicSharedMemorySize, LDS_BYTES) != hipSuccess) { fprintf(stderr, "kernel_launch: hipFuncSetAttribute failed\n"); grid = -1; return; }
        if (hipOccupancyMaxActiveBlocksPerMultiprocessor(&per_cu, (const void*)trunk_fwd, NWAVES * 64, LDS_BYTES) != hipSuccess || per_cu < 1) fprintf(stderr, "kernel_launch: occupancy query reports %d\n", per_cu);
        (void)hipGetLastError();
        if (cus != T / 256 * 2) { fprintf(stderr, "kernel_launch: the team mapping needs %d CUs, device has %d\n", T / 256 * 2, cus); grid = -1; return; }
        grid = cus;
    }
    if (grid < 0) return;
    if (hipMemsetAsync((char*)d_ws + WS_CTL, 0, CTL_ZERO_BYTES, stream) != hipSuccess) { fprintf(stderr, "kernel_launch: memset failed\n"); return; }
    Args a{};
    for (int i = 0; i < 21; ++i) a.in[i] = (const float*)d_in[i];
    a.out = (float*)d_out; a.ws = (unsigned char*)d_ws;
#if N_LAUNCH_MODE == 0
    a.ph_lo = 0; a.ph_hi = NPH;
    hipLaunchKernelGGL(trunk_fwd, dim3(grid), dim3(NWAVES * 64), LDS_BYTES, stream, a);
#else
    for (int p = 0; p < NPH; ++p) { a.ph_lo = p; a.ph_hi = p + 1; hipLaunchKernelGGL(trunk_fwd, dim3(grid), dim3(NWAVES * 64), LDS_BYTES, stream, a); }
#endif
    const hipError_t le = hipPeekAtLastError();
    if (le != hipSuccess) fprintf(stderr, "kernel_launch: launch failed: %s\n", hipGetErrorName(le));
}
```

```cpp
#define PROBE 0
#include <hip/hip_runtime.h>
#include <cstdio>
#include <cstdint>
namespace pg8 {
#define PG8_LAS __attribute__((address_space(3)))
typedef unsigned short bf16_t;
typedef short bf16x8 __attribute__((ext_vector_type(8)));
typedef float f32x4 __attribute__((ext_vector_type(4)));
typedef unsigned u32x4 __attribute__((ext_vector_type(4)));
typedef int v4i_t __attribute__((ext_vector_type(4)));
typedef long v2l_t __attribute__((ext_vector_type(2)));
typedef int v8i_t __attribute__((ext_vector_type(8)));
constexpr int BM = 256, BK = 64, HALF = 128, HTB = HALF * BK * 2  , STAGE_BYTES = 8 * HTB, NXCD = 8, WGM = 8;

__host__ __device__ __forceinline__ int lds_byte(int r, int c) { const int st = (r >> 4) * 2 + (c >> 5), rr = r & 15, cc = c & 31, ob = rr * 64 + cc * 2; return st * 1024 + (ob ^ (((ob >> 9) & 1) << 5)); }
__host__ __device__ __forceinline__ void stage_rc(int b, int& R, int& C) { const int st = b / 1024, sb = b % 1024, swz = sb ^ (((sb >> 9) & 1) << 5); R = (st >> 1) * 16 + swz / 64; C = (st & 1) * 32 + (swz % 64) / 2; }
__host__ __device__ __forceinline__ int perm32(int rho) { const int n = rho >> 4, i = rho & 15; return 8 * (i >> 2) + 4 * n + (i & 3); }

struct Unit { int pm, pn; int ko = 0; };
struct Gemm { const bf16_t* A; const bf16_t* Bt; int M, N, K; int ld = 0; };

struct StaticOrder {
    int nM, nN, nwg, G, c;
    __host__ __device__ void init(int M, int N, int G_, int c_) { nM = M / BM; nN = N / BM; nwg = nM * nN; G = G_; c = c_; }
    __host__ __device__ __forceinline__ bool next(int i, Unit& u) const {
        const long L = (long)i * G + c; if (L >= nwg) return false;
        int wgid = (int)L; { const int q = nwg / NXCD, r = nwg % NXCD, xcd = wgid % NXCD, off = wgid / NXCD; wgid = (xcd < r ? xcd * (q + 1) : r * (q + 1) + (xcd - r) * q) + off; }
        const int nig = WGM * nN, gid = wgid / nig, fm = gid * WGM, gsz = (nM - fm) < WGM ? (nM - fm) : WGM;
        u.pm = fm + ((wgid % nig) % gsz); u.pn = (wgid % nig) / gsz; return true;
    }
    __device__ __forceinline__ void a_ready(const Unit&) const {}
    __device__ __forceinline__ void done(const Unit&) const {}
};

__device__ __forceinline__ unsigned cvt_pk_bf16(float lo, float hi) { unsigned r; asm volatile("v_cvt_pk_bf16_f32 %0, %1, %2" : "=v"(r) : "v"(lo), "v"(hi)); return r; }
typedef float f32x2 __attribute__((ext_vector_type(2)));
__device__ __forceinline__ float row_rs16(const float* ssp, int row) {
    const f32x4* sp = (const f32x4*)(ssp + (size_t)row * 16); const f32x4 s0 = sp[0], s1 = sp[1], s2 = sp[2], s3 = sp[3];
    const float s = (((s0[0] + s0[1]) + (s0[2] + s0[3])) + ((s1[0] + s1[1]) + (s1[2] + s1[3]))) + (((s2[0] + s2[1]) + (s2[2] + s2[3])) + ((s3[0] + s3[1]) + (s3[2] + s3[3])));
    return __builtin_amdgcn_rsqf(s * (1.0f / 1024.0f) + 1e-6f);
}
__device__ __forceinline__ void row_rs16x8(float (&r)[8], const float* ssp, int row0, int fr, int fq) {
    f32x4 c[8];
#pragma unroll
    for (int k = 0; k < 8; ++k) c[k] = *(const f32x4*)(ssp + (size_t)(row0 + (k >> 2) * HALF + (k & 3) * 16) * 16 + 4 * fq);
#pragma unroll
    for (int k = 0; k < 8; ++k) { float s = (c[k][0] + c[k][1]) + (c[k][2] + c[k][3]);
        s += __int_as_float(__builtin_amdgcn_ds_bpermute((((fq * 16 + fr) ^ 16) << 2), __float_as_int(s)));
        { const auto rr = __builtin_amdgcn_permlane32_swap(__float_as_uint(s), __float_as_uint(s), false, false); s = __uint_as_float(rr[0]) + __uint_as_float(rr[1]); }
        r[k] = __builtin_amdgcn_rsqf(s * (1.0f / 1024.0f) + 1e-6f); }
}
struct EpiRowScale {
    static constexpr bool PERM = true, AFTER_DRAIN = false;
    bf16_t* O; int ldc; const float* ssp; float cs;
    __device__ __forceinline__ void operator()(const f32x4 (&acc)[2][2][4][2], const Unit& u, int wr, int wc, int fr, int fq) const {
        const int row0 = u.pm * BM + wr * 64 + fr, col0 = u.pn * BM + wc * 32 + 8 * fq;
        float rr8[8];
        if (ssp) row_rs16x8(rr8, ssp, row0, fr, fq); else {
#pragma unroll
            for (int k = 0; k < 8; ++k) rr8[k] = 1.0f; }
#pragma unroll
        for (int ai = 0; ai < 2; ++ai)
#pragma unroll
            for (int m = 0; m < 4; ++m) { const int row = row0 + ai * HALF + m * 16; const float r = rr8[ai * 4 + m] * cs; bf16_t* rowp = O + (size_t)row * ldc + col0;
#pragma unroll
                for (int bj = 0; bj < 2; ++bj) { const f32x4 v0 = acc[ai][bj][m][0] * r, v1 = acc[ai][bj][m][1] * r;
                    u32x4 w; w.x = cvt_pk_bf16(v0[0], v0[1]); w.y = cvt_pk_bf16(v0[2], v0[3]); w.z = cvt_pk_bf16(v1[0], v1[1]); w.w = cvt_pk_bf16(v1[2], v1[3]);
                    *(u32x4*)(rowp + bj * HALF) = w; } }
    }
};
struct EpiInProj {
    static constexpr bool PERM = true, AFTER_DRAIN = false;
    bf16_t* O; const float* ssp; bf16_t* vt;
    __device__ __forceinline__ void operator()(const f32x4 (&acc)[2][2][4][2], const Unit& u, int wr, int wc, int fr, int fq) const {
        const int row0 = u.pm * BM + wr * 64 + fr;
        if (u.pn == 4 || u.pn == 5) {
            const int cv0 = (u.pn - 4) * BM + wc * 32 + 8 * fq; constexpr size_t CS = (size_t)32768 * 512;
#pragma unroll
            for (int ai = 0; ai < 2; ++ai)
#pragma unroll
                for (int m = 0; m < 4; ++m) { const int row = row0 + ai * HALF + m * 16; const float r = row_rs16(ssp, row); const int b = row >> 13, t = row & 8191;
                    const size_t o0 = (size_t)t, o1 = CS + (size_t)(t & 3) * 2048 + (t >> 2), o2 = 2 * CS + (size_t)(t & 15) * 512 + (t >> 4);
#pragma unroll
                    for (int bj = 0; bj < 2; ++bj)
#pragma unroll
                        for (int n = 0; n < 2; ++n) { const f32x4 v = acc[ai][bj][m][n] * r; const unsigned w01 = cvt_pk_bf16(v[0], v[1]), w23 = cvt_pk_bf16(v[2], v[3]);
                            bf16_t* p = vt + (size_t)(b * 512 + cv0 + bj * HALF + 4 * n) * 8192;
                            const bf16_t e0 = (bf16_t)(w01 & 0xffffu), e1 = (bf16_t)(w01 >> 16), e2 = (bf16_t)(w23 & 0xffffu), e3 = (bf16_t)(w23 >> 16);
                            p[o0] = e0; p[o1] = e0; p[o2] = e0; p[8192 + o0] = e1; p[8192 + o1] = e1; p[8192 + o2] = e1;
                            p[2 * 8192 + o0] = e2; p[2 * 8192 + o1] = e2; p[2 * 8192 + o2] = e2; p[3 * 8192 + o0] = e3; p[3 * 8192 + o1] = e3; p[3 * 8192 + o2] = e3; } }
        } else {
            const int col0 = u.pn * BM + wc * 32 + 8 * fq;
#pragma unroll
            for (int ai = 0; ai < 2; ++ai)
#pragma unroll
                for (int m = 0; m < 4; ++m) { const int row = row0 + ai * HALF + m * 16; const float r = row_rs16(ssp, row); bf16_t* rowp = O + (size_t)row * 2560 + col0;
#pragma unroll
                    for (int bj = 0; bj < 2; ++bj) { const f32x4 v0 = acc[ai][bj][m][0] * r, v1 = acc[ai][bj][m][1] * r;
                        u32x4 w; w.x = cvt_pk_bf16(v0[0], v0[1]); w.y = cvt_pk_bf16(v0[2], v0[3]); w.z = cvt_pk_bf16(v1[0], v1[1]); w.w = cvt_pk_bf16(v1[2], v1[3]);
                        *(u32x4*)(rowp + bj * HALF) = w; } }
        }
    }
};
struct EpiKV {
    static constexpr bool PERM = true, AFTER_DRAIN = false;
    bf16_t* kvx; bf16_t* vtx;
    __device__ __forceinline__ void operator()(const f32x4 (&acc)[2][2][4][2], const Unit& u, int wr, int wc, int fr, int fq) const {
        const int row0 = u.pm * BM + wr * 64 + fr, col0 = u.pn * BM + wc * 32 + 8 * fq;
        if ((u.pn & 3) >= 2) {
            const int lx = u.pn >> 2, dv0 = (col0 & 1023) - 512;
#pragma unroll
            for (int ai = 0; ai < 2; ++ai)
#pragma unroll
                for (int m = 0; m < 4; ++m) { const int row = row0 + ai * HALF + m * 16; const int b = row >> 8, key = row & 255;
#pragma unroll
                    for (int bj = 0; bj < 2; ++bj)
#pragma unroll
                        for (int n = 0; n < 2; ++n) { const f32x4 v = acc[ai][bj][m][n]; const unsigned w01 = cvt_pk_bf16(v[0], v[1]), w23 = cvt_pk_bf16(v[2], v[3]);
                            bf16_t* p = vtx + ((size_t)((lx * 4 + b) * 512 + dv0 + bj * HALF + 4 * n)) * 256 + key;
                            p[0] = (bf16_t)(w01 & 0xffffu); p[256] = (bf16_t)(w01 >> 16); p[512] = (bf16_t)(w23 & 0xffffu); p[768] = (bf16_t)(w23 >> 16); } }
        } else {
#pragma unroll
            for (int ai = 0; ai < 2; ++ai)
#pragma unroll
                for (int m = 0; m < 4; ++m) { const int row = row0 + ai * HALF + m * 16; bf16_t* rowp = kvx + (size_t)row * 4096 + col0;
#pragma unroll
                    for (int bj = 0; bj < 2; ++bj) { const f32x4 v0 = acc[ai][bj][m][0], v1 = acc[ai][bj][m][1];
                        u32x4 w; w.x = cvt_pk_bf16(v0[0], v0[1]); w.y = cvt_pk_bf16(v0[2], v0[3]); w.z = cvt_pk_bf16(v1[0], v1[1]); w.w = cvt_pk_bf16(v1[2], v1[3]);
                        *(u32x4*)(rowp + bj * HALF) = w; } }
        }
    }
};
__device__ __forceinline__ float silu_mul(float g, float u) { return g * u * __builtin_amdgcn_rcpf(1.0f + __expf(-g)); }
struct EpiSwiGLU {
    static constexpr bool PERM = true, AFTER_DRAIN = false;
    bf16_t* O; int ldc; const float* ssp; const float* rmul; int pn_mod;
    __device__ __forceinline__ void operator()(const f32x4 (&acc)[2][2][4][2], const Unit& u, int wr, int wc, int fr, int fq) const {
        const int pnl = pn_mod ? (u.pn % pn_mod) : u.pn;
        const int row0 = u.pm * BM + wr * 64 + fr, col0 = pnl * HALF + wc * 32 + 8 * fq;
        float rr8[8];
        if (ssp) row_rs16x8(rr8, ssp, row0, fr, fq); else {
#pragma unroll
            for (int k = 0; k < 8; ++k) rr8[k] = rmul[row0 + (k >> 2) * HALF + (k & 3) * 16]; }
#pragma unroll
        for (int ai = 0; ai < 2; ++ai)
#pragma unroll
            for (int m = 0; m < 4; ++m) { const int row = row0 + ai * HALF + m * 16; const float r = rr8[ai * 4 + m];
                const f32x4 g0 = acc[ai][0][m][0] * r, g1 = acc[ai][0][m][1] * r, u0 = acc[ai][1][m][0] * r, u1 = acc[ai][1][m][1] * r;
                u32x4 w; w.x = cvt_pk_bf16(silu_mul(g0[0], u0[0]), silu_mul(g0[1], u0[1])); w.y = cvt_pk_bf16(silu_mul(g0[2], u0[2]), silu_mul(g0[3], u0[3]));
                w.z = cvt_pk_bf16(silu_mul(g1[0], u1[0]), silu_mul(g1[1], u1[1])); w.w = cvt_pk_bf16(silu_mul(g1[2], u1[2]), silu_mul(g1[3], u1[3]));
                *(u32x4*)(O + (size_t)row * ldc + col0) = w; }
    }
};
__device__ __forceinline__ float sat8(float v) { return __builtin_amdgcn_fmed3f(v, -448.0f, 448.0f); }
__device__ __forceinline__ unsigned pk4_fp8_w(float a, float b, float c, float d) { int r = __builtin_amdgcn_cvt_pk_fp8_f32(a, b, 0, false); r = __builtin_amdgcn_cvt_pk_fp8_f32(c, d, r, true); return (unsigned)r; }
__device__ __forceinline__ unsigned pk4_fp8(float a, float b, float c, float d) { int r = __builtin_amdgcn_cvt_pk_fp8_f32(sat8(a), sat8(b), 0, false); r = __builtin_amdgcn_cvt_pk_fp8_f32(sat8(c), sat8(d), r, true); return (unsigned)r; }
struct EpiSwiGLU8 {
    static constexpr bool PERM = true, AFTER_DRAIN = false;
    unsigned char* O; int ldc; const float* rmul; int pn_mod; float cs, hs; const float* ssp;
    __device__ __forceinline__ void operator()(const f32x4 (&acc)[2][2][4][2], const Unit& u, int wr, int wc, int fr, int fq) const {
        const int pnl = pn_mod ? (u.pn % pn_mod) : u.pn;
        const int row0 = u.pm * BM + wr * 64 + fr, col0 = pnl * HALF + wc * 32 + 8 * fq;
        float rr8[8];
        if (ssp) row_rs16x8(rr8, ssp, row0, fr, fq); else {
#pragma unroll
            for (int k = 0; k < 8; ++k) rr8[k] = rmul[row0 + (k >> 2) * HALF + (k & 3) * 16]; }
#pragma unroll
        for (int ai = 0; ai < 2; ++ai)
#pragma unroll
            for (int m = 0; m < 4; ++m) { const int row = row0 + ai * HALF + m * 16; const float r = rr8[ai * 4 + m] * cs, r2 = r * -1.4426950408889634f, rrh = r * r * hs;
                unsigned w[2];
#pragma unroll
                for (int n = 0; n < 2; ++n) { const f32x4 ag = acc[ai][0][m][n], au = acc[ai][1][m][n]; const f32x4 t = ag * r2;
                    f32x4 d; d[0] = __builtin_amdgcn_exp2f(t[0]); d[1] = __builtin_amdgcn_exp2f(t[1]); d[2] = __builtin_amdgcn_exp2f(t[2]); d[3] = __builtin_amdgcn_exp2f(t[3]);
                    d = d + 1.0f;
                    f32x4 iv; iv[0] = __builtin_amdgcn_rcpf(d[0]); iv[1] = __builtin_amdgcn_rcpf(d[1]); iv[2] = __builtin_amdgcn_rcpf(d[2]); iv[3] = __builtin_amdgcn_rcpf(d[3]);
                    const f32x4 hv = ((ag * au) * rrh) * iv;
                    w[n] = pk4_fp8(hv[0], hv[1], hv[2], hv[3]); }
                typedef unsigned u32x2_t __attribute__((ext_vector_type(2)));
                *(u32x2_t*)(O + (size_t)row * ldc + col0) = (u32x2_t){w[0], w[1]}; }
    }
};
struct EpiResid {
    static constexpr bool PERM = true, AFTER_DRAIN = false;
    const float* base32; bf16_t* xb; float* ssp_out; unsigned char* xb8; float cs; int w8;
    __device__ __forceinline__ void operator()(const f32x4 (&acc)[2][2][4][2], const Unit& u, int wr, int wc, int fr, int fq) const {
        const int row0 = u.pm * BM + wr * 64 + fr, col0 = u.pn * BM + wc * 32 + 8 * fq;
        u32x4 xw[2][4][2];
        if (!base32) {
#pragma unroll
            for (int ai = 0; ai < 2; ++ai)
#pragma unroll
                for (int m = 0; m < 4; ++m)
#pragma unroll
                    for (int bj = 0; bj < 2; ++bj) xw[ai][m][bj] = *(const u32x4*)(xb + (size_t)(row0 + ai * HALF + m * 16) * 1024 + col0 + bj * HALF);
        }
#pragma unroll
        for (int ai = 0; ai < 2; ++ai)
#pragma unroll
            for (int m = 0; m < 4; ++m) { const int row = row0 + ai * HALF + m * 16; const size_t off = (size_t)row * 1024 + col0; float q = 0.f;
#pragma unroll
                for (int bj = 0; bj < 2; ++bj) { f32x4 b0, b1;
                    if (base32) { b0 = *(const f32x4*)(base32 + off + bj * HALF); b1 = *(const f32x4*)(base32 + off + bj * HALF + 4); }
                    else { const u32x4 w4 = xw[ai][m][bj];
                        b0 = (f32x4){__uint_as_float(w4.x << 16), __uint_as_float(w4.x & 0xffff0000u), __uint_as_float(w4.y << 16), __uint_as_float(w4.y & 0xffff0000u)};
                        b1 = (f32x4){__uint_as_float(w4.z << 16), __uint_as_float(w4.z & 0xffff0000u), __uint_as_float(w4.w << 16), __uint_as_float(w4.w & 0xffff0000u)}; }
                    const f32x4 v0 = b0 + acc[ai][bj][m][0] * cs, v1 = b1 + acc[ai][bj][m][1] * cs;
                    u32x4 w; w.x = cvt_pk_bf16(v0[0], v0[1]); w.y = cvt_pk_bf16(v0[2], v0[3]); w.z = cvt_pk_bf16(v1[0], v1[1]); w.w = cvt_pk_bf16(v1[2], v1[3]);
                    *(u32x4*)(xb + off + bj * HALF) = w;
                    if (w8) { typedef unsigned u32x2_t __attribute__((ext_vector_type(2))); *(u32x2_t*)(xb8 + off + bj * HALF) = (u32x2_t){pk4_fp8(v0[0], v0[1], v0[2], v0[3]), pk4_fp8(v1[0], v1[1], v1[2], v1[3])}; }
                    q += ((v0[0] * v0[0] + v0[1] * v0[1]) + (v0[2] * v0[2] + v0[3] * v0[3])) + ((v1[0] * v1[0] + v1[1] * v1[1]) + (v1[2] * v1[2] + v1[3] * v1[3])); }
                q += __int_as_float(__builtin_amdgcn_ds_bpermute((((fq * 16 + fr) ^ 16) << 2), __float_as_int(q)));
                { const auto rr = __builtin_amdgcn_permlane32_swap(__float_as_uint(q), __float_as_uint(q), false, false); q = __uint_as_float(rr[0]) + __uint_as_float(rr[1]); }
                if (fq == 0) ssp_out[(size_t)row * 16 + u.pn * 4 + wc] = q;
                if (base32 && (m & 1)) asm volatile("" ::: "memory"); }
    }
};
struct EpiMoeOut {
    static constexpr bool PERM = true, AFTER_DRAIN = false;
    bf16_t* Y; const float* gate; float cs = 1.0f;
    __device__ __forceinline__ void operator()(const f32x4 (&acc)[2][2][4][2], const Unit& u, int wr, int wc, int fr, int fq) const {
        const int row0 = u.pm * BM + wr * 64 + fr, col0 = (u.pn & 3) * BM + wc * 32 + 8 * fq;
#pragma unroll
        for (int ai = 0; ai < 2; ++ai)
#pragma unroll
            for (int m = 0; m < 4; ++m) { const int row = row0 + ai * HALF + m * 16; const float gt = gate[row] * cs; bf16_t* rowp = Y + (size_t)row * 1024 + col0;
#pragma unroll
                for (int bj = 0; bj < 2; ++bj) { const f32x4 v0 = acc[ai][bj][m][0] * gt, v1 = acc[ai][bj][m][1] * gt;
                    u32x4 w; w.x = cvt_pk_bf16(v0[0], v0[1]); w.y = cvt_pk_bf16(v0[2], v0[3]); w.z = cvt_pk_bf16(v1[0], v1[1]); w.w = cvt_pk_bf16(v1[2], v1[3]);
                    *(u32x4*)(rowp + bj * HALF) = w; } }
    }
};
struct EpiNull {
    static constexpr bool PERM = true, AFTER_DRAIN = false;
    float* sink;
    __device__ __forceinline__ void operator()(const f32x4 (&acc)[2][2][4][2], const Unit& u, int wr, int wc, int fr, int fq) const {
        float s = 0.f;
#pragma unroll
        for (int ai = 0; ai < 2; ++ai)
#pragma unroll
            for (int bj = 0; bj < 2; ++bj)
#pragma unroll
                for (int m = 0; m < 4; ++m)
#pragma unroll
                    for (int n = 0; n < 2; ++n) s += (acc[ai][bj][m][n][0] + acc[ai][bj][m][n][1]) + (acc[ai][bj][m][n][2] + acc[ai][bj][m][n][3]);
        if (s == 12345.6789f) sink[u.pm * 4 + wr] = s;
    }
};
struct EpiMoePart {
    static constexpr bool PERM = true, AFTER_DRAIN = false;
    bf16_t* P; const float* gate; float cs = 1.0f; int kshift = 10;
    __device__ __forceinline__ void operator()(const f32x4 (&acc)[2][2][4][2], const Unit& u, int wr, int wc, int fr, int fq) const {
        const int row0 = u.pm * BM + wr * 64 + fr, col0 = (u.pn & 3) * BM + wc * 32 + 8 * fq; bf16_t* base = P + (size_t)(u.ko >> kshift) * (2048 * 1024);
#pragma unroll
        for (int ai = 0; ai < 2; ++ai)
#pragma unroll
            for (int m = 0; m < 4; ++m) { const int row = row0 + ai * HALF + m * 16; const float gt = gate[row] * cs; bf16_t* rowp = base + (size_t)(row - 65536) * 1024 + col0;
#pragma unroll
                for (int bj = 0; bj < 2; ++bj) { const f32x4 v0 = acc[ai][bj][m][0] * gt, v1 = acc[ai][bj][m][1] * gt;
                    u32x4 w; w.x = cvt_pk_bf16(v0[0], v0[1]); w.y = cvt_pk_bf16(v0[2], v0[3]); w.z = cvt_pk_bf16(v1[0], v1[1]); w.w = cvt_pk_bf16(v1[2], v1[3]);
                    *(u32x4*)(rowp + bj * HALF) = w; } }
    }
};
struct MoeTailOrder {
    int npieces, G, c; int te[8]; int kstep = 1024;
    __device__ __forceinline__ bool next(int i, Unit& u) const {
        const int p = i * G + c; if (p >= npieces) return false;
        const int tt = p / 7, kp = p - tt * 7; const int pm = 256 + (tt >> 2);
        int e = 0;
#pragma unroll
        for (int k = 0; k < 7; ++k) e += (pm >= te[k]) ? 1 : 0;
        u.pm = pm; u.pn = e * 4 + (tt & 3); u.ko = kp * kstep; return true;
    }
    __device__ __forceinline__ void a_ready(const Unit&) const {}
    __device__ __forceinline__ void done(const Unit&) const {}
};
struct TeamOrder {
    int pm, pn0, npn;
    __device__ __forceinline__ bool next(int i, Unit& u) const { if (i >= npn) return false; u.pm = pm; u.pn = pn0 + i; return true; }
    __device__ __forceinline__ void a_ready(const Unit&) const {}
    __device__ __forceinline__ void done(const Unit&) const {}
};
struct MoeOrder {
    StaticOrder so; int nNl; int te[8];
    __device__ __forceinline__ bool next(int i, Unit& u) const {
        if (!so.next(i, u)) return false;
        int e = 0;
#pragma unroll
        for (int k = 0; k < 7; ++k) e += (u.pm >= te[k]) ? 1 : 0;
        u.pn += e * nNl; return true;
    }
    __device__ __forceinline__ void a_ready(const Unit&) const {}
    __device__ __forceinline__ void done(const Unit&) const {}
};

template <class Epi, class Sched, bool ALIGN_EPI = false, bool SP2 = false, bool F8 = false>
__device__ __forceinline__ void gemm_phase(PG8_LAS unsigned char* lds, const Gemm g, const Sched& S, const Epi& E, const int tid) {
    const int wid = __builtin_amdgcn_readfirstlane(tid >> 6), lane = tid & 63, wr = wid >> 2, wc = wid & 3, fr = lane & 15, fq = lane >> 4;
    const int K = g.K, nt = K / BK, LD = g.ld ? g.ld : K;
    unsigned voffA[2], voffB[2];
#pragma unroll
    for (int i = 0; i < 2; ++i) { int R, C; stage_rc(tid * 16 + i * 8192, R, C); const int Rb = Epi::PERM ? ((R & ~31) + perm32(R & 31)) : R;
        voffA[i] = (unsigned)(R * LD + C) * 2u; voffB[i] = (unsigned)(Rb * LD + C) * 2u; }
    const size_t kstep = (size_t)(BK * 2);
    const size_t hstep = (size_t)HALF * LD * 2;
    const size_t tstep = 2 * hstep;
    const unsigned ldsw = (unsigned)wid * 1024u;
    const int aoff = lds_byte(wr * 64 + fr, fq * 8), boff = lds_byte(wc * 32 + fr, fq * 8);
#define PG8_SA(b, h) (((b) * 2 + (h)) * HTB)
#define PG8_SB(b, h) ((4 + (b) * 2 + (h)) * HTB)
#define PG8_STAGE(bufoff, gbase, voff) do { _Pragma("unroll") for (int _i = 0; _i < 2; ++_i) \
        __builtin_amdgcn_global_load_lds((const unsigned*)((const char*)(gbase) + (voff)[_i]), (PG8_LAS unsigned*)(lds + (bufoff) + ldsw + _i * 8192), 16, 0, 0); } while (0)
#define PG8_CAT8(x, y) __builtin_shufflevector(__builtin_bit_cast(v4i_t, x), __builtin_bit_cast(v4i_t, y), 0, 1, 2, 3, 4, 5, 6, 7)
#define PG8_LDA(dst, b, h) do { _Pragma("unroll") for (int m = 0; m < 4; ++m) { if constexpr (F8) dst##8[m] = PG8_CAT8(*(const PG8_LAS bf16x8*)(lds + PG8_SA(b, h) + aoff + m * 2048), *(const PG8_LAS bf16x8*)(lds + PG8_SA(b, h) + aoff + m * 2048 + 1024)); \
        else { _Pragma("unroll") for (int k = 0; k < 2; ++k) dst[m][k] = *(const PG8_LAS bf16x8*)(lds + PG8_SA(b, h) + aoff + m * 2048 + k * 1024); } } } while (0)
#define PG8_LDB(dst, b, h) do { _Pragma("unroll") for (int n = 0; n < 2; ++n) { if constexpr (F8) dst##8[n] = PG8_CAT8(*(const PG8_LAS bf16x8*)(lds + PG8_SB(b, h) + boff + n * 2048), *(const PG8_LAS bf16x8*)(lds + PG8_SB(b, h) + boff + n * 2048 + 1024)); \
        else { _Pragma("unroll") for (int k = 0; k < 2; ++k) dst[n][k] = *(const PG8_LAS bf16x8*)(lds + PG8_SB(b, h) + boff + n * 2048 + k * 1024); } } } while (0)
#define PG8_MMA(ai, bj, At, Bt) do { __builtin_amdgcn_s_setprio(1); _Pragma("unroll") for (int m = 0; m < 4; ++m) _Pragma("unroll") for (int n = 0; n < 2; ++n) { \
        if constexpr (F8) asm volatile("v_mfma_scale_f32_16x16x128_f8f6f4 %0, %1, %2, %0, %3, %3 op_sel_hi:[0,0,0]" : "+v"(acc[ai][bj][m][n]) : "v"(Bt##8[n]), "v"(At##8[m]), "v"(f8scale)); \
        else { _Pragma("unroll") for (int k = 0; k < 2; ++k) acc[ai][bj][m][n] = __builtin_amdgcn_mfma_f32_16x16x32_bf16(Bt[n][k], At[m][k], acc[ai][bj][m][n], 0, 0, 0); } } __builtin_amdgcn_s_setprio(0); } while (0)
#define PG8_WAIT_V(n) asm volatile("s_waitcnt vmcnt(" #n ")" ::: "memory")
#define PG8_WAIT_L(n) asm volatile("s_waitcnt lgkmcnt(" #n ")" ::: "memory")
#define PG8_BAR __builtin_amdgcn_s_barrier()
#define PG8_SCHED __builtin_amdgcn_sched_barrier(0)
    Unit cur, nxt; int ui = 0;
    if (!S.next(0, cur)) return;
    f32x4 acc[2][2][4][2];
#pragma unroll
    for (int a = 0; a < 2; ++a)
#pragma unroll
        for (int b = 0; b < 2; ++b)
#pragma unroll
            for (int m = 0; m < 4; ++m)
#pragma unroll
                for (int n = 0; n < 2; ++n) acc[a][b][m][n] = (f32x4){0.f, 0.f, 0.f, 0.f};
    const int f8scale = 0x7f7f7f7f;
    bf16x8 At[4][2], B0[2][2], B1[2][2]; v8i_t At8[4], B08[2], B18[2];
    const char* cA = (const char*)g.A + (size_t)cur.pm * tstep + cur.ko; const char* cB = (const char*)g.Bt + (size_t)cur.pn * tstep + cur.ko;
    S.a_ready(cur);
    if constexpr (SP2) {
        PG8_STAGE(PG8_SB(0, 0), cB, voffB); PG8_STAGE(PG8_SB(0, 1), cB + hstep, voffB); PG8_STAGE(PG8_SA(0, 0), cA, voffA); PG8_STAGE(PG8_SA(0, 1), cA + hstep, voffA);
        if (wr == 1) PG8_BAR;
        PG8_WAIT_V(2); PG8_BAR;
        PG8_STAGE(PG8_SB(1, 0), cB + kstep, voffB); PG8_STAGE(PG8_SA(1, 0), cA + kstep, voffA); PG8_STAGE(PG8_SB(1, 1), cB + hstep + kstep, voffB);
        PG8_WAIT_V(6); PG8_BAR;
    } else {
        PG8_STAGE(PG8_SB(0, 0), cB, voffB); PG8_STAGE(PG8_SA(0, 0), cA, voffA); PG8_STAGE(PG8_SB(0, 1), cB + hstep, voffB); PG8_STAGE(PG8_SA(0, 1), cA + hstep, voffA);
        if (wr == 1) PG8_BAR;
        PG8_WAIT_V(4); PG8_BAR;
        PG8_STAGE(PG8_SB(1, 0), cB + kstep, voffB); PG8_STAGE(PG8_SA(1, 0), cA + kstep, voffA); PG8_STAGE(PG8_SB(1, 1), cB + hstep + kstep, voffB);
        PG8_WAIT_V(6); PG8_BAR;
    }
    for (;;) {
        const bool has_next = S.next(ui + 1, nxt);
        const char* nA = has_next ? (const char*)g.A + (size_t)nxt.pm * tstep + nxt.ko : cA; const char* nB = has_next ? (const char*)g.Bt + (size_t)nxt.pn * tstep + nxt.ko : cB;
        for (int t = 0; t < nt; t += 2) {
            const bool last = (t == nt - 2);
            const char* a1 = cA + (size_t)(t + 1) * kstep;
            const char* a2 = last ? nA : cA + (size_t)(t + 2) * kstep; const char* b2 = last ? nB : cB + (size_t)(t + 2) * kstep;
            const char* a3 = a2 + kstep; const char* b3 = b2 + kstep;
            if (last && has_next) S.a_ready(nxt);
            if constexpr (SP2) {
            PG8_LDB(B0, 0, 0); PG8_LDB(B1, 0, 1); PG8_SCHED; PG8_LDA(At, 0, 0); PG8_STAGE(PG8_SA(1, 1), a1 + hstep, voffA);
            PG8_WAIT_V(8); PG8_WAIT_L(0); PG8_BAR; PG8_MMA(0, 0, At, B0); PG8_MMA(0, 1, At, B1); PG8_BAR; PG8_SCHED;
            PG8_LDA(At, 0, 1); PG8_STAGE(PG8_SB(0, 0), b2, voffB); PG8_STAGE(PG8_SB(0, 1), b2 + hstep, voffB); PG8_STAGE(PG8_SA(0, 0), a2, voffA);
            PG8_WAIT_V(8); PG8_WAIT_L(0); PG8_BAR; PG8_MMA(1, 0, At, B0); PG8_MMA(1, 1, At, B1); PG8_BAR; PG8_SCHED;
            PG8_LDB(B0, 1, 0); PG8_LDB(B1, 1, 1); PG8_SCHED; PG8_LDA(At, 1, 0); PG8_STAGE(PG8_SA(0, 1), a2 + hstep, voffA);
            PG8_WAIT_V(8); PG8_WAIT_L(0); PG8_BAR; PG8_MMA(0, 0, At, B0); PG8_MMA(0, 1, At, B1); PG8_BAR; PG8_SCHED;
            PG8_LDA(At, 1, 1); PG8_STAGE(PG8_SB(1, 0), b3, voffB); PG8_STAGE(PG8_SB(1, 1), b3 + hstep, voffB); PG8_STAGE(PG8_SA(1, 0), a3, voffA);
            PG8_WAIT_V(8); PG8_WAIT_L(0); PG8_BAR; PG8_MMA(1, 0, At, B0); PG8_MMA(1, 1, At, B1); PG8_BAR; PG8_SCHED;
            } else {
            PG8_LDB(B0, 0, 0); PG8_SCHED; PG8_LDA(At, 0, 0); PG8_STAGE(PG8_SA(1, 1), a1 + hstep, voffA);
            PG8_WAIT_L(8); PG8_BAR; PG8_WAIT_L(0); PG8_MMA(0, 0, At, B0); PG8_BAR; PG8_SCHED;
            PG8_LDB(B1, 0, 1); PG8_STAGE(PG8_SB(0, 0), b2, voffB);
            PG8_BAR; PG8_WAIT_L(0); PG8_MMA(0, 1, At, B1); PG8_BAR;
            PG8_LDA(At, 0, 1); PG8_STAGE(PG8_SA(0, 0), a2, voffA);
            PG8_BAR; PG8_WAIT_L(0); PG8_MMA(1, 0, At, B0); PG8_BAR; PG8_SCHED;
            PG8_STAGE(PG8_SB(0, 1), b2 + hstep, voffB);
            PG8_WAIT_V(6); PG8_BAR; PG8_MMA(1, 1, At, B1); PG8_BAR;
            PG8_LDB(B0, 1, 0); PG8_SCHED; PG8_LDA(At, 1, 0); PG8_STAGE(PG8_SA(0, 1), a2 + hstep, voffA);
            PG8_WAIT_L(8); PG8_BAR; PG8_WAIT_L(0); PG8_MMA(0, 0, At, B0); PG8_BAR; PG8_SCHED;
            PG8_LDB(B1, 1, 1); PG8_STAGE(PG8_SB(1, 0), b3, voffB);
            PG8_BAR; PG8_WAIT_L(0); PG8_MMA(0, 1, At, B1); PG8_BAR;
            PG8_LDA(At, 1, 1); PG8_STAGE(PG8_SA(1, 0), a3, voffA);
            PG8_BAR; PG8_WAIT_L(0); PG8_MMA(1, 0, At, B0); PG8_BAR; PG8_SCHED;
            PG8_STAGE(PG8_SB(1, 1), b3 + hstep, voffB);
            PG8_WAIT_V(6); PG8_BAR; PG8_MMA(1, 1, At, B1); PG8_BAR;
            }
        }
        if constexpr (ALIGN_EPI) { if (wr == 0) PG8_BAR; }
        if constexpr (F8) asm volatile("s_nop 15\n\ts_nop 15" ::: "memory");
        if constexpr (!Epi::AFTER_DRAIN) { int fr_ = fr, fq_ = fq; asm volatile("" : "+v"(fr_), "+v"(fq_)); E(acc, cur, wr, wc, fr_, fq_); S.done(cur); }
        if (!has_next) break;
#pragma unroll
        for (int a = 0; a < 2; ++a)
#pragma unroll
            for (int b = 0; b < 2; ++b)
#pragma unroll
                for (int m = 0; m < 4; ++m)
#pragma unroll
                    for (int n = 0; n < 2; ++n) acc[a][b][m][n] = (f32x4){0.f, 0.f, 0.f, 0.f};
        cur = nxt; cA = nA; cB = nB; ++ui;
        if constexpr (ALIGN_EPI) { if (wr == 1) PG8_BAR; }
    }
    PG8_WAIT_V(0);
    if constexpr (!ALIGN_EPI) { if (wr == 0) PG8_BAR; }
    PG8_BAR;
    if constexpr (Epi::AFTER_DRAIN) { E.fused(acc, cur, wr, wc, fr, fq, lds, wid, lane); S.done(cur); }
#undef PG8_SA
#undef PG8_SB
#undef PG8_STAGE
#undef PG8_LDA
#undef PG8_LDB
#undef PG8_MMA
#undef PG8_CAT8
#undef PG8_WAIT_V
#undef PG8_WAIT_L
#undef PG8_BAR
#undef PG8_SCHED
}
}
#define GAS __attribute__((address_space(1)))
#define LAS __attribute__((address_space(3)))
typedef unsigned short bf16;
typedef unsigned v4u __attribute__((ext_vector_type(4)));
typedef float f32x4 __attribute__((ext_vector_type(4)));
typedef short bf16x8 __attribute__((ext_vector_type(8)));
typedef GAS unsigned gu32;
typedef GAS unsigned long long gu64;
#define RLX_AGENT __ATOMIC_RELAXED, __HIP_MEMORY_SCOPE_AGENT
#define LDS_WAIT() asm volatile("s_waitcnt lgkmcnt(0)" ::: "memory")
#define VM_WAIT() asm volatile("s_waitcnt vmcnt(0)" ::: "memory")
__device__ __forceinline__ unsigned long long rt() { return __builtin_amdgcn_s_memrealtime(); }
__device__ __forceinline__ unsigned f2bf(float f) { unsigned u = __builtin_bit_cast(unsigned, f); return (u + 0x7fffu + ((u >> 16) & 1u)) >> 16; }
__device__ __forceinline__ unsigned pk2(float lo, float hi) { return f2bf(lo) | (f2bf(hi) << 16); }
#define XB_TMO      128
#define XB_XCNT(j)  (256  + 64 * (j))
#define XB_XSUB(j)  (1280 + 64 * (j))
#define XB_XGEN(j)  (2304 + 64 * (j))
#define XB_TOP      3328
#define XB_TOPGEN   3392
#define XCD_BAR_WORDS 3456
#define XB_SPIN_CAP (1u << 18)

__device__ __forceinline__ unsigned xb_ld(unsigned* p)              { return __hip_atomic_load(p, __ATOMIC_RELAXED, __HIP_MEMORY_SCOPE_AGENT); }
__device__ __forceinline__ unsigned xb_add(unsigned* p, unsigned v) { return __hip_atomic_fetch_add(p, v, __ATOMIC_RELAXED, __HIP_MEMORY_SCOPE_AGENT); }
__device__ __forceinline__ unsigned xb_xcc_id() { return (unsigned)__builtin_amdgcn_s_getreg((3 << 11) | 20) & 0xFu; }
#define XB_SPIN(cond, bar) do { unsigned _sp = 0; while (cond) { __builtin_amdgcn_s_sleep(1); \
    if ((++_sp & 255u) == 0u) { if (xb_ld(&(bar)[XB_TMO])) break; if (_sp > XB_SPIN_CAP) { atomicAdd(&(bar)[XB_TMO], 1u); break; } } } } while (0)

struct XcdBarrier {
    unsigned* bar; unsigned x;
    volatile LAS unsigned* st;
};

__device__ __forceinline__ XcdBarrier xcd_barrier_post(unsigned* bar, volatile LAS unsigned* st) {
    XcdBarrier b; b.bar = bar; b.x = xb_xcc_id(); b.st = st;
    if (threadIdx.x == 0) (void)xb_add(&bar[XB_XCNT(b.x)], 1u);
    return b;
}
__device__ __forceinline__ void xcd_barrier_complete(unsigned* bar, unsigned x, unsigned& nloc, unsigned& nx) {
    const unsigned G = gridDim.x * gridDim.y * gridDim.z;
    unsigned sum, cnt, mine, sp = 0u;
    for (;;) {
        sum = 0u; cnt = 0u; mine = 0u;
#pragma unroll
        for (unsigned j = 0; j < 16; ++j) { const unsigned c = xb_ld(&bar[XB_XCNT(j)]); sum += c; cnt += (c > 0u) ? 1u : 0u; mine = (j == x) ? c : mine; }
        if (sum == G) break;
        __builtin_amdgcn_s_sleep(1);
        if ((++sp & 255u) == 0u) { if (xb_ld(&bar[XB_TMO])) break; if (sp > XB_SPIN_CAP) { atomicAdd(&bar[XB_TMO], 1u); break; } }
    }
    nloc = mine > 0u ? mine : 1u; nx = cnt > 0u ? cnt : 1u;
}

__device__ __forceinline__ void xcd_barrier(const XcdBarrier& b) {
    asm volatile("s_waitcnt vmcnt(0)" ::: "memory");
    __syncthreads();
    if (threadIdx.x == 0) {
        unsigned* bar = b.bar;
        __builtin_amdgcn_s_waitcnt(0);
        unsigned nloc = b.st[0], nx = b.st[1];
        if (nloc == 0u) { xcd_barrier_complete(bar, b.x, nloc, nx); b.st[0] = nloc; b.st[1] = nx; }
        const unsigned old = xb_add(&bar[XB_XSUB(b.x)], 1u);
        const unsigned gen = old / nloc;
        if (old + 1u == (gen + 1u) * nloc) {
            __builtin_amdgcn_fence(__ATOMIC_RELEASE, "agent");
            asm volatile("s_waitcnt vmcnt(0)" ::: "memory");
            const unsigned og = xb_add(&bar[XB_TOP], 1u);
            const unsigned tg = og / nx;
            if (og + 1u == (tg + 1u) * nx) xb_add(&bar[XB_TOPGEN], 1u);
            else XB_SPIN(xb_ld(&bar[XB_TOPGEN]) == tg, bar);
            __builtin_amdgcn_fence(__ATOMIC_ACQUIRE, "agent");
            xb_add(&bar[XB_XGEN(b.x)], 1u);
            asm volatile("s_waitcnt vmcnt(0)" ::: "memory");
        } else {
            XB_SPIN(xb_ld(&bar[XB_XGEN(b.x)]) == gen, bar);
            __builtin_amdgcn_fence(__ATOMIC_ACQUIRE, "agent");
            asm volatile("s_waitcnt vmcnt(0)" ::: "memory");
        }
    }
    __syncthreads();
}
constexpr int NWAVES = 8;
constexpr int BATCH = 4, SEQ = 8192, D = 1024, T = BATCH * SEQ, DEPTH = 4, MEML = 256, MROWS = BATCH * MEML;
constexpr int NPROJ = 2560, FFD = 2816, FFE = 3584, NEXP = 8, XW = 512;
constexpr int MP = 2 * T + NEXP * 256;
constexpr float F8_S1 = 16.0f, F8_S2 = 32.0f, F8_SH = 4.0f;
constexpr int NKEYS = 321;
constexpr int NPH = 1 + 8 + 11 + 8 + 11;
constexpr int PC_Q = 0, PC_K = 512, PC_V = 1024, PC_POOL = 1536, PC_BG = 1792, PC_CG = 2048, PC_HC = 2304;
constexpr size_t MiB = 1u << 20;
constexpr size_t WS_CTL = 0, CTL_ZERO_BYTES = 64 * 1024;
constexpr size_t WS_PWT = 256 * 1024;
constexpr size_t WS_CNT = 1 * MiB, WS_META = 1 * MiB + 64 * 1024;
constexpr size_t WS_TOKE = 1 * MiB + 512 * 1024, WS_TOKG = 2 * MiB, WS_TOKPOS = 2 * MiB + 512 * 1024, WS_ROWGATE = 3 * MiB, WS_ROWRS = 3 * MiB + 512 * 1024;
constexpr size_t WS_SSP = 4 * MiB;
constexpr size_t WS_KVX = 30 * MiB, WS_MEMN = 38 * MiB;
constexpr size_t WS_WIN = 40 * MiB, WS_WOUT = 60 * MiB, WS_WQ = 68 * MiB, WS_WKV = 72 * MiB, WS_WO = 80 * MiB, WS_W13D = 84 * MiB, WS_W2D = 106 * MiB, WS_W13M = 117 * MiB, WS_W2M = 341 * MiB;
constexpr size_t WS_XB = 453 * MiB, WS_QX = 517 * MiB, WS_OX = 549 * MiB, WS_AG = 581 * MiB, WS_YM = 713 * MiB, WS_RA = 977 * MiB, WS_VTX = 1439 * MiB, WS_END = 1443 * MiB;
constexpr size_t WS_PROJ = WS_RA, WS_Y = WS_RA + 160 * MiB, WS_H = WS_RA, WS_VT = WS_RA + 224 * MiB, WS_OPART = WS_RA + 320 * MiB, WS_LSE = WS_RA + 416 * MiB;
constexpr size_t VT_STRIDE = (size_t)T * 512, OP_STRIDE = (size_t)T * 512;
static_assert(WS_AG + (size_t)MP * D * 2 <= WS_YM && WS_YM + (size_t)MP * D * 4 <= WS_RA && WS_RA + (size_t)MP * FFE * 2 <= WS_VTX, "ws map");
constexpr int CW_BAR = 4096, CW_TEAM = 8192;
constexpr size_t WS_XCCTAB = 128 * 1024;
constexpr int RING_BYTES = 131072, LDSCTL_OFF = 159744, MISC_OFF = LDSCTL_OFF + 320, LDS_BYTES = 163840;

__device__ __forceinline__ float shx(float v, int mask, int lane) { return __int_as_float(__builtin_amdgcn_ds_bpermute((lane ^ mask) << 2, __float_as_int(v))); }
__device__ __forceinline__ float xsum32(float v) { const auto rr = __builtin_amdgcn_permlane32_swap(__float_as_uint(v), __float_as_uint(v), false, false); return __uint_as_float(rr[0]) + __uint_as_float(rr[1]); }
__device__ __forceinline__ float xmax32(float v) { const auto rr = __builtin_amdgcn_permlane32_swap(__float_as_uint(v), __float_as_uint(v), false, false); return fmaxf(__uint_as_float(rr[0]), __uint_as_float(rr[1])); }
__device__ __forceinline__ float wave_sum(float v, int lane) {
#pragma unroll
    for (int o = 1; o < 32; o <<= 1) v += shx(v, o, lane);
    return xsum32(v);
}
__device__ __forceinline__ float bflo(unsigned u) { return __uint_as_float(u << 16); }
__device__ __forceinline__ float bfhi(unsigned u) { return __uint_as_float(u & 0xffff0000u); }
__device__ __forceinline__ float bf1(bf16 h) { return __uint_as_float(((unsigned)h) << 16); }
__device__ __forceinline__ float dot8(v4u a, v4u b) {
    return (bflo(a.x) * bflo(b.x) + bfhi(a.x) * bfhi(b.x)) + (bflo(a.y) * bflo(b.y) + bfhi(a.y) * bfhi(b.y)) + (bflo(a.z) * bflo(b.z) + bfhi(a.z) * bfhi(b.z)) + (bflo(a.w) * bflo(b.w) + bfhi(a.w) * bfhi(b.w));
}
__device__ __forceinline__ int key_dist(int i) { return i < 129 ? i : (i < 225 ? 132 + 4 * (i - 129) : 528 + 16 * (i - 225)); }
__device__ __forceinline__ int key_mult(int d) { return d <= 128 ? 1 + ((d & 3) == 0 ? 1 : 0) + ((d & 15) == 0 ? 1 : 0) : (d <= 512 ? 1 + ((d & 15) == 0 ? 1 : 0) : 1); }
__device__ __forceinline__ int t5_bucket(int d) {
    if (d < 16) return d;
    int b = 16 + (int)(logf((float)d / 16.0f) / logf(8.0f) * 16.0f);
    return b < 31 ? b : 31;
}

struct Args { const float* in[21]; float* out; unsigned char* ws; int ph_lo, ph_hi; };

__device__ __forceinline__ void conv_item(const float* W, int K, int N, bf16* WT, const float* gain, int swF, LAS float* scr, int item, int lane) {
    const int nblk = N / 64, kb = item / nblk, nb = item % nblk, k0 = 64 * kb, n0 = 64 * nb;
    float wv[64];
#pragma unroll
    for (int i = 0; i < 64; ++i) wv[i] = W[(size_t)(k0 + i) * N + n0 + lane];
    if (gain) {
#pragma unroll
        for (int i = 0; i < 64; ++i) wv[i] *= gain[k0 + i]; }
#pragma unroll
    for (int i = 0; i < 64; ++i) scr[i * 65 + lane] = wv[i];
    LDS_WAIT(); asm volatile("" ::: "memory");
    int orow0 = n0;
    if (swF) { const int isup = n0 >= swF ? 1 : 0; const int j = n0 - isup * swF; orow0 = (j >> 7) * 256 + isup * 128 + (j & 127); }
    const int c = lane & 7;
#pragma unroll
    for (int j = 0; j < 8; ++j) { const int n = (lane >> 3) + 8 * j; const LAS float* s = scr + (8 * c) * 65 + n;
        v4u o; o.x = pk2(s[0 * 65], s[1 * 65]); o.y = pk2(s[2 * 65], s[3 * 65]); o.z = pk2(s[4 * 65], s[5 * 65]); o.w = pk2(s[6 * 65], s[7 * 65]);
        *(GAS v4u*)(WT + (size_t)(orow0 + n) * K + k0 + 8 * c) = o; }
    LDS_WAIT(); asm volatile("" ::: "memory");
}

typedef unsigned u32x2 __attribute__((ext_vector_type(2)));
__device__ __forceinline__ void conv_item8(const float* W, int K, int N, unsigned char* WT, const float* gain, int swF, float scale, LAS float* scr, int item, int lane) {
    const int nblk = N / 64, kb = item / nblk, nb = item % nblk, k0 = 64 * kb, n0 = 64 * nb;
    float wv[64];
#pragma unroll
    for (int i = 0; i < 64; ++i) wv[i] = W[(size_t)(k0 + i) * N + n0 + lane];
#pragma unroll
    for (int i = 0; i < 64; ++i) wv[i] *= gain ? gain[k0 + i] * scale : scale;
#pragma unroll
    for (int i = 0; i < 64; ++i) scr[i * 65 + lane] = wv[i];
    LDS_WAIT(); asm volatile("" ::: "memory");
    int orow0 = n0;
    if (swF) { const int isup = n0 >= swF ? 1 : 0; const int j = n0 - isup * swF; orow0 = (j >> 7) * 256 + isup * 128 + (j & 127); }
    const int c = lane & 7;
#pragma unroll
    for (int j = 0; j < 8; ++j) { const int n = (lane >> 3) + 8 * j; const LAS float* s = scr + (8 * c) * 65 + n;
        u32x2 o; o.x = pg8::pk4_fp8_w(s[0 * 65], s[1 * 65], s[2 * 65], s[3 * 65]); o.y = pg8::pk4_fp8_w(s[4 * 65], s[5 * 65], s[6 * 65], s[7 * 65]);
        *(GAS u32x2*)(WT + (size_t)(orow0 + n) * K + k0 + 8 * c) = o; }
    LDS_WAIT(); asm volatile("" ::: "memory");
}

typedef float f32x16 __attribute__((ext_vector_type(16)));
typedef float f32x2_t __attribute__((ext_vector_type(2))); typedef __bf16 bf16x2_t __attribute__((ext_vector_type(2)));
__device__ __forceinline__ unsigned cvtpk(float lo, float hi) { f32x2_t v = {lo, hi}; bf16x2_t b = __builtin_convertvector(v, bf16x2_t); return __builtin_bit_cast(unsigned, b); }
__device__ __forceinline__ bf16x8 mk8(unsigned a, unsigned b, unsigned c, unsigned d) { v4u t = {a, b, c, d}; return __builtin_bit_cast(bf16x8, t); }
__device__ __forceinline__ bf16x8 mk8u2(u32x2 lo, u32x2 hi) { v4u t = {lo.x, lo.y, hi.x, hi.y}; return __builtin_bit_cast(bf16x8, t); }
#define NEGINF (-__builtin_inff())
constexpr int BT_LD = 200, BT_OFF = 32;
__device__ __forceinline__ void dil_load_k(bf16x8 (&kf)[4], const bf16* pj, int sh, int b, int h, int r, int k0, int q, int hh) {
    const int sg = (q & ~12) | ((q & 4) << 1) | ((q & 8) >> 1);
    const int tk = b * SEQ + r + ((k0 + sg) << sh);
    const bf16* kp = pj + (size_t)tk * NPROJ + PC_K + h * 64 + 32 * hh;
#pragma unroll
    for (int ks = 0; ks < 4; ++ks) kf[ks] = *(const GAS bf16x8*)(kp + 8 * ks);
}
__device__ __forceinline__ void dil_load_v(bf16x8 (&vf)[2][2], const bf16* vrow, int sh, int k0) {
#pragma unroll
    for (int db = 0; db < 2; ++db)
#pragma unroll
        for (int s2 = 0; s2 < 2; ++s2) { const bf16* vp = vrow + (size_t)db * 32 * SEQ + (sh == 4 ? ((k0 >> 4) + s2) * 256 : k0 + 16 * s2); vf[db][s2] = *(const GAS bf16x8*)vp; }
}
__device__ __forceinline__ void dil_blk(const bf16x8 (&kf)[4], const bf16x8 (&vf)[2][2], const bf16x8 (&qf)[4], f32x16& O0, f32x16& O1, float& m, float& l, const LAS float* btl) {
    f32x16 st;
#pragma unroll
    for (int i = 0; i < 16; ++i) st[i] = 0.f;
#pragma unroll
    for (int ks = 0; ks < 4; ++ks) st = __builtin_amdgcn_mfma_f32_32x32x16_bf16(kf[ks], qf[ks], st, 0, 0, 0);
    float mx = NEGINF;
#pragma unroll
    for (int i = 0; i < 16; ++i) { st[i] = st[i] * 0.18033688011112042f + btl[23 - (16 * (i >> 3) + 4 * ((i >> 2) & 1) + (i & 3))]; mx = fmaxf(mx, st[i]); }
    { const auto rr = __builtin_amdgcn_permlane32_swap(__float_as_uint(mx), __float_as_uint(mx), false, false); mx = fmaxf(__uint_as_float(rr[0]), __uint_as_float(rr[1])); }
    const float mn = fmaxf(m, mx), ms = mn == NEGINF ? 0.f : mn, alpha = __builtin_amdgcn_exp2f(m - ms);
    float ls = 0.f;
#pragma unroll
    for (int i = 0; i < 16; ++i) { st[i] = __builtin_amdgcn_exp2f(st[i] - ms); ls += st[i]; }
    l = l * alpha + ls; m = mn;
#pragma unroll
    for (int i = 0; i < 16; ++i) { O0[i] *= alpha; O1[i] *= alpha; }
    const bf16x8 p0 = mk8(cvtpk(st[0], st[1]), cvtpk(st[2], st[3]), cvtpk(st[4], st[5]), cvtpk(st[6], st[7]));
    const bf16x8 p1 = mk8(cvtpk(st[8], st[9]), cvtpk(st[10], st[11]), cvtpk(st[12], st[13]), cvtpk(st[14], st[15]));
    O0 = __builtin_amdgcn_mfma_f32_32x32x16_bf16(vf[0][0], p0, O0, 0, 0, 0); O0 = __builtin_amdgcn_mfma_f32_32x32x16_bf16(vf[0][1], p1, O0, 0, 0, 0);
    O1 = __builtin_amdgcn_mfma_f32_32x32x16_bf16(vf[1][0], p0, O1, 0, 0, 0); O1 = __builtin_amdgcn_mfma_f32_32x32x16_bf16(vf[1][1], p1, O1, 0, 0, 0);
}
__device__ __forceinline__ void dil_store(const f32x16& O0, const f32x16& O1, float m, float l, bf16* opart, float* lsep, int tq, int h, int hh) {
    l = xsum32(l);
    const float inv = l > 0.f ? 1.0f / l : 0.f;
    bf16* op = opart + (size_t)tq * 512 + h * 64 + 4 * hh;
#pragma unroll
    for (int g4 = 0; g4 < 4; ++g4) {
        u32x2 w0, w1; w0.x = cvtpk(O0[4 * g4] * inv, O0[4 * g4 + 1] * inv); w0.y = cvtpk(O0[4 * g4 + 2] * inv, O0[4 * g4 + 3] * inv);
        w1.x = cvtpk(O1[4 * g4] * inv, O1[4 * g4 + 1] * inv); w1.y = cvtpk(O1[4 * g4 + 2] * inv, O1[4 * g4 + 3] * inv);
        *(GAS u32x2*)(op + 8 * g4) = w0; *(GAS u32x2*)(op + 32 + 8 * g4) = w1; }
    if (hh == 0) lsep[(size_t)tq * 8 + h] = l > 0.f ? (m + __builtin_amdgcn_logf(l)) * 0.6931471805599453f : NEGINF;
}
template <int JLO>
__device__ __forceinline__ void dil_unit32(const bf16* pj, const bf16* vt, bf16* opart, float* lsep, const LAS float* bt, int sh, int b, int h, int r, int n0, bool do_store) {
    constexpr int NT = JLO == 0 ? 5 : 4;
    int lane; asm volatile("v_mbcnt_lo_u32_b32 %0, -1, 0\n\tv_mbcnt_hi_u32_b32 %0, -1, %0" : "=v"(lane));
    const int q = lane & 31, hh = lane >> 5;
    const int L = SEQ >> sh;
    const int tq = b * SEQ + r + ((n0 + q) << sh);
    bf16x8 qf[4];
    { const bf16* qp = pj + (size_t)tq * NPROJ + PC_Q + h * 64 + 32 * hh;
#pragma unroll
      for (int ks = 0; ks < 4; ++ks) qf[ks] = *(const GAS bf16x8*)(qp + 8 * ks); }
    f32x16 O0, O1;
#pragma unroll
    for (int i = 0; i < 16; ++i) { O0[i] = 0.f; O1[i] = 0.f; }
    float m = NEGINF, l = 0.f;
    const bf16* vrow = vt + ((size_t)((b * 8 + h) * 64 + q) * SEQ) + (sh == 4 ? r * 16 : r * L) + 8 * hh;
    bf16x8 kf[2][4], vf[2][2][2];
    { const int k0 = n0 - 128 < 0 ? 0 : n0 - 128; dil_load_k(kf[0], pj, sh, b, h, r, k0, q, hh); dil_load_v(vf[0], vrow, sh, k0); }
#pragma unroll
    for (int t = 0; t < NT; ++t) {
        const int k0 = n0 - 128 + 32 * t;
        if (t + 1 < NT) { const int k1 = k0 + 32 < 0 ? 0 : k0 + 32; dil_load_k(kf[(t + 1) & 1], pj, sh, b, h, r, k1, q, hh); dil_load_v(vf[(t + 1) & 1], vrow, sh, k1); }
        const int jq = k0 < 0 ? 160 : q - 8 * hh + 128 - 32 * t;
        dil_blk(kf[t & 1], vf[t & 1], qf, O0, O1, m, l, bt + jq + BT_OFF - 23);
    }
    if (do_store) dil_store(O0, O1, m, l, opart, lsep, tq, h, hh);
}

constexpr int DK_PITCH = 144, DV_PITCH = 784, DK_BYTES = 384 * DK_PITCH, DV_BYTES = 64 * DV_PITCH;
__device__ __forceinline__ void dil_stage_load_k(v4u (&sk)[6], const bf16* pj, int sh, int b, int h, int r, int n0, int tid) {
    const int ws = n0 - 128;
#pragma unroll
    for (int k = 0; k < 6; ++k) { const int idx = tid + 512 * k, row = idx >> 3, ch = idx & 7; int kk = ws + row; kk = kk < 0 ? 0 : kk;
        sk[k] = *(const GAS v4u*)(pj + (size_t)(b * SEQ + r + (kk << sh)) * NPROJ + PC_K + h * 64 + ch * 8); }
}
__device__ __forceinline__ void dil_stage_load_v(v4u (&sv)[6], const bf16* pj, int sh, int b, int h, int r, int n0, int tid) {
    const int ws = n0 - 128;
#pragma unroll
    for (int k = 0; k < 6; ++k) { const int idx = tid + 512 * k, row = idx >> 3, ch = idx & 7; int kk = ws + row; kk = kk < 0 ? 0 : kk;
        sv[k] = *(const GAS v4u*)(pj + (size_t)(b * SEQ + r + (kk << sh)) * NPROJ + PC_V + h * 64 + ch * 8); }
}
__device__ __forceinline__ void dil_stage_write_k(LAS unsigned char* lds, const v4u (&sk)[6], int tid) {
#pragma unroll
    for (int k = 0; k < 6; ++k) { const int idx = tid + 512 * k, row = idx >> 3, ch = idx & 7; *(LAS v4u*)(lds + row * DK_PITCH + ch * 16) = sk[k]; }
}
__device__ __forceinline__ void dil_stage_write_v(LAS unsigned char* lds, const v4u (&sv)[6], int tid) {
#pragma unroll
    for (int k = 0; k < 6; ++k) { const int idx = tid + 512 * k, row = idx >> 3, ch = idx & 7;
        LAS unsigned short* d = (LAS unsigned short*)(lds + DK_BYTES + (8 * ch) * DV_PITCH + ((((row >> 3) ^ ch) << 3) | (row & 7)) * 2);
        d[0] = (unsigned short)(sv[k].x & 0xffffu); d[DV_PITCH / 2] = (unsigned short)(sv[k].x >> 16); d[2 * (DV_PITCH / 2)] = (unsigned short)(sv[k].y & 0xffffu); d[3 * (DV_PITCH / 2)] = (unsigned short)(sv[k].y >> 16);
        d[4 * (DV_PITCH / 2)] = (unsigned short)(sv[k].z & 0xffffu); d[5 * (DV_PITCH / 2)] = (unsigned short)(sv[k].z >> 16); d[6 * (DV_PITCH / 2)] = (unsigned short)(sv[k].w & 0xffffu); d[7 * (DV_PITCH / 2)] = (unsigned short)(sv[k].w >> 16); }
}
template <int JLO>
__device__ __forceinline__ void dil_wg_compute(const LAS unsigned char* lds, const bf16x8 (&qf)[4], bf16* opart, float* lsep, const LAS float* bt, int tq, int h, int k00, int lane, int wave, bool do_store) {
    constexpr int NT = JLO == 0 ? 5 : 4;
    asm volatile("" : "+v"(lane));
    const int q = lane & 31, hh = lane >> 5;
    f32x16 O0, O1;
#pragma unroll
    for (int i = 0; i < 16; ++i) { O0[i] = 0.f; O1[i] = 0.f; }
    float m = NEGINF, l = 0.f;
    const int sg = (q & ~12) | ((q & 4) << 1) | ((q & 8) >> 1);
    const LAS unsigned char* kl = lds + (32 * wave + sg) * DK_PITCH + 64 * hh;
    const LAS unsigned char* vl = lds + DK_BYTES + q * DV_PITCH;
    bf16x8 kf[2][4], vf[2][2][2];
#define DIL_LDFRAG(t_) do { _Pragma("unroll") for (int ks = 0; ks < 4; ++ks) kf[(t_) & 1][ks] = *(const LAS bf16x8*)(kl + (t_) * 32 * DK_PITCH + 16 * ks); \
        _Pragma("unroll") for (int db = 0; db < 2; ++db) _Pragma("unroll") for (int s2 = 0; s2 < 2; ++s2) \
            vf[(t_) & 1][db][s2] = *(const LAS bf16x8*)(vl + db * 32 * DV_PITCH + (((4 * wave + 4 * (t_) + 2 * s2 + hh) ^ (((32 * db + q) >> 3) & 7)) << 4)); } while (0)
    DIL_LDFRAG(0);
#pragma unroll
    for (int t = 0; t < NT; ++t) {
        if (t + 1 < NT) DIL_LDFRAG(t + 1);
        const int jq = k00 + 32 * t < 0 ? 160 : q - 8 * hh + 128 - 32 * t;
        dil_blk(kf[t & 1], vf[t & 1], qf, O0, O1, m, l, bt + jq + BT_OFF - 23);
        __builtin_amdgcn_sched_barrier(0);
    }
#undef DIL_LDFRAG
    if (do_store) dil_store(O0, O1, m, l, opart, lsep, tq, h, hh);
}

__device__ __forceinline__ void xat_unit(const bf16* qxp, const bf16* kb, const bf16* vtb, bf16* oxp, int t0, int h, int lane) {
    const int q = lane & 31, hh = lane >> 5;
    bf16x8 qf[8];
    { const bf16* qp = qxp + (size_t)(t0 + q) * XW + h * 128 + 64 * hh;
#pragma unroll
      for (int ks = 0; ks < 8; ++ks) qf[ks] = *(const GAS bf16x8*)(qp + 8 * ks); }
    f32x16 O[4];
#pragma unroll
    for (int d = 0; d < 4; ++d)
#pragma unroll
        for (int i = 0; i < 16; ++i) O[d][i] = 0.f;
    float m = NEGINF, l = 0.f;
    const bf16* vrow = vtb + (size_t)(h * 128 + q) * MEML + 4 * hh;
    for (int k0 = 0; k0 < MEML; k0 += 32) {
        const bf16* kp = kb + (size_t)(k0 + q) * 4096 + h * 128 + 64 * hh;
        f32x16 st;
#pragma unroll
        for (int i = 0; i < 16; ++i) st[i] = 0.f;
#pragma unroll
        for (int ks = 0; ks < 8; ++ks) st = __builtin_amdgcn_mfma_f32_32x32x16_bf16(*(const GAS bf16x8*)(kp + 8 * ks), qf[ks], st, 0, 0, 0);
        bf16x8 vf[4][2];
#pragma unroll
        for (int db = 0; db < 4; ++db)
#pragma unroll
            for (int s2 = 0; s2 < 2; ++s2) { const bf16* vp = vrow + (size_t)db * 32 * MEML + k0 + 16 * s2; vf[db][s2] = mk8u2(*(const GAS u32x2*)vp, *(const GAS u32x2*)(vp + 8)); }
        float mx = st[0];
#pragma unroll
        for (int i = 1; i < 16; ++i) mx = fmaxf(mx, st[i]);
        mx = xmax32(mx);
        const float mn = fmaxf(m, mx), alpha = __expf(m - mn);
        float ls = 0.f;
#pragma unroll
        for (int i = 0; i < 16; ++i) { st[i] = __expf(st[i] - mn); ls += st[i]; }
        l = l * alpha + ls; m = mn;
#pragma unroll
        for (int d = 0; d < 4; ++d)
#pragma unroll
            for (int i = 0; i < 16; ++i) O[d][i] *= alpha;
        const bf16x8 p0 = mk8(cvtpk(st[0], st[1]), cvtpk(st[2], st[3]), cvtpk(st[4], st[5]), cvtpk(st[6], st[7]));
        const bf16x8 p1 = mk8(cvtpk(st[8], st[9]), cvtpk(st[10], st[11]), cvtpk(st[12], st[13]), cvtpk(st[14], st[15]));
#pragma unroll
        for (int d = 0; d < 4; ++d) { O[d] = __builtin_amdgcn_mfma_f32_32x32x16_bf16(vf[d][0], p0, O[d], 0, 0, 0); O[d] = __builtin_amdgcn_mfma_f32_32x32x16_bf16(vf[d][1], p1, O[d], 0, 0, 0); }
    }
    l = xsum32(l);
    const float inv = 1.0f / l;
    bf16* op = oxp + (size_t)(t0 + q) * XW + h * 128 + 4 * hh;
#pragma unroll
    for (int d = 0; d < 4; ++d)
#pragma unroll
        for (int g4 = 0; g4 < 4; ++g4) { u32x2 w; w.x = cvtpk(O[d][4 * g4] * inv, O[d][4 * g4 + 1] * inv); w.y = cvtpk(O[d][4 * g4 + 2] * inv, O[d][4 * g4 + 3] * inv); *(GAS u32x2*)(op + 32 * d + 8 * g4) = w; }
}

constexpr int XK_PITCH = 272, XV_PITCH = 528, XK_BYTES = 256 * XK_PITCH, XV_BYTES = 128 * XV_PITCH;
__device__ __forceinline__ void xat_wg_unit(LAS unsigned char* lds, const bf16* qxp, const bf16* kb, const bf16* vtb, bf16* oxp, int t0, int h, int tid) {
    const int lane = tid & 63, q = lane & 31, hh = lane >> 5;
    __syncthreads();
#pragma unroll
    for (int k = 0; k < 8; ++k) { const int idx = tid + 512 * k, row = idx >> 4, ch = idx & 15;
        const v4u x = *(const GAS v4u*)(kb + (size_t)row * 4096 + h * 128 + ch * 8); *(LAS v4u*)(lds + row * XK_PITCH + ch * 16) = x; }
#pragma unroll
    for (int k = 0; k < 8; ++k) { const int idx = tid + 512 * k, row = idx >> 5, ch = idx & 31;
        const v4u x = *(const GAS v4u*)(vtb + (size_t)(h * 128 + row) * MEML + ch * 8); *(LAS v4u*)(lds + XK_BYTES + row * XV_PITCH + ch * 16) = x; }
    bf16x8 qf[8];
    { const bf16* qp = qxp + (size_t)(t0 + q) * XW + h * 128 + 64 * hh;
#pragma unroll
      for (int ks = 0; ks < 8; ++ks) qf[ks] = *(const GAS bf16x8*)(qp + 8 * ks); }
    __syncthreads();
    f32x16 O[4];
#pragma unroll
    for (int d = 0; d < 4; ++d)
#pragma unroll
        for (int i = 0; i < 16; ++i) O[d][i] = 0.f;
    float m = NEGINF, l = 0.f;
    const int sg = (q & ~12) | ((q & 4) << 1) | ((q & 8) >> 1);
    const LAS unsigned char* kl = lds + sg * XK_PITCH + 128 * hh;
    const LAS unsigned char* vl = lds + XK_BYTES + q * XV_PITCH + 16 * hh;
#pragma unroll
    for (int kt = 0; kt < 8; ++kt) {
        f32x16 st;
#pragma unroll
        for (int i = 0; i < 16; ++i) st[i] = 0.f;
#pragma unroll
        for (int ks = 0; ks < 8; ++ks) st = __builtin_amdgcn_mfma_f32_32x32x16_bf16(*(const LAS bf16x8*)(kl + kt * 32 * XK_PITCH + ks * 16), qf[ks], st, 0, 0, 0);
        float mx = st[0];
#pragma unroll
        for (int i = 1; i < 16; ++i) mx = fmaxf(mx, st[i]);
        mx = xmax32(mx);
        const float mn = fmaxf(m, mx), alpha = __builtin_amdgcn_exp2f((m - mn) * 1.4426950408889634f);
        float ls = 0.f;
#pragma unroll
        for (int i = 0; i < 16; ++i) { st[i] = __builtin_amdgcn_exp2f((st[i] - mn) * 1.4426950408889634f); ls += st[i]; }
        l = l * alpha + ls; m = mn;
#pragma unroll
        for (int d = 0; d < 4; ++d)
#pragma unroll
            for (int i = 0; i < 16; ++i) O[d][i] *= alpha;
        const bf16x8 p0 = mk8(cvtpk(st[0], st[1]), cvtpk(st[2], st[3]), cvtpk(st[4], st[5]), cvtpk(st[6], st[7]));
        const bf16x8 p1 = mk8(cvtpk(st[8], st[9]), cvtpk(st[10], st[11]), cvtpk(st[12], st[13]), cvtpk(st[14], st[15]));
#pragma unroll
        for (int d = 0; d < 4; ++d) { const LAS unsigned char* vp = vl + d * 32 * XV_PITCH + kt * 64;
            O[d] = __builtin_amdgcn_mfma_f32_32x32x16_bf16(*(const LAS bf16x8*)vp, p0, O[d], 0, 0, 0); O[d] = __builtin_amdgcn_mfma_f32_32x32x16_bf16(*(const LAS bf16x8*)(vp + 32), p1, O[d], 0, 0, 0); }
    }
    l = xsum32(l);
    const float inv = 1.0f / l;
    bf16* op = oxp + (size_t)(t0 + q) * XW + h * 128 + 4 * hh;
#pragma unroll
    for (int d = 0; d < 4; ++d)
#pragma unroll
        for (int g4 = 0; g4 < 4; ++g4) { u32x2 w; w.x = cvtpk(O[d][4 * g4] * inv, O[d][4 * g4 + 1] * inv); w.y = cvtpk(O[d][4 * g4 + 2] * inv, O[d][4 * g4 + 3] * inv); *(GAS u32x2*)(op + 32 * d + 8 * g4) = w; }
}

__device__ __forceinline__ void pool_unit(const bf16* pj, const bf16* pwT, const float* psc, bf16* ymixp, int t0, int lane, LAS unsigned char* scr) {
    constexpr int PITCH = 144;
    const int q = lane & 31, hh = lane >> 5; const int t = t0 + q, pos = t & (SEQ - 1), pos0 = t0 & (SEQ - 1);
    const int sr = lane >> 3, sc = lane & 7;
    v4u st[6];
#define POOL_LD(g_) do { _Pragma("unroll") for (int k = 0; k < 6; ++k) { const int r = 8 * k + sr, w_ = 2 << (g_); const bool ok = pos0 - (w_ - 1) + r >= 0 && r < 31 + w_; \
        st[k] = *(const GAS v4u*)(pj + (size_t)(ok ? t0 - (w_ - 1) + r : t0) * NPROJ + PC_POOL + (g_) * 64 + 8 * sc); if (!ok) st[k] = (v4u){0u, 0u, 0u, 0u}; } } while (0)
    POOL_LD(0);
#pragma unroll
    for (int g = 0; g < 4; ++g) {
        const int w = 2 << g; const float rn = 1.0f / (float)(pos + 1 < w ? pos + 1 : w);
#pragma unroll
        for (int k = 0; k < 6; ++k) *(LAS v4u*)(scr + (8 * k + sr) * PITCH + 16 * sc) = st[k];
        if (g < 3) POOL_LD(g + 1);
        f32x16 D0, D1;
#pragma unroll
        for (int i = 0; i < 16; ++i) { D0[i] = 0.f; D1[i] = 0.f; }
#pragma unroll
        for (int ks = 0; ks < 4; ++ks) {
            const LAS unsigned char* p0 = scr + (q + w - 1) * PITCH + 16 * (2 * ks + hh);
            const v4u x0 = *(const LAS v4u*)p0;
            float a0 = bflo(x0.x), a1 = bfhi(x0.x), a2 = bflo(x0.y), a3 = bfhi(x0.y), a4 = bflo(x0.z), a5 = bfhi(x0.z), a6 = bflo(x0.w), a7 = bfhi(x0.w);
#pragma unroll
            for (int i = 1; i < w; ++i) { const v4u xi = *(const LAS v4u*)(p0 - i * PITCH);
                a0 += bflo(xi.x); a1 += bfhi(xi.x); a2 += bflo(xi.y); a3 += bfhi(xi.y); a4 += bflo(xi.z); a5 += bfhi(xi.z); a6 += bflo(xi.w); a7 += bfhi(xi.w); }
            const bf16x8 bfr = mk8(cvtpk(a0 * rn - bflo(x0.x), a1 * rn - bfhi(x0.x)), cvtpk(a2 * rn - bflo(x0.y), a3 * rn - bfhi(x0.y)), cvtpk(a4 * rn - bflo(x0.z), a5 * rn - bfhi(x0.z)), cvtpk(a6 * rn - bflo(x0.w), a7 * rn - bfhi(x0.w)));
            const bf16* wp = pwT + (size_t)(g * 64 + q) * 64 + 16 * ks + 8 * hh;
            D0 = __builtin_amdgcn_mfma_f32_32x32x16_bf16(*(const GAS bf16x8*)wp, bfr, D0, 0, 0, 0);
            D1 = __builtin_amdgcn_mfma_f32_32x32x16_bf16(*(const GAS bf16x8*)(wp + 32 * 64), bfr, D1, 0, 0, 0);
        }
        bf16* op = ymixp + (size_t)t * D + 512 + g * 64 + 4 * hh; const float* sp = psc + g * 64 + 4 * hh;
#pragma unroll
        for (int k = 0; k < 4; ++k) { const f32x4 s0 = *(const GAS f32x4*)(sp + 8 * k), s1 = *(const GAS f32x4*)(sp + 32 + 8 * k);
            u32x2 w0, w1; w0.x = cvtpk(D0[4 * k] * s0[0], D0[4 * k + 1] * s0[1]); w0.y = cvtpk(D0[4 * k + 2] * s0[2], D0[4 * k + 3] * s0[3]);
            w1.x = cvtpk(D1[4 * k] * s1[0], D1[4 * k + 1] * s1[1]); w1.y = cvtpk(D1[4 * k + 2] * s1[2], D1[4 * k + 3] * s1[3]);
            *(GAS u32x2*)(op + 8 * k) = w0; *(GAS u32x2*)(op + 32 + 8 * k) = w1; }
    }
#undef POOL_LD
}
__device__ __forceinline__ void mergeconv_unit(const bf16* pj, const bf16* opartp, const float* lsepp, const float* cw, bf16* ymixp, int t0, int lane) {
    const int c4 = 4 * lane, h = lane >> 3;
    const f32x4 w0 = *(const GAS f32x4*)(cw + c4), w1 = *(const GAS f32x4*)(cw + 256 + c4), w2 = *(const GAS f32x4*)(cw + 512 + c4);
    f32x4 u1 = {0.f, 0.f, 0.f, 0.f}, u2 = {0.f, 0.f, 0.f, 0.f};
    const int pos0 = t0 & (SEQ - 1);
    if (pos0 >= 2) {
        const bf16* r1 = pj + (size_t)(t0 - 1) * NPROJ; const bf16* r2 = r1 - NPROJ;
        const u32x2 c1 = *(const GAS u32x2*)(r1 + PC_CG + c4), h1 = *(const GAS u32x2*)(r1 + PC_HC + c4), c2 = *(const GAS u32x2*)(r2 + PC_CG + c4), h2 = *(const GAS u32x2*)(r2 + PC_HC + c4);
        u1 = (f32x4){bflo(c1.x) * bflo(h1.x), bfhi(c1.x) * bfhi(h1.x), bflo(c1.y) * bflo(h1.y), bfhi(c1.y) * bfhi(h1.y)};
        u2 = (f32x4){bflo(c2.x) * bflo(h2.x), bfhi(c2.x) * bfhi(h2.x), bflo(c2.y) * bflo(h2.y), bfhi(c2.y) * bfhi(h2.y)};
    }
#pragma unroll 4
    for (int j = 0; j < 32; ++j) { const int t = t0 + j; const bf16* row = pj + (size_t)t * NPROJ;
        const u32x2 cg = *(const GAS u32x2*)(row + PC_CG + c4), hc = *(const GAS u32x2*)(row + PC_HC + c4), bg = *(const GAS u32x2*)(row + PC_BG + c4);
        const f32x4 u0 = {bflo(cg.x) * bflo(hc.x), bfhi(cg.x) * bfhi(hc.x), bflo(cg.y) * bflo(hc.y), bfhi(cg.y) * bfhi(hc.y)};
        const f32x4 y = (f32x4){bflo(bg.x), bfhi(bg.x), bflo(bg.y), bfhi(bg.y)} * (w0 * u0 + w1 * u1 + w2 * u2);
        u32x2 yo; yo.x = cvtpk(y[0], y[1]); yo.y = cvtpk(y[2], y[3]);
        *(GAS u32x2*)(ymixp + (size_t)t * D + 768 + c4) = yo;
        u2 = u1; u1 = u0;
        const float l0 = lsepp[(size_t)t * 8 + h], l1 = lsepp[(size_t)T * 8 + (size_t)t * 8 + h], l2 = lsepp[(size_t)2 * T * 8 + (size_t)t * 8 + h];
        const float M = fmaxf(l0, fmaxf(l1, l2)); float e0 = __expf(l0 - M), e1 = __expf(l1 - M), e2 = __expf(l2 - M); const float inv = 1.0f / (e0 + e1 + e2); e0 *= inv; e1 *= inv; e2 *= inv;
        const v4u a = *(const GAS v4u*)(opartp + (size_t)t * 512 + 8 * lane), bq = *(const GAS v4u*)(opartp + OP_STRIDE + (size_t)t * 512 + 8 * lane), c = *(const GAS v4u*)(opartp + 2 * OP_STRIDE + (size_t)t * 512 + 8 * lane);
        v4u o; o.x = cvtpk(e0 * bflo(a.x) + e1 * bflo(bq.x) + e2 * bflo(c.x), e0 * bfhi(a.x) + e1 * bfhi(bq.x) + e2 * bfhi(c.x));
        o.y = cvtpk(e0 * bflo(a.y) + e1 * bflo(bq.y) + e2 * bflo(c.y), e0 * bfhi(a.y) + e1 * bfhi(bq.y) + e2 * bfhi(c.y));
        o.z = cvtpk(e0 * bflo(a.z) + e1 * bflo(bq.z) + e2 * bflo(c.z), e0 * bfhi(a.z) + e1 * bfhi(bq.z) + e2 * bfhi(c.z));
        o.w = cvtpk(e0 * bflo(a.w) + e1 * bflo(bq.w) + e2 * bflo(c.w), e0 * bfhi(a.w) + e1 * bfhi(bq.w) + e2 * bfhi(c.w));
        *(GAS v4u*)(ymixp + (size_t)t * D + 8 * lane) = o; }
}

__device__ __forceinline__ void vt_transpose_tile(LAS unsigned char* lds, const bf16* pj, bf16* vt, int pm, int vh, int tid) {
    constexpr int PW = 65;
    LAS unsigned* img = (LAS unsigned*)lds;
    const int row0 = pm * 256, b = row0 >> 13, tt = row0 & 8191;
    for (int hf = 0; hf < 2; ++hf) {
        __syncthreads();
        { const int r = tid >> 1, hc = tid & 1;
            const bf16* src = pj + (size_t)(row0 + r) * NPROJ + PC_V + vh * 256 + hf * 128 + hc * 64;
#pragma unroll
            for (int k = 0; k < 8; ++k) { const v4u x = *(const GAS v4u*)(src + 8 * k); LAS unsigned* d = img + r * PW + hc * 32 + 4 * k; d[0] = x.x; d[1] = x.y; d[2] = x.z; d[3] = x.w; } }
        __syncthreads();
        const LAS unsigned short* im16 = (const LAS unsigned short*)lds;
        bf16* vcol = vt + (size_t)(b * 512 + vh * 256 + hf * 128) * SEQ;
#pragma unroll 2
        for (int k = 0; k < 8; ++k) { const int id = tid + 512 * k, d = id >> 5, c = id & 31;
            {
#define RD16(j) ((unsigned)im16[(8 * c + (j)) * (2 * PW) + d])
              v4u o; o.x = RD16(0) | (RD16(1) << 16); o.y = RD16(2) | (RD16(3) << 16); o.z = RD16(4) | (RD16(5) << 16); o.w = RD16(6) | (RD16(7) << 16);
#undef RD16
              *(GAS v4u*)(vcol + (size_t)d * SEQ + tt + 8 * c) = o; }
            { const int r = c >> 3, n0 = 8 * (c & 7);
#define RD16(j) ((unsigned)im16[(4 * (n0 + (j)) + r) * (2 * PW) + d])
              v4u o; o.x = RD16(0) | (RD16(1) << 16); o.y = RD16(2) | (RD16(3) << 16); o.z = RD16(4) | (RD16(5) << 16); o.w = RD16(6) | (RD16(7) << 16);
#undef RD16
              *(GAS v4u*)(vcol + VT_STRIDE + (size_t)d * SEQ + r * 2048 + (tt >> 2) + n0) = o; }
            { const int r = c >> 1, n0 = 8 * (c & 1);
#define RD16(j) ((unsigned)im16[(16 * (n0 + (j)) + r) * (2 * PW) + d])
              v4u o; o.x = RD16(0) | (RD16(1) << 16); o.y = RD16(2) | (RD16(3) << 16); o.z = RD16(4) | (RD16(5) << 16); o.w = RD16(6) | (RD16(7) << 16);
#undef RD16
              *(GAS v4u*)(vcol + 2 * VT_STRIDE + (size_t)d * SEQ + (tt >> 8) * 256 + r * 16 + n0) = o; }
        }
    }
    __syncthreads();
}

#define x_in (args.in[0])
#define mem_in (args.in[1])
#define rel_bias (args.in[2])
#define mem_g (args.in[3])
#define mix_g (args.in[4])
#define w_in (args.in[5])
#define conv_w (args.in[6])
#define pool_w (args.in[7])
#define pool_scale (args.in[8])
#define w_out (args.in[9])
#define xat_g (args.in[10])
#define wq_x (args.in[11])
#define wkv_x (args.in[12])
#define wo_x (args.in[13])
#define ffn_g (args.in[14])
#define w13_d (args.in[15])
#define w2_d (args.in[16])
#define router_w (args.in[17])
#define w13_m (args.in[18])
#define w2_m (args.in[19])
#define fin_g (args.in[20])
#define out (args.out)
#define Win_t ((bf16*)(ws + WS_WIN))
#define Wout_t ((bf16*)(ws + WS_WOUT))
#define Wq_t ((bf16*)(ws + WS_WQ))
#define Wkv_t ((bf16*)(ws + WS_WKV))
#define Wo_t ((bf16*)(ws + WS_WO))
#define W13d_t ((bf16*)(ws + WS_W13D))
#define W2d_t ((bf16*)(ws + WS_W2D))
#define W13m_t ((bf16*)(ws + WS_W13M))
#define W2m_t ((bf16*)(ws + WS_W2M))
#define xb ((bf16*)(ws + WS_XB))
#define qx ((bf16*)(ws + WS_QX))
#define ox ((bf16*)(ws + WS_OX))
#define Ag ((bf16*)(ws + WS_AG))
#define ym ((bf16*)(ws + WS_YM))
#define ypart ((bf16*)(ws + WS_YM + 136 * MiB))
#define proj ((bf16*)(ws + WS_PROJ))
#define ymix ((bf16*)(ws + WS_Y))
#define hbuf ((bf16*)(ws + WS_H))
#define kvx ((bf16*)(ws + WS_KVX))
#define memn ((bf16*)(ws + WS_MEMN))
#define vtb ((bf16*)(ws + WS_VT))
#define opart ((bf16*)(ws + WS_OPART))
#define lsep ((float*)(ws + WS_LSE))
#define vtx ((bf16*)(ws + WS_VTX))
#define ssp ((float*)(ws + WS_SSP))
#define cnts ((int*)(ws + WS_CNT))
#define meta ((int*)(ws + WS_META))
#define tok_e ((int*)(ws + WS_TOKE))
#define tok_g ((float*)(ws + WS_TOKG))
#define tok_pos ((int*)(ws + WS_TOKPOS))
#define row_gate ((float*)(ws + WS_ROWGATE))
#define row_rs ((float*)(ws + WS_ROWRS))
#ifndef PROBE
#define PROBE 0
#endif
#ifndef N_LAUNCH_MODE
#define N_LAUNCH_MODE 0
#endif

__device__ __forceinline__ void pair_barrier(unsigned* cnt, unsigned target, bool same_xcc, unsigned* tmo, int wave0) {
    asm volatile("s_waitcnt vmcnt(0)" ::: "memory");
    __syncthreads();
    int ln; asm volatile("v_mbcnt_lo_u32_b32 %0, -1, 0\n\tv_mbcnt_hi_u32_b32 %0, -1, %0" : "=v"(ln));
    if (wave0 == 0 && ln == 0) {
        if (!same_xcc) { __builtin_amdgcn_fence(__ATOMIC_RELEASE, "agent"); asm volatile("s_waitcnt vmcnt(0)" ::: "memory"); }
        (void)xb_add(cnt, 1u);
        unsigned sp = 0u;
        while (xb_ld(cnt) < target) { __builtin_amdgcn_s_sleep(1); if ((++sp & 255u) == 0u) { if (xb_ld(tmo)) break; if (sp > XB_SPIN_CAP) { atomicAdd(tmo, 1u); break; } } }
        __builtin_amdgcn_fence(__ATOMIC_ACQUIRE, "agent");
        asm volatile("s_waitcnt vmcnt(0)" ::: "memory");
    }
    __syncthreads();
}
__global__ void __launch_bounds__(NWAVES * 64, 2) trunk_fwd(Args args) {
    extern __shared__ __attribute__((aligned(16))) unsigned char lds_raw[];
    LAS unsigned char* lds = (LAS unsigned char*)lds_raw;
    volatile LAS unsigned* MISC = (volatile LAS unsigned*)(lds + MISC_OFF);
    const int tid0 = threadIdx.x;
    const int G0 = gridDim.x, blk0 = blockIdx.x, wave0 = __builtin_amdgcn_readfirstlane(tid0 >> 6);
    unsigned char* ws0 = args.ws;
    gu32* ctl = (gu32*)(ws0 + WS_CTL);
#define PH_VARS int lane_; asm volatile("v_mbcnt_lo_u32_b32 %0, -1, 0\n\tv_mbcnt_hi_u32_b32 %0, -1, %0" : "=v"(lane_)); int wv_ = wave0; asm volatile("" : "+s"(wv_)); int blk = blk0; asm volatile("" : "+s"(blk)); int G = G0; asm volatile("" : "+s"(G)); \
    unsigned char* ws = ws0; asm volatile("" : "+s"(ws)); const int lane = lane_, wave = wv_, tid = wv_ * 64 + lane_; const int gw = blk * NWAVES + wave, NGW = G * NWAVES; (void)lane; (void)gw; (void)NGW; (void)ws; (void)tid
    for (int u = tid0; u < (LDS_BYTES - LDSCTL_OFF) / 4; u += NWAVES * 64) ((LAS unsigned*)(lds + LDSCTL_OFF))[u] = 0u;
    __syncthreads();
    XcdBarrier bar = xcd_barrier_post((unsigned*)(ctl + CW_BAR), MISC + 8);
    bar.x = __builtin_amdgcn_readfirstlane(bar.x);
    if (tid0 == 0) __hip_atomic_store((unsigned*)(ws0 + WS_XCCTAB) + blk0, bar.x, __ATOMIC_RELAXED, __HIP_MEMORY_SCOPE_AGENT);
    const int tpm0 = (blk0 & 7) + 8 * (blk0 >> 4), tmb0 = (blk0 >> 3) & 1;
    unsigned pepoch = 0u; bool same_xcc = false;
#define PAIR_BAR do { pepoch += 2u; unsigned* tc_ = (unsigned*)(ctl + CW_TEAM) + 64 * tpm0; asm volatile("" : "+s"(tc_)); pair_barrier(tc_, pepoch, same_xcc, (unsigned*)(ctl + CW_BAR) + XB_TMO, wave0); } while (0)
#if N_LAUNCH_MODE == 0
#define PH_ON true
#define PH_END do { for (int br_ = 0; br_ < ((PROBE & 1024) ? 3 : 1); ++br_) { XcdBarrier b_ = bar; asm volatile("" : "+s"(b_.x)); asm volatile("" : "+s"(b_.bar)); xcd_barrier(b_); } } while (0)
#else
    const int lo = args.ph_lo, hi = args.ph_hi;
    int ph = 0;
#define PH_ON (ph >= lo && ph < hi)
#define PH_END do { if (ph >= lo && ph + 1 < hi) { XcdBarrier b_ = bar; asm volatile("" : "+s"(b_.x)); asm volatile("" : "+s"(b_.bar)); xcd_barrier(b_); } ++ph; } while (0)
#endif

    constexpr size_t SSP_STRIDE = (size_t)T * 16;

    if (PH_ON) { PH_VARS;
        LAS float* scr = (LAS float*)(lds + wave * 16896);
        constexpr int I_IN = 16 * 40, I_OUT = 16 * 16, I_Q = 16 * 8, I_KV = 16 * 16, I_O = 8 * 16, I_13D = 16 * 88, I_2D = 44 * 16, I_13M = 16 * 112, I_2M = 56 * 16;
        constexpr int C0 = 4 * I_IN, C1 = C0 + 4 * I_OUT, C2 = C1 + 4 * I_Q, C3 = C2 + 4 * I_KV, C4 = C3 + 4 * I_O, C5 = C4 + 2 * I_13D, C6 = C5 + 2 * I_2D, C7 = C6 + 16 * I_13M, C8 = C7 + 16 * I_2M;
        for (int rep = 0; rep < ((PROBE & 16) ? 2 : 1); ++rep)
        for (int it = gw; it < C8; it += NGW) {
            if (it < C0) { const int m = it / I_IN, r = it % I_IN; if (m < 2) conv_item(w_in + (size_t)m * D * NPROJ, D, NPROJ, Win_t + (size_t)m * NPROJ * D, mix_g + m * D, 0, scr, r, lane);
                else conv_item8(w_in + (size_t)m * D * NPROJ, D, NPROJ, (unsigned char*)(Win_t + (size_t)m * NPROJ * D), mix_g + m * D, 0, F8_S1, scr, r, lane); }
            else if (it < C1) { const int q = it - C0, m = q / I_OUT, r = q % I_OUT; conv_item(w_out + (size_t)m * D * D, D, D, Wout_t + (size_t)m * D * D, nullptr, 0, scr, r, lane); }
            else if (it < C2) { const int q = it - C1, m = q / I_Q, r = q % I_Q; conv_item(wq_x + (size_t)m * D * XW, D, XW, Wq_t + (size_t)m * XW * D, xat_g + m * D, 0, scr, r, lane); }
            else if (it < C3) { const int q = it - C2, m = q / I_KV, r = q % I_KV; conv_item(wkv_x + (size_t)m * D * 1024, D, 1024, Wkv_t + (size_t)m * 1024 * D, nullptr, 0, scr, r, lane); }
            else if (it < C4) { const int q = it - C3, m = q / I_O, r = q % I_O; conv_item(wo_x + (size_t)m * XW * D, XW, D, Wo_t + (size_t)m * D * XW, nullptr, 0, scr, r, lane); }
            else if (it < C5) { const int q = it - C4, m = q / I_13D, r = q % I_13D; if (m == 0) conv_item(w13_d, D, 2 * FFD, W13d_t, ffn_g, FFD, scr, r, lane); else conv_item8(w13_d + (size_t)D * 2 * FFD, D, 2 * FFD, (unsigned char*)(W13d_t + (size_t)2 * FFD * D), ffn_g + 2 * D, FFD, F8_S1, scr, r, lane); }
            else if (it < C6) { const int q = it - C5, m = q / I_2D, r = q % I_2D; if (m == 0) conv_item(w2_d, FFD, D, W2d_t, nullptr, 0, scr, r, lane); else conv_item8(w2_d + (size_t)FFD * D, FFD, D, (unsigned char*)(W2d_t + (size_t)D * FFD), nullptr, 0, F8_S2, scr, r, lane); }
            else if (it < C7) { const int q = it - C6, m = q / I_13M, r = q % I_13M; conv_item8(w13_m + (size_t)m * D * 2 * FFE, D, 2 * FFE, (unsigned char*)W13m_t + (size_t)m * 2 * FFE * D, ffn_g + (2 * (m >> 3) + 1) * D, FFE, F8_S1, scr, r, lane); }
            else { const int q = it - C7, m = q / I_2M, r = q % I_2M; conv_item8(w2_m + (size_t)m * FFE * D, FFE, D, (unsigned char*)W2m_t + (size_t)m * D * FFE, nullptr, 0, F8_S2, scr, r, lane); }
        }
        for (int idx = gw * 64 + lane; idx < DEPTH * 4 * 64 * 64; idx += NGW * 64) { const int c = idx & 63, dp = (idx >> 6) & 63, lg = idx >> 12;
            ((bf16*)(ws + WS_PWT))[idx] = (bf16)f2bf(pool_w[(size_t)(lg * 64 + c) * 64 + dp]); }
        for (int m = gw; m < T; m += NGW) {
            const GAS f32x4* xr = (const GAS f32x4*)(x_in + (size_t)m * D) + lane; f32x4 v[4]; float s = 0.f;
#pragma unroll
            for (int j = 0; j < 4; ++j) { v[j] = xr[64 * j]; s += (v[j].x * v[j].x + v[j].y * v[j].y) + (v[j].z * v[j].z + v[j].w * v[j].w); }
            s = wave_sum(s, lane);
            GAS unsigned long long* o8 = (GAS unsigned long long*)(xb + (size_t)m * D) + lane;
#pragma unroll
            for (int j = 0; j < 4; ++j) o8[64 * j] = (unsigned long long)pk2(v[j].x, v[j].y) | ((unsigned long long)pk2(v[j].z, v[j].w) << 32);
            if (lane < 16) ssp[(size_t)m * 16 + lane] = lane == 0 ? s : 0.f;
        }
        for (int m = gw; m < MROWS; m += NGW) {
            const GAS f32x4* xr = (const GAS f32x4*)(mem_in + (size_t)m * D) + lane; const GAS f32x4* gr = (const GAS f32x4*)mem_g + lane; f32x4 v[4]; float s = 0.f;
#pragma unroll
            for (int j = 0; j < 4; ++j) { v[j] = xr[64 * j]; s += (v[j].x * v[j].x + v[j].y * v[j].y) + (v[j].z * v[j].z + v[j].w * v[j].w); }
            const float r = 1.0f / sqrtf(wave_sum(s, lane) * (1.0f / D) + 1e-6f);
            GAS unsigned long long* o8 = (GAS unsigned long long*)(memn + (size_t)m * D) + lane;
#pragma unroll
            for (int j = 0; j < 4; ++j) { const f32x4 g = gr[64 * j]; o8[64 * j] = (unsigned long long)pk2(v[j].x * r * g.x, v[j].y * r * g.y) | ((unsigned long long)pk2(v[j].z * r * g.z, v[j].w * r * g.w) << 32); }
        }
    }
    PH_END;
    same_xcc = (unsigned)__builtin_amdgcn_readfirstlane((int)xb_ld((unsigned*)(ws0 + WS_XCCTAB) + (blk0 ^ 8))) == bar.x;

    for (int l = 0; l < DEPTH; ++l) {
#define ssp_a (ssp + (size_t)(3 * l) * SSP_STRIDE)
#define ssp_b (ssp + (size_t)(3 * l + 1) * SSP_STRIDE)
#define ssp_c (ssp + (size_t)(3 * l + 2) * SSP_STRIDE)
#define ssp_d (ssp + (size_t)(3 * l + 3) * SSP_STRIDE)
        if (PH_ON) { PH_VARS;
            if (l == 0) {
                pg8::Gemm g{memn, Wkv_t, MROWS, 4096, D}; pg8::StaticOrder S; S.init(MROWS, 4096, G, blk);
                pg8::EpiKV E{kvx, vtx};
                pg8::gemm_phase<pg8::EpiKV, pg8::StaticOrder, true, true>(lds, g, S, E, tid);
#if PROBE & (1 | 64)
                pg8::gemm_phase<pg8::EpiKV, pg8::StaticOrder, true, true>(lds, g, S, E, tid);
#endif
            }
        }
        if (PH_ON) {
            if (l >= 2) { PH_VARS;
                pg8::Gemm g{Ag, Win_t + (size_t)l * NPROJ * D, T, NPROJ, D / 2}; pg8::StaticOrder S; S.init(T, NPROJ, G, blk);
                pg8::EpiRowScale E{proj, NPROJ, ssp_a, 1.0f / F8_S1};
                pg8::gemm_phase<pg8::EpiRowScale, pg8::StaticOrder, true, true, true>(lds, g, S, E, tid);
            } else { PH_VARS;
                pg8::Gemm g{xb, Win_t + (size_t)l * NPROJ * D, T, NPROJ, D}; pg8::StaticOrder S; S.init(T, NPROJ, G, blk);
                pg8::EpiRowScale E{proj, NPROJ, ssp_a, 1.0f};
                pg8::gemm_phase<pg8::EpiRowScale, pg8::StaticOrder, true, true>(lds, g, S, E, tid);
            }
        }
        PH_END;
        if (PH_ON) { PH_VARS;
            LAS float* bt = (LAS float*)lds;
            for (int idx = tid; idx < 3 * 8 * BT_LD; idx += NWAVES * 64) { const int part = idx / (8 * BT_LD), rem = idx % (8 * BT_LD), h = rem / BT_LD, j = rem % BT_LD - BT_OFF, sh = 2 * part, jlo = part ? 33 : 0;
                float v = NEGINF; if (j <= 128 && j >= jlo) { const int d = j << sh; v = (rel_bias[t5_bucket(d) * 8 + h] + logf((float)key_mult(d))) * 1.4426950408889634f; } bt[idx] = v; }
            __syncthreads();
            for (int rep = 0; rep < ((PROBE & (2 | 2048)) ? 2 : 1); ++rep) {
            v4u sk[6], sv[6];
#define DIL_DEC(u_) const int part = (u_) >> 10, v_ = (u_) & 1023, sh = 2 * part, b = v_ >> 8, h = (v_ >> 5) & 7, w5 = v_ & 31, nbs = 5 - sh, r = w5 >> nbs, n0 = 256 * (w5 & ((1 << nbs) - 1))
            { const int u0 = blk < 3 * 1024 ? blk : 0; DIL_DEC(u0); dil_stage_load_k(sk, proj, sh, b, h, r, n0, tid); dil_stage_load_v(sv, proj, sh, b, h, r, n0, tid); }
            for (int u = blk; u < 3 * 1024; u += G) {
                DIL_DEC(u);
                const bool dst = !((PROBE & 2048) && rep == 1);
                __syncthreads();
                dil_stage_write_k(lds + 20480, sk, tid); dil_stage_write_v(lds + 20480, sv, tid);
                const int tq = b * SEQ + r + ((n0 + 32 * wave + (lane & 31)) << sh);
                bf16x8 qf[4];
                { const bf16* qp = proj + (size_t)tq * NPROJ + PC_Q + h * 64 + 32 * (lane >> 5);
#pragma unroll
                  for (int ks = 0; ks < 4; ++ks) qf[ks] = *(const GAS bf16x8*)(qp + 8 * ks); }
                __syncthreads();
                { const int un = u + G < 3 * 1024 ? u + G : u, part2 = un >> 10, v2 = un & 1023, sh2 = 2 * part2, nbs2 = 5 - sh2, w52 = v2 & 31, b2 = v2 >> 8, h2 = (v2 >> 5) & 7, r2 = w52 >> nbs2, n02 = 256 * (w52 & ((1 << nbs2) - 1));
                    dil_stage_load_k(sk, proj, sh2, b2, h2, r2, n02, tid); dil_stage_load_v(sv, proj, sh2, b2, h2, r2, n02, tid); }
                if (part == 0) dil_wg_compute<0>(lds + 20480, qf, opart, lsep, bt + h * BT_LD, tq, h, n0 + 32 * wave - 128, lane, wave, dst);
                else dil_wg_compute<33>(lds + 20480, qf, opart + (size_t)part * OP_STRIDE, lsep + (size_t)part * T * 8, bt + (part * 8 + h) * BT_LD, tq, h, n0 + 32 * wave - 128, lane, wave, dst);
            }
#undef DIL_DEC
            }
            __syncthreads();
        }
        PH_END;
        if (PH_ON) { PH_VARS;
            const bf16* pwT = (const bf16*)(ws + WS_PWT) + (size_t)l * 4 * 64 * 64;
            const int t0 = 32 * (tpm0 * 8 + 4 * tmb0 + (wave >> 1));
            if ((wave & 1) == 0) pool_unit(proj, pwT, pool_scale + (size_t)l * 256, ymix, t0, lane, lds + wave * 16896);
            else mergeconv_unit(proj, opart, lsep, conv_w + (size_t)l * 768, ymix, t0, lane);
        }
        PAIR_BAR;
        if (PH_ON) { PH_VARS;
            pg8::Gemm g{ymix, Wout_t + (size_t)l * D * D, T, D, D}; pg8::TeamOrder S{tpm0, 2 * tmb0, 2};
            pg8::EpiResid E{l == 0 ? x_in : (const float*)nullptr, xb, ssp_b, nullptr, 1.0f, 0};
            pg8::gemm_phase<pg8::EpiResid, pg8::TeamOrder, true, true>(lds, g, S, E, tid);
        }
        PAIR_BAR;
        if (PH_ON) { PH_VARS;
            pg8::Gemm g{xb, Wq_t + (size_t)l * XW * D, T, XW, D}; pg8::TeamOrder S{tpm0, tmb0, 1};
            pg8::EpiRowScale E{qx, XW, ssp_b, 0.08838834764831845f};
            pg8::gemm_phase<pg8::EpiRowScale, pg8::TeamOrder, true, true>(lds, g, S, E, tid);
            { const int b = (tpm0 * 256) / SEQ;
              for (int h2 = 0; h2 < 2; ++h2) xat_wg_unit(lds, qx, kvx + (size_t)(b * MEML) * 4096 + l * 1024, vtx + (size_t)((l * 4 + b) * 512) * MEML, ox, tpm0 * 256 + wave * 32, 2 * tmb0 + h2, tid); }
            __syncthreads();
        }
        PAIR_BAR;
        if (PH_ON) { PH_VARS;
            pg8::Gemm g{ox, Wo_t + (size_t)l * D * XW, T, D, XW}; pg8::TeamOrder S{tpm0, 2 * tmb0, 2};
            pg8::EpiResid E{nullptr, xb, ssp_c, (unsigned char*)Ag, 1.0f, l == 2 ? 1 : 0};
            pg8::gemm_phase<pg8::EpiResid, pg8::TeamOrder, true, true>(lds, g, S, E, tid);
        }
        PH_END;
        if ((l & 1) == 0) {
            if (PH_ON) { PH_VARS;
                pg8::StaticOrder S; S.init(T, 2 * FFD, G, blk);
                if (l == 2) {
                    pg8::Gemm g{Ag, W13d_t + (size_t)2 * FFD * D, T, 2 * FFD, D / 2};
                    pg8::EpiSwiGLU8 E{(unsigned char*)hbuf, FFD, nullptr, 0, 1.0f / F8_S1, F8_SH, ssp_c};
                    pg8::gemm_phase<pg8::EpiSwiGLU8, pg8::StaticOrder, true, true, true>(lds, g, S, E, tid);
                } else {
                    pg8::Gemm g{xb, W13d_t, T, 2 * FFD, D};
                    pg8::EpiSwiGLU E{hbuf, FFD, ssp_c, nullptr, 0};
                    pg8::gemm_phase<pg8::EpiSwiGLU, pg8::StaticOrder, true, true>(lds, g, S, E, tid);
                }
            }
            PH_END;
            if (PH_ON) { PH_VARS;
                pg8::StaticOrder S; S.init(T, D, G, blk);
                if (l == 2) {
                    pg8::Gemm g{hbuf, W2d_t + (size_t)D * FFD, T, D, FFD / 2};
                    pg8::EpiResid E{nullptr, xb, ssp_d, (unsigned char*)Ag, 1.0f / (F8_S2 * F8_SH), 1};
                    pg8::gemm_phase<pg8::EpiResid, pg8::StaticOrder, true, true, true>(lds, g, S, E, tid);
                } else {
                    pg8::Gemm g{hbuf, W2d_t, T, D, FFD};
                    pg8::EpiResid E{nullptr, xb, ssp_d, nullptr, 1.0f, 0};
                    pg8::gemm_phase<pg8::EpiResid, pg8::StaticOrder, true, true>(lds, g, S, E, tid);
                }
            }
            PH_END;
        } else {
#define chunk ((T + G - 1) / G)
            if (PH_ON) { PH_VARS;
                LAS int* lcnt = (LAS int*)lds; const float* rw = router_w + (size_t)(l >> 1) * D * NEXP; const float* fg = ffn_g + (size_t)l * D;
                if (tid < NEXP) lcnt[tid] = 0;
                __syncthreads();
                for (int i = wave; i < chunk; i += NWAVES) { const int t = blk * chunk + i; if (t >= T) break;
                    const float r = pg8::row_rs16(ssp_c, t);
                    float lg[8];
#pragma unroll
                    for (int e = 0; e < 8; ++e) lg[e] = 0.f;
#pragma unroll
                    for (int j = 0; j < 4; ++j) { const u32x2 xw = *((const GAS u32x2*)(xb + (size_t)t * D) + lane + 64 * j); const f32x4 xv = {bflo(xw.x), bfhi(xw.x), bflo(xw.y), bfhi(xw.y)}; const f32x4 gv = *((const GAS f32x4*)fg + lane + 64 * j);
#pragma unroll
                        for (int c = 0; c < 4; ++c) { const float hn = xv[c] * r * gv[c]; const int k = 4 * (lane + 64 * j) + c; const f32x4 w0 = *(const GAS f32x4*)(rw + (size_t)k * 8), w1 = *(const GAS f32x4*)(rw + (size_t)k * 8 + 4);
                            lg[0] += hn * w0[0]; lg[1] += hn * w0[1]; lg[2] += hn * w0[2]; lg[3] += hn * w0[3]; lg[4] += hn * w1[0]; lg[5] += hn * w1[1]; lg[6] += hn * w1[2]; lg[7] += hn * w1[3]; } }
#pragma unroll
                    for (int e = 0; e < 8; ++e) lg[e] = wave_sum(lg[e], lane);
                    int e0 = 0; float v0 = lg[0];
#pragma unroll
                    for (int e = 1; e < 8; ++e) if (lg[e] > v0) { v0 = lg[e]; e0 = e; }
                    int e1 = -1; float v1 = -3.0e38f;
#pragma unroll
                    for (int e = 0; e < 8; ++e) if (e != e0 && lg[e] > v1) { v1 = lg[e]; e1 = e; }
                    const float p0 = 1.0f / (1.0f + __expf(v1 - v0)), p1 = 1.0f - p0;
                    if (lane == 0) { tok_e[2 * t] = e0; tok_e[2 * t + 1] = e1; tok_g[2 * t] = p0; tok_g[2 * t + 1] = p1; atomicAdd((int*)&lcnt[e0], 1); atomicAdd((int*)&lcnt[e1], 1); }
                }
                __syncthreads();
                if (tid < NEXP) cnts[blk * NEXP + tid] = lcnt[tid];
                __syncthreads();
            }
            PH_END;
            if (PH_ON) { PH_VARS;
                LAS int* lc = (LAS int*)lds;
                LAS int* lbase = (LAS int*)(lds + 32768);
                LAS int* lseg = (LAS int*)(lds + 32768 + 64);
                LAS int* lpos = (LAS int*)(lds + 36864);
                for (int i = tid; i < G * NEXP; i += NWAVES * 64) lc[i] = cnts[i];
                __syncthreads();
                { int base = 0, tot = 0;
                  for (int b2 = lane; b2 < G; b2 += 64) { const int c = lc[b2 * NEXP + wave]; tot += c; base += b2 < blk ? c : 0; }
                  for (int o = 1; o < 32; o <<= 1) { tot += __builtin_amdgcn_ds_bpermute((lane ^ o) << 2, tot); base += __builtin_amdgcn_ds_bpermute((lane ^ o) << 2, base); }
                  tot += __builtin_amdgcn_ds_bpermute((lane ^ 32) << 2, tot); base += __builtin_amdgcn_ds_bpermute((lane ^ 32) << 2, base);
                  if (lane == 0) { lbase[wave] = base; lseg[8 + wave] = tot; } }
                __syncthreads();
                if (tid == 0) { int s = 0; for (int e = 0; e < NEXP; ++e) { lseg[e] = s; lbase[e] += s; s += (lseg[8 + e] + 255) & ~255; lseg[16 + e] = s; if (blk == 0) meta[e] = s >> 8; } }
                __syncthreads();
                if (wave == 0) {
                    int run[8];
#pragma unroll
                    for (int e = 0; e < 8; ++e) run[e] = lbase[e];
                    const int nent = 2 * chunk;
                    for (int r0 = 0; r0 < nent; r0 += 64) { const int idx = r0 + lane; const int t = blk * chunk + (idx >> 1); const bool ok = idx < nent && t < T;
                        const int e = ok ? tok_e[2 * t + (idx & 1)] : -1; int pos = 0;
#pragma unroll
                        for (int ee = 0; ee < 8; ++ee) { const unsigned long long mk = __ballot(e == ee); if (e == ee) pos = run[ee] + __popcll(mk & ((1ull << lane) - 1ull)); run[ee] += __popcll(mk); }
                        if (ok) { tok_pos[2 * t + (idx & 1)] = pos; row_gate[pos] = tok_g[2 * t + (idx & 1)]; row_rs[pos] = pg8::row_rs16(ssp_c, t); lpos[idx] = pos; } }
                }
                __syncthreads();
                for (int idx = wave; idx < 2 * chunk; idx += NWAVES) { const int t = blk * chunk + (idx >> 1); if (t >= T) break; const int pos = lpos[idx];
                    const GAS v4u* src = (const GAS v4u*)(xb + (size_t)t * D); const v4u a = src[2 * lane], c = src[2 * lane + 1];
                    v4u o; o.x = pg8::pk4_fp8(bflo(a.x), bfhi(a.x), bflo(a.y), bfhi(a.y)); o.y = pg8::pk4_fp8(bflo(a.z), bfhi(a.z), bflo(a.w), bfhi(a.w));
                    o.z = pg8::pk4_fp8(bflo(c.x), bfhi(c.x), bflo(c.y), bfhi(c.y)); o.w = pg8::pk4_fp8(bflo(c.z), bfhi(c.z), bflo(c.w), bfhi(c.w));
                    *((GAS v4u*)((unsigned char*)Ag + (size_t)pos * D) + lane) = o; }
                if (blk < NEXP) { const int r0 = lseg[blk] + lseg[8 + blk], r1 = lseg[16 + blk];
                    for (int r = r0 + wave; r < r1; r += NWAVES) { GAS v4u* dst = (GAS v4u*)((unsigned char*)Ag + (size_t)r * D); unsigned z0; asm volatile("v_mov_b32 %0, 0" : "=v"(z0)); const v4u z = {z0, z0, z0, z0}; dst[lane] = z; if (lane == 0) { row_gate[r] = 0.f; row_rs[r] = 0.f; } } }
                __syncthreads();
            }
            PH_END;
            if (PH_ON) { PH_VARS;
                pg8::MoeOrder S;
#pragma unroll
                for (int e = 0; e < 8; ++e) S.te[e] = __builtin_amdgcn_readfirstlane(meta[e]);
                S.nNl = 2 * FFE / 256; S.so.init(S.te[7] * 256, 2 * FFE, G, blk);
                pg8::Gemm g{Ag, W13m_t + (size_t)(l >> 1) * NEXP * 2 * FFE * (D / 2), MP, NEXP * 2 * FFE, D / 2};
                pg8::EpiSwiGLU8 E{(unsigned char*)hbuf, FFE, row_rs, 2 * FFE / 256, 1.0f / F8_S1, F8_SH, nullptr};
                pg8::gemm_phase<pg8::EpiSwiGLU8, pg8::MoeOrder, true, true, true>(lds, g, S, E, tid);
#if PROBE & (1 | 512)
                pg8::gemm_phase<pg8::EpiSwiGLU8, pg8::MoeOrder, true, true, true>(lds, g, S, E, tid);
#endif
            }
            PH_END;
            if (PH_ON) { PH_VARS;
                pg8::MoeOrder S;
#pragma unroll
                for (int e = 0; e < 8; ++e) S.te[e] = __builtin_amdgcn_readfirstlane(meta[e]);
                const int ntile = S.te[7], nmain = ntile < 256 ? ntile : 256;
                S.nNl = D / 256; S.so.init(nmain * 256, D, G, blk);
                pg8::Gemm g{hbuf, W2m_t + (size_t)(l >> 1) * NEXP * D * (FFE / 2), MP, NEXP * D, FFE / 2};
                pg8::EpiMoeOut E{ym, row_gate, 1.0f / (F8_S2 * F8_SH)};
                pg8::gemm_phase<pg8::EpiMoeOut, pg8::MoeOrder, true, true, true>(lds, g, S, E, tid);
#if PROBE & (1 | 512)
                pg8::gemm_phase<pg8::EpiMoeOut, pg8::MoeOrder, true, true, true>(lds, g, S, E, tid);
#endif
                if (ntile > 256) {
                    pg8::MoeTailOrder ST; ST.npieces = (ntile - 256) * 4 * 7; ST.G = G; ST.c = blk; ST.kstep = 512;
#pragma unroll
                    for (int e = 0; e < 8; ++e) ST.te[e] = S.te[e];
                    pg8::Gemm g2{hbuf, W2m_t + (size_t)(l >> 1) * NEXP * D * (FFE / 2), MP, NEXP * D, 256, FFE / 2};
                    pg8::EpiMoePart EP{ypart, row_gate, 1.0f / (F8_S2 * F8_SH), 9};
                    pg8::gemm_phase<pg8::EpiMoePart, pg8::MoeTailOrder, true, true, true>(lds, g2, ST, EP, tid);
                }
            }
            PH_END;
            if (PH_ON) { PH_VARS;
                const bool last = (l == DEPTH - 1);
                for (int t = gw; t < T; t += NGW) {
                    const int p0 = tok_pos[2 * t], p1 = tok_pos[2 * t + 1];
                    const GAS u32x2* xr = (const GAS u32x2*)(xb + (size_t)t * D) + lane; const GAS u32x2* y0 = (const GAS u32x2*)(ym + (size_t)p0 * D) + lane; const GAS u32x2* y1 = (const GAS u32x2*)(ym + (size_t)p1 * D) + lane;
                    f32x4 v[4]; float s = 0.f;
#pragma unroll
                    for (int j = 0; j < 4; ++j) { const u32x2 a = xr[64 * j]; f32x4 e0, e1;
                        if (p0 < 65536) { const u32x2 b0 = y0[64 * j]; e0 = (f32x4){bflo(b0.x), bfhi(b0.x), bflo(b0.y), bfhi(b0.y)}; }
                        else { e0 = (f32x4){0.f, 0.f, 0.f, 0.f};
                            for (int kp = 0; kp < 7; ++kp) { const u32x2 b0 = *((const GAS u32x2*)(ypart + ((size_t)kp * 2048 + (p0 - 65536)) * D) + lane + 64 * j); e0 += (f32x4){bflo(b0.x), bfhi(b0.x), bflo(b0.y), bfhi(b0.y)}; } }
                        if (p1 < 65536) { const u32x2 b1 = y1[64 * j]; e1 = (f32x4){bflo(b1.x), bfhi(b1.x), bflo(b1.y), bfhi(b1.y)}; }
                        else { e1 = (f32x4){0.f, 0.f, 0.f, 0.f};
                            for (int kp = 0; kp < 7; ++kp) { const u32x2 b1 = *((const GAS u32x2*)(ypart + ((size_t)kp * 2048 + (p1 - 65536)) * D) + lane + 64 * j); e1 += (f32x4){bflo(b1.x), bfhi(b1.x), bflo(b1.y), bfhi(b1.y)}; } }
                        v[j] = ((f32x4){bflo(a.x), bfhi(a.x), bflo(a.y), bfhi(a.y)} + e0) + e1;
                        s += (v[j].x * v[j].x + v[j].y * v[j].y) + (v[j].z * v[j].z + v[j].w * v[j].w); }
                    s = wave_sum(s, lane);
                    GAS f32x4* orow = (GAS f32x4*)(out + (size_t)t * D) + lane;
                    if (last) { const float r = 1.0f / sqrtf(s * (1.0f / D) + 1e-6f); const GAS f32x4* gr = (const GAS f32x4*)fin_g + lane;
#pragma unroll
                        for (int j = 0; j < 4; ++j) orow[64 * j] = v[j] * r * gr[64 * j]; }
                    else { GAS unsigned long long* o8 = (GAS unsigned long long*)(xb + (size_t)t * D) + lane;
#pragma unroll
                        for (int j = 0; j < 4; ++j) o8[64 * j] = (unsigned long long)pk2(v[j].x, v[j].y) | ((unsigned long long)pk2(v[j].z, v[j].w) << 32);
                        { GAS unsigned* o4 = (GAS unsigned*)((unsigned char*)Ag + (size_t)t * D) + lane;
#pragma unroll
                          for (int j = 0; j < 4; ++j) o4[64 * j] = pg8::pk4_fp8(v[j].x, v[j].y, v[j].z, v[j].w); }
                        if (lane < 16) ssp_d[(size_t)t * 16 + lane] = lane == 0 ? s : 0.f; }
                }
            }
            if (l != DEPTH - 1) { PH_END; }
        }
    }
#undef PH_ON
#undef PH_END
}
#undef x_in
#undef mem_in
#undef rel_bias
#undef mem_g
#undef mix_g
#undef w_in
#undef conv_w
#undef pool_w
#undef pool_scale
#undef w_out
#undef xat_g
#undef wq_x
#undef wkv_x
#undef wo_x
#undef ffn_g
#undef w13_d
#undef w2_d
#undef router_w
#undef w13_m
#undef w2_m
#undef fin_g
#undef out
#undef Win_t
#undef Wout_t
#undef Wq_t
#undef Wkv_t
#undef Wo_t
#undef W13d_t
#undef W2d_t
#undef W13m_t
#undef W2m_t
#undef xb
#undef qx
#undef ox
#undef Ag
#undef ym
#undef proj
#undef ymix
#undef hbuf
#undef kvx
#undef memn
#undef ssp
#undef cnts
#undef meta
#undef tok_e
#undef tok_g
#undef tok_pos
#undef row_gate
#undef row_rs
#undef ssp_a
#undef ssp_b
#undef ssp_c
#undef ssp_d
#undef PH_VARS
#undef ypart
#undef chunk
#undef vtb
#undef opart
#undef lsep
#undef vtx

extern "C" void kernel_launch(void* const* d_in, const int* in_sizes, int n_in, void* d_out, int out_size, void* d_ws, size_t ws_size, hipStream_t stream) {
    static int grid = 0;
    if (grid == 0) {
        if (n_in != 21 || in_sizes[0] != T * D || out_size != T * D || ws_size < WS_END) { fprintf(stderr, "kernel_launch: unexpected shapes: n_in %d in0 %d out %d ws %zu (need %zu)\n", n_in, n_in > 0 ? in_sizes[0] : -1, out_size, ws_size, (size_t)WS_END); grid = -1; return; }
        int dev = 0, cus = 0, per_cu = 0;
        if (hipGetDevice(&dev) != hipSuccess || hipDeviceGetAttribute(&cus, hipDeviceAttributeMultiprocessorCount, dev) != hipSuccess) { fprintf(stderr, "kernel_launch: device query failed\n"); grid = -1; return; }
        if (hipFuncSetAttribute((const void*)trunk_fwd, hipFuncAttributeMaxDynamicSharedMemorySize, LDS_BYTES) != hipSuccess) { fprintf(stderr, "kernel_launch: hipFuncSetAttribute failed\n"); grid = -1; return; }
        if (hipOccupancyMaxActiveBlocksPerMultiprocessor(&per_cu, (const void*)trunk_fwd, NWAVES * 64, LDS_BYTES) != hipSuccess || per_cu < 1) fprintf(stderr, "kernel_launch: occupancy query reports %d\n", per_cu);
        (void)hipGetLastError();
        if (cus != T / 256 * 2) { fprintf(stderr, "kernel_launch: the team mapping needs %d CUs, device has %d\n", T / 256 * 2, cus); grid = -1; return; }
        grid = cus;
    }
    if (grid < 0) return;
    if (hipMemsetAsync((char*)d_ws + WS_CTL, 0, CTL_ZERO_BYTES, stream) != hipSuccess) { fprintf(stderr, "kernel_launch: memset failed\n"); return; }
    Args a{};
    for (int i = 0; i < 21; ++i) a.in[i] = (const float*)d_in[i];
    a.out = (float*)d_out; a.ws = (unsigned char*)d_ws;
#if N_LAUNCH_MODE == 0
    a.ph_lo = 0; a.ph_hi = NPH;
    hipLaunchKernelGGL(trunk_fwd, dim3(grid), dim3(NWAVES * 64), LDS_BYTES, stream, a);
#else
    for (int p = 0; p < NPH; ++p) { a.ph_lo = p; a.ph_hi = p + 1; hipLaunchKernelGGL(trunk_fwd, dim3(grid), dim3(NWAVES * 64), LDS_BYTES, stream, a); }
#endif
    const hipError_t le = hipPeekAtLastError();
    if (le != hipSuccess) fprintf(stderr, "kernel_launch: launch failed: %s\n", hipGetErrorName(le));
}
```

```cpp
#define PROBE 0
#include <hip/hip_runtime.h>
#include <cstdio>
#include <cstdint>
namespace pg8 {
#define PG8_LAS __attribute__((address_space(3)))
typedef unsigned short bf16_t;
typedef short bf16x8 __attribute__((ext_vector_type(8)));
typedef float f32x4 __attribute__((ext_vector_type(4)));
typedef unsigned u32x4 __attribute__((ext_vector_type(4)));
typedef int v4i_t __attribute__((ext_vector_type(4)));
typedef long v2l_t __attribute__((ext_vector_type(2)));
typedef int v8i_t __attribute__((ext_vector_type(8)));
constexpr int BM = 256, BK = 64, HALF = 128, HTB = HALF * BK * 2  , STAGE_BYTES = 8 * HTB, NXCD = 8, WGM = 8;

__host__ __device__ __forceinline__ int lds_byte(int r, int c) { const int st = (r >> 4) * 2 + (c >> 5), rr = r & 15, cc = c & 31, ob = rr * 64 + cc * 2; return st * 1024 + (ob ^ (((ob >> 9) & 1) << 5)); }
__host__ __device__ __forceinline__ void stage_rc(int b, int& R, int& C) { const int st = b / 1024, sb = b % 1024, swz = sb ^ (((sb >> 9) & 1) << 5); R = (st >> 1) * 16 + swz / 64; C = (st & 1) * 32 + (swz % 64) / 2; }
__host__ __device__ __forceinline__ int perm32(int rho) { const int n = rho >> 4, i = rho & 15; return 8 * (i >> 2) + 4 * n + (i & 3); }

struct Unit { int pm, pn; int ko = 0; };
struct Gemm { const bf16_t* A; const bf16_t* Bt; int M, N, K; int ld = 0; };

struct StaticOrder {
    int nM, nN, nwg, G, c;
    __host__ __device__ void init(int M, int N, int G_, int c_) { nM = M / BM; nN = N / BM; nwg = nM * nN; G = G_; c = c_; }
    __host__ __device__ __forceinline__ bool next(int i, Unit& u) const {
        const long L = (long)i * G + c; if (L >= nwg) return false;
        int wgid = (int)L; { const int q = nwg / NXCD, r = nwg % NXCD, xcd = wgid % NXCD, off = wgid / NXCD; wgid = (xcd < r ? xcd * (q + 1) : r * (q + 1) + (xcd - r) * q) + off; }
        const int nig = WGM * nN, gid = wgid / nig, fm = gid * WGM, gsz = (nM - fm) < WGM ? (nM - fm) : WGM;
        u.pm = fm + ((wgid % nig) % gsz); u.pn = (wgid % nig) / gsz; return true;
    }
    __device__ __forceinline__ void a_ready(const Unit&) const {}
    __device__ __forceinline__ void done(const Unit&) const {}
};

__device__ __forceinline__ unsigned cvt_pk_bf16(float lo, float hi) { unsigned r; asm volatile("v_cvt_pk_bf16_f32 %0, %1, %2" : "=v"(r) : "v"(lo), "v"(hi)); return r; }
typedef float f32x2 __attribute__((ext_vector_type(2)));
__device__ __forceinline__ float row_rs16(const float* ssp, int row) {
    const f32x4* sp = (const f32x4*)(ssp + (size_t)row * 16); const f32x4 s0 = sp[0], s1 = sp[1], s2 = sp[2], s3 = sp[3];
    const float s = (((s0[0] + s0[1]) + (s0[2] + s0[3])) + ((s1[0] + s1[1]) + (s1[2] + s1[3]))) + (((s2[0] + s2[1]) + (s2[2] + s2[3])) + ((s3[0] + s3[1]) + (s3[2] + s3[3])));
    return __builtin_amdgcn_rsqf(s * (1.0f / 1024.0f) + 1e-6f);
}
__device__ __forceinline__ void row_rs16x8(float (&r)[8], const float* ssp, int row0, int fr, int fq) {
    f32x4 c[8];
#pragma unroll
    for (int k = 0; k < 8; ++k) c[k] = *(const f32x4*)(ssp + (size_t)(row0 + (k >> 2) * HALF + (k & 3) * 16) * 16 + 4 * fq);
#pragma unroll
    for (int k = 0; k < 8; ++k) { float s = (c[k][0] + c[k][1]) + (c[k][2] + c[k][3]);
        s += __int_as_float(__builtin_amdgcn_ds_bpermute((((fq * 16 + fr) ^ 16) << 2), __float_as_int(s)));
        { const auto rr = __builtin_amdgcn_permlane32_swap(__float_as_uint(s), __float_as_uint(s), false, false); s = __uint_as_float(rr[0]) + __uint_as_float(rr[1]); }
        r[k] = __builtin_amdgcn_rsqf(s * (1.0f / 1024.0f) + 1e-6f); }
}
struct EpiRowScale {
    static constexpr bool PERM = true, AFTER_DRAIN = false;
    bf16_t* O; int ldc; const float* ssp; float cs;
    __device__ __forceinline__ void operator()(const f32x4 (&acc)[2][2][4][2], const Unit& u, int wr, int wc, int fr, int fq) const {
        const int row0 = u.pm * BM + wr * 64 + fr, col0 = u.pn * BM + wc * 32 + 8 * fq;
        float rr8[8];
        if (ssp) row_rs16x8(rr8, ssp, row0, fr, fq); else {
#pragma unroll
            for (int k = 0; k < 8; ++k) rr8[k] = 1.0f; }
#pragma unroll
        for (int ai = 0; ai < 2; ++ai)
#pragma unroll
            for (int m = 0; m < 4; ++m) { const int row = row0 + ai * HALF + m * 16; const float r = rr8[ai * 4 + m] * cs; bf16_t* rowp = O + (size_t)row * ldc + col0;
#pragma unroll
                for (int bj = 0; bj < 2; ++bj) { const f32x4 v0 = acc[ai][bj][m][0] * r, v1 = acc[ai][bj][m][1] * r;
                    u32x4 w; w.x = cvt_pk_bf16(v0[0], v0[1]); w.y = cvt_pk_bf16(v0[2], v0[3]); w.z = cvt_pk_bf16(v1[0], v1[1]); w.w = cvt_pk_bf16(v1[2], v1[3]);
                    *(u32x4*)(rowp + bj * HALF) = w; } }
    }
};
struct EpiInProj {
    static constexpr bool PERM = true, AFTER_DRAIN = false;
    bf16_t* O; const float* ssp; bf16_t* vt;
    __device__ __forceinline__ void operator()(const f32x4 (&acc)[2][2][4][2], const Unit& u, int wr, int wc, int fr, int fq) const {
        const int row0 = u.pm * BM + wr * 64 + fr;
        if (u.pn == 4 || u.pn == 5) {
            const int cv0 = (u.pn - 4) * BM + wc * 32 + 8 * fq; constexpr size_t CS = (size_t)32768 * 512;
#pragma unroll
            for (int ai = 0; ai < 2; ++ai)
#pragma unroll
                for (int m = 0; m < 4; ++m) { const int row = row0 + ai * HALF + m * 16; const float r = row_rs16(ssp, row); const int b = row >> 13, t = row & 8191;
                    const size_t o0 = (size_t)t, o1 = CS + (size_t)(t & 3) * 2048 + (t >> 2), o2 = 2 * CS + (size_t)(t & 15) * 512 + (t >> 4);
#pragma unroll
                    for (int bj = 0; bj < 2; ++bj)
#pragma unroll
                        for (int n = 0; n < 2; ++n) { const f32x4 v = acc[ai][bj][m][n] * r; const unsigned w01 = cvt_pk_bf16(v[0], v[1]), w23 = cvt_pk_bf16(v[2], v[3]);
                            bf16_t* p = vt + (size_t)(b * 512 + cv0 + bj * HALF + 4 * n) * 8192;
                            const bf16_t e0 = (bf16_t)(w01 & 0xffffu), e1 = (bf16_t)(w01 >> 16), e2 = (bf16_t)(w23 & 0xffffu), e3 = (bf16_t)(w23 >> 16);
                            p[o0] = e0; p[o1] = e0; p[o2] = e0; p[8192 + o0] = e1; p[8192 + o1] = e1; p[8192 + o2] = e1;
                            p[2 * 8192 + o0] = e2; p[2 * 8192 + o1] = e2; p[2 * 8192 + o2] = e2; p[3 * 8192 + o0] = e3; p[3 * 8192 + o1] = e3; p[3 * 8192 + o2] = e3; } }
        } else {
            const int col0 = u.pn * BM + wc * 32 + 8 * fq;
#pragma unroll
            for (int ai = 0; ai < 2; ++ai)
#pragma unroll
                for (int m = 0; m < 4; ++m) { const int row = row0 + ai * HALF + m * 16; const float r = row_rs16(ssp, row); bf16_t* rowp = O + (size_t)row * 2560 + col0;
#pragma unroll
                    for (int bj = 0; bj < 2; ++bj) { const f32x4 v0 = acc[ai][bj][m][0] * r, v1 = acc[ai][bj][m][1] * r;
                        u32x4 w; w.x = cvt_pk_bf16(v0[0], v0[1]); w.y = cvt_pk_bf16(v0[2], v0[3]); w.z = cvt_pk_bf16(v1[0], v1[1]); w.w = cvt_pk_bf16(v1[2], v1[3]);
                        *(u32x4*)(rowp + bj * HALF) = w; } }
        }
    }
};
struct EpiKV {
    static constexpr bool PERM = true, AFTER_DRAIN = false;
    bf16_t* kvx; bf16_t* vtx;
    __device__ __forceinline__ void operator()(const f32x4 (&acc)[2][2][4][2], const Unit& u, int wr, int wc, int fr, int fq) const {
        const int row0 = u.pm * BM + wr * 64 + fr, col0 = u.pn * BM + wc * 32 + 8 * fq;
        if ((u.pn & 3) >= 2) {
            const int lx = u.pn >> 2, dv0 = (col0 & 1023) - 512;
#pragma unroll
            for (int ai = 0; ai < 2; ++ai)
#pragma unroll
                for (int m = 0; m < 4; ++m) { const int row = row0 + ai * HALF + m * 16; const int b = row >> 8, key = row & 255;
#pragma unroll
                    for (int bj = 0; bj < 2; ++bj)
#pragma unroll
                        for (int n = 0; n < 2; ++n) { const f32x4 v = acc[ai][bj][m][n]; const unsigned w01 = cvt_pk_bf16(v[0], v[1]), w23 = cvt_pk_bf16(v[2], v[3]);
                            bf16_t* p = vtx + ((size_t)((lx * 4 + b) * 512 + dv0 + bj * HALF + 4 * n)) * 256 + key;
                            p[0] = (bf16_t)(w01 & 0xffffu); p[256] = (bf16_t)(w01 >> 16); p[512] = (bf16_t)(w23 & 0xffffu); p[768] = (bf16_t)(w23 >> 16); } }
        } else {
#pragma unroll
            for (int ai = 0; ai < 2; ++ai)
#pragma unroll
                for (int m = 0; m < 4; ++m) { const int row = row0 + ai * HALF + m * 16; bf16_t* rowp = kvx + (size_t)row * 4096 + col0;
#pragma unroll
                    for (int bj = 0; bj < 2; ++bj) { const f32x4 v0 = acc[ai][bj][m][0], v1 = acc[ai][bj][m][1];
                        u32x4 w; w.x = cvt_pk_bf16(v0[0], v0[1]); w.y = cvt_pk_bf16(v0[2], v0[3]); w.z = cvt_pk_bf16(v1[0], v1[1]); w.w = cvt_pk_bf16(v1[2], v1[3]);
                        *(u32x4*)(rowp + bj * HALF) = w; } }
        }
    }
};
__device__ __forceinline__ float silu_mul(float g, float u) { return g * u * __builtin_amdgcn_rcpf(1.0f + __expf(-g)); }
struct EpiSwiGLU {
    static constexpr bool PERM = true, AFTER_DRAIN = false;
    bf16_t* O; int ldc; const float* ssp; const float* rmul; int pn_mod;
    __device__ __forceinline__ void operator()(const f32x4 (&acc)[2][2][4][2], const Unit& u, int wr, int wc, int fr, int fq) const {
        const int pnl = pn_mod ? (u.pn % pn_mod) : u.pn;
        const int row0 = u.pm * BM + wr * 64 + fr, col0 = pnl * HALF + wc * 32 + 8 * fq;
        float rr8[8];
        if (ssp) row_rs16x8(rr8, ssp, row0, fr, fq); else {
#pragma unroll
            for (int k = 0; k < 8; ++k) rr8[k] = rmul[row0 + (k >> 2) * HALF + (k & 3) * 16]; }
#pragma unroll
        for (int ai = 0; ai < 2; ++ai)
#pragma unroll
            for (int m = 0; m < 4; ++m) { const int row = row0 + ai * HALF + m * 16; const float r = rr8[ai * 4 + m];
                const f32x4 g0 = acc[ai][0][m][0] * r, g1 = acc[ai][0][m][1] * r, u0 = acc[ai][1][m][0] * r, u1 = acc[ai][1][m][1] * r;
                u32x4 w; w.x = cvt_pk_bf16(silu_mul(g0[0], u0[0]), silu_mul(g0[1], u0[1])); w.y = cvt_pk_bf16(silu_mul(g0[2], u0[2]), silu_mul(g0[3], u0[3]));
                w.z = cvt_pk_bf16(silu_mul(g1[0], u1[0]), silu_mul(g1[1], u1[1])); w.w = cvt_pk_bf16(silu_mul(g1[2], u1[2]), silu_mul(g1[3], u1[3]));
                *(u32x4*)(O + (size_t)row * ldc + col0) = w; }
    }
};
__device__ __forceinline__ float sat8(float v) { return __builtin_amdgcn_fmed3f(v, -448.0f, 448.0f); }
__device__ __forceinline__ unsigned pk4_fp8_w(float a, float b, float c, float d) { int r = __builtin_amdgcn_cvt_pk_fp8_f32(a, b, 0, false); r = __builtin_amdgcn_cvt_pk_fp8_f32(c, d, r, true); return (unsigned)r; }
__device__ __forceinline__ unsigned pk4_fp8(float a, float b, float c, float d) { int r = __builtin_amdgcn_cvt_pk_fp8_f32(sat8(a), sat8(b), 0, false); r = __builtin_amdgcn_cvt_pk_fp8_f32(sat8(c), sat8(d), r, true); return (unsigned)r; }
struct EpiSwiGLU8 {
    static constexpr bool PERM = true, AFTER_DRAIN = false;
    unsigned char* O; int ldc; const float* rmul; int pn_mod; float cs, hs; const float* ssp;
    __device__ __forceinline__ void operator()(const f32x4 (&acc)[2][2][4][2], const Unit& u, int wr, int wc, int fr, int fq) const {
        const int pnl = pn_mod ? (u.pn % pn_mod) : u.pn;
        const int row0 = u.pm * BM + wr * 64 + fr, col0 = pnl * HALF + wc * 32 + 8 * fq;
        float rr8[8];
        if (ssp) row_rs16x8(rr8, ssp, row0, fr, fq); else {
#pragma unroll
            for (int k = 0; k < 8; ++k) rr8[k] = rmul[row0 + (k >> 2) * HALF + (k & 3) * 16]; }
#pragma unroll
        for (int ai = 0; ai < 2; ++ai)
#pragma unroll
            for (int m = 0; m < 4; ++m) { const int row = row0 + ai * HALF + m * 16; const float r = rr8[ai * 4 + m] * cs, r2 = r * -1.4426950408889634f, rrh = r * r * hs;
                unsigned w[2];
#pragma unroll
                for (int n = 0; n < 2; ++n) { const f32x4 ag = acc[ai][0][m][n], au = acc[ai][1][m][n]; const f32x4 t = ag * r2;
                    f32x4 d; d[0] = __builtin_amdgcn_exp2f(t[0]); d[1] = __builtin_amdgcn_exp2f(t[1]); d[2] = __builtin_amdgcn_exp2f(t[2]); d[3] = __builtin_amdgcn_exp2f(t[3]);
                    d = d + 1.0f;
                    f32x4 iv; iv[0] = __builtin_amdgcn_rcpf(d[0]); iv[1] = __builtin_amdgcn_rcpf(d[1]); iv[2] = __builtin_amdgcn_rcpf(d[2]); iv[3] = __builtin_amdgcn_rcpf(d[3]);
                    const f32x4 hv = ((ag * au) * rrh) * iv;
                    w[n] = pk4_fp8(hv[0], hv[1], hv[2], hv[3]); }
                typedef unsigned u32x2_t __attribute__((ext_vector_type(2)));
                *(u32x2_t*)(O + (size_t)row * ldc + col0) = (u32x2_t){w[0], w[1]}; }
    }
};
struct EpiResid {
    static constexpr bool PERM = true, AFTER_DRAIN = false;
    const float* base32; bf16_t* xb; float* ssp_out; unsigned char* xb8; float cs; int w8;
    __device__ __forceinline__ void operator()(const f32x4 (&acc)[2][2][4][2], const Unit& u, int wr, int wc, int fr, int fq) const {
        const int row0 = u.pm * BM + wr * 64 + fr, col0 = u.pn * BM + wc * 32 + 8 * fq;
        u32x4 xw[2][4][2];
        if (!base32) {
#pragma unroll
            for (int ai = 0; ai < 2; ++ai)
#pragma unroll
                for (int m = 0; m < 4; ++m)
#pragma unroll
                    for (int bj = 0; bj < 2; ++bj) xw[ai][m][bj] = *(const u32x4*)(xb + (size_t)(row0 + ai * HALF + m * 16) * 1024 + col0 + bj * HALF);
        }
#pragma unroll
        for (int ai = 0; ai < 2; ++ai)
#pragma unroll
            for (int m = 0; m < 4; ++m) { const int row = row0 + ai * HALF + m * 16; const size_t off = (size_t)row * 1024 + col0; float q = 0.f;
#pragma unroll
                for (int bj = 0; bj < 2; ++bj) { f32x4 b0, b1;
                    if (base32) { b0 = *(const f32x4*)(base32 + off + bj * HALF); b1 = *(const f32x4*)(base32 + off + bj * HALF + 4); }
                    else { const u32x4 w4 = xw[ai][m][bj];
                        b0 = (f32x4){__uint_as_float(w4.x << 16), __uint_as_float(w4.x & 0xffff0000u), __uint_as_float(w4.y << 16), __uint_as_float(w4.y & 0xffff0000u)};
                        b1 = (f32x4){__uint_as_float(w4.z << 16), __uint_as_float(w4.z & 0xffff0000u), __uint_as_float(w4.w << 16), __uint_as_float(w4.w & 0xffff0000u)}; }
                    const f32x4 v0 = b0 + acc[ai][bj][m][0] * cs, v1 = b1 + acc[ai][bj][m][1] * cs;
                    u32x4 w; w.x = cvt_pk_bf16(v0[0], v0[1]); w.y = cvt_pk_bf16(v0[2], v0[3]); w.z = cvt_pk_bf16(v1[0], v1[1]); w.w = cvt_pk_bf16(v1[2], v1[3]);
                    *(u32x4*)(xb + off + bj * HALF) = w;
                    if (w8) { typedef unsigned u32x2_t __attribute__((ext_vector_type(2))); *(u32x2_t*)(xb8 + off + bj * HALF) = (u32x2_t){pk4_fp8(v0[0], v0[1], v0[2], v0[3]), pk4_fp8(v1[0], v1[1], v1[2], v1[3])}; }
                    q += ((v0[0] * v0[0] + v0[1] * v0[1]) + (v0[2] * v0[2] + v0[3] * v0[3])) + ((v1[0] * v1[0] + v1[1] * v1[1]) + (v1[2] * v1[2] + v1[3] * v1[3])); }
                q += __int_as_float(__builtin_amdgcn_ds_bpermute((((fq * 16 + fr) ^ 16) << 2), __float_as_int(q)));
                { const auto rr = __builtin_amdgcn_permlane32_swap(__float_as_uint(q), __float_as_uint(q), false, false); q = __uint_as_float(rr[0]) + __uint_as_float(rr[1]); }
                if (fq == 0) ssp_out[(size_t)row * 16 + u.pn * 4 + wc] = q;
                if (base32 && (m & 1)) asm volatile("" ::: "memory"); }
    }
};
struct EpiMoeOut {
    static constexpr bool PERM = true, AFTER_DRAIN = false;
    bf16_t* Y; const float* gate; float cs = 1.0f;
    __device__ __forceinline__ void operator()(const f32x4 (&acc)[2][2][4][2], const Unit& u, int wr, int wc, int fr, int fq) const {
        const int row0 = u.pm * BM + wr * 64 + fr, col0 = (u.pn & 3) * BM + wc * 32 + 8 * fq;
#pragma unroll
        for (int ai = 0; ai < 2; ++ai)
#pragma unroll
            for (int m = 0; m < 4; ++m) { const int row = row0 + ai * HALF + m * 16; const float gt = gate[row] * cs; bf16_t* rowp = Y + (size_t)row * 1024 + col0;
#pragma unroll
                for (int bj = 0; bj < 2; ++bj) { const f32x4 v0 = acc[ai][bj][m][0] * gt, v1 = acc[ai][bj][m][1] * gt;
                    u32x4 w; w.x = cvt_pk_bf16(v0[0], v0[1]); w.y = cvt_pk_bf16(v0[2], v0[3]); w.z = cvt_pk_bf16(v1[0], v1[1]); w.w = cvt_pk_bf16(v1[2], v1[3]);
                    *(u32x4*)(rowp + bj * HALF) = w; } }
    }
};
struct EpiNull {
    static constexpr bool PERM = true, AFTER_DRAIN = false;
    float* sink;
    __device__ __forceinline__ void operator()(const f32x4 (&acc)[2][2][4][2], const Unit& u, int wr, int wc, int fr, int fq) const {
        float s = 0.f;
#pragma unroll
        for (int ai = 0; ai < 2; ++ai)
#pragma unroll
            for (int bj = 0; bj < 2; ++bj)
#pragma unroll
                for (int m = 0; m < 4; ++m)
#pragma unroll
                    for (int n = 0; n < 2; ++n) s += (acc[ai][bj][m][n][0] + acc[ai][bj][m][n][1]) + (acc[ai][bj][m][n][2] + acc[ai][bj][m][n][3]);
        if (s == 12345.6789f) sink[u.pm * 4 + wr] = s;
    }
};
struct EpiMoePart {
    static constexpr bool PERM = true, AFTER_DRAIN = false;
    bf16_t* P; const float* gate; float cs = 1.0f; int kshift = 10;
    __device__ __forceinline__ void operator()(const f32x4 (&acc)[2][2][4][2], const Unit& u, int wr, int wc, int fr, int fq) const {
        const int row0 = u.pm * BM + wr * 64 + fr, col0 = (u.pn & 3) * BM + wc * 32 + 8 * fq; bf16_t* base = P + (size_t)(u.ko >> kshift) * (2048 * 1024);
#pragma unroll
        for (int ai = 0; ai < 2; ++ai)
#pragma unroll
            for (int m = 0; m < 4; ++m) { const int row = row0 + ai * HALF + m * 16; const float gt = gate[row] * cs; bf16_t* rowp = base + (size_t)(row - 65536) * 1024 + col0;
#pragma unroll
                for (int bj = 0; bj < 2; ++bj) { const f32x4 v0 = acc[ai][bj][m][0] * gt, v1 = acc[ai][bj][m][1] * gt;
                    u32x4 w; w.x = cvt_pk_bf16(v0[0], v0[1]); w.y = cvt_pk_bf16(v0[2], v0[3]); w.z = cvt_pk_bf16(v1[0], v1[1]); w.w = cvt_pk_bf16(v1[2], v1[3]);
                    *(u32x4*)(rowp + bj * HALF) = w; } }
    }
};
struct MoeTailOrder {
    int npieces, G, c; int te[8]; int kstep = 1024;
    __device__ __forceinline__ bool next(int i, Unit& u) const {
        const int p = i * G + c; if (p >= npieces) return false;
        const int tt = p / 7, kp = p - tt * 7; const int pm = 256 + (tt >> 2);
        int e = 0;
#pragma unroll
        for (int k = 0; k < 7; ++k) e += (pm >= te[k]) ? 1 : 0;
        u.pm = pm; u.pn = e * 4 + (tt & 3); u.ko = kp * kstep; return true;
    }
    __device__ __forceinline__ void a_ready(const Unit&) const {}
    __device__ __forceinline__ void done(const Unit&) const {}
};
struct TeamOrder {
    int pm, pn0, npn;
    __device__ __forceinline__ bool next(int i, Unit& u) const { if (i >= npn) return false; u.pm = pm; u.pn = pn0 + i; return true; }
    __device__ __forceinline__ void a_ready(const Unit&) const {}
    __device__ __forceinline__ void done(const Unit&) const {}
};
struct MoeOrder {
    StaticOrder so; int nNl; int te[8];
    __device__ __forceinline__ bool next(int i, Unit& u) const {
        if (!so.next(i, u)) return false;
        int e = 0;
#pragma unroll
        for (int k = 0; k < 7; ++k) e += (u.pm >= te[k]) ? 1 : 0;
        u.pn += e * nNl; return true;
    }
    __device__ __forceinline__ void a_ready(const Unit&) const {}
    __device__ __forceinline__ void done(const Unit&) const {}
};

template <class Epi, class Sched, bool ALIGN_EPI = false, bool SP2 = false, bool F8 = false>
__device__ __forceinline__ void gemm_phase(PG8_LAS unsigned char* lds, const Gemm g, const Sched& S, const Epi& E, const int tid) {
    const int wid = __builtin_amdgcn_readfirstlane(tid >> 6), lane = tid & 63, wr = wid >> 2, wc = wid & 3, fr = lane & 15, fq = lane >> 4;
    const int K = g.K, nt = K / BK, LD = g.ld ? g.ld : K;
    unsigned voffA[2], voffB[2];
#pragma unroll
    for (int i = 0; i < 2; ++i) { int R, C; stage_rc(tid * 16 + i * 8192, R, C); const int Rb = Epi::PERM ? ((R & ~31) + perm32(R & 31)) : R;
        voffA[i] = (unsigned)(R * LD + C) * 2u; voffB[i] = (unsigned)(Rb * LD + C) * 2u; }
    const size_t kstep = (size_t)(BK * 2);
    const size_t hstep = (size_t)HALF * LD * 2;
    const size_t tstep = 2 * hstep;
    const unsigned ldsw = (unsigned)wid * 1024u;
    const int aoff = lds_byte(wr * 64 + fr, fq * 8), boff = lds_byte(wc * 32 + fr, fq * 8);
#define PG8_SA(b, h) (((b) * 2 + (h)) * HTB)
#define PG8_SB(b, h) ((4 + (b) * 2 + (h)) * HTB)
#define PG8_STAGE(bufoff, gbase, voff) do { _Pragma("unroll") for (int _i = 0; _i < 2; ++_i) \
        __builtin_amdgcn_global_load_lds((const unsigned*)((const char*)(gbase) + (voff)[_i]), (PG8_LAS unsigned*)(lds + (bufoff) + ldsw + _i * 8192), 16, 0, 0); } while (0)
#define PG8_CAT8(x, y) __builtin_shufflevector(__builtin_bit_cast(v4i_t, x), __builtin_bit_cast(v4i_t, y), 0, 1, 2, 3, 4, 5, 6, 7)
#define PG8_LDA(dst, b, h) do { _Pragma("unroll") for (int m = 0; m < 4; ++m) { if constexpr (F8) dst##8[m] = PG8_CAT8(*(const PG8_LAS bf16x8*)(lds + PG8_SA(b, h) + aoff + m * 2048), *(const PG8_LAS bf16x8*)(lds + PG8_SA(b, h) + aoff + m * 2048 + 1024)); \
        else { _Pragma("unroll") for (int k = 0; k < 2; ++k) dst[m][k] = *(const PG8_LAS bf16x8*)(lds + PG8_SA(b, h) + aoff + m * 2048 + k * 1024); } } } while (0)
#define PG8_LDB(dst, b, h) do { _Pragma("unroll") for (int n = 0; n < 2; ++n) { if constexpr (F8) dst##8[n] = PG8_CAT8(*(const PG8_LAS bf16x8*)(lds + PG8_SB(b, h) + boff + n * 2048), *(const PG8_LAS bf16x8*)(lds + PG8_SB(b, h) + boff + n * 2048 + 1024)); \
        else { _Pragma("unroll") for (int k = 0; k < 2; ++k) dst[n][k] = *(const PG8_LAS bf16x8*)(lds + PG8_SB(b, h) + boff + n * 2048 + k * 1024); } } } while (0)
#define PG8_MMA(ai, bj, At, Bt) do { __builtin_amdgcn_s_setprio(1); _Pragma("unroll") for (int m = 0; m < 4; ++m) _Pragma("unroll") for (int n = 0; n < 2; ++n) { \
        if constexpr (F8) asm volatile("v_mfma_scale_f32_16x16x128_f8f6f4 %0, %1, %2, %0, %3, %3 op_sel_hi:[0,0,0]" : "+v"(acc[ai][bj][m][n]) : "v"(Bt##8[n]), "v"(At##8[m]), "v"(f8scale)); \
        else { _Pragma("unroll") for (int k = 0; k < 2; ++k) acc[ai][bj][m][n] = __builtin_amdgcn_mfma_f32_16x16x32_bf16(Bt[n][k], At[m][k], acc[ai][bj][m][n], 0, 0, 0); } } __builtin_amdgcn_s_setprio(0); } while (0)
#define PG8_WAIT_V(n) asm volatile("s_waitcnt vmcnt(" #n ")" ::: "memory")
#define PG8_WAIT_L(n) asm volatile("s_waitcnt lgkmcnt(" #n ")" ::: "memory")
#define PG8_BAR __builtin_amdgcn_s_barrier()
#define PG8_SCHED __builtin_amdgcn_sched_barrier(0)
    Unit cur, nxt; int ui = 0;
    if (!S.next(0, cur)) return;
    f32x4 acc[2][2][4][2];
#pragma unroll
    for (int a = 0; a < 2; ++a)
#pragma unroll
        for (int b = 0; b < 2; ++b)
#pragma unroll
            for (int m = 0; m < 4; ++m)
#pragma unroll
                for (int n = 0; n < 2; ++n) acc[a][b][m][n] = (f32x4){0.f, 0.f, 0.f, 0.f};
    const int f8scale = 0x7f7f7f7f;
    bf16x8 At[4][2], B0[2][2], B1[2][2]; v8i_t At8[4], B08[2], B18[2];
    const char* cA = (const char*)g.A + (size_t)cur.pm * tstep + cur.ko; const char* cB = (const char*)g.Bt + (size_t)cur.pn * tstep + cur.ko;
    S.a_ready(cur);
    if constexpr (SP2) {
        PG8_STAGE(PG8_SB(0, 0), cB, voffB); PG8_STAGE(PG8_SB(0, 1), cB + hstep, voffB); PG8_STAGE(PG8_SA(0, 0), cA, voffA); PG8_STAGE(PG8_SA(0, 1), cA + hstep, voffA);
        if (wr == 1) PG8_BAR;
        PG8_WAIT_V(2); PG8_BAR;
        PG8_STAGE(PG8_SB(1, 0), cB + kstep, voffB); PG8_STAGE(PG8_SA(1, 0), cA + kstep, voffA); PG8_STAGE(PG8_SB(1, 1), cB + hstep + kstep, voffB);
        PG8_WAIT_V(6); PG8_BAR;
    } else {
        PG8_STAGE(PG8_SB(0, 0), cB, voffB); PG8_STAGE(PG8_SA(0, 0), cA, voffA); PG8_STAGE(PG8_SB(0, 1), cB + hstep, voffB); PG8_STAGE(PG8_SA(0, 1), cA + hstep, voffA);
        if (wr == 1) PG8_BAR;
        PG8_WAIT_V(4); PG8_BAR;
        PG8_STAGE(PG8_SB(1, 0), cB + kstep, voffB); PG8_STAGE(PG8_SA(1, 0), cA + kstep, voffA); PG8_STAGE(PG8_SB(1, 1), cB + hstep + kstep, voffB);
        PG8_WAIT_V(6); PG8_BAR;
    }
    for (;;) {
        const bool has_next = S.next(ui + 1, nxt);
        const char* nA = has_next ? (const char*)g.A + (size_t)nxt.pm * tstep + nxt.ko : cA; const char* nB = has_next ? (const char*)g.Bt + (size_t)nxt.pn * tstep + nxt.ko : cB;
        for (int t = 0; t < nt; t += 2) {
            const bool last = (t == nt - 2);
            const char* a1 = cA + (size_t)(t + 1) * kstep;
            const char* a2 = last ? nA : cA + (size_t)(t + 2) * kstep; const char* b2 = last ? nB : cB + (size_t)(t + 2) * kstep;
            const char* a3 = a2 + kstep; const char* b3 = b2 + kstep;
            if (last && has_next) S.a_ready(nxt);
            if constexpr (SP2) {
            PG8_LDB(B0, 0, 0); PG8_LDB(B1, 0, 1); PG8_SCHED; PG8_LDA(At, 0, 0); PG8_STAGE(PG8_SA(1, 1), a1 + hstep, voffA);
            PG8_WAIT_V(8); PG8_WAIT_L(0); PG8_BAR; PG8_MMA(0, 0, At, B0); PG8_MMA(0, 1, At, B1); PG8_BAR; PG8_SCHED;
            PG8_LDA(At, 0, 1); PG8_STAGE(PG8_SB(0, 0), b2, voffB); PG8_STAGE(PG8_SB(0, 1), b2 + hstep, voffB); PG8_STAGE(PG8_SA(0, 0), a2, voffA);
            PG8_WAIT_V(8); PG8_WAIT_L(0); PG8_BAR; PG8_MMA(1, 0, At, B0); PG8_MMA(1, 1, At, B1); PG8_BAR; PG8_SCHED;
            PG8_LDB(B0, 1, 0); PG8_LDB(B1, 1, 1); PG8_SCHED; PG8_LDA(At, 1, 0); PG8_STAGE(PG8_SA(0, 1), a2 + hstep, voffA);
            PG8_WAIT_V(8); PG8_WAIT_L(0); PG8_BAR; PG8_MMA(0, 0, At, B0); PG8_MMA(0, 1, At, B1); PG8_BAR; PG8_SCHED;
            PG8_LDA(At, 1, 1); PG8_STAGE(PG8_SB(1, 0), b3, voffB); PG8_STAGE(PG8_SB(1, 1), b3 + hstep, voffB); PG8_STAGE(PG8_SA(1, 0), a3, voffA);
            PG8_WAIT_V(8); PG8_WAIT_L(0); PG8_BAR; PG8_MMA(1, 0, At, B0); PG8_MMA(1, 1, At, B1); PG8_BAR; PG8_SCHED;
            } else {
            PG8_LDB(B0, 0, 0); PG8_SCHED; PG8_LDA(At, 0, 0); PG8_STAGE(PG8_SA(1, 1), a1 + hstep, voffA);
            PG8_WAIT_L(8); PG8_BAR; PG8_WAIT_L(0); PG8_MMA(0, 0, At, B0); PG8_BAR; PG8_SCHED;
            PG8_LDB(B1, 0, 1); PG8_STAGE(PG8_SB(0, 0), b2, voffB);
            PG8_BAR; PG8_WAIT_L(0); PG8_MMA(0, 1, At, B1); PG8_BAR;
            PG8_LDA(At, 0, 1); PG8_STAGE(PG8_SA(0, 0), a2, voffA);
            PG8_BAR; PG8_WAIT_L(0); PG8_MMA(1, 0, At, B0); PG8_BAR; PG8_SCHED;
            PG8_STAGE(PG8_SB(0, 1), b2 + hstep, voffB);
            PG8_WAIT_V(6); PG8_BAR; PG8_MMA(1, 1, At, B1); PG8_BAR;
            PG8_LDB(B0, 1, 0); PG8_SCHED; PG8_LDA(At, 1, 0); PG8_STAGE(PG8_SA(0, 1), a2 + hstep, voffA);
            PG8_WAIT_L(8); PG8_BAR; PG8_WAIT_L(0); PG8_MMA(0, 0, At, B0); PG8_BAR; PG8_SCHED;
            PG8_LDB(B1, 1, 1); PG8_STAGE(PG8_SB(1, 0), b3, voffB);
            PG8_BAR; PG8_WAIT_L(0); PG8_MMA(0, 1, At, B1); PG8_BAR;
            PG8_LDA(At, 1, 1); PG8_STAGE(PG8_SA(1, 0), a3, voffA);
            PG8_BAR; PG8_WAIT_L(0); PG8_MMA(1, 0, At, B0); PG8_BAR; PG8_SCHED;
            PG8_STAGE(PG8_SB(1, 1), b3 + hstep, voffB);
            PG8_WAIT_V(6); PG8_BAR; PG8_MMA(1, 1, At, B1); PG8_BAR;
            }
        }
        if constexpr (ALIGN_EPI) { if (wr == 0) PG8_BAR; }
        if constexpr (F8) asm volatile("s_nop 15\n\ts_nop 15" ::: "memory");
        if constexpr (!Epi::AFTER_DRAIN) { int fr_ = fr, fq_ = fq; asm volatile("" : "+v"(fr_), "+v"(fq_)); E(acc, cur, wr, wc, fr_, fq_); S.done(cur); }
        if (!has_next) break;
#pragma unroll
        for (int a = 0; a < 2; ++a)
#pragma unroll
            for (int b = 0; b < 2; ++b)
#pragma unroll
                for (int m = 0; m < 4; ++m)
#pragma unroll
                    for (int n = 0; n < 2; ++n) acc[a][b][m][n] = (f32x4){0.f, 0.f, 0.f, 0.f};
        cur = nxt; cA = nA; cB = nB; ++ui;
        if constexpr (ALIGN_EPI) { if (wr == 1) PG8_BAR; }
    }
    PG8_WAIT_V(0);
    if constexpr (!ALIGN_EPI) { if (wr == 0) PG8_BAR; }
    PG8_BAR;
    if constexpr (Epi::AFTER_DRAIN) { E.fused(acc, cur, wr, wc, fr, fq, lds, wid, lane); S.done(cur); }
#undef PG8_SA
#undef PG8_SB
#undef PG8_STAGE
#undef PG8_LDA
#undef PG8_LDB
#undef PG8_MMA
#undef PG8_CAT8
#undef PG8_WAIT_V
#undef PG8_WAIT_L
#undef PG8_BAR
#undef PG8_SCHED
}
}
#define GAS __attribute__((address_space(1)))
#define LAS __attribute__((address_space(3)))
typedef unsigned short bf16;
typedef unsigned v4u __attribute__((ext_vector_type(4)));
typedef float f32x4 __attribute__((ext_vector_type(4)));
typedef short bf16x8 __attribute__((ext_vector_type(8)));
typedef GAS unsigned gu32;
typedef GAS unsigned long long gu64;
#define RLX_AGENT __ATOMIC_RELAXED, __HIP_MEMORY_SCOPE_AGENT
#define LDS_WAIT() asm volatile("s_waitcnt lgkmcnt(0)" ::: "memory")
#define VM_WAIT() asm volatile("s_waitcnt vmcnt(0)" ::: "memory")
__device__ __forceinline__ unsigned long long rt() { return __builtin_amdgcn_s_memrealtime(); }
__device__ __forceinline__ unsigned f2bf(float f) { unsigned u = __builtin_bit_cast(unsigned, f); return (u + 0x7fffu + ((u >> 16) & 1u)) >> 16; }
__device__ __forceinline__ unsigned pk2(float lo, float hi) { return f2bf(lo) | (f2bf(hi) << 16); }
#define XB_TMO      128
#define XB_XCNT(j)  (256  + 64 * (j))
#define XB_XSUB(j)  (1280 + 64 * (j))
#define XB_XGEN(j)  (2304 + 64 * (j))
#define XB_TOP      3328
#define XB_TOPGEN   3392
#define XCD_BAR_WORDS 3456
#define XB_SPIN_CAP (1u << 18)

__device__ __forceinline__ unsigned xb_ld(unsigned* p)              { return __hip_atomic_load(p, __ATOMIC_RELAXED, __HIP_MEMORY_SCOPE_AGENT); }
__device__ __forceinline__ unsigned xb_add(unsigned* p, unsigned v) { return __hip_atomic_fetch_add(p, v, __ATOMIC_RELAXED, __HIP_MEMORY_SCOPE_AGENT); }
__device__ __forceinline__ unsigned xb_xcc_id() { return (unsigned)__builtin_amdgcn_s_getreg((3 << 11) | 20) & 0xFu; }
#define XB_SPIN(cond, bar) do { unsigned _sp = 0; while (cond) { __builtin_amdgcn_s_sleep(1); \
    if ((++_sp & 255u) == 0u) { if (xb_ld(&(bar)[XB_TMO])) break; if (_sp > XB_SPIN_CAP) { atomicAdd(&(bar)[XB_TMO], 1u); break; } } } } while (0)

struct XcdBarrier {
    unsigned* bar; unsigned x;
    volatile LAS unsigned* st;
};

__device__ __forceinline__ XcdBarrier xcd_barrier_post(unsigned* bar, volatile LAS unsigned* st) {
    XcdBarrier b; b.bar = bar; b.x = xb_xcc_id(); b.st = st;
    if (threadIdx.x == 0) (void)xb_add(&bar[XB_XCNT(b.x)], 1u);
    return b;
}
__device__ __forceinline__ void xcd_barrier_complete(unsigned* bar, unsigned x, unsigned& nloc, unsigned& nx) {
    const unsigned G = gridDim.x * gridDim.y * gridDim.z;
    unsigned sum, cnt, mine, sp = 0u;
    for (;;) {
        sum = 0u; cnt = 0u; mine = 0u;
#pragma unroll
        for (unsigned j = 0; j < 16; ++j) { const unsigned c = xb_ld(&bar[XB_XCNT(j)]); sum += c; cnt += (c > 0u) ? 1u : 0u; mine = (j == x) ? c : mine; }
        if (sum == G) break;
        __builtin_amdgcn_s_sleep(1);
        if ((++sp & 255u) == 0u) { if (xb_ld(&bar[XB_TMO])) break; if (sp > XB_SPIN_CAP) { atomicAdd(&bar[XB_TMO], 1u); break; } }
    }
    nloc = mine > 0u ? mine : 1u; nx = cnt > 0u ? cnt : 1u;
}

__device__ __forceinline__ void xcd_barrier(const XcdBarrier& b) {
    asm volatile("s_waitcnt vmcnt(0)" ::: "memory");
    __syncthreads();
    if (threadIdx.x == 0) {
        unsigned* bar = b.bar;
        __builtin_amdgcn_s_waitcnt(0);
        unsigned nloc = b.st[0], nx = b.st[1];
        if (nloc == 0u) { xcd_barrier_complete(bar, b.x, nloc, nx); b.st[0] = nloc; b.st[1] = nx; }
        const unsigned old = xb_add(&bar[XB_XSUB(b.x)], 1u);
        const unsigned gen = old / nloc;
        if (old + 1u == (gen + 1u) * nloc) {
            __builtin_amdgcn_fence(__ATOMIC_RELEASE, "agent");
            asm volatile("s_waitcnt vmcnt(0)" ::: "memory");
            const unsigned og = xb_add(&bar[XB_TOP], 1u);
            const unsigned tg = og / nx;
            if (og + 1u == (tg + 1u) * nx) xb_add(&bar[XB_TOPGEN], 1u);
            else XB_SPIN(xb_ld(&bar[XB_TOPGEN]) == tg, bar);
            __builtin_amdgcn_fence(__ATOMIC_ACQUIRE, "agent");
            xb_add(&bar[XB_XGEN(b.x)], 1u);
            asm volatile("s_waitcnt vmcnt(0)" ::: "memory");
        } else {
            XB_SPIN(xb_ld(&bar[XB_XGEN(b.x)]) == gen, bar);
            __builtin_amdgcn_fence(__ATOMIC_ACQUIRE, "agent");
            asm volatile("s_waitcnt vmcnt(0)" ::: "memory");
        }
    }
    __syncthreads();
}
constexpr int NWAVES = 8;
constexpr int BATCH = 4, SEQ = 8192, D = 1024, T = BATCH * SEQ, DEPTH = 4, MEML = 256, MROWS = BATCH * MEML;
constexpr int NPROJ = 2560, FFD = 2816, FFE = 3584, NEXP = 8, XW = 512;
constexpr int MP = 2 * T + NEXP * 256;
constexpr float F8_S1 = 16.0f, F8_S2 = 32.0f, F8_SH = 4.0f;
constexpr int NKEYS = 321;
constexpr int NPH = 1 + 8 + 11 + 8 + 11;
constexpr int PC_Q = 0, PC_K = 512, PC_V = 1024, PC_POOL = 1536, PC_BG = 1792, PC_CG = 2048, PC_HC = 2304;
constexpr size_t MiB = 1u << 20;
constexpr size_t WS_CTL = 0, CTL_ZERO_BYTES = 64 * 1024;
constexpr size_t WS_PWT = 256 * 1024;
constexpr size_t WS_CNT = 1 * MiB, WS_META = 1 * MiB + 64 * 1024;
constexpr size_t WS_TOKE = 1 * MiB + 512 * 1024, WS_TOKG = 2 * MiB, WS_TOKPOS = 2 * MiB + 512 * 1024, WS_ROWGATE = 3 * MiB, WS_ROWRS = 3 * MiB + 512 * 1024;
constexpr size_t WS_SSP = 4 * MiB;
constexpr size_t WS_KVX = 30 * MiB, WS_MEMN = 38 * MiB;
constexpr size_t WS_WIN = 40 * MiB, WS_WOUT = 60 * MiB, WS_WQ = 68 * MiB, WS_WKV = 72 * MiB, WS_WO = 80 * MiB, WS_W13D = 84 * MiB, WS_W2D = 106 * MiB, WS_W13M = 117 * MiB, WS_W2M = 341 * MiB;
constexpr size_t WS_XB = 453 * MiB, WS_QX = 517 * MiB, WS_OX = 549 * MiB, WS_AG = 581 * MiB, WS_YM = 713 * MiB, WS_RA = 977 * MiB, WS_VTX = 1439 * MiB, WS_END = 1443 * MiB;
constexpr size_t WS_PROJ = WS_RA, WS_Y = WS_RA + 160 * MiB, WS_H = WS_RA, WS_VT = WS_RA + 224 * MiB, WS_OPART = WS_RA + 320 * MiB, WS_LSE = WS_RA + 416 * MiB;
constexpr size_t VT_STRIDE = (size_t)T * 512, OP_STRIDE = (size_t)T * 512;
static_assert(WS_AG + (size_t)MP * D * 2 <= WS_YM && WS_YM + (size_t)MP * D * 4 <= WS_RA && WS_RA + (size_t)MP * FFE * 2 <= WS_VTX, "ws map");
constexpr int CW_BAR = 4096, CW_TEAM = 8192;
constexpr size_t WS_XCCTAB = 128 * 1024;
constexpr int RING_BYTES = 131072, LDSCTL_OFF = 159744, MISC_OFF = LDSCTL_OFF + 320, LDS_BYTES = 163840;

__device__ __forceinline__ float shx(float v, int mask, int lane) { return __int_as_float(__builtin_amdgcn_ds_bpermute((lane ^ mask) << 2, __float_as_int(v))); }
__device__ __forceinline__ float xsum32(float v) { const auto rr = __builtin_amdgcn_permlane32_swap(__float_as_uint(v), __float_as_uint(v), false, false); return __uint_as_float(rr[0]) + __uint_as_float(rr[1]); }
__device__ __forceinline__ float xmax32(float v) { const auto rr = __builtin_amdgcn_permlane32_swap(__float_as_uint(v), __float_as_uint(v), false, false); return fmaxf(__uint_as_float(rr[0]), __uint_as_float(rr[1])); }
__device__ __forceinline__ float wave_sum(float v, int lane) {
#pragma unroll
    for (int o = 1; o < 32; o <<= 1) v += shx(v, o, lane);
    return xsum32(v);
}
__device__ __forceinline__ float bflo(unsigned u) { return __uint_as_float(u << 16); }
__device__ __forceinline__ float bfhi(unsigned u) { return __uint_as_float(u & 0xffff0000u); }
__device__ __forceinline__ float bf1(bf16 h) { return __uint_as_float(((unsigned)h) << 16); }
__device__ __forceinline__ float dot8(v4u a, v4u b) {
    return (bflo(a.x) * bflo(b.x) + bfhi(a.x) * bfhi(b.x)) + (bflo(a.y) * bflo(b.y) + bfhi(a.y) * bfhi(b.y)) + (bflo(a.z) * bflo(b.z) + bfhi(a.z) * bfhi(b.z)) + (bflo(a.w) * bflo(b.w) + bfhi(a.w) * bfhi(b.w));
}
__device__ __forceinline__ int key_dist(int i) { return i < 129 ? i : (i < 225 ? 132 + 4 * (i - 129) : 528 + 16 * (i - 225)); }
__device__ __forceinline__ int key_mult(int d) { return d <= 128 ? 1 + ((d & 3) == 0 ? 1 : 0) + ((d & 15) == 0 ? 1 : 0) : (d <= 512 ? 1 + ((d & 15) == 0 ? 1 : 0) : 1); }
__device__ __forceinline__ int t5_bucket(int d) {
    if (d < 16) return d;
    int b = 16 + (int)(logf((float)d / 16.0f) / logf(8.0f) * 16.0f);
    return b < 31 ? b : 31;
}

struct Args { const float* in[21]; float* out; unsigned char* ws; int ph_lo, ph_hi; };

__device__ __forceinline__ void conv_item(const float* W, int K, int N, bf16* WT, const float* gain, int swF, LAS float* scr, int item, int lane) {
    const int nblk = N / 64, kb = item / nblk, nb = item % nblk, k0 = 64 * kb, n0 = 64 * nb;
    float wv[64];
#pragma unroll
    for (int i = 0; i < 64; ++i) wv[i] = W[(size_t)(k0 + i) * N + n0 + lane];
    if (gain) {
#pragma unroll
        for (int i = 0; i < 64; ++i) wv[i] *= gain[k0 + i]; }
#pragma unroll
    for (int i = 0; i < 64; ++i) scr[i * 65 + lane] = wv[i];
    LDS_WAIT(); asm volatile("" ::: "memory");
    int orow0 = n0;
    if (swF) { const int isup = n0 >= swF ? 1 : 0; const int j = n0 - isup * swF; orow0 = (j >> 7) * 256 + isup * 128 + (j & 127); }
    const int c = lane & 7;
#pragma unroll
    for (int j = 0; j < 8; ++j) { const int n = (lane >> 3) + 8 * j; const LAS float* s = scr + (8 * c) * 65 + n;
        v4u o; o.x = pk2(s[0 * 65], s[1 * 65]); o.y = pk2(s[2 * 65], s[3 * 65]); o.z = pk2(s[4 * 65], s[5 * 65]); o.w = pk2(s[6 * 65], s[7 * 65]);
        *(GAS v4u*)(WT + (size_t)(orow0 + n) * K + k0 + 8 * c) = o; }
    LDS_WAIT(); asm volatile("" ::: "memory");
}

typedef unsigned u32x2 __attribute__((ext_vector_type(2)));
__device__ __forceinline__ void conv_item8(const float* W, int K, int N, unsigned char* WT, const float* gain, int swF, float scale, LAS float* scr, int item, int lane) {
    const int nblk = N / 64, kb = item / nblk, nb = item % nblk, k0 = 64 * kb, n0 = 64 * nb;
    float wv[64];
#pragma unroll
    for (int i = 0; i < 64; ++i) wv[i] = W[(size_t)(k0 + i) * N + n0 + lane];
#pragma unroll
    for (int i = 0; i < 64; ++i) wv[i] *= gain ? gain[k0 + i] * scale : scale;
#pragma unroll
    for (int i = 0; i < 64; ++i) scr[i * 65 + lane] = wv[i];
    LDS_WAIT(); asm volatile("" ::: "memory");
    int orow0 = n0;
    if (swF) { const int isup = n0 >= swF ? 1 : 0; const int j = n0 - isup * swF; orow0 = (j >> 7) * 256 + isup * 128 + (j & 127); }
    const int c = lane & 7;
#pragma unroll
    for (int j = 0; j < 8; ++j) { const int n = (lane >> 3) + 8 * j; const LAS float* s = scr + (8 * c) * 65 + n;
        u32x2 o; o.x = pg8::pk4_fp8_w(s[0 * 65], s[1 * 65], s[2 * 65], s[3 * 65]); o.y = pg8::pk4_fp8_w(s[4 * 65], s[5 * 65], s[6 * 65], s[7 * 65]);
        *(GAS u32x2*)(WT + (size_t)(orow0 + n) * K + k0 + 8 * c) = o; }
    LDS_WAIT(); asm volatile("" ::: "memory");
}

typedef float f32x16 __attribute__((ext_vector_type(16)));
typedef float f32x2_t __attribute__((ext_vector_type(2))); typedef __bf16 bf16x2_t __attribute__((ext_vector_type(2)));
__device__ __forceinline__ unsigned cvtpk(float lo, float hi) { f32x2_t v = {lo, hi}; bf16x2_t b = __builtin_convertvector(v, bf16x2_t); return __builtin_bit_cast(unsigned, b); }
__device__ __forceinline__ bf16x8 mk8(unsigned a, unsigned b, unsigned c, unsigned d) { v4u t = {a, b, c, d}; return __builtin_bit_cast(bf16x8, t); }
__device__ __forceinline__ bf16x8 mk8u2(u32x2 lo, u32x2 hi) { v4u t = {lo.x, lo.y, hi.x, hi.y}; return __builtin_bit_cast(bf16x8, t); }
#define NEGINF (-__builtin_inff())
constexpr int BT_LD = 200, BT_OFF = 32;
__device__ __forceinline__ void dil_load_k(bf16x8 (&kf)[4], const bf16* pj, int sh, int b, int h, int r, int k0, int q, int hh) {
    const int sg = (q & ~12) | ((q & 4) << 1) | ((q & 8) >> 1);
    const int tk = b * SEQ + r + ((k0 + sg) << sh);
    const bf16* kp = pj + (size_t)tk * NPROJ + PC_K + h * 64 + 32 * hh;
#pragma unroll
    for (int ks = 0; ks < 4; ++ks) kf[ks] = *(const GAS bf16x8*)(kp + 8 * ks);
}
__device__ __forceinline__ void dil_load_v(bf16x8 (&vf)[2][2], const bf16* vrow, int sh, int k0) {
#pragma unroll
    for (int db = 0; db < 2; ++db)
#pragma unroll
        for (int s2 = 0; s2 < 2; ++s2) { const bf16* vp = vrow + (size_t)db * 32 * SEQ + (sh == 4 ? ((k0 >> 4) + s2) * 256 : k0 + 16 * s2); vf[db][s2] = *(const GAS bf16x8*)vp; }
}
__device__ __forceinline__ void dil_blk(const bf16x8 (&kf)[4], const bf16x8 (&vf)[2][2], const bf16x8 (&qf)[4], f32x16& O0, f32x16& O1, float& m, float& l, const LAS float* btl) {
    f32x16 st;
#pragma unroll
    for (int i = 0; i < 16; ++i) st[i] = 0.f;
#pragma unroll
    for (int ks = 0; ks < 4; ++ks) st = __builtin_amdgcn_mfma_f32_32x32x16_bf16(kf[ks], qf[ks], st, 0, 0, 0);
    float mx = NEGINF;
#pragma unroll
    for (int i = 0; i < 16; ++i) { st[i] = st[i] * 0.18033688011112042f + btl[23 - (16 * (i >> 3) + 4 * ((i >> 2) & 1) + (i & 3))]; mx = fmaxf(mx, st[i]); }
    { const auto rr = __builtin_amdgcn_permlane32_swap(__float_as_uint(mx), __float_as_uint(mx), false, false); mx = fmaxf(__uint_as_float(rr[0]), __uint_as_float(rr[1])); }
    const float mn = fmaxf(m, mx), ms = mn == NEGINF ? 0.f : mn, alpha = __builtin_amdgcn_exp2f(m - ms);
    float ls = 0.f;
#pragma unroll
    for (int i = 0; i < 16; ++i) { st[i] = __builtin_amdgcn_exp2f(st[i] - ms); ls += st[i]; }
    l = l * alpha + ls; m = mn;
#pragma unroll
    for (int i = 0; i < 16; ++i) { O0[i] *= alpha; O1[i] *= alpha; }
    const bf16x8 p0 = mk8(cvtpk(st[0], st[1]), cvtpk(st[2], st[3]), cvtpk(st[4], st[5]), cvtpk(st[6], st[7]));
    const bf16x8 p1 = mk8(cvtpk(st[8], st[9]), cvtpk(st[10], st[11]), cvtpk(st[12], st[13]), cvtpk(st[14], st[15]));
    O0 = __builtin_amdgcn_mfma_f32_32x32x16_bf16(vf[0][0], p0, O0, 0, 0, 0); O0 = __builtin_amdgcn_mfma_f32_32x32x16_bf16(vf[0][1], p1, O0, 0, 0, 0);
    O1 = __builtin_amdgcn_mfma_f32_32x32x16_bf16(vf[1][0], p0, O1, 0, 0, 0); O1 = __builtin_amdgcn_mfma_f32_32x32x16_bf16(vf[1][1], p1, O1, 0, 0, 0);
}
__device__ __forceinline__ void dil_store(const f32x16& O0, const f32x16& O1, float m, float l, bf16* opart, float* lsep, int tq, int h, int hh) {
    l = xsum32(l);
    const float inv = l > 0.f ? 1.0f / l : 0.f;
    bf16* op = opart + (size_t)tq * 512 + h * 64 + 4 * hh;
#pragma unroll
    for (int g4 = 0; g4 < 4; ++g4) {
        u32x2 w0, w1; w0.x = cvtpk(O0[4 * g4] * inv, O0[4 * g4 + 1] * inv); w0.y = cvtpk(O0[4 * g4 + 2] * inv, O0[4 * g4 + 3] * inv);
        w1.x = cvtpk(O1[4 * g4] * inv, O1[4 * g4 + 1] * inv); w1.y = cvtpk(O1[4 * g4 + 2] * inv, O1[4 * g4 + 3] * inv);
        *(GAS u32x2*)(op + 8 * g4) = w0; *(GAS u32x2*)(op + 32 + 8 * g4) = w1; }
    if (hh == 0) lsep[(size_t)tq * 8 + h] = l > 0.f ? (m + __builtin_amdgcn_logf(l)) * 0.6931471805599453f : NEGINF;
}
template <int JLO>
__device__ __forceinline__ void dil_unit32(const bf16* pj, const bf16* vt, bf16* opart, float* lsep, const LAS float* bt, int sh, int b, int h, int r, int n0, bool do_store) {
    constexpr int NT = JLO == 0 ? 5 : 4;
    int lane; asm volatile("v_mbcnt_lo_u32_b32 %0, -1, 0\n\tv_mbcnt_hi_u32_b32 %0, -1, %0" : "=v"(lane));
    const int q = lane & 31, hh = lane >> 5;
    const int L = SEQ >> sh;
    const int tq = b * SEQ + r + ((n0 + q) << sh);
    bf16x8 qf[4];
    { const bf16* qp = pj + (size_t)tq * NPROJ + PC_Q + h * 64 + 32 * hh;
#pragma unroll
      for (int ks = 0; ks < 4; ++ks) qf[ks] = *(const GAS bf16x8*)(qp + 8 * ks); }
    f32x16 O0, O1;
#pragma unroll
    for (int i = 0; i < 16; ++i) { O0[i] = 0.f; O1[i] = 0.f; }
    float m = NEGINF, l = 0.f;
    const bf16* vrow = vt + ((size_t)((b * 8 + h) * 64 + q) * SEQ) + (sh == 4 ? r * 16 : r * L) + 8 * hh;
    bf16x8 kf[2][4], vf[2][2][2];
    { const int k0 = n0 - 128 < 0 ? 0 : n0 - 128; dil_load_k(kf[0], pj, sh, b, h, r, k0, q, hh); dil_load_v(vf[0], vrow, sh, k0); }
#pragma unroll
    for (int t = 0; t < NT; ++t) {
        const int k0 = n0 - 128 + 32 * t;
        if (t + 1 < NT) { const int k1 = k0 + 32 < 0 ? 0 : k0 + 32; dil_load_k(kf[(t + 1) & 1], pj, sh, b, h, r, k1, q, hh); dil_load_v(vf[(t + 1) & 1], vrow, sh, k1); }
        const int jq = k0 < 0 ? 160 : q - 8 * hh + 128 - 32 * t;
        dil_blk(kf[t & 1], vf[t & 1], qf, O0, O1, m, l, bt + jq + BT_OFF - 23);
    }
    if (do_store) dil_store(O0, O1, m, l, opart, lsep, tq, h, hh);
}

constexpr int DK_PITCH = 144, DV_PITCH = 784, DK_BYTES = 384 * DK_PITCH, DV_BYTES = 64 * DV_PITCH;
__device__ __forceinline__ void dil_stage_load_k(v4u (&sk)[6], const bf16* pj, int sh, int b, int h, int r, int n0, int tid) {
    const int ws = n0 - 128;
#pragma unroll
    for (int k = 0; k < 6; ++k) { const int idx = tid + 512 * k, row = idx >> 3, ch = idx & 7; int kk = ws + row; kk = kk < 0 ? 0 : kk;
        sk[k] = *(const GAS v4u*)(pj + (size_t)(b * SEQ + r + (kk << sh)) * NPROJ + PC_K + h * 64 + ch * 8); }
}
__device__ __forceinline__ void dil_stage_load_v(v4u (&sv)[6], const bf16* pj, int sh, int b, int h, int r, int n0, int tid) {
    const int ws = n0 - 128;
#pragma unroll
    for (int k = 0; k < 6; ++k) { const int idx = tid + 512 * k, row = idx >> 3, ch = idx & 7; int kk = ws + row; kk = kk < 0 ? 0 : kk;
        sv[k] = *(const GAS v4u*)(pj + (size_t)(b * SEQ + r + (kk << sh)) * NPROJ + PC_V + h * 64 + ch * 8); }
}
__device__ __forceinline__ void dil_stage_write_k(LAS unsigned char* lds, const v4u (&sk)[6], int tid) {
#pragma unroll
    for (int k = 0; k < 6; ++k) { const int idx = tid + 512 * k, row = idx >> 3, ch = idx & 7; *(LAS v4u*)(lds + row * DK_PITCH + ch * 16) = sk[k]; }
}
__device__ __forceinline__ void dil_stage_write_v(LAS unsigned char* lds, const v4u (&sv)[6], int tid) {
#pragma unroll
    for (int k = 0; k < 6; ++k) { const int idx = tid + 512 * k, row = idx >> 3, ch = idx & 7;
        LAS unsigned short* d = (LAS unsigned short*)(lds + DK_BYTES + (8 * ch) * DV_PITCH + ((((row >> 3) ^ ch) << 3) | (row & 7)) * 2);
        d[0] = (unsigned short)(sv[k].x & 0xffffu); d[DV_PITCH / 2] = (unsigned short)(sv[k].x >> 16); d[2 * (DV_PITCH / 2)] = (unsigned short)(sv[k].y & 0xffffu); d[3 * (DV_PITCH / 2)] = (unsigned short)(sv[k].y >> 16);
        d[4 * (DV_PITCH / 2)] = (unsigned short)(sv[k].z & 0xffffu); d[5 * (DV_PITCH / 2)] = (unsigned short)(sv[k].z >> 16); d[6 * (DV_PITCH / 2)] = (unsigned short)(sv[k].w & 0xffffu); d[7 * (DV_PITCH / 2)] = (unsigned short)(sv[k].w >> 16); }
}
template <int JLO>
__device__ __forceinline__ void dil_wg_compute(const LAS unsigned char* lds, const bf16x8 (&qf)[4], bf16* opart, float* lsep, const LAS float* bt, int tq, int h, int k00, int lane, int wave, bool do_store) {
    constexpr int NT = JLO == 0 ? 5 : 4;
    asm volatile("" : "+v"(lane));
    const int q = lane & 31, hh = lane >> 5;
    f32x16 O0, O1;
#pragma unroll
    for (int i = 0; i < 16; ++i) { O0[i] = 0.f; O1[i] = 0.f; }
    float m = NEGINF, l = 0.f;
    const int sg = (q & ~12) | ((q & 4) << 1) | ((q & 8) >> 1);
    const LAS unsigned char* kl = lds + (32 * wave + sg) * DK_PITCH + 64 * hh;
    const LAS unsigned char* vl = lds + DK_BYTES + q * DV_PITCH;
    bf16x8 kf[2][4], vf[2][2][2];
#define DIL_LDFRAG(t_) do { _Pragma("unroll") for (int ks = 0; ks < 4; ++ks) kf[(t_) & 1][ks] = *(const LAS bf16x8*)(kl + (t_) * 32 * DK_PITCH + 16 * ks); \
        _Pragma("unroll") for (int db = 0; db < 2; ++db) _Pragma("unroll") for (int s2 = 0; s2 < 2; ++s2) \
            vf[(t_) & 1][db][s2] = *(const LAS bf16x8*)(vl + db * 32 * DV_PITCH + (((4 * wave + 4 * (t_) + 2 * s2 + hh) ^ (((32 * db + q) >> 3) & 7)) << 4)); } while (0)
    DIL_LDFRAG(0);
#pragma unroll
    for (int t = 0; t < NT; ++t) {
        if (t + 1 < NT) DIL_LDFRAG(t + 1);
        const int jq = k00 + 32 * t < 0 ? 160 : q - 8 * hh + 128 - 32 * t;
        dil_blk(kf[t & 1], vf[t & 1], qf, O0, O1, m, l, bt + jq + BT_OFF - 23);
        __builtin_amdgcn_sched_barrier(0);
    }
#undef DIL_LDFRAG
    if (do_store) dil_store(O0, O1, m, l, opart, lsep, tq, h, hh);
}

__device__ __forceinline__ void xat_unit(const bf16* qxp, const bf16* kb, const bf16* vtb, bf16* oxp, int t0, int h, int lane) {
    const int q = lane & 31, hh = lane >> 5;
    bf16x8 qf[8];
    { const bf16* qp = qxp + (size_t)(t0 + q) * XW + h * 128 + 64 * hh;
#pragma unroll
      for (int ks = 0; ks < 8; ++ks) qf[ks] = *(const GAS bf16x8*)(qp + 8 * ks); }
    f32x16 O[4];
#pragma unroll
    for (int d = 0; d < 4; ++d)
#pragma unroll
        for (int i = 0; i < 16; ++i) O[d][i] = 0.f;
    float m = NEGINF, l = 0.f;
    const bf16* vrow = vtb + (size_t)(h * 128 + q) * MEML + 4 * hh;
    for (int k0 = 0; k0 < MEML; k0 += 32) {
        const bf16* kp = kb + (size_t)(k0 + q) * 4096 + h * 128 + 64 * hh;
        f32x16 st;
#pragma unroll
        for (int i = 0; i < 16; ++i) st[i] = 0.f;
#pragma unroll
        for (int ks = 0; ks < 8; ++ks) st = __builtin_amdgcn_mfma_f32_32x32x16_bf16(*(const GAS bf16x8*)(kp + 8 * ks), qf[ks], st, 0, 0, 0);
        bf16x8 vf[4][2];
#pragma unroll
        for (int db = 0; db < 4; ++db)
#pragma unroll
            for (int s2 = 0; s2 < 2; ++s2) { const bf16* vp = vrow + (size_t)db * 32 * MEML + k0 + 16 * s2; vf[db][s2] = mk8u2(*(const GAS u32x2*)vp, *(const GAS u32x2*)(vp + 8)); }
        float mx = st[0];
#pragma unroll
        for (int i = 1; i < 16; ++i) mx = fmaxf(mx, st[i]);
        mx = xmax32(mx);
        const float mn = fmaxf(m, mx), alpha = __expf(m - mn);
        float ls = 0.f;
#pragma unroll
        for (int i = 0; i < 16; ++i) { st[i] = __expf(st[i] - mn); ls += st[i]; }
        l = l * alpha + ls; m = mn;
#pragma unroll
        for (int d = 0; d < 4; ++d)
#pragma unroll
            for (int i = 0; i < 16; ++i) O[d][i] *= alpha;
        const bf16x8 p0 = mk8(cvtpk(st[0], st[1]), cvtpk(st[2], st[3]), cvtpk(st[4], st[5]), cvtpk(st[6], st[7]));
        const bf16x8 p1 = mk8(cvtpk(st[8], st[9]), cvtpk(st[10], st[11]), cvtpk(st[12], st[13]), cvtpk(st[14], st[15]));
#pragma unroll
        for (int d = 0; d < 4; ++d) { O[d] = __builtin_amdgcn_mfma_f32_32x32x16_bf16(vf[d][0], p0, O[d], 0, 0, 0); O[d] = __builtin_amdgcn_mfma_f32_32x32x16_bf16(vf[d][1], p1, O[d], 0, 0, 0); }
    }
    l = xsum32(l);
    const float inv = 1.0f / l;
    bf16* op = oxp + (size_t)(t0 + q) * XW + h * 128 + 4 * hh;
#pragma unroll
    for (int d = 0; d < 4; ++d)
#pragma unroll
        for (int g4 = 0; g4 < 4; ++g4) { u32x2 w; w.x = cvtpk(O[d][4 * g4] * inv, O[d][4 * g4 + 1] * inv); w.y = cvtpk(O[d][4 * g4 + 2] * inv, O[d][4 * g4 + 3] * inv); *(GAS u32x2*)(op + 32 * d + 8 * g4) = w; }
}

constexpr int XK_PITCH = 272, XV_PITCH = 528, XK_BYTES = 256 * XK_PITCH, XV_BYTES = 128 * XV_PITCH;
__device__ __forceinline__ void xat_wg_unit(LAS unsigned char* lds, const bf16* qxp, const bf16* kb, const bf16* vtb, bf16* oxp, int t0, int h, int tid) {
    const int lane = tid & 63, q = lane & 31, hh = lane >> 5;
    __syncthreads();
#pragma unroll
    for (int k = 0; k < 8; ++k) { const int idx = tid + 512 * k, row = idx >> 4, ch = idx & 15;
        const v4u x = *(const GAS v4u*)(kb + (size_t)row * 4096 + h * 128 + ch * 8); *(LAS v4u*)(lds + row * XK_PITCH + ch * 16) = x; }
#pragma unroll
    for (int k = 0; k < 8; ++k) { const int idx = tid + 512 * k, row = idx >> 5, ch = idx & 31;
        const v4u x = *(const GAS v4u*)(vtb + (size_t)(h * 128 + row) * MEML + ch * 8); *(LAS v4u*)(lds + XK_BYTES + row * XV_PITCH + ch * 16) = x; }
    bf16x8 qf[8];
    { const bf16* qp = qxp + (size_t)(t0 + q) * XW + h * 128 + 64 * hh;
#pragma unroll
      for (int ks = 0; ks < 8; ++ks) qf[ks] = *(const GAS bf16x8*)(qp + 8 * ks); }
    __syncthreads();
    f32x16 O[4];
#pragma unroll
    for (int d = 0; d < 4; ++d)
#pragma unroll
        for (int i = 0; i < 16; ++i) O[d][i] = 0.f;
    float m = NEGINF, l = 0.f;
    const int sg = (q & ~12) | ((q & 4) << 1) | ((q & 8) >> 1);
    const LAS unsigned char* kl = lds + sg * XK_PITCH + 128 * hh;
    const LAS unsigned char* vl = lds + XK_BYTES + q * XV_PITCH + 16 * hh;
#pragma unroll
    for (int kt = 0; kt < 8; ++kt) {
        f32x16 st;
#pragma unroll
        for (int i = 0; i < 16; ++i) st[i] = 0.f;
#pragma unroll
        for (int ks = 0; ks < 8; ++ks) st = __builtin_amdgcn_mfma_f32_32x32x16_bf16(*(const LAS bf16x8*)(kl + kt * 32 * XK_PITCH + ks * 16), qf[ks], st, 0, 0, 0);
        float mx = st[0];
#pragma unroll
        for (int i = 1; i < 16; ++i) mx = fmaxf(mx, st[i]);
        mx = xmax32(mx);
        const float mn = fmaxf(m, mx), alpha = __builtin_amdgcn_exp2f((m - mn) * 1.4426950408889634f);
        float ls = 0.f;
#pragma unroll
        for (int i = 0; i < 16; ++i) { st[i] = __builtin_amdgcn_exp2f((st[i] - mn) * 1.4426950408889634f); ls += st[i]; }
        l = l * alpha + ls; m = mn;
#pragma unroll
        for (int d = 0; d < 4; ++d)
#pragma unroll
            for (int i = 0; i < 16; ++i) O[d][i] *= alpha;
        const bf16x8 p0 = mk8(cvtpk(st[0], st[1]), cvtpk(st[2], st[3]), cvtpk(st[4], st[5]), cvtpk(st[6], st[7]));
        const bf16x8 p1 = mk8(cvtpk(st[8], st[9]), cvtpk(st[10], st[11]), cvtpk(st[12], st[13]), cvtpk(st[14], st[15]));
#pragma unroll
        for (int d = 0; d < 4; ++d) { const LAS unsigned char* vp = vl + d * 32 * XV_PITCH + kt * 64;
            O[d] = __builtin_amdgcn_mfma_f32_32x32x16_bf16(*(const LAS bf16x8*)vp, p0, O[d], 0, 0, 0); O[d] = __builtin_amdgcn_mfma_f32_32x32x16_bf16(*(const LAS bf16x8*)(vp + 32), p1, O[d], 0, 0, 0); }
    }
    l = xsum32(l);
    const float inv = 1.0f / l;
    bf16* op = oxp + (size_t)(t0 + q) * XW + h * 128 + 4 * hh;
#pragma unroll
    for (int d = 0; d < 4; ++d)
#pragma unroll
        for (int g4 = 0; g4 < 4; ++g4) { u32x2 w; w.x = cvtpk(O[d][4 * g4] * inv, O[d][4 * g4 + 1] * inv); w.y = cvtpk(O[d][4 * g4 + 2] * inv, O[d][4 * g4 + 3] * inv); *(GAS u32x2*)(op + 32 * d + 8 * g4) = w; }
}

__device__ __forceinline__ void pool_unit(const bf16* pj, const bf16* pwT, const float* psc, bf16* ymixp, int t0, int lane, LAS unsigned char* scr) {
    constexpr int PITCH = 144;
    const int q = lane & 31, hh = lane >> 5; const int t = t0 + q, pos = t & (SEQ - 1), pos0 = t0 & (SEQ - 1);
    const int sr = lane >> 3, sc = lane & 7;
    v4u st[6];
#define POOL_LD(g_) do { _Pragma("unroll") for (int k = 0; k < 6; ++k) { const int r = 8 * k + sr, w_ = 2 << (g_); const bool ok = pos0 - (w_ - 1) + r >= 0 && r < 31 + w_; \
        st[k] = *(const GAS v4u*)(pj + (size_t)(ok ? t0 - (w_ - 1) + r : t0) * NPROJ + PC_POOL + (g_) * 64 + 8 * sc); if (!ok) st[k] = (v4u){0u, 0u, 0u, 0u}; } } while (0)
    POOL_LD(0);
#pragma unroll
    for (int g = 0; g < 4; ++g) {
        const int w = 2 << g; const float rn = 1.0f / (float)(pos + 1 < w ? pos + 1 : w);
#pragma unroll
        for (int k = 0; k < 6; ++k) *(LAS v4u*)(scr + (8 * k + sr) * PITCH + 16 * sc) = st[k];
        if (g < 3) POOL_LD(g + 1);
        f32x16 D0, D1;
#pragma unroll
        for (int i = 0; i < 16; ++i) { D0[i] = 0.f; D1[i] = 0.f; }
#pragma unroll
        for (int ks = 0; ks < 4; ++ks) {
            const LAS unsigned char* p0 = scr + (q + w - 1) * PITCH + 16 * (2 * ks + hh);
            const v4u x0 = *(const LAS v4u*)p0;
            float a0 = bflo(x0.x), a1 = bfhi(x0.x), a2 = bflo(x0.y), a3 = bfhi(x0.y), a4 = bflo(x0.z), a5 = bfhi(x0.z), a6 = bflo(x0.w), a7 = bfhi(x0.w);
#pragma unroll
            for (int i = 1; i < w; ++i) { const v4u xi = *(const LAS v4u*)(p0 - i * PITCH);
                a0 += bflo(xi.x); a1 += bfhi(xi.x); a2 += bflo(xi.y); a3 += bfhi(xi.y); a4 += bflo(xi.z); a5 += bfhi(xi.z); a6 += bflo(xi.w); a7 += bfhi(xi.w); }
            const bf16x8 bfr = mk8(cvtpk(a0 * rn - bflo(x0.x), a1 * rn - bfhi(x0.x)), cvtpk(a2 * rn - bflo(x0.y), a3 * rn - bfhi(x0.y)), cvtpk(a4 * rn - bflo(x0.z), a5 * rn - bfhi(x0.z)), cvtpk(a6 * rn - bflo(x0.w), a7 * rn - bfhi(x0.w)));
            const bf16* wp = pwT + (size_t)(g * 64 + q) * 64 + 16 * ks + 8 * hh;
            D0 = __builtin_amdgcn_mfma_f32_32x32x16_bf16(*(const GAS bf16x8*)wp, bfr, D0, 0, 0, 0);
            D1 = __builtin_amdgcn_mfma_f32_32x32x16_bf16(*(const GAS bf16x8*)(wp + 32 * 64), bfr, D1, 0, 0, 0);
        }
        bf16* op = ymixp + (size_t)t * D + 512 + g * 64 + 4 * hh; const float* sp = psc + g * 64 + 4 * hh;
#pragma unroll
        for (int k = 0; k < 4; ++k) { const f32x4 s0 = *(const GAS f32x4*)(sp + 8 * k), s1 = *(const GAS f32x4*)(sp + 32 + 8 * k);
            u32x2 w0, w1; w0.x = cvtpk(D0[4 * k] * s0[0], D0[4 * k + 1] * s0[1]); w0.y = cvtpk(D0[4 * k + 2] * s0[2], D0[4 * k + 3] * s0[3]);
            w1.x = cvtpk(D1[4 * k] * s1[0], D1[4 * k + 1] * s1[1]); w1.y = cvtpk(D1[4 * k + 2] * s1[2], D1[4 * k + 3] * s1[3]);
            *(GAS u32x2*)(op + 8 * k) = w0; *(GAS u32x2*)(op + 32 + 8 * k) = w1; }
    }
#undef POOL_LD
}
__device__ __forceinline__ void mergeconv_unit(const bf16* pj, const bf16* opartp, const float* lsepp, const float* cw, bf16* ymixp, int t0, int lane) {
    const int c4 = 4 * lane, h = lane >> 3;
    const f32x4 w0 = *(const GAS f32x4*)(cw + c4), w1 = *(const GAS f32x4*)(cw + 256 + c4), w2 = *(const GAS f32x4*)(cw + 512 + c4);
    f32x4 u1 = {0.f, 0.f, 0.f, 0.f}, u2 = {0.f, 0.f, 0.f, 0.f};
    const int pos0 = t0 & (SEQ - 1);
    if (pos0 >= 2) {
        const bf16* r1 = pj + (size_t)(t0 - 1) * NPROJ; const bf16* r2 = r1 - NPROJ;
        const u32x2 c1 = *(const GAS u32x2*)(r1 + PC_CG + c4), h1 = *(const GAS u32x2*)(r1 + PC_HC + c4), c2 = *(const GAS u32x2*)(r2 + PC_CG + c4), h2 = *(const GAS u32x2*)(r2 + PC_HC + c4);
        u1 = (f32x4){bflo(c1.x) * bflo(h1.x), bfhi(c1.x) * bfhi(h1.x), bflo(c1.y) * bflo(h1.y), bfhi(c1.y) * bfhi(h1.y)};
        u2 = (f32x4){bflo(c2.x) * bflo(h2.x), bfhi(c2.x) * bfhi(h2.x), bflo(c2.y) * bflo(h2.y), bfhi(c2.y) * bfhi(h2.y)};
    }
    constexpr int NB = 8;
    for (int j0 = 0; j0 < 32; j0 += NB) {
        u32x2 cg[NB], hc[NB], bg[NB]; float l0[NB], l1[NB], l2[NB]; v4u pa[NB], pb[NB], pc[NB];
#pragma unroll
        for (int j = 0; j < NB; ++j) { const int t = t0 + j0 + j; const bf16* row = pj + (size_t)t * NPROJ;
            cg[j] = *(const GAS u32x2*)(row + PC_CG + c4); hc[j] = *(const GAS u32x2*)(row + PC_HC + c4); bg[j] = *(const GAS u32x2*)(row + PC_BG + c4);
            l0[j] = lsepp[(size_t)t * 8 + h]; l1[j] = lsepp[(size_t)T * 8 + (size_t)t * 8 + h]; l2[j] = lsepp[(size_t)2 * T * 8 + (size_t)t * 8 + h];
            pa[j] = *(const GAS v4u*)(opartp + (size_t)t * 512 + 8 * lane); pb[j] = *(const GAS v4u*)(opartp + OP_STRIDE + (size_t)t * 512 + 8 * lane); pc[j] = *(const GAS v4u*)(opartp + 2 * OP_STRIDE + (size_t)t * 512 + 8 * lane); }
        asm volatile("" ::: "memory");
#pragma unroll
        for (int j = 0; j < NB; ++j) { const int t = t0 + j0 + j;
            const f32x4 u0 = {bflo(cg[j].x) * bflo(hc[j].x), bfhi(cg[j].x) * bfhi(hc[j].x), bflo(cg[j].y) * bflo(hc[j].y), bfhi(cg[j].y) * bfhi(hc[j].y)};
            const f32x4 y = (f32x4){bflo(bg[j].x), bfhi(bg[j].x), bflo(bg[j].y), bfhi(bg[j].y)} * (w0 * u0 + w1 * u1 + w2 * u2);
            u32x2 yo; yo.x = cvtpk(y[0], y[1]); yo.y = cvtpk(y[2], y[3]);
            *(GAS u32x2*)(ymixp + (size_t)t * D + 768 + c4) = yo;
            u2 = u1; u1 = u0;
            const float M = fmaxf(l0[j], fmaxf(l1[j], l2[j])); float e0 = __expf(l0[j] - M), e1 = __expf(l1[j] - M), e2 = __expf(l2[j] - M); const float inv = 1.0f / (e0 + e1 + e2); e0 *= inv; e1 *= inv; e2 *= inv;
            const v4u a = pa[j], bq = pb[j], c = pc[j];
            v4u o; o.x = cvtpk(e0 * bflo(a.x) + e1 * bflo(bq.x) + e2 * bflo(c.x), e0 * bfhi(a.x) + e1 * bfhi(bq.x) + e2 * bfhi(c.x));
            o.y = cvtpk(e0 * bflo(a.y) + e1 * bflo(bq.y) + e2 * bflo(c.y), e0 * bfhi(a.y) + e1 * bfhi(bq.y) + e2 * bfhi(c.y));
            o.z = cvtpk(e0 * bflo(a.z) + e1 * bflo(bq.z) + e2 * bflo(c.z), e0 * bfhi(a.z) + e1 * bfhi(bq.z) + e2 * bfhi(c.z));
            o.w = cvtpk(e0 * bflo(a.w) + e1 * bflo(bq.w) + e2 * bflo(c.w), e0 * bfhi(a.w) + e1 * bfhi(bq.w) + e2 * bfhi(c.w));
            *(GAS v4u*)(ymixp + (size_t)t * D + 8 * lane) = o; }
    }
}

__device__ __forceinline__ void vt_transpose_tile(LAS unsigned char* lds, const bf16* pj, bf16* vt, int pm, int vh, int tid) {
    constexpr int PW = 65;
    LAS unsigned* img = (LAS unsigned*)lds;
    const int row0 = pm * 256, b = row0 >> 13, tt = row0 & 8191;
    for (int hf = 0; hf < 2; ++hf) {
        __syncthreads();
        { const int r = tid >> 1, hc = tid & 1;
            const bf16* src = pj + (size_t)(row0 + r) * NPROJ + PC_V + vh * 256 + hf * 128 + hc * 64;
#pragma unroll
            for (int k = 0; k < 8; ++k) { const v4u x = *(const GAS v4u*)(src + 8 * k); LAS unsigned* d = img + r * PW + hc * 32 + 4 * k; d[0] = x.x; d[1] = x.y; d[2] = x.z; d[3] = x.w; } }
        __syncthreads();
        const LAS unsigned short* im16 = (const LAS unsigned short*)lds;
        bf16* vcol = vt + (size_t)(b * 512 + vh * 256 + hf * 128) * SEQ;
#pragma unroll 2
        for (int k = 0; k < 8; ++k) { const int id = tid + 512 * k, d = id >> 5, c = id & 31;
            {
#define RD16(j) ((unsigned)im16[(8 * c + (j)) * (2 * PW) + d])
              v4u o; o.x = RD16(0) | (RD16(1) << 16); o.y = RD16(2) | (RD16(3) << 16); o.z = RD16(4) | (RD16(5) << 16); o.w = RD16(6) | (RD16(7) << 16);
#undef RD16
              *(GAS v4u*)(vcol + (size_t)d * SEQ + tt + 8 * c) = o; }
            { const int r = c >> 3, n0 = 8 * (c & 7);
#define RD16(j) ((unsigned)im16[(4 * (n0 + (j)) + r) * (2 * PW) + d])
              v4u o; o.x = RD16(0) | (RD16(1) << 16); o.y = RD16(2) | (RD16(3) << 16); o.z = RD16(4) | (RD16(5) << 16); o.w = RD16(6) | (RD16(7) << 16);
#undef RD16
              *(GAS v4u*)(vcol + VT_STRIDE + (size_t)d * SEQ + r * 2048 + (tt >> 2) + n0) = o; }
            { const int r = c >> 1, n0 = 8 * (c & 1);
#define RD16(j) ((unsigned)im16[(16 * (n0 + (j)) + r) * (2 * PW) + d])
              v4u o; o.x = RD16(0) | (RD16(1) << 16); o.y = RD16(2) | (RD16(3) << 16); o.z = RD16(4) | (RD16(5) << 16); o.w = RD16(6) | (RD16(7) << 16);
#undef RD16
              *(GAS v4u*)(vcol + 2 * VT_STRIDE + (size_t)d * SEQ + (tt >> 8) * 256 + r * 16 + n0) = o; }
        }
    }
    __syncthreads();
}

#define x_in (args.in[0])
#define mem_in (args.in[1])
#define rel_bias (args.in[2])
#define mem_g (args.in[3])
#define mix_g (args.in[4])
#define w_in (args.in[5])
#define conv_w (args.in[6])
#define pool_w (args.in[7])
#define pool_scale (args.in[8])
#define w_out (args.in[9])
#define xat_g (args.in[10])
#define wq_x (args.in[11])
#define wkv_x (args.in[12])
#define wo_x (args.in[13])
#define ffn_g (args.in[14])
#define w13_d (args.in[15])
#define w2_d (args.in[16])
#define router_w (args.in[17])
#define w13_m (args.in[18])
#define w2_m (args.in[19])
#define fin_g (args.in[20])
#define out (args.out)
#define Win_t ((bf16*)(ws + WS_WIN))
#define Wout_t ((bf16*)(ws + WS_WOUT))
#define Wq_t ((bf16*)(ws + WS_WQ))
#define Wkv_t ((bf16*)(ws + WS_WKV))
#define Wo_t ((bf16*)(ws + WS_WO))
#define W13d_t ((bf16*)(ws + WS_W13D))
#define W2d_t ((bf16*)(ws + WS_W2D))
#define W13m_t ((bf16*)(ws + WS_W13M))
#define W2m_t ((bf16*)(ws + WS_W2M))
#define xb ((bf16*)(ws + WS_XB))
#define qx ((bf16*)(ws + WS_QX))
#define ox ((bf16*)(ws + WS_OX))
#define Ag ((bf16*)(ws + WS_AG))
#define ym ((bf16*)(ws + WS_YM))
#define ypart ((bf16*)(ws + WS_YM + 136 * MiB))
#define proj ((bf16*)(ws + WS_PROJ))
#define ymix ((bf16*)(ws + WS_Y))
#define hbuf ((bf16*)(ws + WS_H))
#define kvx ((bf16*)(ws + WS_KVX))
#define memn ((bf16*)(ws + WS_MEMN))
#define vtb ((bf16*)(ws + WS_VT))
#define opart ((bf16*)(ws + WS_OPART))
#define lsep ((float*)(ws + WS_LSE))
#define vtx ((bf16*)(ws + WS_VTX))
#define ssp ((float*)(ws + WS_SSP))
#define cnts ((int*)(ws + WS_CNT))
#define meta ((int*)(ws + WS_META))
#define tok_e ((int*)(ws + WS_TOKE))
#define tok_g ((float*)(ws + WS_TOKG))
#define tok_pos ((int*)(ws + WS_TOKPOS))
#define row_gate ((float*)(ws + WS_ROWGATE))
#define row_rs ((float*)(ws + WS_ROWRS))
#ifndef PROBE
#define PROBE 0
#endif
#ifndef N_LAUNCH_MODE
#define N_LAUNCH_MODE 0
#endif

__device__ __forceinline__ void pair_barrier(unsigned* cnt, unsigned target, bool same_xcc, unsigned* tmo, int wave0) {
    asm volatile("s_waitcnt vmcnt(0)" ::: "memory");
    __syncthreads();
    int ln; asm volatile("v_mbcnt_lo_u32_b32 %0, -1, 0\n\tv_mbcnt_hi_u32_b32 %0, -1, %0" : "=v"(ln));
    if (wave0 == 0 && ln == 0) {
        if (!same_xcc) { __builtin_amdgcn_fence(__ATOMIC_RELEASE, "agent"); asm volatile("s_waitcnt vmcnt(0)" ::: "memory"); }
        (void)xb_add(cnt, 1u);
        unsigned sp = 0u;
        while (xb_ld(cnt) < target) { __builtin_amdgcn_s_sleep(1); if ((++sp & 255u) == 0u) { if (xb_ld(tmo)) break; if (sp > XB_SPIN_CAP) { atomicAdd(tmo, 1u); break; } } }
        __builtin_amdgcn_fence(__ATOMIC_ACQUIRE, "agent");
        asm volatile("s_waitcnt vmcnt(0)" ::: "memory");
    }
    __syncthreads();
}
__global__ void __launch_bounds__(NWAVES * 64, 2) trunk_fwd(Args args) {
    extern __shared__ __attribute__((aligned(16))) unsigned char lds_raw[];
    LAS unsigned char* lds = (LAS unsigned char*)lds_raw;
    volatile LAS unsigned* MISC = (volatile LAS unsigned*)(lds + MISC_OFF);
    const int tid0 = threadIdx.x;
    const int G0 = gridDim.x, blk0 = blockIdx.x, wave0 = __builtin_amdgcn_readfirstlane(tid0 >> 6);
    unsigned char* ws0 = args.ws;
    gu32* ctl = (gu32*)(ws0 + WS_CTL);
#define PH_VARS int lane_; asm volatile("v_mbcnt_lo_u32_b32 %0, -1, 0\n\tv_mbcnt_hi_u32_b32 %0, -1, %0" : "=v"(lane_)); int wv_ = wave0; asm volatile("" : "+s"(wv_)); int blk = blk0; asm volatile("" : "+s"(blk)); int G = G0; asm volatile("" : "+s"(G)); \
    unsigned char* ws = ws0; asm volatile("" : "+s"(ws)); const int lane = lane_, wave = wv_, tid = wv_ * 64 + lane_; const int gw = blk * NWAVES + wave, NGW = G * NWAVES; (void)lane; (void)gw; (void)NGW; (void)ws; (void)tid
    for (int u = tid0; u < (LDS_BYTES - LDSCTL_OFF) / 4; u += NWAVES * 64) ((LAS unsigned*)(lds + LDSCTL_OFF))[u] = 0u;
    __syncthreads();
    XcdBarrier bar = xcd_barrier_post((unsigned*)(ctl + CW_BAR), MISC + 8);
    bar.x = __builtin_amdgcn_readfirstlane(bar.x);
    if (tid0 == 0) __hip_atomic_store((unsigned*)(ws0 + WS_XCCTAB) + blk0, bar.x, __ATOMIC_RELAXED, __HIP_MEMORY_SCOPE_AGENT);
    const int tpm0 = (blk0 & 7) + 8 * (blk0 >> 4), tmb0 = (blk0 >> 3) & 1;
    unsigned pepoch = 0u; bool same_xcc = false;
#define PAIR_BAR do { pepoch += 2u; unsigned* tc_ = (unsigned*)(ctl + CW_TEAM) + 64 * tpm0; asm volatile("" : "+s"(tc_)); pair_barrier(tc_, pepoch, same_xcc, (unsigned*)(ctl + CW_BAR) + XB_TMO, wave0); } while (0)
#if N_LAUNCH_MODE == 0
#define PH_ON true
#define PH_END do { for (int br_ = 0; br_ < ((PROBE & 1024) ? 3 : 1); ++br_) { XcdBarrier b_ = bar; asm volatile("" : "+s"(b_.x)); asm volatile("" : "+s"(b_.bar)); xcd_barrier(b_); } } while (0)
#else
    const int lo = args.ph_lo, hi = args.ph_hi;
    int ph = 0;
#define PH_ON (ph >= lo && ph < hi)
#define PH_END do { if (ph >= lo && ph + 1 < hi) { XcdBarrier b_ = bar; asm volatile("" : "+s"(b_.x)); asm volatile("" : "+s"(b_.bar)); xcd_barrier(b_); } ++ph; } while (0)
#endif

    constexpr size_t SSP_STRIDE = (size_t)T * 16;

    if (PH_ON) { PH_VARS;
        LAS float* scr = (LAS float*)(lds + wave * 16896);
        constexpr int I_IN = 16 * 40, I_OUT = 16 * 16, I_Q = 16 * 8, I_KV = 16 * 16, I_O = 8 * 16, I_13D = 16 * 88, I_2D = 44 * 16, I_13M = 16 * 112, I_2M = 56 * 16;
        constexpr int C0 = 4 * I_IN, C1 = C0 + 4 * I_OUT, C2 = C1 + 4 * I_Q, C3 = C2 + 4 * I_KV, C4 = C3 + 4 * I_O, C5 = C4 + 2 * I_13D, C6 = C5 + 2 * I_2D, C7 = C6 + 16 * I_13M, C8 = C7 + 16 * I_2M;
        for (int rep = 0; rep < ((PROBE & 16) ? 2 : 1); ++rep)
        for (int it = gw; it < C8; it += NGW) {
            if (it < C0) { const int m = it / I_IN, r = it % I_IN; if (m < 2) conv_item(w_in + (size_t)m * D * NPROJ, D, NPROJ, Win_t + (size_t)m * NPROJ * D, mix_g + m * D, 0, scr, r, lane);
                else conv_item8(w_in + (size_t)m * D * NPROJ, D, NPROJ, (unsigned char*)(Win_t + (size_t)m * NPROJ * D), mix_g + m * D, 0, F8_S1, scr, r, lane); }
            else if (it < C1) { const int q = it - C0, m = q / I_OUT, r = q % I_OUT; conv_item(w_out + (size_t)m * D * D, D, D, Wout_t + (size_t)m * D * D, nullptr, 0, scr, r, lane); }
            else if (it < C2) { const int q = it - C1, m = q / I_Q, r = q % I_Q; conv_item(wq_x + (size_t)m * D * XW, D, XW, Wq_t + (size_t)m * XW * D, xat_g + m * D, 0, scr, r, lane); }
            else if (it < C3) { const int q = it - C2, m = q / I_KV, r = q % I_KV; conv_item(wkv_x + (size_t)m * D * 1024, D, 1024, Wkv_t + (size_t)m * 1024 * D, nullptr, 0, scr, r, lane); }
            else if (it < C4) { const int q = it - C3, m = q / I_O, r = q % I_O; conv_item(wo_x + (size_t)m * XW * D, XW, D, Wo_t + (size_t)m * D * XW, nullptr, 0, scr, r, lane); }
            else if (it < C5) { const int q = it - C4, m = q / I_13D, r = q % I_13D; if (m == 0) conv_item(w13_d, D, 2 * FFD, W13d_t, ffn_g, FFD, scr, r, lane); else conv_item8(w13_d + (size_t)D * 2 * FFD, D, 2 * FFD, (unsigned char*)(W13d_t + (size_t)2 * FFD * D), ffn_g + 2 * D, FFD, F8_S1, scr, r, lane); }
            else if (it < C6) { const int q = it - C5, m = q / I_2D, r = q % I_2D; if (m == 0) conv_item(w2_d, FFD, D, W2d_t, nullptr, 0, scr, r, lane); else conv_item8(w2_d + (size_t)FFD * D, FFD, D, (unsigned char*)(W2d_t + (size_t)D * FFD), nullptr, 0, F8_S2, scr, r, lane); }
            else if (it < C7) { const int q = it - C6, m = q / I_13M, r = q % I_13M; conv_item8(w13_m + (size_t)m * D * 2 * FFE, D, 2 * FFE, (unsigned char*)W13m_t + (size_t)m * 2 * FFE * D, ffn_g + (2 * (m >> 3) + 1) * D, FFE, F8_S1, scr, r, lane); }
            else { const int q = it - C7, m = q / I_2M, r = q % I_2M; conv_item8(w2_m + (size_t)m * FFE * D, FFE, D, (unsigned char*)W2m_t + (size_t)m * D * FFE, nullptr, 0, F8_S2, scr, r, lane); }
        }
        for (int idx = gw * 64 + lane; idx < DEPTH * 4 * 64 * 64; idx += NGW * 64) { const int c = idx & 63, dp = (idx >> 6) & 63, lg = idx >> 12;
            ((bf16*)(ws + WS_PWT))[idx] = (bf16)f2bf(pool_w[(size_t)(lg * 64 + c) * 64 + dp]); }
        for (int m = gw; m < T; m += NGW) {
            const GAS f32x4* xr = (const GAS f32x4*)(x_in + (size_t)m * D) + lane; f32x4 v[4]; float s = 0.f;
#pragma unroll
            for (int j = 0; j < 4; ++j) { v[j] = xr[64 * j]; s += (v[j].x * v[j].x + v[j].y * v[j].y) + (v[j].z * v[j].z + v[j].w * v[j].w); }
            s = wave_sum(s, lane);
            GAS unsigned long long* o8 = (GAS unsigned long long*)(xb + (size_t)m * D) + lane;
#pragma unroll
            for (int j = 0; j < 4; ++j) o8[64 * j] = (unsigned long long)pk2(v[j].x, v[j].y) | ((unsigned long long)pk2(v[j].z, v[j].w) << 32);
            if (lane < 16) ssp[(size_t)m * 16 + lane] = lane == 0 ? s : 0.f;
        }
        for (int m = gw; m < MROWS; m += NGW) {
            const GAS f32x4* xr = (const GAS f32x4*)(mem_in + (size_t)m * D) + lane; const GAS f32x4* gr = (const GAS f32x4*)mem_g + lane; f32x4 v[4]; float s = 0.f;
#pragma unroll
            for (int j = 0; j < 4; ++j) { v[j] = xr[64 * j]; s += (v[j].x * v[j].x + v[j].y * v[j].y) + (v[j].z * v[j].z + v[j].w * v[j].w); }
            const float r = 1.0f / sqrtf(wave_sum(s, lane) * (1.0f / D) + 1e-6f);
            GAS unsigned long long* o8 = (GAS unsigned long long*)(memn + (size_t)m * D) + lane;
#pragma unroll
            for (int j = 0; j < 4; ++j) { const f32x4 g = gr[64 * j]; o8[64 * j] = (unsigned long long)pk2(v[j].x * r * g.x, v[j].y * r * g.y) | ((unsigned long long)pk2(v[j].z * r * g.z, v[j].w * r * g.w) << 32); }
        }
    }
    PH_END;
    same_xcc = (unsigned)__builtin_amdgcn_readfirstlane((int)xb_ld((unsigned*)(ws0 + WS_XCCTAB) + (blk0 ^ 8))) == bar.x;

    for (int l = 0; l < DEPTH; ++l) {
#define ssp_a (ssp + (size_t)(3 * l) * SSP_STRIDE)
#define ssp_b (ssp + (size_t)(3 * l + 1) * SSP_STRIDE)
#define ssp_c (ssp + (size_t)(3 * l + 2) * SSP_STRIDE)
#define ssp_d (ssp + (size_t)(3 * l + 3) * SSP_STRIDE)
        if (PH_ON) { PH_VARS;
            if (l == 0) {
                pg8::Gemm g{memn, Wkv_t, MROWS, 4096, D}; pg8::StaticOrder S; S.init(MROWS, 4096, G, blk);
                pg8::EpiKV E{kvx, vtx};
                pg8::gemm_phase<pg8::EpiKV, pg8::StaticOrder, true, true>(lds, g, S, E, tid);
#if PROBE & (1 | 64)
                pg8::gemm_phase<pg8::EpiKV, pg8::StaticOrder, true, true>(lds, g, S, E, tid);
#endif
            }
        }
        if (PH_ON) {
            if (l >= 2) { PH_VARS;
                pg8::Gemm g{Ag, Win_t + (size_t)l * NPROJ * D, T, NPROJ, D / 2}; pg8::StaticOrder S; S.init(T, NPROJ, G, blk);
                pg8::EpiRowScale E{proj, NPROJ, ssp_a, 1.0f / F8_S1};
                pg8::gemm_phase<pg8::EpiRowScale, pg8::StaticOrder, true, true, true>(lds, g, S, E, tid);
            } else { PH_VARS;
                pg8::Gemm g{xb, Win_t + (size_t)l * NPROJ * D, T, NPROJ, D}; pg8::StaticOrder S; S.init(T, NPROJ, G, blk);
                pg8::EpiRowScale E{proj, NPROJ, ssp_a, 1.0f};
                pg8::gemm_phase<pg8::EpiRowScale, pg8::StaticOrder, true, true>(lds, g, S, E, tid);
            }
        }
        PH_END;
        if (PH_ON) { PH_VARS;
            LAS float* bt = (LAS float*)lds;
            for (int idx = tid; idx < 3 * 8 * BT_LD; idx += NWAVES * 64) { const int part = idx / (8 * BT_LD), rem = idx % (8 * BT_LD), h = rem / BT_LD, j = rem % BT_LD - BT_OFF, sh = 2 * part, jlo = part ? 33 : 0;
                float v = NEGINF; if (j <= 128 && j >= jlo) { const int d = j << sh; v = (rel_bias[t5_bucket(d) * 8 + h] + logf((float)key_mult(d))) * 1.4426950408889634f; } bt[idx] = v; }
            __syncthreads();
            for (int rep = 0; rep < ((PROBE & (2 | 2048)) ? 2 : 1); ++rep) {
            v4u sk[6], sv[6];
#define DIL_DEC(u_) const int part = (u_) >> 10, v_ = (u_) & 1023, sh = 2 * part, b = v_ >> 8, h = (v_ >> 5) & 7, w5 = v_ & 31, nbs = 5 - sh, r = w5 >> nbs, n0 = 256 * (w5 & ((1 << nbs) - 1))
            { const int u0 = blk < 3 * 1024 ? blk : 0; DIL_DEC(u0); dil_stage_load_k(sk, proj, sh, b, h, r, n0, tid); dil_stage_load_v(sv, proj, sh, b, h, r, n0, tid); }
            for (int u = blk; u < 3 * 1024; u += G) {
                DIL_DEC(u);
                const bool dst = !((PROBE & 2048) && rep == 1);
                __syncthreads();
                dil_stage_write_k(lds + 20480, sk, tid); dil_stage_write_v(lds + 20480, sv, tid);
                const int tq = b * SEQ + r + ((n0 + 32 * wave + (lane & 31)) << sh);
                bf16x8 qf[4];
                { const bf16* qp = proj + (size_t)tq * NPROJ + PC_Q + h * 64 + 32 * (lane >> 5);
#pragma unroll
                  for (int ks = 0; ks < 4; ++ks) qf[ks] = *(const GAS bf16x8*)(qp + 8 * ks); }
                __syncthreads();
                { const int un = u + G < 3 * 1024 ? u + G : u, part2 = un >> 10, v2 = un & 1023, sh2 = 2 * part2, nbs2 = 5 - sh2, w52 = v2 & 31, b2 = v2 >> 8, h2 = (v2 >> 5) & 7, r2 = w52 >> nbs2, n02 = 256 * (w52 & ((1 << nbs2) - 1));
                    dil_stage_load_k(sk, proj, sh2, b2, h2, r2, n02, tid); dil_stage_load_v(sv, proj, sh2, b2, h2, r2, n02, tid); }
                if (part == 0) dil_wg_compute<0>(lds + 20480, qf, opart, lsep, bt + h * BT_LD, tq, h, n0 + 32 * wave - 128, lane, wave, dst);
                else dil_wg_compute<33>(lds + 20480, qf, opart + (size_t)part * OP_STRIDE, lsep + (size_t)part * T * 8, bt + (part * 8 + h) * BT_LD, tq, h, n0 + 32 * wave - 128, lane, wave, dst);
            }
#undef DIL_DEC
            }
            __syncthreads();
        }
        PH_END;
        if (PH_ON) { PH_VARS;
            const bf16* pwT = (const bf16*)(ws + WS_PWT) + (size_t)l * 4 * 64 * 64;
            const int t0 = 32 * (tpm0 * 8 + 4 * tmb0 + (wave >> 1));
            if ((wave & 1) == 0) pool_unit(proj, pwT, pool_scale + (size_t)l * 256, ymix, t0, lane, lds + wave * 16896);
            else mergeconv_unit(proj, opart, lsep, conv_w + (size_t)l * 768, ymix, t0, lane);
        }
        PAIR_BAR;
        if (PH_ON) { PH_VARS;
            pg8::Gemm g{ymix, Wout_t + (size_t)l * D * D, T, D, D}; pg8::TeamOrder S{tpm0, 2 * tmb0, 2};
            pg8::EpiResid E{l == 0 ? x_in : (const float*)nullptr, xb, ssp_b, nullptr, 1.0f, 0};
            pg8::gemm_phase<pg8::EpiResid, pg8::TeamOrder, true, true>(lds, g, S, E, tid);
        }
        PAIR_BAR;
        if (PH_ON) { PH_VARS;
            pg8::Gemm g{xb, Wq_t + (size_t)l * XW * D, T, XW, D}; pg8::TeamOrder S{tpm0, tmb0, 1};
            pg8::EpiRowScale E{qx, XW, ssp_b, 0.08838834764831845f};
            pg8::gemm_phase<pg8::EpiRowScale, pg8::TeamOrder, true, true>(lds, g, S, E, tid);
            { const int b = (tpm0 * 256) / SEQ;
              for (int h2 = 0; h2 < 2; ++h2) xat_wg_unit(lds, qx, kvx + (size_t)(b * MEML) * 4096 + l * 1024, vtx + (size_t)((l * 4 + b) * 512) * MEML, ox, tpm0 * 256 + wave * 32, 2 * tmb0 + h2, tid); }
            __syncthreads();
        }
        PAIR_BAR;
        if (PH_ON) { PH_VARS;
            pg8::Gemm g{ox, Wo_t + (size_t)l * D * XW, T, D, XW}; pg8::TeamOrder S{tpm0, 2 * tmb0, 2};
            pg8::EpiResid E{nullptr, xb, ssp_c, (unsigned char*)Ag, 1.0f, l == 2 ? 1 : 0};
            pg8::gemm_phase<pg8::EpiResid, pg8::TeamOrder, true, true>(lds, g, S, E, tid);
        }
        PH_END;
        if ((l & 1) == 0) {
            if (PH_ON) { PH_VARS;
                pg8::StaticOrder S; S.init(T, 2 * FFD, G, blk);
                if (l == 2) {
                    pg8::Gemm g{Ag, W13d_t + (size_t)2 * FFD * D, T, 2 * FFD, D / 2};
                    pg8::EpiSwiGLU8 E{(unsigned char*)hbuf, FFD, nullptr, 0, 1.0f / F8_S1, F8_SH, ssp_c};
                    pg8::gemm_phase<pg8::EpiSwiGLU8, pg8::StaticOrder, true, true, true>(lds, g, S, E, tid);
                } else {
                    pg8::Gemm g{xb, W13d_t, T, 2 * FFD, D};
                    pg8::EpiSwiGLU E{hbuf, FFD, ssp_c, nullptr, 0};
                    pg8::gemm_phase<pg8::EpiSwiGLU, pg8::StaticOrder, true, true>(lds, g, S, E, tid);
                }
            }
            PH_END;
            if (PH_ON) { PH_VARS;
                pg8::StaticOrder S; S.init(T, D, G, blk);
                if (l == 2) {
                    pg8::Gemm g{hbuf, W2d_t + (size_t)D * FFD, T, D, FFD / 2};
                    pg8::EpiResid E{nullptr, xb, ssp_d, (unsigned char*)Ag, 1.0f / (F8_S2 * F8_SH), 1};
                    pg8::gemm_phase<pg8::EpiResid, pg8::StaticOrder, true, true, true>(lds, g, S, E, tid);
                } else {
                    pg8::Gemm g{hbuf, W2d_t, T, D, FFD};
                    pg8::EpiResid E{nullptr, xb, ssp_d, nullptr, 1.0f, 0};
                    pg8::gemm_phase<pg8::EpiResid, pg8::StaticOrder, true, true>(lds, g, S, E, tid);
                }
            }
            PH_END;
        } else {
#define chunk ((T + G - 1) / G)
            if (PH_ON) { PH_VARS;
                LAS int* lcnt = (LAS int*)lds; const float* rw = router_w + (size_t)(l >> 1) * D * NEXP; const float* fg = ffn_g + (size_t)l * D;
                if (tid < NEXP) lcnt[tid] = 0;
                __syncthreads();
                for (int i = wave; i < chunk; i += NWAVES) { const int t = blk * chunk + i; if (t >= T) break;
                    const float r = pg8::row_rs16(ssp_c, t);
                    float lg[8];
#pragma unroll
                    for (int e = 0; e < 8; ++e) lg[e] = 0.f;
#pragma unroll
                    for (int j = 0; j < 4; ++j) { const u32x2 xw = *((const GAS u32x2*)(xb + (size_t)t * D) + lane + 64 * j); const f32x4 xv = {bflo(xw.x), bfhi(xw.x), bflo(xw.y), bfhi(xw.y)}; const f32x4 gv = *((const GAS f32x4*)fg + lane + 64 * j);
#pragma unroll
                        for (int c = 0; c < 4; ++c) { const float hn = xv[c] * r * gv[c]; const int k = 4 * (lane + 64 * j) + c; const f32x4 w0 = *(const GAS f32x4*)(rw + (size_t)k * 8), w1 = *(const GAS f32x4*)(rw + (size_t)k * 8 + 4);
                            lg[0] += hn * w0[0]; lg[1] += hn * w0[1]; lg[2] += hn * w0[2]; lg[3] += hn * w0[3]; lg[4] += hn * w1[0]; lg[5] += hn * w1[1]; lg[6] += hn * w1[2]; lg[7] += hn * w1[3]; } }
#pragma unroll
                    for (int e = 0; e < 8; ++e) lg[e] = wave_sum(lg[e], lane);
                    int e0 = 0; float v0 = lg[0];
#pragma unroll
                    for (int e = 1; e < 8; ++e) if (lg[e] > v0) { v0 = lg[e]; e0 = e; }
                    int e1 = -1; float v1 = -3.0e38f;
#pragma unroll
                    for (int e = 0; e < 8; ++e) if (e != e0 && lg[e] > v1) { v1 = lg[e]; e1 = e; }
                    const float p0 = 1.0f / (1.0f + __expf(v1 - v0)), p1 = 1.0f - p0;
                    if (lane == 0) { tok_e[2 * t] = e0; tok_e[2 * t + 1] = e1; tok_g[2 * t] = p0; tok_g[2 * t + 1] = p1; atomicAdd((int*)&lcnt[e0], 1); atomicAdd((int*)&lcnt[e1], 1); }
                }
                __syncthreads();
                if (tid < NEXP) cnts[blk * NEXP + tid] = lcnt[tid];
                __syncthreads();
            }
            PH_END;
            if (PH_ON) { PH_VARS;
                LAS int* lc = (LAS int*)lds;
                LAS int* lbase = (LAS int*)(lds + 32768);
                LAS int* lseg = (LAS int*)(lds + 32768 + 64);
                LAS int* lpos = (LAS int*)(lds + 36864);
                for (int i = tid; i < G * NEXP; i += NWAVES * 64) lc[i] = cnts[i];
                __syncthreads();
                { int base = 0, tot = 0;
                  for (int b2 = lane; b2 < G; b2 += 64) { const int c = lc[b2 * NEXP + wave]; tot += c; base += b2 < blk ? c : 0; }
                  for (int o = 1; o < 32; o <<= 1) { tot += __builtin_amdgcn_ds_bpermute((lane ^ o) << 2, tot); base += __builtin_amdgcn_ds_bpermute((lane ^ o) << 2, base); }
                  tot += __builtin_amdgcn_ds_bpermute((lane ^ 32) << 2, tot); base += __builtin_amdgcn_ds_bpermute((lane ^ 32) << 2, base);
                  if (lane == 0) { lbase[wave] = base; lseg[8 + wave] = tot; } }
                __syncthreads();
                if (tid == 0) { int s = 0; for (int e = 0; e < NEXP; ++e) { lseg[e] = s; lbase[e] += s; s += (lseg[8 + e] + 255) & ~255; lseg[16 + e] = s; if (blk == 0) meta[e] = s >> 8; } }
                __syncthreads();
                if (wave == 0) {
                    int run[8];
#pragma unroll
                    for (int e = 0; e < 8; ++e) run[e] = lbase[e];
                    const int nent = 2 * chunk;
                    for (int r0 = 0; r0 < nent; r0 += 64) { const int idx = r0 + lane; const int t = blk * chunk + (idx >> 1); const bool ok = idx < nent && t < T;
                        const int e = ok ? tok_e[2 * t + (idx & 1)] : -1; int pos = 0;
#pragma unroll
                        for (int ee = 0; ee < 8; ++ee) { const unsigned long long mk = __ballot(e == ee); if (e == ee) pos = run[ee] + __popcll(mk & ((1ull << lane) - 1ull)); run[ee] += __popcll(mk); }
                        if (ok) { tok_pos[2 * t + (idx & 1)] = pos; row_gate[pos] = tok_g[2 * t + (idx & 1)]; row_rs[pos] = pg8::row_rs16(ssp_c, t); lpos[idx] = pos; } }
                }
                __syncthreads();
                for (int idx = wave; idx < 2 * chunk; idx += NWAVES) { const int t = blk * chunk + (idx >> 1); if (t >= T) break; const int pos = lpos[idx];
                    const GAS v4u* src = (const GAS v4u*)(xb + (size_t)t * D); const v4u a = src[2 * lane], c = src[2 * lane + 1];
                    v4u o; o.x = pg8::pk4_fp8(bflo(a.x), bfhi(a.x), bflo(a.y), bfhi(a.y)); o.y = pg8::pk4_fp8(bflo(a.z), bfhi(a.z), bflo(a.w), bfhi(a.w));
                    o.z = pg8::pk4_fp8(bflo(c.x), bfhi(c.x), bflo(c.y), bfhi(c.y)); o.w = pg8::pk4_fp8(bflo(c.z), bfhi(c.z), bflo(c.w), bfhi(c.w));
                    *((GAS v4u*)((unsigned char*)Ag + (size_t)pos * D) + lane) = o; }
                if (blk < NEXP) { const int r0 = lseg[blk] + lseg[8 + blk], r1 = lseg[16 + blk];
                    for (int r = r0 + wave; r < r1; r += NWAVES) { GAS v4u* dst = (GAS v4u*)((unsigned char*)Ag + (size_t)r * D); unsigned z0; asm volatile("v_mov_b32 %0, 0" : "=v"(z0)); const v4u z = {z0, z0, z0, z0}; dst[lane] = z; if (lane == 0) { row_gate[r] = 0.f; row_rs[r] = 0.f; } } }
                __syncthreads();
            }
            PH_END;
            if (PH_ON) { PH_VARS;
                pg8::MoeOrder S;
#pragma unroll
                for (int e = 0; e < 8; ++e) S.te[e] = __builtin_amdgcn_readfirstlane(meta[e]);
                S.nNl = 2 * FFE / 256; S.so.init(S.te[7] * 256, 2 * FFE, G, blk);
                pg8::Gemm g{Ag, W13m_t + (size_t)(l >> 1) * NEXP * 2 * FFE * (D / 2), MP, NEXP * 2 * FFE, D / 2};
                pg8::EpiSwiGLU8 E{(unsigned char*)hbuf, FFE, row_rs, 2 * FFE / 256, 1.0f / F8_S1, F8_SH, nullptr};
                pg8::gemm_phase<pg8::EpiSwiGLU8, pg8::MoeOrder, true, true, true>(lds, g, S, E, tid);
#if PROBE & (1 | 512)
                pg8::gemm_phase<pg8::EpiSwiGLU8, pg8::MoeOrder, true, true, true>(lds, g, S, E, tid);
#endif
            }
            PH_END;
            if (PH_ON) { PH_VARS;
                pg8::MoeOrder S;
#pragma unroll
                for (int e = 0; e < 8; ++e) S.te[e] = __builtin_amdgcn_readfirstlane(meta[e]);
                const int ntile = S.te[7], nmain = ntile < 256 ? ntile : 256;
                S.nNl = D / 256; S.so.init(nmain * 256, D, G, blk);
                pg8::Gemm g{hbuf, W2m_t + (size_t)(l >> 1) * NEXP * D * (FFE / 2), MP, NEXP * D, FFE / 2};
                pg8::EpiMoeOut E{ym, row_gate, 1.0f / (F8_S2 * F8_SH)};
                pg8::gemm_phase<pg8::EpiMoeOut, pg8::MoeOrder, true, true, true>(lds, g, S, E, tid);
#if PROBE & (1 | 512)
                pg8::gemm_phase<pg8::EpiMoeOut, pg8::MoeOrder, true, true, true>(lds, g, S, E, tid);
#endif
                if (ntile > 256) {
                    pg8::MoeTailOrder ST; ST.npieces = (ntile - 256) * 4 * 7; ST.G = G; ST.c = blk; ST.kstep = 512;
#pragma unroll
                    for (int e = 0; e < 8; ++e) ST.te[e] = S.te[e];
                    pg8::Gemm g2{hbuf, W2m_t + (size_t)(l >> 1) * NEXP * D * (FFE / 2), MP, NEXP * D, 256, FFE / 2};
                    pg8::EpiMoePart EP{ypart, row_gate, 1.0f / (F8_S2 * F8_SH), 9};
                    pg8::gemm_phase<pg8::EpiMoePart, pg8::MoeTailOrder, true, true, true>(lds, g2, ST, EP, tid);
                }
            }
            PH_END;
            if (PH_ON) { PH_VARS;
                const bool last = (l == DEPTH - 1);
                for (int t = gw; t < T; t += NGW) {
                    const int p0 = tok_pos[2 * t], p1 = tok_pos[2 * t + 1];
                    const GAS u32x2* xr = (const GAS u32x2*)(xb + (size_t)t * D) + lane; const GAS u32x2* y0 = (const GAS u32x2*)(ym + (size_t)p0 * D) + lane; const GAS u32x2* y1 = (const GAS u32x2*)(ym + (size_t)p1 * D) + lane;
                    f32x4 v[4]; float s = 0.f;
#pragma unroll
                    for (int j = 0; j < 4; ++j) { const u32x2 a = xr[64 * j]; f32x4 e0, e1;
                        if (p0 < 65536) { const u32x2 b0 = y0[64 * j]; e0 = (f32x4){bflo(b0.x), bfhi(b0.x), bflo(b0.y), bfhi(b0.y)}; }
                        else { e0 = (f32x4){0.f, 0.f, 0.f, 0.f};
                            for (int kp = 0; kp < 7; ++kp) { const u32x2 b0 = *((const GAS u32x2*)(ypart + ((size_t)kp * 2048 + (p0 - 65536)) * D) + lane + 64 * j); e0 += (f32x4){bflo(b0.x), bfhi(b0.x), bflo(b0.y), bfhi(b0.y)}; } }
                        if (p1 < 65536) { const u32x2 b1 = y1[64 * j]; e1 = (f32x4){bflo(b1.x), bfhi(b1.x), bflo(b1.y), bfhi(b1.y)}; }
                        else { e1 = (f32x4){0.f, 0.f, 0.f, 0.f};
                            for (int kp = 0; kp < 7; ++kp) { const u32x2 b1 = *((const GAS u32x2*)(ypart + ((size_t)kp * 2048 + (p1 - 65536)) * D) + lane + 64 * j); e1 += (f32x4){bflo(b1.x), bfhi(b1.x), bflo(b1.y), bfhi(b1.y)}; } }
                        v[j] = ((f32x4){bflo(a.x), bfhi(a.x), bflo(a.y), bfhi(a.y)} + e0) + e1;
                        s += (v[j].x * v[j].x + v[j].y * v[j].y) + (v[j].z * v[j].z + v[j].w * v[j].w); }
                    s = wave_sum(s, lane);
                    GAS f32x4* orow = (GAS f32x4*)(out + (size_t)t * D) + lane;
                    if (last) { const float r = 1.0f / sqrtf(s * (1.0f / D) + 1e-6f); const GAS f32x4* gr = (const GAS f32x4*)fin_g + lane;
#pragma unroll
                        for (int j = 0; j < 4; ++j) orow[64 * j] = v[j] * r * gr[64 * j]; }
                    else { GAS unsigned long long* o8 = (GAS unsigned long long*)(xb + (size_t)t * D) + lane;
#pragma unroll
                        for (int j = 0; j < 4; ++j) o8[64 * j] = (unsigned long long)pk2(v[j].x, v[j].y) | ((unsigned long long)pk2(v[j].z, v[j].w) << 32);
                        { GAS unsigned* o4 = (GAS unsigned*)((unsigned char*)Ag + (size_t)t * D) + lane;
#pragma unroll
                          for (int j = 0; j < 4; ++j) o4[64 * j] = pg8::pk4_fp8(v[j].x, v[j].y, v[j].z, v[j].w); }
                        if (lane < 16) ssp_d[(size_t)t * 16 + lane] = lane == 0 ? s : 0.f; }
                }
            }
            if (l != DEPTH - 1) { PH_END; }
        }
    }
#undef PH_ON
#undef PH_END
}
#undef x_in
#undef mem_in
#undef rel_bias
#undef mem_g
#undef mix_g
#undef w_in
#undef conv_w
#undef pool_w
#undef pool_scale
#undef w_out
#undef xat_g
#undef wq_x
#undef wkv_x
#undef wo_x
#undef ffn_g
#undef w13_d
#undef w2_d
#undef router_w
#undef w13_m
#undef w2_m
#undef fin_g
#undef out
#undef Win_t
#undef Wout_t
#undef Wq_t
#undef Wkv_t
#undef Wo_t
#undef W13d_t
#undef W2d_t
#undef W13m_t
#undef W2m_t
#undef xb
#undef qx
#undef ox
#undef Ag
#undef ym
#undef proj
#undef ymix
#undef hbuf
#undef kvx
#undef memn
#undef ssp
#undef cnts
#undef meta
#undef tok_e
#undef tok_g
#undef tok_pos
#undef row_gate
#undef row_rs
#undef ssp_a
#undef ssp_b
#undef ssp_c
#undef ssp_d
#undef PH_VARS
#undef ypart
#undef chunk
#undef vtb
#undef opart
#undef lsep
#undef vtx

extern "C" void kernel_launch(void* const* d_in, const int* in_sizes, int n_in, void* d_out, int out_size, void* d_ws, size_t ws_size, hipStream_t stream) {
    static int grid = 0;
    if (grid == 0) {
        if (n_in != 21 || in_sizes[0] != T * D || out_size != T * D || ws_size < WS_END) { fprintf(stderr, "kernel_launch: unexpected shapes: n_in %d in0 %d out %d ws %zu (need %zu)\n", n_in, n_in > 0 ? in_sizes[0] : -1, out_size, ws_size, (size_t)WS_END); grid = -1; return; }
        int dev = 0, cus = 0, per_cu = 0;
        if (hipGetDevice(&dev) != hipSuccess || hipDeviceGetAttribute(&cus, hipDeviceAttributeMultiprocessorCount, dev) != hipSuccess) { fprintf(stderr, "kernel_launch: device query failed\n"); grid = -1; return; }
        if (hipFuncSetAttribute((const void*)trunk_fwd, hipFuncAttributeMaxDynamicSharedMemorySize, LDS_BYTES) != hipSuccess) { fprintf(stderr, "kernel_launch: hipFuncSetAttribute failed\n"); grid = -1; return; }
        if (hipOccupancyMaxActiveBlocksPerMultiprocessor(&per_cu, (const void*)trunk_fwd, NWAVES * 64, LDS_BYTES) != hipSuccess || per_cu < 1) fprintf(stderr, "kernel_launch: occupancy query reports %d\n", per_cu);
        (void)hipGetLastError();
        if (cus != T / 256 * 2) { fprintf(stderr, "kernel_launch: the team mapping needs %d CUs, device has %d\n", T / 256 * 2, cus); grid = -1; return; }
        grid = cus;
    }
    if (grid < 0) return;
    if (hipMemsetAsync((char*)d_ws + WS_CTL, 0, CTL_ZERO_BYTES, stream) != hipSuccess) { fprintf(stderr, "kernel_launch: memset failed\n"); return; }
    Args a{};
    for (int i = 0; i < 21; ++i) a.in[i] = (const float*)d_in[i];
    a.out = (float*)d_out; a.ws = (unsigned char*)d_ws;
#if N_LAUNCH_MODE == 0
    a.ph_lo = 0; a.ph_hi = NPH;
    hipLaunchKernelGGL(trunk_fwd, dim3(grid), dim3(NWAVES * 64), LDS_BYTES, stream, a);
#else
    for (int p = 0; p < NPH; ++p) { a.ph_lo = p; a.ph_hi = p + 1; hipLaunchKernelGGL(trunk_fwd, dim3(grid), dim3(NWAVES * 64), LDS_BYTES, stream, a); }
#endif
    const hipError_t le = hipPeekAtLastError();
    if (le != hipSuccess) fprintf(stderr, "kernel_launch: launch failed: %s\n", hipGetErrorName(le));
}
```

```cpp
#define PROBE 0
#include <hip/hip_runtime.h>
#include <cstdio>
#include <cstdint>
namespace pg8 {
#define PG8_LAS __attribute__((address_space(3)))
typedef unsigned short bf16_t;
typedef short bf16x8 __attribute__((ext_vector_type(8)));
typedef float f32x4 __attribute__((ext_vector_type(4)));
typedef unsigned u32x4 __attribute__((ext_vector_type(4)));
typedef int v4i_t __attribute__((ext_vector_type(4)));
typedef long v2l_t __attribute__((ext_vector_type(2)));
typedef int v8i_t __attribute__((ext_vector_type(8)));
constexpr int BM = 256, BK = 64, HALF = 128, HTB = HALF * BK * 2  , STAGE_BYTES = 8 * HTB, NXCD = 8, WGM = 8;

__host__ __device__ __forceinline__ int lds_byte(int r, int c) { const int st = (r >> 4) * 2 + (c >> 5), rr = r & 15, cc = c & 31, ob = rr * 64 + cc * 2; return st * 1024 + (ob ^ (((ob >> 9) & 1) << 5)); }
__host__ __device__ __forceinline__ void stage_rc(int b, int& R, int& C) { const int st = b / 1024, sb = b % 1024, swz = sb ^ (((sb >> 9) & 1) << 5); R = (st >> 1) * 16 + swz / 64; C = (st & 1) * 32 + (swz % 64) / 2; }
__host__ __device__ __forceinline__ int perm32(int rho) { const int n = rho >> 4, i = rho & 15; return 8 * (i >> 2) + 4 * n + (i & 3); }

struct Unit { int pm, pn; int ko = 0; };
struct Gemm { const bf16_t* A; const bf16_t* Bt; int M, N, K; int ld = 0; };

struct StaticOrder {
    int nM, nN, nwg, G, c;
    __host__ __device__ void init(int M, int N, int G_, int c_) { nM = M / BM; nN = N / BM; nwg = nM * nN; G = G_; c = c_; }
    __host__ __device__ __forceinline__ bool next(int i, Unit& u) const {
        const long L = (long)i * G + c; if (L >= nwg) return false;
        int wgid = (int)L; { const int q = nwg / NXCD, r = nwg % NXCD, xcd = wgid % NXCD, off = wgid / NXCD; wgid = (xcd < r ? xcd * (q + 1) : r * (q + 1) + (xcd - r) * q) + off; }
        const int nig = WGM * nN, gid = wgid / nig, fm = gid * WGM, gsz = (nM - fm) < WGM ? (nM - fm) : WGM;
        u.pm = fm + ((wgid % nig) % gsz); u.pn = (wgid % nig) / gsz; return true;
    }
    __device__ __forceinline__ void a_ready(const Unit&) const {}
    __device__ __forceinline__ void done(const Unit&) const {}
};

__device__ __forceinline__ unsigned cvt_pk_bf16(float lo, float hi) { unsigned r; asm volatile("v_cvt_pk_bf16_f32 %0, %1, %2" : "=v"(r) : "v"(lo), "v"(hi)); return r; }
typedef float f32x2 __attribute__((ext_vector_type(2)));
__device__ __forceinline__ float row_rs16(const float* ssp, int row) {
    const f32x4* sp = (const f32x4*)(ssp + (size_t)row * 16); const f32x4 s0 = sp[0], s1 = sp[1], s2 = sp[2], s3 = sp[3];
    const float s = (((s0[0] + s0[1]) + (s0[2] + s0[3])) + ((s1[0] + s1[1]) + (s1[2] + s1[3]))) + (((s2[0] + s2[1]) + (s2[2] + s2[3])) + ((s3[0] + s3[1]) + (s3[2] + s3[3])));
    return __builtin_amdgcn_rsqf(s * (1.0f / 1024.0f) + 1e-6f);
}
__device__ __forceinline__ void row_rs16x8(float (&r)[8], const float* ssp, int row0, int fr, int fq) {
    f32x4 c[8];
#pragma unroll
    for (int k = 0; k < 8; ++k) c[k] = *(const f32x4*)(ssp + (size_t)(row0 + (k >> 2) * HALF + (k & 3) * 16) * 16 + 4 * fq);
#pragma unroll
    for (int k = 0; k < 8; ++k) { float s = (c[k][0] + c[k][1]) + (c[k][2] + c[k][3]);
        s += __int_as_float(__builtin_amdgcn_ds_bpermute((((fq * 16 + fr) ^ 16) << 2), __float_as_int(s)));
        { const auto rr = __builtin_amdgcn_permlane32_swap(__float_as_uint(s), __float_as_uint(s), false, false); s = __uint_as_float(rr[0]) + __uint_as_float(rr[1]); }
        r[k] = __builtin_amdgcn_rsqf(s * (1.0f / 1024.0f) + 1e-6f); }
}
struct EpiRowScale {
    static constexpr bool PERM = true, AFTER_DRAIN = false;
    bf16_t* O; int ldc; const float* ssp; float cs;
    __device__ __forceinline__ void operator()(const f32x4 (&acc)[2][2][4][2], const Unit& u, int wr, int wc, int fr, int fq) const {
        const int row0 = u.pm * BM + wr * 64 + fr, col0 = u.pn * BM + wc * 32 + 8 * fq;
        float rr8[8];
        if (ssp) row_rs16x8(rr8, ssp, row0, fr, fq); else {
#pragma unroll
            for (int k = 0; k < 8; ++k) rr8[k] = 1.0f; }
#pragma unroll
        for (int ai = 0; ai < 2; ++ai)
#pragma unroll
            for (int m = 0; m < 4; ++m) { const int row = row0 + ai * HALF + m * 16; const float r = rr8[ai * 4 + m] * cs; bf16_t* rowp = O + (size_t)row * ldc + col0;
#pragma unroll
                for (int bj = 0; bj < 2; ++bj) { const f32x4 v0 = acc[ai][bj][m][0] * r, v1 = acc[ai][bj][m][1] * r;
                    u32x4 w; w.x = cvt_pk_bf16(v0[0], v0[1]); w.y = cvt_pk_bf16(v0[2], v0[3]); w.z = cvt_pk_bf16(v1[0], v1[1]); w.w = cvt_pk_bf16(v1[2], v1[3]);
                    *(u32x4*)(rowp + bj * HALF) = w; } }
    }
};
struct EpiInProj {
    static constexpr bool PERM = true, AFTER_DRAIN = false;
    bf16_t* O; const float* ssp; bf16_t* vt;
    __device__ __forceinline__ void operator()(const f32x4 (&acc)[2][2][4][2], const Unit& u, int wr, int wc, int fr, int fq) const {
        const int row0 = u.pm * BM + wr * 64 + fr;
        if (u.pn == 4 || u.pn == 5) {
            const int cv0 = (u.pn - 4) * BM + wc * 32 + 8 * fq; constexpr size_t CS = (size_t)32768 * 512;
#pragma unroll
            for (int ai = 0; ai < 2; ++ai)
#pragma unroll
                for (int m = 0; m < 4; ++m) { const int row = row0 + ai * HALF + m * 16; const float r = row_rs16(ssp, row); const int b = row >> 13, t = row & 8191;
                    const size_t o0 = (size_t)t, o1 = CS + (size_t)(t & 3) * 2048 + (t >> 2), o2 = 2 * CS + (size_t)(t & 15) * 512 + (t >> 4);
#pragma unroll
                    for (int bj = 0; bj < 2; ++bj)
#pragma unroll
                        for (int n = 0; n < 2; ++n) { const f32x4 v = acc[ai][bj][m][n] * r; const unsigned w01 = cvt_pk_bf16(v[0], v[1]), w23 = cvt_pk_bf16(v[2], v[3]);
                            bf16_t* p = vt + (size_t)(b * 512 + cv0 + bj * HALF + 4 * n) * 8192;
                            const bf16_t e0 = (bf16_t)(w01 & 0xffffu), e1 = (bf16_t)(w01 >> 16), e2 = (bf16_t)(w23 & 0xffffu), e3 = (bf16_t)(w23 >> 16);
                            p[o0] = e0; p[o1] = e0; p[o2] = e0; p[8192 + o0] = e1; p[8192 + o1] = e1; p[8192 + o2] = e1;
                            p[2 * 8192 + o0] = e2; p[2 * 8192 + o1] = e2; p[2 * 8192 + o2] = e2; p[3 * 8192 + o0] = e3; p[3 * 8192 + o1] = e3; p[3 * 8192 + o2] = e3; } }
        } else {
            const int col0 = u.pn * BM + wc * 32 + 8 * fq;
#pragma unroll
            for (int ai = 0; ai < 2; ++ai)
#pragma unroll
                for (int m = 0; m < 4; ++m) { const int row = row0 + ai * HALF + m * 16; const float r = row_rs16(ssp, row); bf16_t* rowp = O + (size_t)row * 2560 + col0;
#pragma unroll
                    for (int bj = 0; bj < 2; ++bj) { const f32x4 v0 = acc[ai][bj][m][0] * r, v1 = acc[ai][bj][m][1] * r;
                        u32x4 w; w.x = cvt_pk_bf16(v0[0], v0[1]); w.y = cvt_pk_bf16(v0[2], v0[3]); w.z = cvt_pk_bf16(v1[0], v1[1]); w.w = cvt_pk_bf16(v1[2], v1[3]);
                        *(u32x4*)(rowp + bj * HALF) = w; } }
        }
    }
};
struct EpiKV {
    static constexpr bool PERM = true, AFTER_DRAIN = false;
    bf16_t* kvx; bf16_t* vtx;
    __device__ __forceinline__ void operator()(const f32x4 (&acc)[2][2][4][2], const Unit& u, int wr, int wc, int fr, int fq) const {
        const int row0 = u.pm * BM + wr * 64 + fr, col0 = u.pn * BM + wc * 32 + 8 * fq;
        if ((u.pn & 3) >= 2) {
            const int lx = u.pn >> 2, dv0 = (col0 & 1023) - 512;
#pragma unroll
            for (int ai = 0; ai < 2; ++ai)
#pragma unroll
                for (int m = 0; m < 4; ++m) { const int row = row0 + ai * HALF + m * 16; const int b = row >> 8, key = row & 255;
#pragma unroll
                    for (int bj = 0; bj < 2; ++bj)
#pragma unroll
                        for (int n = 0; n < 2; ++n) { const f32x4 v = acc[ai][bj][m][n]; const unsigned w01 = cvt_pk_bf16(v[0], v[1]), w23 = cvt_pk_bf16(v[2], v[3]);
                            bf16_t* p = vtx + ((size_t)((lx * 4 + b) * 512 + dv0 + bj * HALF + 4 * n)) * 256 + key;
                            p[0] = (bf16_t)(w01 & 0xffffu); p[256] = (bf16_t)(w01 >> 16); p[512] = (bf16_t)(w23 & 0xffffu); p[768] = (bf16_t)(w23 >> 16); } }
        } else {
#pragma unroll
            for (int ai = 0; ai < 2; ++ai)
#pragma unroll
                for (int m = 0; m < 4; ++m) { const int row = row0 + ai * HALF + m * 16; bf16_t* rowp = kvx + (size_t)row * 4096 + col0;
#pragma unroll
                    for (int bj = 0; bj < 2; ++bj) { const f32x4 v0 = acc[ai][bj][m][0], v1 = acc[ai][bj][m][1];
                        u32x4 w; w.x = cvt_pk_bf16(v0[0], v0[1]); w.y = cvt_pk_bf16(v0[2], v0[3]); w.z = cvt_pk_bf16(v1[0], v1[1]); w.w = cvt_pk_bf16(v1[2], v1[3]);
                        *(u32x4*)(rowp + bj * HALF) = w; } }
        }
    }
};
__device__ __forceinline__ float silu_mul(float g, float u) { return g * u * __builtin_amdgcn_rcpf(1.0f + __expf(-g)); }
struct EpiSwiGLU {
    static constexpr bool PERM = true, AFTER_DRAIN = false;
    bf16_t* O; int ldc; const float* ssp; const float* rmul; int pn_mod;
    __device__ __forceinline__ void operator()(const f32x4 (&acc)[2][2][4][2], const Unit& u, int wr, int wc, int fr, int fq) const {
        const int pnl = pn_mod ? (u.pn % pn_mod) : u.pn;
        const int row0 = u.pm * BM + wr * 64 + fr, col0 = pnl * HALF + wc * 32 + 8 * fq;
        float rr8[8];
        if (ssp) row_rs16x8(rr8, ssp, row0, fr, fq); else {
#pragma unroll
            for (int k = 0; k < 8; ++k) rr8[k] = rmul[row0 + (k >> 2) * HALF + (k & 3) * 16]; }
#pragma unroll
        for (int ai = 0; ai < 2; ++ai)
#pragma unroll
            for (int m = 0; m < 4; ++m) { const int row = row0 + ai * HALF + m * 16; const float r = rr8[ai * 4 + m];
                const f32x4 g0 = acc[ai][0][m][0] * r, g1 = acc[ai][0][m][1] * r, u0 = acc[ai][1][m][0] * r, u1 = acc[ai][1][m][1] * r;
                u32x4 w; w.x = cvt_pk_bf16(silu_mul(g0[0], u0[0]), silu_mul(g0[1], u0[1])); w.y = cvt_pk_bf16(silu_mul(g0[2], u0[2]), silu_mul(g0[3], u0[3]));
                w.z = cvt_pk_bf16(silu_mul(g1[0], u1[0]), silu_mul(g1[1], u1[1])); w.w = cvt_pk_bf16(silu_mul(g1[2], u1[2]), silu_mul(g1[3], u1[3]));
                *(u32x4*)(O + (size_t)row * ldc + col0) = w; }
    }
};
__device__ __forceinline__ float sat8(float v) { return __builtin_amdgcn_fmed3f(v, -448.0f, 448.0f); }
__device__ __forceinline__ unsigned pk4_fp8_w(float a, float b, float c, float d) { int r = __builtin_amdgcn_cvt_pk_fp8_f32(a, b, 0, false); r = __builtin_amdgcn_cvt_pk_fp8_f32(c, d, r, true); return (unsigned)r; }
__device__ __forceinline__ unsigned pk4_fp8(float a, float b, float c, float d) { int r = __builtin_amdgcn_cvt_pk_fp8_f32(sat8(a), sat8(b), 0, false); r = __builtin_amdgcn_cvt_pk_fp8_f32(sat8(c), sat8(d), r, true); return (unsigned)r; }
struct EpiSwiGLU8 {
    static constexpr bool PERM = true, AFTER_DRAIN = false;
    unsigned char* O; int ldc; const float* rmul; int pn_mod; float cs, hs; const float* ssp;
    __device__ __forceinline__ void operator()(const f32x4 (&acc)[2][2][4][2], const Unit& u, int wr, int wc, int fr, int fq) const {
        const int pnl = pn_mod ? (u.pn % pn_mod) : u.pn;
        const int row0 = u.pm * BM + wr * 64 + fr, col0 = pnl * HALF + wc * 32 + 8 * fq;
        float rr8[8];
        if (ssp) row_rs16x8(rr8, ssp, row0, fr, fq); else {
#pragma unroll
            for (int k = 0; k < 8; ++k) rr8[k] = rmul[row0 + (k >> 2) * HALF + (k & 3) * 16]; }
#pragma unroll
        for (int ai = 0; ai < 2; ++ai)
#pragma unroll
            for (int m = 0; m < 4; ++m) { const int row = row0 + ai * HALF + m * 16; const float r = rr8[ai * 4 + m] * cs, r2 = r * -1.4426950408889634f, rrh = r * r * hs;
                unsigned w[2];
#pragma unroll
                for (int n = 0; n < 2; ++n) { const f32x4 ag = acc[ai][0][m][n], au = acc[ai][1][m][n]; const f32x4 t = ag * r2;
                    f32x4 d; d[0] = __builtin_amdgcn_exp2f(t[0]); d[1] = __builtin_amdgcn_exp2f(t[1]); d[2] = __builtin_amdgcn_exp2f(t[2]); d[3] = __builtin_amdgcn_exp2f(t[3]);
                    d = d + 1.0f;
                    f32x4 iv; iv[0] = __builtin_amdgcn_rcpf(d[0]); iv[1] = __builtin_amdgcn_rcpf(d[1]); iv[2] = __builtin_amdgcn_rcpf(d[2]); iv[3] = __builtin_amdgcn_rcpf(d[3]);
                    const f32x4 hv = ((ag * au) * rrh) * iv;
                    w[n] = pk4_fp8(hv[0], hv[1], hv[2], hv[3]); }
                typedef unsigned u32x2_t __attribute__((ext_vector_type(2)));
                *(u32x2_t*)(O + (size_t)row * ldc + col0) = (u32x2_t){w[0], w[1]}; }
    }
};
struct EpiResid {
    static constexpr bool PERM = true, AFTER_DRAIN = false;
    const float* base32; bf16_t* xb; float* ssp_out; unsigned char* xb8; float cs; int w8;
    __device__ __forceinline__ void operator()(const f32x4 (&acc)[2][2][4][2], const Unit& u, int wr, int wc, int fr, int fq) const {
        const int row0 = u.pm * BM + wr * 64 + fr, col0 = u.pn * BM + wc * 32 + 8 * fq;
        u32x4 xw[2][4][2];
        if (!base32) {
#pragma unroll
            for (int ai = 0; ai < 2; ++ai)
#pragma unroll
                for (int m = 0; m < 4; ++m)
#pragma unroll
                    for (int bj = 0; bj < 2; ++bj) xw[ai][m][bj] = *(const u32x4*)(xb + (size_t)(row0 + ai * HALF + m * 16) * 1024 + col0 + bj * HALF);
        }
#pragma unroll
        for (int ai = 0; ai < 2; ++ai)
#pragma unroll
            for (int m = 0; m < 4; ++m) { const int row = row0 + ai * HALF + m * 16; const size_t off = (size_t)row * 1024 + col0; float q = 0.f;
#pragma unroll
                for (int bj = 0; bj < 2; ++bj) { f32x4 b0, b1;
                    if (base32) { b0 = *(const f32x4*)(base32 + off + bj * HALF); b1 = *(const f32x4*)(base32 + off + bj * HALF + 4); }
                    else { const u32x4 w4 = xw[ai][m][bj];
                        b0 = (f32x4){__uint_as_float(w4.x << 16), __uint_as_float(w4.x & 0xffff0000u), __uint_as_float(w4.y << 16), __uint_as_float(w4.y & 0xffff0000u)};
                        b1 = (f32x4){__uint_as_float(w4.z << 16), __uint_as_float(w4.z & 0xffff0000u), __uint_as_float(w4.w << 16), __uint_as_float(w4.w & 0xffff0000u)}; }
                    const f32x4 v0 = b0 + acc[ai][bj][m][0] * cs, v1 = b1 + acc[ai][bj][m][1] * cs;
                    u32x4 w; w.x = cvt_pk_bf16(v0[0], v0[1]); w.y = cvt_pk_bf16(v0[2], v0[3]); w.z = cvt_pk_bf16(v1[0], v1[1]); w.w = cvt_pk_bf16(v1[2], v1[3]);
                    *(u32x4*)(xb + off + bj * HALF) = w;
                    if (w8) { typedef unsigned u32x2_t __attribute__((ext_vector_type(2))); *(u32x2_t*)(xb8 + off + bj * HALF) = (u32x2_t){pk4_fp8(v0[0], v0[1], v0[2], v0[3]), pk4_fp8(v1[0], v1[1], v1[2], v1[3])}; }
                    q += ((v0[0] * v0[0] + v0[1] * v0[1]) + (v0[2] * v0[2] + v0[3] * v0[3])) + ((v1[0] * v1[0] + v1[1] * v1[1]) + (v1[2] * v1[2] + v1[3] * v1[3])); }
                q += __int_as_float(__builtin_amdgcn_ds_bpermute((((fq * 16 + fr) ^ 16) << 2), __float_as_int(q)));
                { const auto rr = __builtin_amdgcn_permlane32_swap(__float_as_uint(q), __float_as_uint(q), false, false); q = __uint_as_float(rr[0]) + __uint_as_float(rr[1]); }
                if (fq == 0) ssp_out[(size_t)row * 16 + u.pn * 4 + wc] = q;
                if (base32 && (m & 1)) asm volatile("" ::: "memory"); }
    }
};
struct EpiMoeOut {
    static constexpr bool PERM = true, AFTER_DRAIN = false;
    bf16_t* Y; const float* gate; float cs = 1.0f;
    __device__ __forceinline__ void operator()(const f32x4 (&acc)[2][2][4][2], const Unit& u, int wr, int wc, int fr, int fq) const {
        const int row0 = u.pm * BM + wr * 64 + fr, col0 = (u.pn & 3) * BM + wc * 32 + 8 * fq;
#pragma unroll
        for (int ai = 0; ai < 2; ++ai)
#pragma unroll
            for (int m = 0; m < 4; ++m) { const int row = row0 + ai * HALF + m * 16; const float gt = gate[row] * cs; bf16_t* rowp = Y + (size_t)row * 1024 + col0;
#pragma unroll
                for (int bj = 0; bj < 2; ++bj) { const f32x4 v0 = acc[ai][bj][m][0] * gt, v1 = acc[ai][bj][m][1] * gt;
                    u32x4 w; w.x = cvt_pk_bf16(v0[0], v0[1]); w.y = cvt_pk_bf16(v0[2], v0[3]); w.z = cvt_pk_bf16(v1[0], v1[1]); w.w = cvt_pk_bf16(v1[2], v1[3]);
                    *(u32x4*)(rowp + bj * HALF) = w; } }
    }
};
struct EpiNull {
    static constexpr bool PERM = true, AFTER_DRAIN = false;
    float* sink;
    __device__ __forceinline__ void operator()(const f32x4 (&acc)[2][2][4][2], const Unit& u, int wr, int wc, int fr, int fq) const {
        float s = 0.f;
#pragma unroll
        for (int ai = 0; ai < 2; ++ai)
#pragma unroll
            for (int bj = 0; bj < 2; ++bj)
#pragma unroll
                for (int m = 0; m < 4; ++m)
#pragma unroll
                    for (int n = 0; n < 2; ++n) s += (acc[ai][bj][m][n][0] + acc[ai][bj][m][n][1]) + (acc[ai][bj][m][n][2] + acc[ai][bj][m][n][3]);
        if (s == 12345.6789f) sink[u.pm * 4 + wr] = s;
    }
};
struct EpiMoePart {
    static constexpr bool PERM = true, AFTER_DRAIN = false;
    bf16_t* P; const float* gate; float cs = 1.0f; int kshift = 10;
    __device__ __forceinline__ void operator()(const f32x4 (&acc)[2][2][4][2], const Unit& u, int wr, int wc, int fr, int fq) const {
        const int row0 = u.pm * BM + wr * 64 + fr, col0 = (u.pn & 3) * BM + wc * 32 + 8 * fq; bf16_t* base = P + (size_t)(u.ko >> kshift) * (2048 * 1024);
#pragma unroll
        for (int ai = 0; ai < 2; ++ai)
#pragma unroll
            for (int m = 0; m < 4; ++m) { const int row = row0 + ai * HALF + m * 16; const float gt = gate[row] * cs; bf16_t* rowp = base + (size_t)(row - 65536) * 1024 + col0;
#pragma unroll
                for (int bj = 0; bj < 2; ++bj) { const f32x4 v0 = acc[ai][bj][m][0] * gt, v1 = acc[ai][bj][m][1] * gt;
                    u32x4 w; w.x = cvt_pk_bf16(v0[0], v0[1]); w.y = cvt_pk_bf16(v0[2], v0[3]); w.z = cvt_pk_bf16(v1[0], v1[1]); w.w = cvt_pk_bf16(v1[2], v1[3]);
                    *(u32x4*)(rowp + bj * HALF) = w; } }
    }
};
struct MoeTailOrder {
    int npieces, G, c; int te[8]; int kstep = 1024;
    __device__ __forceinline__ bool next(int i, Unit& u) const {
        const int p = i * G + c; if (p >= npieces) return false;
        const int tt = p / 7, kp = p - tt * 7; const int pm = 256 + (tt >> 2);
        int e = 0;
#pragma unroll
        for (int k = 0; k < 7; ++k) e += (pm >= te[k]) ? 1 : 0;
        u.pm = pm; u.pn = e * 4 + (tt & 3); u.ko = kp * kstep; return true;
    }
    __device__ __forceinline__ void a_ready(const Unit&) const {}
    __device__ __forceinline__ void done(const Unit&) const {}
};
struct TeamOrder {
    int pm, pn0, npn;
    __device__ __forceinline__ bool next(int i, Unit& u) const { if (i >= npn) return false; u.pm = pm; u.pn = pn0 + i; return true; }
    __device__ __forceinline__ void a_ready(const Unit&) const {}
    __device__ __forceinline__ void done(const Unit&) const {}
};
struct MoeOrder {
    StaticOrder so; int nNl; int te[8];
    __device__ __forceinline__ bool next(int i, Unit& u) const {
        if (!so.next(i, u)) return false;
        int e = 0;
#pragma unroll
        for (int k = 0; k < 7; ++k) e += (u.pm >= te[k]) ? 1 : 0;
        u.pn += e * nNl; return true;
    }
    __device__ __forceinline__ void a_ready(const Unit&) const {}
    __device__ __forceinline__ void done(const Unit&) const {}
};

template <class Epi, class Sched, bool ALIGN_EPI = false, bool SP2 = false, bool F8 = false>
__device__ __forceinline__ void gemm_phase(PG8_LAS unsigned char* lds, const Gemm g, const Sched& S, const Epi& E, const int tid) {
    const int wid = __builtin_amdgcn_readfirstlane(tid >> 6), lane = tid & 63, wr = wid >> 2, wc = wid & 3, fr = lane & 15, fq = lane >> 4;
    const int K = g.K, nt = K / BK, LD = g.ld ? g.ld : K;
    unsigned voffA[2], voffB[2];
#pragma unroll
    for (int i = 0; i < 2; ++i) { int R, C; stage_rc(tid * 16 + i * 8192, R, C); const int Rb = Epi::PERM ? ((R & ~31) + perm32(R & 31)) : R;
        voffA[i] = (unsigned)(R * LD + C) * 2u; voffB[i] = (unsigned)(Rb * LD + C) * 2u; }
    const size_t kstep = (size_t)(BK * 2);
    const size_t hstep = (size_t)HALF * LD * 2;
    const size_t tstep = 2 * hstep;
    const unsigned ldsw = (unsigned)wid * 1024u;
    const int aoff = lds_byte(wr * 64 + fr, fq * 8), boff = lds_byte(wc * 32 + fr, fq * 8);
#define PG8_SA(b, h) (((b) * 2 + (h)) * HTB)
#define PG8_SB(b, h) ((4 + (b) * 2 + (h)) * HTB)
#define PG8_STAGE(bufoff, gbase, voff) do { _Pragma("unroll") for (int _i = 0; _i < 2; ++_i) \
        __builtin_amdgcn_global_load_lds((const unsigned*)((const char*)(gbase) + (voff)[_i]), (PG8_LAS unsigned*)(lds + (bufoff) + ldsw + _i * 8192), 16, 0, 0); } while (0)
#define PG8_CAT8(x, y) __builtin_shufflevector(__builtin_bit_cast(v4i_t, x), __builtin_bit_cast(v4i_t, y), 0, 1, 2, 3, 4, 5, 6, 7)
#define PG8_LDA(dst, b, h) do { _Pragma("unroll") for (int m = 0; m < 4; ++m) { if constexpr (F8) dst##8[m] = PG8_CAT8(*(const PG8_LAS bf16x8*)(lds + PG8_SA(b, h) + aoff + m * 2048), *(const PG8_LAS bf16x8*)(lds + PG8_SA(b, h) + aoff + m * 2048 + 1024)); \
        else { _Pragma("unroll") for (int k = 0; k < 2; ++k) dst[m][k] = *(const PG8_LAS bf16x8*)(lds + PG8_SA(b, h) + aoff + m * 2048 + k * 1024); } } } while (0)
#define PG8_LDB(dst, b, h) do { _Pragma("unroll") for (int n = 0; n < 2; ++n) { if constexpr (F8) dst##8[n] = PG8_CAT8(*(const PG8_LAS bf16x8*)(lds + PG8_SB(b, h) + boff + n * 2048), *(const PG8_LAS bf16x8*)(lds + PG8_SB(b, h) + boff + n * 2048 + 1024)); \
        else { _Pragma("unroll") for (int k = 0; k < 2; ++k) dst[n][k] = *(const PG8_LAS bf16x8*)(lds + PG8_SB(b, h) + boff + n * 2048 + k * 1024); } } } while (0)
#define PG8_MMA(ai, bj, At, Bt) do { __builtin_amdgcn_s_setprio(1); _Pragma("unroll") for (int m = 0; m < 4; ++m) _Pragma("unroll") for (int n = 0; n < 2; ++n) { \
        if constexpr (F8) asm volatile("v_mfma_scale_f32_16x16x128_f8f6f4 %0, %1, %2, %0, %3, %3 op_sel_hi:[0,0,0]" : "+v"(acc[ai][bj][m][n]) : "v"(Bt##8[n]), "v"(At##8[m]), "v"(f8scale)); \
        else { _Pragma("unroll") for (int k = 0; k < 2; ++k) acc[ai][bj][m][n] = __builtin_amdgcn_mfma_f32_16x16x32_bf16(Bt[n][k], At[m][k], acc[ai][bj][m][n], 0, 0, 0); } } __builtin_amdgcn_s_setprio(0); } while (0)
#define PG8_WAIT_V(n) asm volatile("s_waitcnt vmcnt(" #n ")" ::: "memory")
#define PG8_WAIT_L(n) asm volatile("s_waitcnt lgkmcnt(" #n ")" ::: "memory")
#define PG8_BAR __builtin_amdgcn_s_barrier()
#define PG8_SCHED __builtin_amdgcn_sched_barrier(0)
    Unit cur, nxt; int ui = 0;
    if (!S.next(0, cur)) return;
    f32x4 acc[2][2][4][2];
#pragma unroll
    for (int a = 0; a < 2; ++a)
#pragma unroll
        for (int b = 0; b < 2; ++b)
#pragma unroll
            for (int m = 0; m < 4; ++m)
#pragma unroll
                for (int n = 0; n < 2; ++n) acc[a][b][m][n] = (f32x4){0.f, 0.f, 0.f, 0.f};
    const int f8scale = 0x7f7f7f7f;
    bf16x8 At[4][2], B0[2][2], B1[2][2]; v8i_t At8[4], B08[2], B18[2];
    const char* cA = (const char*)g.A + (size_t)cur.pm * tstep + cur.ko; const char* cB = (const char*)g.Bt + (size_t)cur.pn * tstep + cur.ko;
    S.a_ready(cur);
    if constexpr (SP2) {
        PG8_STAGE(PG8_SB(0, 0), cB, voffB); PG8_STAGE(PG8_SB(0, 1), cB + hstep, voffB); PG8_STAGE(PG8_SA(0, 0), cA, voffA); PG8_STAGE(PG8_SA(0, 1), cA + hstep, voffA);
        if (wr == 1) PG8_BAR;
        PG8_WAIT_V(2); PG8_BAR;
        PG8_STAGE(PG8_SB(1, 0), cB + kstep, voffB); PG8_STAGE(PG8_SA(1, 0), cA + kstep, voffA); PG8_STAGE(PG8_SB(1, 1), cB + hstep + kstep, voffB);
        PG8_WAIT_V(6); PG8_BAR;
    } else {
        PG8_STAGE(PG8_SB(0, 0), cB, voffB); PG8_STAGE(PG8_SA(0, 0), cA, voffA); PG8_STAGE(PG8_SB(0, 1), cB + hstep, voffB); PG8_STAGE(PG8_SA(0, 1), cA + hstep, voffA);
        if (wr == 1) PG8_BAR;
        PG8_WAIT_V(4); PG8_BAR;
        PG8_STAGE(PG8_SB(1, 0), cB + kstep, voffB); PG8_STAGE(PG8_SA(1, 0), cA + kstep, voffA); PG8_STAGE(PG8_SB(1, 1), cB + hstep + kstep, voffB);
        PG8_WAIT_V(6); PG8_BAR;
    }
    for (;;) {
        const bool has_next = S.next(ui + 1, nxt);
        const char* nA = has_next ? (const char*)g.A + (size_t)nxt.pm * tstep + nxt.ko : cA; const char* nB = has_next ? (const char*)g.Bt + (size_t)nxt.pn * tstep + nxt.ko : cB;
        for (int t = 0; t < nt; t += 2) {
            const bool last = (t == nt - 2);
            const char* a1 = cA + (size_t)(t + 1) * kstep;
            const char* a2 = last ? nA : cA + (size_t)(t + 2) * kstep; const char* b2 = last ? nB : cB + (size_t)(t + 2) * kstep;
            const char* a3 = a2 + kstep; const char* b3 = b2 + kstep;
            if (last && has_next) S.a_ready(nxt);
            if constexpr (SP2) {
            PG8_LDB(B0, 0, 0); PG8_LDB(B1, 0, 1); PG8_SCHED; PG8_LDA(At, 0, 0); PG8_STAGE(PG8_SA(1, 1), a1 + hstep, voffA);
            PG8_WAIT_V(8); PG8_WAIT_L(0); PG8_BAR; PG8_MMA(0, 0, At, B0); PG8_MMA(0, 1, At, B1); PG8_BAR; PG8_SCHED;
            PG8_LDA(At, 0, 1); PG8_STAGE(PG8_SB(0, 0), b2, voffB); PG8_STAGE(PG8_SB(0, 1), b2 + hstep, voffB); PG8_STAGE(PG8_SA(0, 0), a2, voffA);
            PG8_WAIT_V(8); PG8_WAIT_L(0); PG8_BAR; PG8_MMA(1, 0, At, B0); PG8_MMA(1, 1, At, B1); PG8_BAR; PG8_SCHED;
            PG8_LDB(B0, 1, 0); PG8_LDB(B1, 1, 1); PG8_SCHED; PG8_LDA(At, 1, 0); PG8_STAGE(PG8_SA(0, 1), a2 + hstep, voffA);
            PG8_WAIT_V(8); PG8_WAIT_L(0); PG8_BAR; PG8_MMA(0, 0, At, B0); PG8_MMA(0, 1, At, B1); PG8_BAR; PG8_SCHED;
            PG8_LDA(At, 1, 1); PG8_STAGE(PG8_SB(1, 0), b3, voffB); PG8_STAGE(PG8_SB(1, 1), b3 + hstep, voffB); PG8_STAGE(PG8_SA(1, 0), a3, voffA);
            PG8_WAIT_V(8); PG8_WAIT_L(0); PG8_BAR; PG8_MMA(1, 0, At, B0); PG8_MMA(1, 1, At, B1); PG8_BAR; PG8_SCHED;
            } else {
            PG8_LDB(B0, 0, 0); PG8_SCHED; PG8_LDA(At, 0, 0); PG8_STAGE(PG8_SA(1, 1), a1 + hstep, voffA);
            PG8_WAIT_L(8); PG8_BAR; PG8_WAIT_L(0); PG8_MMA(0, 0, At, B0); PG8_BAR; PG8_SCHED;
            PG8_LDB(B1, 0, 1); PG8_STAGE(PG8_SB(0, 0), b2, voffB);
            PG8_BAR; PG8_WAIT_L(0); PG8_MMA(0, 1, At, B1); PG8_BAR;
            PG8_LDA(At, 0, 1); PG8_STAGE(PG8_SA(0, 0), a2, voffA);
            PG8_BAR; PG8_WAIT_L(0); PG8_MMA(1, 0, At, B0); PG8_BAR; PG8_SCHED;
            PG8_STAGE(PG8_SB(0, 1), b2 + hstep, voffB);
            PG8_WAIT_V(6); PG8_BAR; PG8_MMA(1, 1, At, B1); PG8_BAR;
            PG8_LDB(B0, 1, 0); PG8_SCHED; PG8_LDA(At, 1, 0); PG8_STAGE(PG8_SA(0, 1), a2 + hstep, voffA);
            PG8_WAIT_L(8); PG8_BAR; PG8_WAIT_L(0); PG8_MMA(0, 0, At, B0); PG8_BAR; PG8_SCHED;
            PG8_LDB(B1, 1, 1); PG8_STAGE(PG8_SB(1, 0), b3, voffB);
            PG8_BAR; PG8_WAIT_L(0); PG8_MMA(0, 1, At, B1); PG8_BAR;
            PG8_LDA(At, 1, 1); PG8_STAGE(PG8_SA(1, 0), a3, voffA);
            PG8_BAR; PG8_WAIT_L(0); PG8_MMA(1, 0, At, B0); PG8_BAR; PG8_SCHED;
            PG8_STAGE(PG8_SB(1, 1), b3 + hstep, voffB);
            PG8_WAIT_V(6); PG8_BAR; PG8_MMA(1, 1, At, B1); PG8_BAR;
            }
        }
        if constexpr (ALIGN_EPI) { if (wr == 0) PG8_BAR; }
        if constexpr (F8) asm volatile("s_nop 15\n\ts_nop 15" ::: "memory");
        if constexpr (!Epi::AFTER_DRAIN) { int fr_ = fr, fq_ = fq; asm volatile("" : "+v"(fr_), "+v"(fq_)); E(acc, cur, wr, wc, fr_, fq_); S.done(cur); }
        if (!has_next) break;
#pragma unroll
        for (int a = 0; a < 2; ++a)
#pragma unroll
            for (int b = 0; b < 2; ++b)
#pragma unroll
                for (int m = 0; m < 4; ++m)
#pragma unroll
                    for (int n = 0; n < 2; ++n) acc[a][b][m][n] = (f32x4){0.f, 0.f, 0.f, 0.f};
        cur = nxt; cA = nA; cB = nB; ++ui;
        if constexpr (ALIGN_EPI) { if (wr == 1) PG8_BAR; }
    }
    PG8_WAIT_V(0);
    if constexpr (!ALIGN_EPI) { if (wr == 0) PG8_BAR; }
    PG8_BAR;
    if constexpr (Epi::AFTER_DRAIN) { E.fused(acc, cur, wr, wc, fr, fq, lds, wid, lane); S.done(cur); }
#undef PG8_SA
#undef PG8_SB
#undef PG8_STAGE
#undef PG8_LDA
#undef PG8_LDB
#undef PG8_MMA
#undef PG8_CAT8
#undef PG8_WAIT_V
#undef PG8_WAIT_L
#undef PG8_BAR
#undef PG8_SCHED
}
}
#define GAS __attribute__((address_space(1)))
#define LAS __attribute__((address_space(3)))
typedef unsigned short bf16;
typedef unsigned v4u __attribute__((ext_vector_type(4)));
typedef float f32x4 __attribute__((ext_vector_type(4)));
typedef short bf16x8 __attribute__((ext_vector_type(8)));
typedef GAS unsigned gu32;
typedef GAS unsigned long long gu64;
#define RLX_AGENT __ATOMIC_RELAXED, __HIP_MEMORY_SCOPE_AGENT
#define LDS_WAIT() asm volatile("s_waitcnt lgkmcnt(0)" ::: "memory")
#define VM_WAIT() asm volatile("s_waitcnt vmcnt(0)" ::: "memory")
__device__ __forceinline__ unsigned long long rt() { return __builtin_amdgcn_s_memrealtime(); }
__device__ __forceinline__ unsigned f2bf(float f) { unsigned u = __builtin_bit_cast(unsigned, f); return (u + 0x7fffu + ((u >> 16) & 1u)) >> 16; }
__device__ __forceinline__ unsigned pk2(float lo, float hi) { return f2bf(lo) | (f2bf(hi) << 16); }
#define XB_TMO      128
#define XB_XCNT(j)  (256  + 64 * (j))
#define XB_XSUB(j)  (1280 + 64 * (j))
#define XB_XGEN(j)  (2304 + 64 * (j))
#define XB_TOP      3328
#define XB_TOPGEN   3392
#define XCD_BAR_WORDS 3456
#define XB_SPIN_CAP (1u << 18)

__device__ __forceinline__ unsigned xb_ld(unsigned* p)              { return __hip_atomic_load(p, __ATOMIC_RELAXED, __HIP_MEMORY_SCOPE_AGENT); }
__device__ __forceinline__ unsigned xb_add(unsigned* p, unsigned v) { return __hip_atomic_fetch_add(p, v, __ATOMIC_RELAXED, __HIP_MEMORY_SCOPE_AGENT); }
__device__ __forceinline__ unsigned xb_xcc_id() { return (unsigned)__builtin_amdgcn_s_getreg((3 << 11) | 20) & 0xFu; }
#define XB_SPIN(cond, bar) do { unsigned _sp = 0; while (cond) { __builtin_amdgcn_s_sleep(1); \
    if ((++_sp & 255u) == 0u) { if (xb_ld(&(bar)[XB_TMO])) break; if (_sp > XB_SPIN_CAP) { atomicAdd(&(bar)[XB_TMO], 1u); break; } } } } while (0)

struct XcdBarrier {
    unsigned* bar; unsigned x;
    volatile LAS unsigned* st;
};

__device__ __forceinline__ XcdBarrier xcd_barrier_post(unsigned* bar, volatile LAS unsigned* st) {
    XcdBarrier b; b.bar = bar; b.x = xb_xcc_id(); b.st = st;
    if (threadIdx.x == 0) (void)xb_add(&bar[XB_XCNT(b.x)], 1u);
    return b;
}
__device__ __forceinline__ void xcd_barrier_complete(unsigned* bar, unsigned x, unsigned& nloc, unsigned& nx) {
    const unsigned G = gridDim.x * gridDim.y * gridDim.z;
    unsigned sum, cnt, mine, sp = 0u;
    for (;;) {
        sum = 0u; cnt = 0u; mine = 0u;
#pragma unroll
        for (unsigned j = 0; j < 16; ++j) { const unsigned c = xb_ld(&bar[XB_XCNT(j)]); sum += c; cnt += (c > 0u) ? 1u : 0u; mine = (j == x) ? c : mine; }
        if (sum == G) break;
        __builtin_amdgcn_s_sleep(1);
        if ((++sp & 255u) == 0u) { if (xb_ld(&bar[XB_TMO])) break; if (sp > XB_SPIN_CAP) { atomicAdd(&bar[XB_TMO], 1u); break; } }
    }
    nloc = mine > 0u ? mine : 1u; nx = cnt > 0u ? cnt : 1u;
}

__device__ __forceinline__ void xcd_barrier(const XcdBarrier& b) {
    asm volatile("s_waitcnt vmcnt(0)" ::: "memory");
    __syncthreads();
    if (threadIdx.x == 0) {
        unsigned* bar = b.bar;
        __builtin_amdgcn_s_waitcnt(0);
        unsigned nloc = b.st[0], nx = b.st[1];
        if (nloc == 0u) { xcd_barrier_complete(bar, b.x, nloc, nx); b.st[0] = nloc; b.st[1] = nx; }
        const unsigned old = xb_add(&bar[XB_XSUB(b.x)], 1u);
        const unsigned gen = old / nloc;
        if (old + 1u == (gen + 1u) * nloc) {
            __builtin_amdgcn_fence(__ATOMIC_RELEASE, "agent");
            asm volatile("s_waitcnt vmcnt(0)" ::: "memory");
            const unsigned og = xb_add(&bar[XB_TOP], 1u);
            const unsigned tg = og / nx;
            if (og + 1u == (tg + 1u) * nx) xb_add(&bar[XB_TOPGEN], 1u);
            else XB_SPIN(xb_ld(&bar[XB_TOPGEN]) == tg, bar);
            __builtin_amdgcn_fence(__ATOMIC_ACQUIRE, "agent");
            xb_add(&bar[XB_XGEN(b.x)], 1u);
            asm volatile("s_waitcnt vmcnt(0)" ::: "memory");
        } else {
            XB_SPIN(xb_ld(&bar[XB_XGEN(b.x)]) == gen, bar);
            __builtin_amdgcn_fence(__ATOMIC_ACQUIRE, "agent");
            asm volatile("s_waitcnt vmcnt(0)" ::: "memory");
        }
    }
    __syncthreads();
}
constexpr int NWAVES = 8;
constexpr int BATCH = 4, SEQ = 8192, D = 1024, T = BATCH * SEQ, DEPTH = 4, MEML = 256, MROWS = BATCH * MEML;
constexpr int NPROJ = 2560, FFD = 2816, FFE = 3584, NEXP = 8, XW = 512;
constexpr int MP = 2 * T + NEXP * 256;
constexpr float F8_S1 = 16.0f, F8_S2 = 32.0f, F8_SH = 4.0f;
constexpr int NKEYS = 321;
constexpr int NPH = 1 + 8 + 11 + 8 + 11;
constexpr int PC_Q = 0, PC_K = 512, PC_V = 1024, PC_POOL = 1536, PC_BG = 1792, PC_CG = 2048, PC_HC = 2304;
constexpr size_t MiB = 1u << 20;
constexpr size_t WS_CTL = 0, CTL_ZERO_BYTES = 64 * 1024;
constexpr size_t WS_PWT = 256 * 1024;
constexpr size_t WS_CNT = 1 * MiB, WS_META = 1 * MiB + 64 * 1024;
constexpr size_t WS_TOKE = 1 * MiB + 512 * 1024, WS_TOKG = 2 * MiB, WS_TOKPOS = 2 * MiB + 512 * 1024, WS_ROWGATE = 3 * MiB, WS_ROWRS = 3 * MiB + 512 * 1024;
constexpr size_t WS_SSP = 4 * MiB;
constexpr size_t WS_KVX = 30 * MiB, WS_MEMN = 38 * MiB;
constexpr size_t WS_WIN = 40 * MiB, WS_WOUT = 60 * MiB, WS_WQ = 68 * MiB, WS_WKV = 72 * MiB, WS_WO = 80 * MiB, WS_W13D = 84 * MiB, WS_W2D = 106 * MiB, WS_W13M = 117 * MiB, WS_W2M = 341 * MiB;
constexpr size_t WS_XB = 453 * MiB, WS_QX = 517 * MiB, WS_OX = 549 * MiB, WS_AG = 581 * MiB, WS_YM = 713 * MiB, WS_RA = 977 * MiB, WS_VTX = 1439 * MiB, WS_END = 1443 * MiB;
constexpr size_t WS_PROJ = WS_RA, WS_Y = WS_RA + 160 * MiB, WS_H = WS_RA, WS_VT = WS_RA + 224 * MiB, WS_OPART = WS_RA + 320 * MiB, WS_LSE = WS_RA + 416 * MiB;
constexpr size_t VT_STRIDE = (size_t)T * 512, OP_STRIDE = (size_t)T * 512;
static_assert(WS_AG + (size_t)MP * D * 2 <= WS_YM && WS_YM + (size_t)MP * D * 4 <= WS_RA && WS_RA + (size_t)MP * FFE * 2 <= WS_VTX, "ws map");
constexpr int CW_BAR = 4096, CW_TEAM = 8192;
constexpr size_t WS_XCCTAB = 128 * 1024;
constexpr int RING_BYTES = 131072, LDSCTL_OFF = 159744, MISC_OFF = LDSCTL_OFF + 320, LDS_BYTES = 163840;

__device__ __forceinline__ float shx(float v, int mask, int lane) { return __int_as_float(__builtin_amdgcn_ds_bpermute((lane ^ mask) << 2, __float_as_int(v))); }
__device__ __forceinline__ float xsum32(float v) { const auto rr = __builtin_amdgcn_permlane32_swap(__float_as_uint(v), __float_as_uint(v), false, false); return __uint_as_float(rr[0]) + __uint_as_float(rr[1]); }
__device__ __forceinline__ float xmax32(float v) { const auto rr = __builtin_amdgcn_permlane32_swap(__float_as_uint(v), __float_as_uint(v), false, false); return fmaxf(__uint_as_float(rr[0]), __uint_as_float(rr[1])); }
__device__ __forceinline__ float wave_sum(float v, int lane) {
#pragma unroll
    for (int o = 1; o < 32; o <<= 1) v += shx(v, o, lane);
    return xsum32(v);
}
__device__ __forceinline__ float bflo(unsigned u) { return __uint_as_float(u << 16); }
__device__ __forceinline__ float bfhi(unsigned u) { return __uint_as_float(u & 0xffff0000u); }
__device__ __forceinline__ float bf1(bf16 h) { return __uint_as_float(((unsigned)h) << 16); }
__device__ __forceinline__ float dot8(v4u a, v4u b) {
    return (bflo(a.x) * bflo(b.x) + bfhi(a.x) * bfhi(b.x)) + (bflo(a.y) * bflo(b.y) + bfhi(a.y) * bfhi(b.y)) + (bflo(a.z) * bflo(b.z) + bfhi(a.z) * bfhi(b.z)) + (bflo(a.w) * bflo(b.w) + bfhi(a.w) * bfhi(b.w));
}
__device__ __forceinline__ int key_dist(int i) { return i < 129 ? i : (i < 225 ? 132 + 4 * (i - 129) : 528 + 16 * (i - 225)); }
__device__ __forceinline__ int key_mult(int d) { return d <= 128 ? 1 + ((d & 3) == 0 ? 1 : 0) + ((d & 15) == 0 ? 1 : 0) : (d <= 512 ? 1 + ((d & 15) == 0 ? 1 : 0) : 1); }
__device__ __forceinline__ int t5_bucket(int d) {
    if (d < 16) return d;
    int b = 16 + (int)(logf((float)d / 16.0f) / logf(8.0f) * 16.0f);
    return b < 31 ? b : 31;
}

struct Args { const float* in[21]; float* out; unsigned char* ws; int ph_lo, ph_hi; };

__device__ __forceinline__ void conv_item(const float* W, int K, int N, bf16* WT, const float* gain, int swF, LAS float* scr, int item, int lane) {
    const int nblk = N / 64, kb = item / nblk, nb = item % nblk, k0 = 64 * kb, n0 = 64 * nb;
    float wv[64];
#pragma unroll
    for (int i = 0; i < 64; ++i) wv[i] = W[(size_t)(k0 + i) * N + n0 + lane];
    if (gain) {
#pragma unroll
        for (int i = 0; i < 64; ++i) wv[i] *= gain[k0 + i]; }
#pragma unroll
    for (int i = 0; i < 64; ++i) scr[i * 65 + lane] = wv[i];
    LDS_WAIT(); asm volatile("" ::: "memory");
    int orow0 = n0;
    if (swF) { const int isup = n0 >= swF ? 1 : 0; const int j = n0 - isup * swF; orow0 = (j >> 7) * 256 + isup * 128 + (j & 127); }
    const int c = lane & 7;
#pragma unroll
    for (int j = 0; j < 8; ++j) { const int n = (lane >> 3) + 8 * j; const LAS float* s = scr + (8 * c) * 65 + n;
        v4u o; o.x = pk2(s[0 * 65], s[1 * 65]); o.y = pk2(s[2 * 65], s[3 * 65]); o.z = pk2(s[4 * 65], s[5 * 65]); o.w = pk2(s[6 * 65], s[7 * 65]);
        *(GAS v4u*)(WT + (size_t)(orow0 + n) * K + k0 + 8 * c) = o; }
    LDS_WAIT(); asm volatile("" ::: "memory");
}

typedef unsigned u32x2 __attribute__((ext_vector_type(2)));
__device__ __forceinline__ void conv_item8(const float* W, int K, int N, unsigned char* WT, const float* gain, int swF, float scale, LAS float* scr, int item, int lane) {
    const int nblk = N / 64, kb = item / nblk, nb = item % nblk, k0 = 64 * kb, n0 = 64 * nb;
    float wv[64];
#pragma unroll
    for (int i = 0; i < 64; ++i) wv[i] = W[(size_t)(k0 + i) * N + n0 + lane];
#pragma unroll
    for (int i = 0; i < 64; ++i) wv[i] *= gain ? gain[k0 + i] * scale : scale;
#pragma unroll
    for (int i = 0; i < 64; ++i) scr[i * 65 + lane] = wv[i];
    LDS_WAIT(); asm volatile("" ::: "memory");
    int orow0 = n0;
    if (swF) { const int isup = n0 >= swF ? 1 : 0; const int j = n0 - isup * swF; orow0 = (j >> 7) * 256 + isup * 128 + (j & 127); }
    const int c = lane & 7;
#pragma unroll
    for (int j = 0; j < 8; ++j) { const int n = (lane >> 3) + 8 * j; const LAS float* s = scr + (8 * c) * 65 + n;
        u32x2 o; o.x = pg8::pk4_fp8_w(s[0 * 65], s[1 * 65], s[2 * 65], s[3 * 65]); o.y = pg8::pk4_fp8_w(s[4 * 65], s[5 * 65], s[6 * 65], s[7 * 65]);
        *(GAS u32x2*)(WT + (size_t)(orow0 + n) * K + k0 + 8 * c) = o; }
    LDS_WAIT(); asm volatile("" ::: "memory");
}

typedef float f32x16 __attribute__((ext_vector_type(16)));
typedef float f32x2_t __attribute__((ext_vector_type(2))); typedef __bf16 bf16x2_t __attribute__((ext_vector_type(2)));
__device__ __forceinline__ unsigned cvtpk(float lo, float hi) { f32x2_t v = {lo, hi}; bf16x2_t b = __builtin_convertvector(v, bf16x2_t); return __builtin_bit_cast(unsigned, b); }
__device__ __forceinline__ bf16x8 mk8(unsigned a, unsigned b, unsigned c, unsigned d) { v4u t = {a, b, c, d}; return __builtin_bit_cast(bf16x8, t); }
__device__ __forceinline__ bf16x8 mk8u2(u32x2 lo, u32x2 hi) { v4u t = {lo.x, lo.y, hi.x, hi.y}; return __builtin_bit_cast(bf16x8, t); }
#define NEGINF (-__builtin_inff())
constexpr int BT_LD = 200, BT_OFF = 32;
__device__ __forceinline__ void dil_load_k(bf16x8 (&kf)[4], const bf16* pj, int sh, int b, int h, int r, int k0, int q, int hh) {
    const int sg = (q & ~12) | ((q & 4) << 1) | ((q & 8) >> 1);
    const int tk = b * SEQ + r + ((k0 + sg) << sh);
    const bf16* kp = pj + (size_t)tk * NPROJ + PC_K + h * 64 + 32 * hh;
#pragma unroll
    for (int ks = 0; ks < 4; ++ks) kf[ks] = *(const GAS bf16x8*)(kp + 8 * ks);
}
__device__ __forceinline__ void dil_load_v(bf16x8 (&vf)[2][2], const bf16* vrow, int sh, int k0) {
#pragma unroll
    for (int db = 0; db < 2; ++db)
#pragma unroll
        for (int s2 = 0; s2 < 2; ++s2) { const bf16* vp = vrow + (size_t)db * 32 * SEQ + (sh == 4 ? ((k0 >> 4) + s2) * 256 : k0 + 16 * s2); vf[db][s2] = *(const GAS bf16x8*)vp; }
}
__device__ __forceinline__ void dil_blk(const bf16x8 (&kf)[4], const bf16x8 (&vf)[2][2], const bf16x8 (&qf)[4], f32x16& O0, f32x16& O1, float& m, float& l, const LAS float* btl) {
    f32x16 st;
#pragma unroll
    for (int i = 0; i < 16; ++i) st[i] = 0.f;
#pragma unroll
    for (int ks = 0; ks < 4; ++ks) st = __builtin_amdgcn_mfma_f32_32x32x16_bf16(kf[ks], qf[ks], st, 0, 0, 0);
    float mx = NEGINF;
#pragma unroll
    for (int i = 0; i < 16; ++i) { st[i] = st[i] * 0.18033688011112042f + btl[23 - (16 * (i >> 3) + 4 * ((i >> 2) & 1) + (i & 3))]; mx = fmaxf(mx, st[i]); }
    { const auto rr = __builtin_amdgcn_permlane32_swap(__float_as_uint(mx), __float_as_uint(mx), false, false); mx = fmaxf(__uint_as_float(rr[0]), __uint_as_float(rr[1])); }
    const float mn = fmaxf(m, mx), ms = mn == NEGINF ? 0.f : mn, alpha = __builtin_amdgcn_exp2f(m - ms);
    float ls = 0.f;
#pragma unroll
    for (int i = 0; i < 16; ++i) { st[i] = __builtin_amdgcn_exp2f(st[i] - ms); ls += st[i]; }
    l = l * alpha + ls; m = mn;
#pragma unroll
    for (int i = 0; i < 16; ++i) { O0[i] *= alpha; O1[i] *= alpha; }
    const bf16x8 p0 = mk8(cvtpk(st[0], st[1]), cvtpk(st[2], st[3]), cvtpk(st[4], st[5]), cvtpk(st[6], st[7]));
    const bf16x8 p1 = mk8(cvtpk(st[8], st[9]), cvtpk(st[10], st[11]), cvtpk(st[12], st[13]), cvtpk(st[14], st[15]));
    O0 = __builtin_amdgcn_mfma_f32_32x32x16_bf16(vf[0][0], p0, O0, 0, 0, 0); O0 = __builtin_amdgcn_mfma_f32_32x32x16_bf16(vf[0][1], p1, O0, 0, 0, 0);
    O1 = __builtin_amdgcn_mfma_f32_32x32x16_bf16(vf[1][0], p0, O1, 0, 0, 0); O1 = __builtin_amdgcn_mfma_f32_32x32x16_bf16(vf[1][1], p1, O1, 0, 0, 0);
}
__device__ __forceinline__ void dil_store(const f32x16& O0, const f32x16& O1, float m, float l, bf16* opart, float* lsep, int tq, int h, int hh) {
    l = xsum32(l);
    const float inv = l > 0.f ? 1.0f / l : 0.f;
    bf16* op = opart + (size_t)tq * 512 + h * 64 + 4 * hh;
#pragma unroll
    for (int g4 = 0; g4 < 4; ++g4) {
        u32x2 w0, w1; w0.x = cvtpk(O0[4 * g4] * inv, O0[4 * g4 + 1] * inv); w0.y = cvtpk(O0[4 * g4 + 2] * inv, O0[4 * g4 + 3] * inv);
        w1.x = cvtpk(O1[4 * g4] * inv, O1[4 * g4 + 1] * inv); w1.y = cvtpk(O1[4 * g4 + 2] * inv, O1[4 * g4 + 3] * inv);
        *(GAS u32x2*)(op + 8 * g4) = w0; *(GAS u32x2*)(op + 32 + 8 * g4) = w1; }
    if (hh == 0) lsep[(size_t)tq * 8 + h] = l > 0.f ? (m + __builtin_amdgcn_logf(l)) * 0.6931471805599453f : NEGINF;
}
template <int JLO>
__device__ __forceinline__ void dil_unit32(const bf16* pj, const bf16* vt, bf16* opart, float* lsep, const LAS float* bt, int sh, int b, int h, int r, int n0, bool do_store) {
    constexpr int NT = JLO == 0 ? 5 : 4;
    int lane; asm volatile("v_mbcnt_lo_u32_b32 %0, -1, 0\n\tv_mbcnt_hi_u32_b32 %0, -1, %0" : "=v"(lane));
    const int q = lane & 31, hh = lane >> 5;
    const int L = SEQ >> sh;
    const int tq = b * SEQ + r + ((n0 + q) << sh);
    bf16x8 qf[4];
    { const bf16* qp = pj + (size_t)tq * NPROJ + PC_Q + h * 64 + 32 * hh;
#pragma unroll
      for (int ks = 0; ks < 4; ++ks) qf[ks] = *(const GAS bf16x8*)(qp + 8 * ks); }
    f32x16 O0, O1;
#pragma unroll
    for (int i = 0; i < 16; ++i) { O0[i] = 0.f; O1[i] = 0.f; }
    float m = NEGINF, l = 0.f;
    const bf16* vrow = vt + ((size_t)((b * 8 + h) * 64 + q) * SEQ) + (sh == 4 ? r * 16 : r * L) + 8 * hh;
    bf16x8 kf[2][4], vf[2][2][2];
    { const int k0 = n0 - 128 < 0 ? 0 : n0 - 128; dil_load_k(kf[0], pj, sh, b, h, r, k0, q, hh); dil_load_v(vf[0], vrow, sh, k0); }
#pragma unroll
    for (int t = 0; t < NT; ++t) {
        const int k0 = n0 - 128 + 32 * t;
        if (t + 1 < NT) { const int k1 = k0 + 32 < 0 ? 0 : k0 + 32; dil_load_k(kf[(t + 1) & 1], pj, sh, b, h, r, k1, q, hh); dil_load_v(vf[(t + 1) & 1], vrow, sh, k1); }
        const int jq = k0 < 0 ? 160 : q - 8 * hh + 128 - 32 * t;
        dil_blk(kf[t & 1], vf[t & 1], qf, O0, O1, m, l, bt + jq + BT_OFF - 23);
    }
    if (do_store) dil_store(O0, O1, m, l, opart, lsep, tq, h, hh);
}

constexpr int DK_PITCH = 144, DV_PITCH = 784, DK_BYTES = 384 * DK_PITCH, DV_BYTES = 64 * DV_PITCH;
__device__ __forceinline__ void dil_stage_load_k(v4u (&sk)[6], const bf16* pj, int sh, int b, int h, int r, int n0, int tid) {
    const int ws = n0 - 128;
#pragma unroll
    for (int k = 0; k < 6; ++k) { const int idx = tid + 512 * k, row = idx >> 3, ch = idx & 7; int kk = ws + row; kk = kk < 0 ? 0 : kk;
        sk[k] = *(const GAS v4u*)(pj + (size_t)(b * SEQ + r + (kk << sh)) * NPROJ + PC_K + h * 64 + ch * 8); }
}
__device__ __forceinline__ void dil_stage_load_v(v4u (&sv)[6], const bf16* pj, int sh, int b, int h, int r, int n0, int tid) {
    const int ws = n0 - 128;
#pragma unroll
    for (int k = 0; k < 6; ++k) { const int idx = tid + 512 * k, row = idx >> 3, ch = idx & 7; int kk = ws + row; kk = kk < 0 ? 0 : kk;
        sv[k] = *(const GAS v4u*)(pj + (size_t)(b * SEQ + r + (kk << sh)) * NPROJ + PC_V + h * 64 + ch * 8); }
}
__device__ __forceinline__ void dil_stage_write_k(LAS unsigned char* lds, const v4u (&sk)[6], int tid) {
#pragma unroll
    for (int k = 0; k < 6; ++k) { const int idx = tid + 512 * k, row = idx >> 3, ch = idx & 7; *(LAS v4u*)(lds + row * DK_PITCH + ch * 16) = sk[k]; }
}
__device__ __forceinline__ void dil_stage_write_v(LAS unsigned char* lds, const v4u (&sv)[6], int tid) {
#pragma unroll
    for (int k = 0; k < 6; ++k) { const int idx = tid + 512 * k, row = idx >> 3, ch = idx & 7;
        LAS unsigned short* d = (LAS unsigned short*)(lds + DK_BYTES + (8 * ch) * DV_PITCH + ((((row >> 3) ^ ch) << 3) | (row & 7)) * 2);
        d[0] = (unsigned short)(sv[k].x & 0xffffu); d[DV_PITCH / 2] = (unsigned short)(sv[k].x >> 16); d[2 * (DV_PITCH / 2)] = (unsigned short)(sv[k].y & 0xffffu); d[3 * (DV_PITCH / 2)] = (unsigned short)(sv[k].y >> 16);
        d[4 * (DV_PITCH / 2)] = (unsigned short)(sv[k].z & 0xffffu); d[5 * (DV_PITCH / 2)] = (unsigned short)(sv[k].z >> 16); d[6 * (DV_PITCH / 2)] = (unsigned short)(sv[k].w & 0xffffu); d[7 * (DV_PITCH / 2)] = (unsigned short)(sv[k].w >> 16); }
}
template <int JLO>
__device__ __forceinline__ void dil_wg_compute(const LAS unsigned char* lds, const bf16x8 (&qf)[4], bf16* opart, float* lsep, const LAS float* bt, int tq, int h, int k00, int lane, int wave, bool do_store) {
    constexpr int NT = JLO == 0 ? 5 : 4;
    asm volatile("" : "+v"(lane));
    const int q = lane & 31, hh = lane >> 5;
    f32x16 O0, O1;
#pragma unroll
    for (int i = 0; i < 16; ++i) { O0[i] = 0.f; O1[i] = 0.f; }
    float m = NEGINF, l = 0.f;
    const int sg = (q & ~12) | ((q & 4) << 1) | ((q & 8) >> 1);
    const LAS unsigned char* kl = lds + (32 * wave + sg) * DK_PITCH + 64 * hh;
    const LAS unsigned char* vl = lds + DK_BYTES + q * DV_PITCH;
    bf16x8 kf[2][4], vf[2][2][2];
#define DIL_LDFRAG(t_) do { _Pragma("unroll") for (int ks = 0; ks < 4; ++ks) kf[(t_) & 1][ks] = *(const LAS bf16x8*)(kl + (t_) * 32 * DK_PITCH + 16 * ks); \
        _Pragma("unroll") for (int db = 0; db < 2; ++db) _Pragma("unroll") for (int s2 = 0; s2 < 2; ++s2) \
            vf[(t_) & 1][db][s2] = *(const LAS bf16x8*)(vl + db * 32 * DV_PITCH + (((4 * wave + 4 * (t_) + 2 * s2 + hh) ^ (((32 * db + q) >> 3) & 7)) << 4)); } while (0)
    DIL_LDFRAG(0);
#pragma unroll
    for (int t = 0; t < NT; ++t) {
        if (t + 1 < NT) DIL_LDFRAG(t + 1);
        const int jq = k00 + 32 * t < 0 ? 160 : q - 8 * hh + 128 - 32 * t;
        dil_blk(kf[t & 1], vf[t & 1], qf, O0, O1, m, l, bt + jq + BT_OFF - 23);
        __builtin_amdgcn_sched_barrier(0);
    }
#undef DIL_LDFRAG
    if (do_store) dil_store(O0, O1, m, l, opart, lsep, tq, h, hh);
}

__device__ __forceinline__ void xat_unit(const bf16* qxp, const bf16* kb, const bf16* vtb, bf16* oxp, int t0, int h, int lane) {
    const int q = lane & 31, hh = lane >> 5;
    bf16x8 qf[8];
    { const bf16* qp = qxp + (size_t)(t0 + q) * XW + h * 128 + 64 * hh;
#pragma unroll
      for (int ks = 0; ks < 8; ++ks) qf[ks] = *(const GAS bf16x8*)(qp + 8 * ks); }
    f32x16 O[4];
#pragma unroll
    for (int d = 0; d < 4; ++d)
#pragma unroll
        for (int i = 0; i < 16; ++i) O[d][i] = 0.f;
    float m = NEGINF, l = 0.f;
    const bf16* vrow = vtb + (size_t)(h * 128 + q) * MEML + 4 * hh;
    for (int k0 = 0; k0 < MEML; k0 += 32) {
        const bf16* kp = kb + (size_t)(k0 + q) * 4096 + h * 128 + 64 * hh;
        f32x16 st;
#pragma unroll
        for (int i = 0; i < 16; ++i) st[i] = 0.f;
#pragma unroll
        for (int ks = 0; ks < 8; ++ks) st = __builtin_amdgcn_mfma_f32_32x32x16_bf16(*(const GAS bf16x8*)(kp + 8 * ks), qf[ks], st, 0, 0, 0);
        bf16x8 vf[4][2];
#pragma unroll
        for (int db = 0; db < 4; ++db)
#pragma unroll
            for (int s2 = 0; s2 < 2; ++s2) { const bf16* vp = vrow + (size_t)db * 32 * MEML + k0 + 16 * s2; vf[db][s2] = mk8u2(*(const GAS u32x2*)vp, *(const GAS u32x2*)(vp + 8)); }
        float mx = st[0];
#pragma unroll
        for (int i = 1; i < 16; ++i) mx = fmaxf(mx, st[i]);
        mx = xmax32(mx);
        const float mn = fmaxf(m, mx), alpha = __expf(m - mn);
        float ls = 0.f;
#pragma unroll
        for (int i = 0; i < 16; ++i) { st[i] = __expf(st[i] - mn); ls += st[i]; }
        l = l * alpha + ls; m = mn;
#pragma unroll
        for (int d = 0; d < 4; ++d)
#pragma unroll
            for (int i = 0; i < 16; ++i) O[d][i] *= alpha;
        const bf16x8 p0 = mk8(cvtpk(st[0], st[1]), cvtpk(st[2], st[3]), cvtpk(st[4], st[5]), cvtpk(st[6], st[7]));
        const bf16x8 p1 = mk8(cvtpk(st[8], st[9]), cvtpk(st[10], st[11]), cvtpk(st[12], st[13]), cvtpk(st[14], st[15]));
#pragma unroll
        for (int d = 0; d < 4; ++d) { O[d] = __builtin_amdgcn_mfma_f32_32x32x16_bf16(vf[d][0], p0, O[d], 0, 0, 0); O[d] = __builtin_amdgcn_mfma_f32_32x32x16_bf16(vf[d][1], p1, O[d], 0, 0, 0); }
    }
    l = xsum32(l);
    const float inv = 1.0f / l;
    bf16* op = oxp + (size_t)(t0 + q) * XW + h * 128 + 4 * hh;
#pragma unroll
    for (int d = 0; d < 4; ++d)
#pragma unroll
        for (int g4 = 0; g4 < 4; ++g4) { u32x2 w; w.x = cvtpk(O[d][4 * g4] * inv, O[d][4 * g4 + 1] * inv); w.y = cvtpk(O[d][4 * g4 + 2] * inv, O[d][4 * g4 + 3] * inv); *(GAS u32x2*)(op + 32 * d + 8 * g4) = w; }
}

constexpr int XK_PITCH = 272, XV_PITCH = 528, XK_BYTES = 256 * XK_PITCH, XV_BYTES = 128 * XV_PITCH;
__device__ __forceinline__ void xat_wg_unit(LAS unsigned char* lds, const bf16* qxp, const bf16* kb, const bf16* vtb, bf16* oxp, int t0, int h, int tid) {
    const int lane = tid & 63, q = lane & 31, hh = lane >> 5;
    __syncthreads();
#pragma unroll
    for (int k = 0; k < 8; ++k) { const int idx = tid + 512 * k, row = idx >> 4, ch = idx & 15;
        const v4u x = *(const GAS v4u*)(kb + (size_t)row * 4096 + h * 128 + ch * 8); *(LAS v4u*)(lds + row * XK_PITCH + ch * 16) = x; }
#pragma unroll
    for (int k = 0; k < 8; ++k) { const int idx = tid + 512 * k, row = idx >> 5, ch = idx & 31;
        const v4u x = *(const GAS v4u*)(vtb + (size_t)(h * 128 + row) * MEML + ch * 8); *(LAS v4u*)(lds + XK_BYTES + row * XV_PITCH + ch * 16) = x; }
    bf16x8 qf[8];
    { const bf16* qp = qxp + (size_t)(t0 + q) * XW + h * 128 + 64 * hh;
#pragma unroll
      for (int ks = 0; ks < 8; ++ks) qf[ks] = *(const GAS bf16x8*)(qp + 8 * ks); }
    __syncthreads();
    f32x16 O[4];
#pragma unroll
    for (int d = 0; d < 4; ++d)
#pragma unroll
        for (int i = 0; i < 16; ++i) O[d][i] = 0.f;
    float m = NEGINF, l = 0.f;
    const int sg = (q & ~12) | ((q & 4) << 1) | ((q & 8) >> 1);
    const LAS unsigned char* kl = lds + sg * XK_PITCH + 128 * hh;
    const LAS unsigned char* vl = lds + XK_BYTES + q * XV_PITCH + 16 * hh;
#pragma unroll
    for (int kt = 0; kt < 8; ++kt) {
        f32x16 st;
#pragma unroll
        for (int i = 0; i < 16; ++i) st[i] = 0.f;
#pragma unroll
        for (int ks = 0; ks < 8; ++ks) st = __builtin_amdgcn_mfma_f32_32x32x16_bf16(*(const LAS bf16x8*)(kl + kt * 32 * XK_PITCH + ks * 16), qf[ks], st, 0, 0, 0);
        float mx = st[0];
#pragma unroll
        for (int i = 1; i < 16; ++i) mx = fmaxf(mx, st[i]);
        mx = xmax32(mx);
        const float mn = fmaxf(m, mx), alpha = __builtin_amdgcn_exp2f((m - mn) * 1.4426950408889634f);
        float ls = 0.f;
#pragma unroll
        for (int i = 0; i < 16; ++i) { st[i] = __builtin_amdgcn_exp2f((st[i] - mn) * 1.4426950408889634f); ls += st[i]; }
        l = l * alpha + ls; m = mn;
#pragma unroll
        for (int d = 0; d < 4; ++d)
#pragma unroll
            for (int i = 0; i < 16; ++i) O[d][i] *= alpha;
        const bf16x8 p0 = mk8(cvtpk(st[0], st[1]), cvtpk(st[2], st[3]), cvtpk(st[4], st[5]), cvtpk(st[6], st[7]));
        const bf16x8 p1 = mk8(cvtpk(st[8], st[9]), cvtpk(st[10], st[11]), cvtpk(st[12], st[13]), cvtpk(st[14], st[15]));
#pragma unroll
        for (int d = 0; d < 4; ++d) { const LAS unsigned char* vp = vl + d * 32 * XV_PITCH + kt * 64;
            O[d] = __builtin_amdgcn_mfma_f32_32x32x16_bf16(*(const LAS bf16x8*)vp, p0, O[d], 0, 0, 0); O[d] = __builtin_amdgcn_mfma_f32_32x32x16_bf16(*(const LAS bf16x8*)(vp + 32), p1, O[d], 0, 0, 0); }
    }
    l = xsum32(l);
    const float inv = 1.0f / l;
    bf16* op = oxp + (size_t)(t0 + q) * XW + h * 128 + 4 * hh;
#pragma unroll
    for (int d = 0; d < 4; ++d)
#pragma unroll
        for (int g4 = 0; g4 < 4; ++g4) { u32x2 w; w.x = cvtpk(O[d][4 * g4] * inv, O[d][4 * g4 + 1] * inv); w.y = cvtpk(O[d][4 * g4 + 2] * inv, O[d][4 * g4 + 3] * inv); *(GAS u32x2*)(op + 32 * d + 8 * g4) = w; }
}

__device__ __forceinline__ void pool_unit(const bf16* pj, const bf16* pwT, const float* psc, bf16* ymixp, int t0, int lane, LAS unsigned char* scr) {
    constexpr int PITCH = 144;
    const int q = lane & 31, hh = lane >> 5; const int t = t0 + q, pos = t & (SEQ - 1), pos0 = t0 & (SEQ - 1);
    const int sr = lane >> 3, sc = lane & 7;
    v4u st[6];
#define POOL_LD(g_) do { _Pragma("unroll") for (int k = 0; k < 6; ++k) { const int r = 8 * k + sr, w_ = 2 << (g_); const bool ok = pos0 - (w_ - 1) + r >= 0 && r < 31 + w_; \
        st[k] = *(const GAS v4u*)(pj + (size_t)(ok ? t0 - (w_ - 1) + r : t0) * NPROJ + PC_POOL + (g_) * 64 + 8 * sc); if (!ok) st[k] = (v4u){0u, 0u, 0u, 0u}; } } while (0)
    POOL_LD(0);
#pragma unroll
    for (int g = 0; g < 4; ++g) {
        const int w = 2 << g; const float rn = 1.0f / (float)(pos + 1 < w ? pos + 1 : w);
#pragma unroll
        for (int k = 0; k < 6; ++k) *(LAS v4u*)(scr + (8 * k + sr) * PITCH + 16 * sc) = st[k];
        if (g < 3) POOL_LD(g + 1);
        f32x16 D0, D1;
#pragma unroll
        for (int i = 0; i < 16; ++i) { D0[i] = 0.f; D1[i] = 0.f; }
#pragma unroll
        for (int ks = 0; ks < 4; ++ks) {
            const LAS unsigned char* p0 = scr + (q + w - 1) * PITCH + 16 * (2 * ks + hh);
            const v4u x0 = *(const LAS v4u*)p0;
            float a0 = bflo(x0.x), a1 = bfhi(x0.x), a2 = bflo(x0.y), a3 = bfhi(x0.y), a4 = bflo(x0.z), a5 = bfhi(x0.z), a6 = bflo(x0.w), a7 = bfhi(x0.w);
#pragma unroll
            for (int i = 1; i < w; ++i) { const v4u xi = *(const LAS v4u*)(p0 - i * PITCH);
                a0 += bflo(xi.x); a1 += bfhi(xi.x); a2 += bflo(xi.y); a3 += bfhi(xi.y); a4 += bflo(xi.z); a5 += bfhi(xi.z); a6 += bflo(xi.w); a7 += bfhi(xi.w); }
            const bf16x8 bfr = mk8(cvtpk(a0 * rn - bflo(x0.x), a1 * rn - bfhi(x0.x)), cvtpk(a2 * rn - bflo(x0.y), a3 * rn - bfhi(x0.y)), cvtpk(a4 * rn - bflo(x0.z), a5 * rn - bfhi(x0.z)), cvtpk(a6 * rn - bflo(x0.w), a7 * rn - bfhi(x0.w)));
            const bf16* wp = pwT + (size_t)(g * 64 + q) * 64 + 16 * ks + 8 * hh;
            D0 = __builtin_amdgcn_mfma_f32_32x32x16_bf16(*(const GAS bf16x8*)wp, bfr, D0, 0, 0, 0);
            D1 = __builtin_amdgcn_mfma_f32_32x32x16_bf16(*(const GAS bf16x8*)(wp + 32 * 64), bfr, D1, 0, 0, 0);
        }
        bf16* op = ymixp + (size_t)t * D + 512 + g * 64 + 4 * hh; const float* sp = psc + g * 64 + 4 * hh;
#pragma unroll
        for (int k = 0; k < 4; ++k) { const f32x4 s0 = *(const GAS f32x4*)(sp + 8 * k), s1 = *(const GAS f32x4*)(sp + 32 + 8 * k);
            u32x2 w0, w1; w0.x = cvtpk(D0[4 * k] * s0[0], D0[4 * k + 1] * s0[1]); w0.y = cvtpk(D0[4 * k + 2] * s0[2], D0[4 * k + 3] * s0[3]);
            w1.x = cvtpk(D1[4 * k] * s1[0], D1[4 * k + 1] * s1[1]); w1.y = cvtpk(D1[4 * k + 2] * s1[2], D1[4 * k + 3] * s1[3]);
            *(GAS u32x2*)(op + 8 * k) = w0; *(GAS u32x2*)(op + 32 + 8 * k) = w1; }
    }
#undef POOL_LD
}
__device__ __forceinline__ void mergeconv_unit(const bf16* pj, const bf16* opartp, const float* lsepp, const float* cw, bf16* ymixp, int t0, int lane) {
    const int c4 = 4 * lane, h = lane >> 3;
    const f32x4 w0 = *(const GAS f32x4*)(cw + c4), w1 = *(const GAS f32x4*)(cw + 256 + c4), w2 = *(const GAS f32x4*)(cw + 512 + c4);
    f32x4 u1 = {0.f, 0.f, 0.f, 0.f}, u2 = {0.f, 0.f, 0.f, 0.f};
    const int pos0 = t0 & (SEQ - 1);
    if (pos0 >= 2) {
        const bf16* r1 = pj + (size_t)(t0 - 1) * NPROJ; const bf16* r2 = r1 - NPROJ;
        const u32x2 c1 = *(const GAS u32x2*)(r1 + PC_CG + c4), h1 = *(const GAS u32x2*)(r1 + PC_HC + c4), c2 = *(const GAS u32x2*)(r2 + PC_CG + c4), h2 = *(const GAS u32x2*)(r2 + PC_HC + c4);
        u1 = (f32x4){bflo(c1.x) * bflo(h1.x), bfhi(c1.x) * bfhi(h1.x), bflo(c1.y) * bflo(h1.y), bfhi(c1.y) * bfhi(h1.y)};
        u2 = (f32x4){bflo(c2.x) * bflo(h2.x), bfhi(c2.x) * bfhi(h2.x), bflo(c2.y) * bflo(h2.y), bfhi(c2.y) * bfhi(h2.y)};
    }
    constexpr int NB = 8;
    for (int j0 = 0; j0 < 32; j0 += NB) {
        u32x2 cg[NB], hc[NB], bg[NB]; float l0[NB], l1[NB], l2[NB]; v4u pa[NB], pb[NB], pc[NB];
#pragma unroll
        for (int j = 0; j < NB; ++j) { const int t = t0 + j0 + j; const bf16* row = pj + (size_t)t * NPROJ;
            cg[j] = *(const GAS u32x2*)(row + PC_CG + c4); hc[j] = *(const GAS u32x2*)(row + PC_HC + c4); bg[j] = *(const GAS u32x2*)(row + PC_BG + c4);
            l0[j] = lsepp[(size_t)t * 8 + h]; l1[j] = lsepp[(size_t)T * 8 + (size_t)t * 8 + h]; l2[j] = lsepp[(size_t)2 * T * 8 + (size_t)t * 8 + h];
            pa[j] = *(const GAS v4u*)(opartp + (size_t)t * 512 + 8 * lane); pb[j] = *(const GAS v4u*)(opartp + OP_STRIDE + (size_t)t * 512 + 8 * lane); pc[j] = *(const GAS v4u*)(opartp + 2 * OP_STRIDE + (size_t)t * 512 + 8 * lane); }
        asm volatile("" ::: "memory");
#pragma unroll
        for (int j = 0; j < NB; ++j) { const int t = t0 + j0 + j;
            const f32x4 u0 = {bflo(cg[j].x) * bflo(hc[j].x), bfhi(cg[j].x) * bfhi(hc[j].x), bflo(cg[j].y) * bflo(hc[j].y), bfhi(cg[j].y) * bfhi(hc[j].y)};
            const f32x4 y = (f32x4){bflo(bg[j].x), bfhi(bg[j].x), bflo(bg[j].y), bfhi(bg[j].y)} * (w0 * u0 + w1 * u1 + w2 * u2);
            u32x2 yo; yo.x = cvtpk(y[0], y[1]); yo.y = cvtpk(y[2], y[3]);
            *(GAS u32x2*)(ymixp + (size_t)t * D + 768 + c4) = yo;
            u2 = u1; u1 = u0;
            const float M = fmaxf(l0[j], fmaxf(l1[j], l2[j])); float e0 = __expf(l0[j] - M), e1 = __expf(l1[j] - M), e2 = __expf(l2[j] - M); const float inv = 1.0f / (e0 + e1 + e2); e0 *= inv; e1 *= inv; e2 *= inv;
            const v4u a = pa[j], bq = pb[j], c = pc[j];
            v4u o; o.x = cvtpk(e0 * bflo(a.x) + e1 * bflo(bq.x) + e2 * bflo(c.x), e0 * bfhi(a.x) + e1 * bfhi(bq.x) + e2 * bfhi(c.x));
            o.y = cvtpk(e0 * bflo(a.y) + e1 * bflo(bq.y) + e2 * bflo(c.y), e0 * bfhi(a.y) + e1 * bfhi(bq.y) + e2 * bfhi(c.y));
            o.z = cvtpk(e0 * bflo(a.z) + e1 * bflo(bq.z) + e2 * bflo(c.z), e0 * bfhi(a.z) + e1 * bfhi(bq.z) + e2 * bfhi(c.z));
            o.w = cvtpk(e0 * bflo(a.w) + e1 * bflo(bq.w) + e2 * bflo(c.w), e0 * bfhi(a.w) + e1 * bfhi(bq.w) + e2 * bfhi(c.w));
            *(GAS v4u*)(ymixp + (size_t)t * D + 8 * lane) = o; }
    }
}

__device__ __forceinline__ void vt_transpose_tile(LAS unsigned char* lds, const bf16* pj, bf16* vt, int pm, int vh, int tid) {
    constexpr int PW = 65;
    LAS unsigned* img = (LAS unsigned*)lds;
    const int row0 = pm * 256, b = row0 >> 13, tt = row0 & 8191;
    for (int hf = 0; hf < 2; ++hf) {
        __syncthreads();
        { const int r = tid >> 1, hc = tid & 1;
            const bf16* src = pj + (size_t)(row0 + r) * NPROJ + PC_V + vh * 256 + hf * 128 + hc * 64;
#pragma unroll
            for (int k = 0; k < 8; ++k) { const v4u x = *(const GAS v4u*)(src + 8 * k); LAS unsigned* d = img + r * PW + hc * 32 + 4 * k; d[0] = x.x; d[1] = x.y; d[2] = x.z; d[3] = x.w; } }
        __syncthreads();
        const LAS unsigned short* im16 = (const LAS unsigned short*)lds;
        bf16* vcol = vt + (size_t)(b * 512 + vh * 256 + hf * 128) * SEQ;
#pragma unroll 2
        for (int k = 0; k < 8; ++k) { const int id = tid + 512 * k, d = id >> 5, c = id & 31;
            {
#define RD16(j) ((unsigned)im16[(8 * c + (j)) * (2 * PW) + d])
              v4u o; o.x = RD16(0) | (RD16(1) << 16); o.y = RD16(2) | (RD16(3) << 16); o.z = RD16(4) | (RD16(5) << 16); o.w = RD16(6) | (RD16(7) << 16);
#undef RD16
              *(GAS v4u*)(vcol + (size_t)d * SEQ + tt + 8 * c) = o; }
            { const int r = c >> 3, n0 = 8 * (c & 7);
#define RD16(j) ((unsigned)im16[(4 * (n0 + (j)) + r) * (2 * PW) + d])
              v4u o; o.x = RD16(0) | (RD16(1) << 16); o.y = RD16(2) | (RD16(3) << 16); o.z = RD16(4) | (RD16(5) << 16); o.w = RD16(6) | (RD16(7) << 16);
#undef RD16
              *(GAS v4u*)(vcol + VT_STRIDE + (size_t)d * SEQ + r * 2048 + (tt >> 2) + n0) = o; }
            { const int r = c >> 1, n0 = 8 * (c & 1);
#define RD16(j) ((unsigned)im16[(16 * (n0 + (j)) + r) * (2 * PW) + d])
              v4u o; o.x = RD16(0) | (RD16(1) << 16); o.y = RD16(2) | (RD16(3) << 16); o.z = RD16(4) | (RD16(5) << 16); o.w = RD16(6) | (RD16(7) << 16);
#undef RD16
              *(GAS v4u*)(vcol + 2 * VT_STRIDE + (size_t)d * SEQ + (tt >> 8) * 256 + r * 16 + n0) = o; }
        }
    }
    __syncthreads();
}

#define x_in (args.in[0])
#define mem_in (args.in[1])
#define rel_bias (args.in[2])
#define mem_g (args.in[3])
#define mix_g (args.in[4])
#define w_in (args.in[5])
#define conv_w (args.in[6])
#define pool_w (args.in[7])
#define pool_scale (args.in[8])
#define w_out (args.in[9])
#define xat_g (args.in[10])
#define wq_x (args.in[11])
#define wkv_x (args.in[12])
#define wo_x (args.in[13])
#define ffn_g (args.in[14])
#define w13_d (args.in[15])
#define w2_d (args.in[16])
#define router_w (args.in[17])
#define w13_m (args.in[18])
#define w2_m (args.in[19])
#define fin_g (args.in[20])
#define out (args.out)
#define Win_t ((bf16*)(ws + WS_WIN))
#define Wout_t ((bf16*)(ws + WS_WOUT))
#define Wq_t ((bf16*)(ws + WS_WQ))
#define Wkv_t ((bf16*)(ws + WS_WKV))
#define Wo_t ((bf16*)(ws + WS_WO))
#define W13d_t ((bf16*)(ws + WS_W13D))
#define W2d_t ((bf16*)(ws + WS_W2D))
#define W13m_t ((bf16*)(ws + WS_W13M))
#define W2m_t ((bf16*)(ws + WS_W2M))
#define xb ((bf16*)(ws + WS_XB))
#define qx ((bf16*)(ws + WS_QX))
#define ox ((bf16*)(ws + WS_OX))
#define Ag ((bf16*)(ws + WS_AG))
#define ym ((bf16*)(ws + WS_YM))
#define ypart ((bf16*)(ws + WS_YM + 136 * MiB))
#define proj ((bf16*)(ws + WS_PROJ))
#define ymix ((bf16*)(ws + WS_Y))
#define hbuf ((bf16*)(ws + WS_H))
#define kvx ((bf16*)(ws + WS_KVX))
#define memn ((bf16*)(ws + WS_MEMN))
#define vtb ((bf16*)(ws + WS_VT))
#define opart ((bf16*)(ws + WS_OPART))
#define lsep ((float*)(ws + WS_LSE))
#define vtx ((bf16*)(ws + WS_VTX))
#define ssp ((float*)(ws + WS_SSP))
#define cnts ((int*)(ws + WS_CNT))
#define meta ((int*)(ws + WS_META))
#define tok_e ((int*)(ws + WS_TOKE))
#define tok_g ((float*)(ws + WS_TOKG))
#define tok_pos ((int*)(ws + WS_TOKPOS))
#define row_gate ((float*)(ws + WS_ROWGATE))
#define row_rs ((float*)(ws + WS_ROWRS))
#ifndef PROBE
#define PROBE 0
#endif
#ifndef N_LAUNCH_MODE
#define N_LAUNCH_MODE 0
#endif

__device__ __forceinline__ void pair_barrier(unsigned* cnt, unsigned target, bool same_xcc, unsigned* tmo, int wave0) {
    asm volatile("s_waitcnt vmcnt(0)" ::: "memory");
    __syncthreads();
    int ln; asm volatile("v_mbcnt_lo_u32_b32 %0, -1, 0\n\tv_mbcnt_hi_u32_b32 %0, -1, %0" : "=v"(ln));
    if (wave0 == 0 && ln == 0) {
        if (!same_xcc) { __builtin_amdgcn_fence(__ATOMIC_RELEASE, "agent"); asm volatile("s_waitcnt vmcnt(0)" ::: "memory"); }
        (void)xb_add(cnt, 1u);
        unsigned sp = 0u;
        while (xb_ld(cnt) < target) { __builtin_amdgcn_s_sleep(1); if ((++sp & 255u) == 0u) { if (xb_ld(tmo)) break; if (sp > XB_SPIN_CAP) { atomicAdd(tmo, 1u); break; } } }
        __builtin_amdgcn_fence(__ATOMIC_ACQUIRE, "agent");
        asm volatile("s_waitcnt vmcnt(0)" ::: "memory");
    }
    __syncthreads();
}
__global__ void __launch_bounds__(NWAVES * 64, 2) trunk_fwd(Args args) {
    extern __shared__ __attribute__((aligned(16))) unsigned char lds_raw[];
    LAS unsigned char* lds = (LAS unsigned char*)lds_raw;
    volatile LAS unsigned* MISC = (volatile LAS unsigned*)(lds + MISC_OFF);
    const int tid0 = threadIdx.x;
    const int G0 = gridDim.x, blk0 = blockIdx.x, wave0 = __builtin_amdgcn_readfirstlane(tid0 >> 6);
    unsigned char* ws0 = args.ws;
    gu32* ctl = (gu32*)(ws0 + WS_CTL);
#define PH_VARS int lane_; asm volatile("v_mbcnt_lo_u32_b32 %0, -1, 0\n\tv_mbcnt_hi_u32_b32 %0, -1, %0" : "=v"(lane_)); int wv_ = wave0; asm volatile("" : "+s"(wv_)); int blk = blk0; asm volatile("" : "+s"(blk)); int G = G0; asm volatile("" : "+s"(G)); \
    unsigned char* ws = ws0; asm volatile("" : "+s"(ws)); const int lane = lane_, wave = wv_, tid = wv_ * 64 + lane_; const int gw = blk * NWAVES + wave, NGW = G * NWAVES; (void)lane; (void)gw; (void)NGW; (void)ws; (void)tid
    for (int u = tid0; u < (LDS_BYTES - LDSCTL_OFF) / 4; u += NWAVES * 64) ((LAS unsigned*)(lds + LDSCTL_OFF))[u] = 0u;
    __syncthreads();
    XcdBarrier bar = xcd_barrier_post((unsigned*)(ctl + CW_BAR), MISC + 8);
    bar.x = __builtin_amdgcn_readfirstlane(bar.x);
    if (tid0 == 0) __hip_atomic_store((unsigned*)(ws0 + WS_XCCTAB) + blk0, bar.x, __ATOMIC_RELAXED, __HIP_MEMORY_SCOPE_AGENT);
    const int tpm0 = (blk0 & 7) + 8 * (blk0 >> 4), tmb0 = (blk0 >> 3) & 1;
    unsigned pepoch = 0u; bool same_xcc = false;
#define PAIR_BAR do { pepoch += 2u; unsigned* tc_ = (unsigned*)(ctl + CW_TEAM) + 64 * tpm0; asm volatile("" : "+s"(tc_)); pair_barrier(tc_, pepoch, same_xcc, (unsigned*)(ctl + CW_BAR) + XB_TMO, wave0); } while (0)
#if N_LAUNCH_MODE == 0
#define PH_ON true
#define PH_END do { for (int br_ = 0; br_ < ((PROBE & 1024) ? 3 : 1); ++br_) { XcdBarrier b_ = bar; asm volatile("" : "+s"(b_.x)); asm volatile("" : "+s"(b_.bar)); xcd_barrier(b_); } } while (0)
#else
    const int lo = args.ph_lo, hi = args.ph_hi;
    int ph = 0;
#define PH_ON (ph >= lo && ph < hi)
#define PH_END do { if (ph >= lo && ph + 1 < hi) { XcdBarrier b_ = bar; asm volatile("" : "+s"(b_.x)); asm volatile("" : "+s"(b_.bar)); xcd_barrier(b_); } ++ph; } while (0)
#endif

    constexpr size_t SSP_STRIDE = (size_t)T * 16;

    if (PH_ON) { PH_VARS;
        LAS float* scr = (LAS float*)(lds + wave * 16896);
        constexpr int I_IN = 16 * 40, I_OUT = 16 * 16, I_Q = 16 * 8, I_KV = 16 * 16, I_O = 8 * 16, I_13D = 16 * 88, I_2D = 44 * 16, I_13M = 16 * 112, I_2M = 56 * 16;
        constexpr int C0 = 4 * I_IN, C1 = C0 + 4 * I_OUT, C2 = C1 + 4 * I_Q, C3 = C2 + 4 * I_KV, C4 = C3 + 4 * I_O, C5 = C4 + 2 * I_13D, C6 = C5 + 2 * I_2D, C7 = C6 + 16 * I_13M, C8 = C7 + 16 * I_2M;
        for (int rep = 0; rep < ((PROBE & 16) ? 2 : 1); ++rep)
        for (int it = gw; it < C8; it += NGW) {
            if (it < C0) { const int m = it / I_IN, r = it % I_IN; if (m < 2) conv_item(w_in + (size_t)m * D * NPROJ, D, NPROJ, Win_t + (size_t)m * NPROJ * D, mix_g + m * D, 0, scr, r, lane);
                else conv_item8(w_in + (size_t)m * D * NPROJ, D, NPROJ, (unsigned char*)(Win_t + (size_t)m * NPROJ * D), mix_g + m * D, 0, F8_S1, scr, r, lane); }
            else if (it < C1) { const int q = it - C0, m = q / I_OUT, r = q % I_OUT; conv_item(w_out + (size_t)m * D * D, D, D, Wout_t + (size_t)m * D * D, nullptr, 0, scr, r, lane); }
            else if (it < C2) { const int q = it - C1, m = q / I_Q, r = q % I_Q; conv_item(wq_x + (size_t)m * D * XW, D, XW, Wq_t + (size_t)m * XW * D, xat_g + m * D, 0, scr, r, lane); }
            else if (it < C3) { const int q = it - C2, m = q / I_KV, r = q % I_KV; conv_item(wkv_x + (size_t)m * D * 1024, D, 1024, Wkv_t + (size_t)m * 1024 * D, nullptr, 0, scr, r, lane); }
            else if (it < C4) { const int q = it - C3, m = q / I_O, r = q % I_O; conv_item(wo_x + (size_t)m * XW * D, XW, D, Wo_t + (size_t)m * D * XW, nullptr, 0, scr, r, lane); }
            else if (it < C5) { const int q = it - C4, m = q / I_13D, r = q % I_13D; if (m == 0) conv_item(w13_d, D, 2 * FFD, W13d_t, ffn_g, FFD, scr, r, lane); else conv_item8(w13_d + (size_t)D * 2 * FFD, D, 2 * FFD, (unsigned char*)(W13d_t + (size_t)2 * FFD * D), ffn_g + 2 * D, FFD, F8_S1, scr, r, lane); }
            else if (it < C6) { const int q = it - C5, m = q / I_2D, r = q % I_2D; if (m == 0) conv_item(w2_d, FFD, D, W2d_t, nullptr, 0, scr, r, lane); else conv_item8(w2_d + (size_t)FFD * D, FFD, D, (unsigned char*)(W2d_t + (size_t)D * FFD), nullptr, 0, F8_S2, scr, r, lane); }
            else if (it < C7) { const int q = it - C6, m = q / I_13M, r = q % I_13M; conv_item8(w13_m + (size_t)m * D * 2 * FFE, D, 2 * FFE, (unsigned char*)W13m_t + (size_t)m * 2 * FFE * D, ffn_g + (2 * (m >> 3) + 1) * D, FFE, F8_S1, scr, r, lane); }
            else { const int q = it - C7, m = q / I_2M, r = q % I_2M; conv_item8(w2_m + (size_t)m * FFE * D, FFE, D, (unsigned char*)W2m_t + (size_t)m * D * FFE, nullptr, 0, F8_S2, scr, r, lane); }
        }
        for (int idx = gw * 64 + lane; idx < DEPTH * 4 * 64 * 64; idx += NGW * 64) { const int c = idx & 63, dp = (idx >> 6) & 63, lg = idx >> 12;
            ((bf16*)(ws + WS_PWT))[idx] = (bf16)f2bf(pool_w[(size_t)(lg * 64 + c) * 64 + dp]); }
        for (int m = gw; m < T; m += NGW) {
            const GAS f32x4* xr = (const GAS f32x4*)(x_in + (size_t)m * D) + lane; f32x4 v[4]; float s = 0.f;
#pragma unroll
            for (int j = 0; j < 4; ++j) { v[j] = xr[64 * j]; s += (v[j].x * v[j].x + v[j].y * v[j].y) + (v[j].z * v[j].z + v[j].w * v[j].w); }
            s = wave_sum(s, lane);
            GAS unsigned long long* o8 = (GAS unsigned long long*)(xb + (size_t)m * D) + lane;
#pragma unroll
            for (int j = 0; j < 4; ++j) o8[64 * j] = (unsigned long long)pk2(v[j].x, v[j].y) | ((unsigned long long)pk2(v[j].z, v[j].w) << 32);
            if (lane < 16) ssp[(size_t)m * 16 + lane] = lane == 0 ? s : 0.f;
        }
        for (int m = gw; m < MROWS; m += NGW) {
            const GAS f32x4* xr = (const GAS f32x4*)(mem_in + (size_t)m * D) + lane; const GAS f32x4* gr = (const GAS f32x4*)mem_g + lane; f32x4 v[4]; float s = 0.f;
#pragma unroll
            for (int j = 0; j < 4; ++j) { v[j] = xr[64 * j]; s += (v[j].x * v[j].x + v[j].y * v[j].y) + (v[j].z * v[j].z + v[j].w * v[j].w); }
            const float r = 1.0f / sqrtf(wave_sum(s, lane) * (1.0f / D) + 1e-6f);
            GAS unsigned long long* o8 = (GAS unsigned long long*)(memn + (size_t)m * D) + lane;
#pragma unroll
            for (int j = 0; j < 4; ++j) { const f32x4 g = gr[64 * j]; o8[64 * j] = (unsigned long long)pk2(v[j].x * r * g.x, v[j].y * r * g.y) | ((unsigned long long)pk2(v[j].z * r * g.z, v[j].w * r * g.w) << 32); }
        }
    }
    PH_END;
    same_xcc = (unsigned)__builtin_amdgcn_readfirstlane((int)xb_ld((unsigned*)(ws0 + WS_XCCTAB) + (blk0 ^ 8))) == bar.x;

    for (int l = 0; l < DEPTH; ++l) {
#define ssp_a (ssp + (size_t)(3 * l) * SSP_STRIDE)
#define ssp_b (ssp + (size_t)(3 * l + 1) * SSP_STRIDE)
#define ssp_c (ssp + (size_t)(3 * l + 2) * SSP_STRIDE)
#define ssp_d (ssp + (size_t)(3 * l + 3) * SSP_STRIDE)
        if (PH_ON) { PH_VARS;
            if (l == 0) {
                pg8::Gemm g{memn, Wkv_t, MROWS, 4096, D}; pg8::StaticOrder S; S.init(MROWS, 4096, G, blk);
                pg8::EpiKV E{kvx, vtx};
                pg8::gemm_phase<pg8::EpiKV, pg8::StaticOrder, true, true>(lds, g, S, E, tid);
#if PROBE & (1 | 64)
                pg8::gemm_phase<pg8::EpiKV, pg8::StaticOrder, true, true>(lds, g, S, E, tid);
#endif
            }
        }
        if (PH_ON) {
            if (l >= 2) { PH_VARS;
                pg8::Gemm g{Ag, Win_t + (size_t)l * NPROJ * D, T, NPROJ, D / 2}; pg8::StaticOrder S; S.init(T, NPROJ, G, blk);
                pg8::EpiRowScale E{proj, NPROJ, ssp_a, 1.0f / F8_S1};
                pg8::gemm_phase<pg8::EpiRowScale, pg8::StaticOrder, true, true, true>(lds, g, S, E, tid);
            } else { PH_VARS;
                pg8::Gemm g{xb, Win_t + (size_t)l * NPROJ * D, T, NPROJ, D}; pg8::StaticOrder S; S.init(T, NPROJ, G, blk);
                pg8::EpiRowScale E{proj, NPROJ, ssp_a, 1.0f};
                pg8::gemm_phase<pg8::EpiRowScale, pg8::StaticOrder, true, true>(lds, g, S, E, tid);
            }
        }
        PH_END;
        if (PH_ON) { PH_VARS;
            LAS float* bt = (LAS float*)lds;
            for (int idx = tid; idx < 3 * 8 * BT_LD; idx += NWAVES * 64) { const int part = idx / (8 * BT_LD), rem = idx % (8 * BT_LD), h = rem / BT_LD, j = rem % BT_LD - BT_OFF, sh = 2 * part, jlo = part ? 33 : 0;
                float v = NEGINF; if (j <= 128 && j >= jlo) { const int d = j << sh; v = (rel_bias[t5_bucket(d) * 8 + h] + logf((float)key_mult(d))) * 1.4426950408889634f; } bt[idx] = v; }
            __syncthreads();
            for (int rep = 0; rep < ((PROBE & (2 | 2048)) ? 2 : 1); ++rep) {
            v4u sk[6], sv[6];
#define DIL_DEC(u_) const int part = (u_) >> 10, v_ = (u_) & 1023, sh = 2 * part, b = v_ >> 8, h = (v_ >> 5) & 7, w5 = v_ & 31, nbs = 5 - sh, r = w5 >> nbs, n0 = 256 * (w5 & ((1 << nbs) - 1))
            { const int u0 = blk < 3 * 1024 ? blk : 0; DIL_DEC(u0); dil_stage_load_k(sk, proj, sh, b, h, r, n0, tid); dil_stage_load_v(sv, proj, sh, b, h, r, n0, tid); }
            for (int u = blk; u < 3 * 1024; u += G) {
                DIL_DEC(u);
                const bool dst = !((PROBE & 2048) && rep == 1);
                __syncthreads();
                dil_stage_write_k(lds + 20480, sk, tid); dil_stage_write_v(lds + 20480, sv, tid);
                const int tq = b * SEQ + r + ((n0 + 32 * wave + (lane & 31)) << sh);
                bf16x8 qf[4];
                { const bf16* qp = proj + (size_t)tq * NPROJ + PC_Q + h * 64 + 32 * (lane >> 5);
#pragma unroll
                  for (int ks = 0; ks < 4; ++ks) qf[ks] = *(const GAS bf16x8*)(qp + 8 * ks); }
                __syncthreads();
                { const int un = u + G < 3 * 1024 ? u + G : u, part2 = un >> 10, v2 = un & 1023, sh2 = 2 * part2, nbs2 = 5 - sh2, w52 = v2 & 31, b2 = v2 >> 8, h2 = (v2 >> 5) & 7, r2 = w52 >> nbs2, n02 = 256 * (w52 & ((1 << nbs2) - 1));
                    dil_stage_load_k(sk, proj, sh2, b2, h2, r2, n02, tid); dil_stage_load_v(sv, proj, sh2, b2, h2, r2, n02, tid); }
                if (part == 0) dil_wg_compute<0>(lds + 20480, qf, opart, lsep, bt + h * BT_LD, tq, h, n0 + 32 * wave - 128, lane, wave, dst);
                else dil_wg_compute<33>(lds + 20480, qf, opart + (size_t)part * OP_STRIDE, lsep + (size_t)part * T * 8, bt + (part * 8 + h) * BT_LD, tq, h, n0 + 32 * wave - 128, lane, wave, dst);
            }
#undef DIL_DEC
            }
            __syncthreads();
        }
        PH_END;
        if (PH_ON) { PH_VARS;
            const bf16* pwT = (const bf16*)(ws + WS_PWT) + (size_t)l * 4 * 64 * 64;
            const int t0 = 32 * (tpm0 * 8 + 4 * tmb0 + (wave >> 1));
            if ((wave & 1) == 0) pool_unit(proj, pwT, pool_scale + (size_t)l * 256, ymix, t0, lane, lds + wave * 16896);
            else mergeconv_unit(proj, opart, lsep, conv_w + (size_t)l * 768, ymix, t0, lane);
        }
        PAIR_BAR;
        if (PH_ON) { PH_VARS;
            pg8::Gemm g{ymix, Wout_t + (size_t)l * D * D, T, D, D}; pg8::TeamOrder S{tpm0, 2 * tmb0, 2};
            pg8::EpiResid E{l == 0 ? x_in : (const float*)nullptr, xb, ssp_b, nullptr, 1.0f, 0};
            pg8::gemm_phase<pg8::EpiResid, pg8::TeamOrder, true, true>(lds, g, S, E, tid);
        }
        PAIR_BAR;
        if (PH_ON) { PH_VARS;
            pg8::Gemm g{xb, Wq_t + (size_t)l * XW * D, T, XW, D}; pg8::TeamOrder S{tpm0, tmb0, 1};
            pg8::EpiRowScale E{qx, XW, ssp_b, 0.08838834764831845f};
            pg8::gemm_phase<pg8::EpiRowScale, pg8::TeamOrder, true, true>(lds, g, S, E, tid);
            { const int b = (tpm0 * 256) / SEQ;
              for (int h2 = 0; h2 < 2; ++h2) xat_wg_unit(lds, qx, kvx + (size_t)(b * MEML) * 4096 + l * 1024, vtx + (size_t)((l * 4 + b) * 512) * MEML, ox, tpm0 * 256 + wave * 32, 2 * tmb0 + h2, tid); }
            __syncthreads();
        }
        PAIR_BAR;
        if (PH_ON) { PH_VARS;
            pg8::Gemm g{ox, Wo_t + (size_t)l * D * XW, T, D, XW}; pg8::TeamOrder S{tpm0, 2 * tmb0, 2};
            pg8::EpiResid E{nullptr, xb, ssp_c, (unsigned char*)Ag, 1.0f, l == 2 ? 1 : 0};
            pg8::gemm_phase<pg8::EpiResid, pg8::TeamOrder, true, true>(lds, g, S, E, tid);
        }
        PH_END;
        if ((l & 1) == 0) {
            if (PH_ON) { PH_VARS;
                pg8::StaticOrder S; S.init(T, 2 * FFD, G, blk);
                if (l == 2) {
                    pg8::Gemm g{Ag, W13d_t + (size_t)2 * FFD * D, T, 2 * FFD, D / 2};
                    pg8::EpiSwiGLU8 E{(unsigned char*)hbuf, FFD, nullptr, 0, 1.0f / F8_S1, F8_SH, ssp_c};
                    pg8::gemm_phase<pg8::EpiSwiGLU8, pg8::StaticOrder, true, true, true>(lds, g, S, E, tid);
                } else {
                    pg8::Gemm g{xb, W13d_t, T, 2 * FFD, D};
                    pg8::EpiSwiGLU E{hbuf, FFD, ssp_c, nullptr, 0};
                    pg8::gemm_phase<pg8::EpiSwiGLU, pg8::StaticOrder, true, true>(lds, g, S, E, tid);
                }
            }
            PH_END;
            if (PH_ON) { PH_VARS;
                pg8::StaticOrder S; S.init(T, D, G, blk);
                if (l == 2) {
                    pg8::Gemm g{hbuf, W2d_t + (size_t)D * FFD, T, D, FFD / 2};
                    pg8::EpiResid E{nullptr, xb, ssp_d, (unsigned char*)Ag, 1.0f / (F8_S2 * F8_SH), 1};
                    pg8::gemm_phase<pg8::EpiResid, pg8::StaticOrder, true, true, true>(lds, g, S, E, tid);
                } else {
                    pg8::Gemm g{hbuf, W2d_t, T, D, FFD};
                    pg8::EpiResid E{nullptr, xb, ssp_d, nullptr, 1.0f, 0};
                    pg8::gemm_phase<pg8::EpiResid, pg8::StaticOrder, true, true>(lds, g, S, E, tid);
                }
            }
            PH_END;
        } else {
#define chunk ((T + G - 1) / G)
            if (PH_ON) { PH_VARS;
                LAS int* lcnt = (LAS int*)lds; const float* rw = router_w + (size_t)(l >> 1) * D * NEXP; const float* fg = ffn_g + (size_t)l * D;
                if (tid < NEXP) lcnt[tid] = 0;
                __syncthreads();
                for (int i = wave; i < chunk; i += NWAVES) { const int t = blk * chunk + i; if (t >= T) break;
                    const float r = pg8::row_rs16(ssp_c, t);
                    float lg[8];
#pragma unroll
                    for (int e = 0; e < 8; ++e) lg[e] = 0.f;
#pragma unroll
                    for (int j = 0; j < 4; ++j) { const u32x2 xw = *((const GAS u32x2*)(xb + (size_t)t * D) + lane + 64 * j); const f32x4 xv = {bflo(xw.x), bfhi(xw.x), bflo(xw.y), bfhi(xw.y)}; const f32x4 gv = *((const GAS f32x4*)fg + lane + 64 * j);
#pragma unroll
                        for (int c = 0; c < 4; ++c) { const float hn = xv[c] * r * gv[c]; const int k = 4 * (lane + 64 * j) + c; const f32x4 w0 = *(const GAS f32x4*)(rw + (size_t)k * 8), w1 = *(const GAS f32x4*)(rw + (size_t)k * 8 + 4);
                            lg[0] += hn * w0[0]; lg[1] += hn * w0[1]; lg[2] += hn * w0[2]; lg[3] += hn * w0[3]; lg[4] += hn * w1[0]; lg[5] += hn * w1[1]; lg[6] += hn * w1[2]; lg[7] += hn * w1[3]; } }
#pragma unroll
                    for (int e = 0; e < 8; ++e) lg[e] = wave_sum(lg[e], lane);
                    int e0 = 0; float v0 = lg[0];
#pragma unroll
                    for (int e = 1; e < 8; ++e) if (lg[e] > v0) { v0 = lg[e]; e0 = e; }
                    int e1 = -1; float v1 = -3.0e38f;
#pragma unroll
                    for (int e = 0; e < 8; ++e) if (e != e0 && lg[e] > v1) { v1 = lg[e]; e1 = e; }
                    const float p0 = 1.0f / (1.0f + __expf(v1 - v0)), p1 = 1.0f - p0;
                    if (lane == 0) { tok_e[2 * t] = e0; tok_e[2 * t + 1] = e1; tok_g[2 * t] = p0; tok_g[2 * t + 1] = p1; atomicAdd((int*)&lcnt[e0], 1); atomicAdd((int*)&lcnt[e1], 1); }
                }
                __syncthreads();
                if (tid < NEXP) cnts[blk * NEXP + tid] = lcnt[tid];
                __syncthreads();
            }
            PH_END;
            if (PH_ON) { PH_VARS;
                LAS int* lc = (LAS int*)lds;
                LAS int* lbase = (LAS int*)(lds + 32768);
                LAS int* lseg = (LAS int*)(lds + 32768 + 64);
                LAS int* lpos = (LAS int*)(lds + 36864);
                for (int i = tid; i < G * NEXP; i += NWAVES * 64) lc[i] = cnts[i];
                __syncthreads();
                { int base = 0, tot = 0;
                  for (int b2 = lane; b2 < G; b2 += 64) { const int c = lc[b2 * NEXP + wave]; tot += c; base += b2 < blk ? c : 0; }
                  for (int o = 1; o < 32; o <<= 1) { tot += __builtin_amdgcn_ds_bpermute((lane ^ o) << 2, tot); base += __builtin_amdgcn_ds_bpermute((lane ^ o) << 2, base); }
                  tot += __builtin_amdgcn_ds_bpermute((lane ^ 32) << 2, tot); base += __builtin_amdgcn_ds_bpermute((lane ^ 32) << 2, base);
                  if (lane == 0) { lbase[wave] = base; lseg[8 + wave] = tot; } }
                __syncthreads();
                if (tid == 0) { int s = 0; for (int e = 0; e < NEXP; ++e) { lseg[e] = s; lbase[e] += s; s += (lseg[8 + e] + 255) & ~255; lseg[16 + e] = s; if (blk == 0) meta[e] = s >> 8; } }
                __syncthreads();
                if (wave == 0) {
                    int run[8];
#pragma unroll
                    for (int e = 0; e < 8; ++e) run[e] = lbase[e];
                    const int nent = 2 * chunk;
                    for (int r0 = 0; r0 < nent; r0 += 64) { const int idx = r0 + lane; const int t = blk * chunk + (idx >> 1); const bool ok = idx < nent && t < T;
                        const int e = ok ? tok_e[2 * t + (idx & 1)] : -1; int pos = 0;
#pragma unroll
                        for (int ee = 0; ee < 8; ++ee) { const unsigned long long mk = __ballot(e == ee); if (e == ee) pos = run[ee] + __popcll(mk & ((1ull << lane) - 1ull)); run[ee] += __popcll(mk); }
                        if (ok) { tok_pos[2 * t + (idx & 1)] = pos; row_gate[pos] = tok_g[2 * t + (idx & 1)]; row_rs[pos] = pg8::row_rs16(ssp_c, t); lpos[idx] = pos; } }
                }
                __syncthreads();
                for (int idx = wave; idx < 2 * chunk; idx += NWAVES) { const int t = blk * chunk + (idx >> 1); if (t >= T) break; const int pos = lpos[idx];
                    const GAS v4u* src = (const GAS v4u*)(xb + (size_t)t * D); const v4u a = src[2 * lane], c = src[2 * lane + 1];
                    v4u o; o.x = pg8::pk4_fp8(bflo(a.x), bfhi(a.x), bflo(a.y), bfhi(a.y)); o.y = pg8::pk4_fp8(bflo(a.z), bfhi(a.z), bflo(a.w), bfhi(a.w));
                    o.z = pg8::pk4_fp8(bflo(c.x), bfhi(c.x), bflo(c.y), bfhi(c.y)); o.w = pg8::pk4_fp8(bflo(c.z), bfhi(c.z), bflo(c.w), bfhi(c.w));
                    *((GAS v4u*)((unsigned char*)Ag + (size_t)pos * D) + lane) = o; }
                if (blk < NEXP) { const int r0 = lseg[blk] + lseg[8 + blk], r1 = lseg[16 + blk];
                    for (int r = r0 + wave; r < r1; r += NWAVES) { GAS v4u* dst = (GAS v4u*)((unsigned char*)Ag + (size_t)r * D); unsigned z0; asm volatile("v_mov_b32 %0, 0" : "=v"(z0)); const v4u z = {z0, z0, z0, z0}; dst[lane] = z; if (lane == 0) { row_gate[r] = 0.f; row_rs[r] = 0.f; } } }
                __syncthreads();
            }
            PH_END;
            if (PH_ON) { PH_VARS;
                pg8::MoeOrder S;
#pragma unroll
                for (int e = 0; e < 8; ++e) S.te[e] = __builtin_amdgcn_readfirstlane(meta[e]);
                S.nNl = 2 * FFE / 256; S.so.init(S.te[7] * 256, 2 * FFE, G, blk);
                pg8::Gemm g{Ag, W13m_t + (size_t)(l >> 1) * NEXP * 2 * FFE * (D / 2), MP, NEXP * 2 * FFE, D / 2};
                pg8::EpiSwiGLU8 E{(unsigned char*)hbuf, FFE, row_rs, 2 * FFE / 256, 1.0f / F8_S1, F8_SH, nullptr};
                pg8::gemm_phase<pg8::EpiSwiGLU8, pg8::MoeOrder, true, true, true>(lds, g, S, E, tid);
#if PROBE & (1 | 512)
                pg8::gemm_phase<pg8::EpiSwiGLU8, pg8::MoeOrder, true, true, true>(lds, g, S, E, tid);
#endif
            }
            PH_END;
            if (PH_ON) { PH_VARS;
                pg8::MoeOrder S;
#pragma unroll
                for (int e = 0; e < 8; ++e) S.te[e] = __builtin_amdgcn_readfirstlane(meta[e]);
                const int ntile = S.te[7], nmain = ntile < 256 ? ntile : 256;
                S.nNl = D / 256; S.so.init(nmain * 256, D, G, blk);
                pg8::Gemm g{hbuf, W2m_t + (size_t)(l >> 1) * NEXP * D * (FFE / 2), MP, NEXP * D, FFE / 2};
                pg8::EpiMoeOut E{ym, row_gate, 1.0f / (F8_S2 * F8_SH)};
                pg8::gemm_phase<pg8::EpiMoeOut, pg8::MoeOrder, true, true, true>(lds, g, S, E, tid);
#if PROBE & (1 | 512)
                pg8::gemm_phase<pg8::EpiMoeOut, pg8::MoeOrder, true, true, true>(lds, g, S, E, tid);
#endif
                if (ntile > 256) {
                    pg8::MoeTailOrder ST; ST.npieces = (ntile - 256) * 4 * 7; ST.G = G; ST.c = blk; ST.kstep = 512;
#pragma unroll
                    for (int e = 0; e < 8; ++e) ST.te[e] = S.te[e];
                    pg8::Gemm g2{hbuf, W2m_t + (size_t)(l >> 1) * NEXP * D * (FFE / 2), MP, NEXP * D, 256, FFE / 2};
                    pg8::EpiMoePart EP{ypart, row_gate, 1.0f / (F8_S2 * F8_SH), 9};
                    pg8::gemm_phase<pg8::EpiMoePart, pg8::MoeTailOrder, true, true, true>(lds, g2, ST, EP, tid);
                }
            }
            PH_END;
            if (PH_ON) { PH_VARS;
                const bool last = (l == DEPTH - 1);
                static_assert(T % (4 * 256 * NWAVES) == 0, "combine batches"); constexpr int NBC = 4;
                for (int tb = gw; tb < T; tb += NBC * NGW) {
                    int p0[NBC], p1[NBC];
#pragma unroll
                    for (int k = 0; k < NBC; ++k) { const int t = tb + k * NGW; p0[k] = tok_pos[2 * t]; p1[k] = tok_pos[2 * t + 1]; }
                    u32x2 xa[NBC][4], ya[NBC][4], yb[NBC][4];
#pragma unroll
                    for (int k = 0; k < NBC; ++k) { const int t = tb + k * NGW;
                        const GAS u32x2* xr = (const GAS u32x2*)(xb + (size_t)t * D) + lane;
                        const GAS u32x2* y0 = (const GAS u32x2*)(ym + (size_t)(p0[k] < 65536 ? p0[k] : 0) * D) + lane; const GAS u32x2* y1 = (const GAS u32x2*)(ym + (size_t)(p1[k] < 65536 ? p1[k] : 0) * D) + lane;
#pragma unroll
                        for (int j = 0; j < 4; ++j) { xa[k][j] = xr[64 * j]; ya[k][j] = y0[64 * j]; yb[k][j] = y1[64 * j]; } }
                    asm volatile("" ::: "memory");
#pragma unroll
                    for (int k = 0; k < NBC; ++k) { const int t = tb + k * NGW;
                        f32x4 v[4]; float s = 0.f;
#pragma unroll
                        for (int j = 0; j < 4; ++j) { const u32x2 a = xa[k][j]; f32x4 e0, e1;
                            if (p0[k] < 65536) { const u32x2 b0 = ya[k][j]; e0 = (f32x4){bflo(b0.x), bfhi(b0.x), bflo(b0.y), bfhi(b0.y)}; }
                            else { e0 = (f32x4){0.f, 0.f, 0.f, 0.f};
                                for (int kp = 0; kp < 7; ++kp) { const u32x2 b0 = *((const GAS u32x2*)(ypart + ((size_t)kp * 2048 + (p0[k] - 65536)) * D) + lane + 64 * j); e0 += (f32x4){bflo(b0.x), bfhi(b0.x), bflo(b0.y), bfhi(b0.y)}; } }
                            if (p1[k] < 65536) { const u32x2 b1 = yb[k][j]; e1 = (f32x4){bflo(b1.x), bfhi(b1.x), bflo(b1.y), bfhi(b1.y)}; }
                            else { e1 = (f32x4){0.f, 0.f, 0.f, 0.f};
                                for (int kp = 0; kp < 7; ++kp) { const u32x2 b1 = *((const GAS u32x2*)(ypart + ((size_t)kp * 2048 + (p1[k] - 65536)) * D) + lane + 64 * j); e1 += (f32x4){bflo(b1.x), bfhi(b1.x), bflo(b1.y), bfhi(b1.y)}; } }
                            v[j] = ((f32x4){bflo(a.x), bfhi(a.x), bflo(a.y), bfhi(a.y)} + e0) + e1;
                            s += (v[j].x * v[j].x + v[j].y * v[j].y) + (v[j].z * v[j].z + v[j].w * v[j].w); }
                        s = wave_sum(s, lane);
                        GAS f32x4* orow = (GAS f32x4*)(out + (size_t)t * D) + lane;
                        if (last) { const float r = 1.0f / sqrtf(s * (1.0f / D) + 1e-6f); const GAS f32x4* gr = (const GAS f32x4*)fin_g + lane;
#pragma unroll
                            for (int j = 0; j < 4; ++j) orow[64 * j] = v[j] * r * gr[64 * j]; }
                        else { GAS unsigned long long* o8 = (GAS unsigned long long*)(xb + (size_t)t * D) + lane;
#pragma unroll
                            for (int j = 0; j < 4; ++j) o8[64 * j] = (unsigned long long)pk2(v[j].x, v[j].y) | ((unsigned long long)pk2(v[j].z, v[j].w) << 32);
                            { GAS unsigned* o4 = (GAS unsigned*)((unsigned char*)Ag + (size_t)t * D) + lane;
#pragma unroll
                              for (int j = 0; j < 4; ++j) o4[64 * j] = pg8::pk4_fp8(v[j].x, v[j].y, v[j].z, v[j].w); }
                            if (lane < 16) ssp_d[(size_t)t * 16 + lane] = lane == 0 ? s : 0.f; }
                    }
                }
            }
            if (l != DEPTH - 1) { PH_END; }
        }
    }
#undef PH_ON
#undef PH_END
}
#undef x_in
#undef mem_in
#undef rel_bias
#undef mem_g
#undef mix_g
#undef w_in
#undef conv_w
#undef pool_w
#undef pool_scale
#undef w_out
#undef xat_g
#undef wq_x
#undef wkv_x
#undef wo_x
#undef ffn_g
#undef w13_d
#undef w2_d
#undef router_w
#undef w13_m
#undef w2_m
#undef fin_g
#undef out
#undef Win_t
#undef Wout_t
#undef Wq_t
#undef Wkv_t
#undef Wo_t
#undef W13d_t
#undef W2d_t
#undef W13m_t
#undef W2m_t
#undef xb
#undef qx
#undef ox
#undef Ag
#undef ym
#undef proj
#undef ymix
#undef hbuf
#undef kvx
#undef memn
#undef ssp
#undef cnts
#undef meta
#undef tok_e
#undef tok_g
#undef tok_pos
#undef row_gate
#undef row_rs
#undef ssp_a
#undef ssp_b
#undef ssp_c
#undef ssp_d
#undef PH_VARS
#undef ypart
#undef chunk
#undef vtb
#undef opart
#undef lsep
#undef vtx

extern "C" void kernel_launch(void* const* d_in, const int* in_sizes, int n_in, void* d_out, int out_size, void* d_ws, size_t ws_size, hipStream_t stream) {
    static int grid = 0;
    if (grid == 0) {
        if (n_in != 21 || in_sizes[0] != T * D || out_size != T * D || ws_size < WS_END) { fprintf(stderr, "kernel_launch: unexpected shapes: n_in %d in0 %d out %d ws %zu (need %zu)\n", n_in, n_in > 0 ? in_sizes[0] : -1, out_size, ws_size, (size_t)WS_END); grid = -1; return; }
        int dev = 0, cus = 0, per_cu = 0;
        if (hipGetDevice(&dev) != hipSuccess || hipDeviceGetAttribute(&cus, hipDeviceAttributeMultiprocessorCount, dev) != hipSuccess) { fprintf(stderr, "kernel_launch: device query failed\n"); grid = -1; return; }
        if (hipFuncSetAttribute((const void*)trunk_fwd, hipFuncAttributeMaxDynamicSharedMemorySize, LDS_BYTES) != hipSuccess) { fprintf(stderr, "kernel_launch: hipFuncSetAttribute failed\n"); grid = -1; return; }
        if (hipOccupancyMaxActiveBlocksPerMultiprocessor(&per_cu, (const void*)trunk_fwd, NWAVES * 64, LDS_BYTES) != hipSuccess || per_cu < 1) fprintf(stderr, "kernel_launch: occupancy query reports %d\n", per_cu);
        (void)hipGetLastError();
        if (cus != T / 256 * 2) { fprintf(stderr, "kernel_launch: the team mapping needs %d CUs, device has %d\n", T / 256 * 2, cus); grid = -1; return; }
        grid = cus;
    }
    if (grid < 0) return;
    if (hipMemsetAsync((char*)d_ws + WS_CTL, 0, CTL_ZERO_BYTES, stream) != hipSuccess) { fprintf(stderr, "kernel_launch: memset failed\n"); return; }
    Args a{};
    for (int i = 0; i < 21; ++i) a.in[i] = (const float*)d_in[i];
    a.out = (float*)d_out; a.ws = (unsigned char*)d_ws;
#if N_LAUNCH_MODE == 0
    a.ph_lo = 0; a.ph_hi = NPH;
    hipLaunchKernelGGL(trunk_fwd, dim3(grid), dim3(NWAVES * 64), LDS_BYTES, stream, a);
#else
    for (int p = 0; p < NPH; ++p) { a.ph_lo = p; a.ph_hi = p + 1; hipLaunchKernelGGL(trunk_fwd, dim3(grid), dim3(NWAVES * 64), LDS_BYTES, stream, a); }
#endif
    const hipError_t le = hipPeekAtLastError();
    if (le != hipSuccess) fprintf(stderr, "kernel_launch: launch failed: %s\n", hipGetErrorName(le));
}
```

```cpp
#define PROBE 0
#include <hip/hip_runtime.h>
#include <cstdio>
#include <cstdint>
namespace pg8 {
#define PG8_LAS __attribute__((address_space(3)))
typedef unsigned short bf16_t;
typedef short bf16x8 __attribute__((ext_vector_type(8)));
typedef float f32x4 __attribute__((ext_vector_type(4)));
typedef unsigned u32x4 __attribute__((ext_vector_type(4)));
typedef int v4i_t __attribute__((ext_vector_type(4)));
typedef long v2l_t __attribute__((ext_vector_type(2)));
typedef int v8i_t __attribute__((ext_vector_type(8)));
constexpr int BM = 256, BK = 64, HALF = 128, HTB = HALF * BK * 2  , STAGE_BYTES = 8 * HTB, NXCD = 8, WGM = 8;

__host__ __device__ __forceinline__ int lds_byte(int r, int c) { const int st = (r >> 4) * 2 + (c >> 5), rr = r & 15, cc = c & 31, ob = rr * 64 + cc * 2; return st * 1024 + (ob ^ (((ob >> 9) & 1) << 5)); }
__host__ __device__ __forceinline__ void stage_rc(int b, int& R, int& C) { const int st = b / 1024, sb = b % 1024, swz = sb ^ (((sb >> 9) & 1) << 5); R = (st >> 1) * 16 + swz / 64; C = (st & 1) * 32 + (swz % 64) / 2; }
__host__ __device__ __forceinline__ int perm32(int rho) { const int n = rho >> 4, i = rho & 15; return 8 * (i >> 2) + 4 * n + (i & 3); }

struct Unit { int pm, pn; int ko = 0; };
struct Gemm { const bf16_t* A; const bf16_t* Bt; int M, N, K; int ld = 0; };

struct StaticOrder {
    int nM, nN, nwg, G, c;
    __host__ __device__ void init(int M, int N, int G_, int c_) { nM = M / BM; nN = N / BM; nwg = nM * nN; G = G_; c = c_; }
    __host__ __device__ __forceinline__ bool next(int i, Unit& u) const {
        const long L = (long)i * G + c; if (L >= nwg) return false;
        int wgid = (int)L; { const int q = nwg / NXCD, r = nwg % NXCD, xcd = wgid % NXCD, off = wgid / NXCD; wgid = (xcd < r ? xcd * (q + 1) : r * (q + 1) + (xcd - r) * q) + off; }
        const int nig = WGM * nN, gid = wgid / nig, fm = gid * WGM, gsz = (nM - fm) < WGM ? (nM - fm) : WGM;
        u.pm = fm + ((wgid % nig) % gsz); u.pn = (wgid % nig) / gsz; return true;
    }
    __device__ __forceinline__ void a_ready(const Unit&) const {}
    __device__ __forceinline__ void done(const Unit&) const {}
};

__device__ __forceinline__ unsigned cvt_pk_bf16(float lo, float hi) { unsigned r; asm volatile("v_cvt_pk_bf16_f32 %0, %1, %2" : "=v"(r) : "v"(lo), "v"(hi)); return r; }
typedef float f32x2 __attribute__((ext_vector_type(2)));
__device__ __forceinline__ float row_rs16(const float* ssp, int row) {
    const f32x4* sp = (const f32x4*)(ssp + (size_t)row * 16); const f32x4 s0 = sp[0], s1 = sp[1], s2 = sp[2], s3 = sp[3];
    const float s = (((s0[0] + s0[1]) + (s0[2] + s0[3])) + ((s1[0] + s1[1]) + (s1[2] + s1[3]))) + (((s2[0] + s2[1]) + (s2[2] + s2[3])) + ((s3[0] + s3[1]) + (s3[2] + s3[3])));
    return __builtin_amdgcn_rsqf(s * (1.0f / 1024.0f) + 1e-6f);
}
__device__ __forceinline__ void row_rs16x8(float (&r)[8], const float* ssp, int row0, int fr, int fq) {
    f32x4 c[8];
#pragma unroll
    for (int k = 0; k < 8; ++k) c[k] = *(const f32x4*)(ssp + (size_t)(row0 + (k >> 2) * HALF + (k & 3) * 16) * 16 + 4 * fq);
#pragma unroll
    for (int k = 0; k < 8; ++k) { float s = (c[k][0] + c[k][1]) + (c[k][2] + c[k][3]);
        s += __int_as_float(__builtin_amdgcn_ds_bpermute((((fq * 16 + fr) ^ 16) << 2), __float_as_int(s)));
        { const auto rr = __builtin_amdgcn_permlane32_swap(__float_as_uint(s), __float_as_uint(s), false, false); s = __uint_as_float(rr[0]) + __uint_as_float(rr[1]); }
        r[k] = __builtin_amdgcn_rsqf(s * (1.0f / 1024.0f) + 1e-6f); }
}
struct EpiRowScale {
    static constexpr bool PERM = true, AFTER_DRAIN = false;
    bf16_t* O; int ldc; const float* ssp; float cs;
    __device__ __forceinline__ void operator()(const f32x4 (&acc)[2][2][4][2], const Unit& u, int wr, int wc, int fr, int fq) const {
        const int row0 = u.pm * BM + wr * 64 + fr, col0 = u.pn * BM + wc * 32 + 8 * fq;
        float rr8[8];
        if (ssp) row_rs16x8(rr8, ssp, row0, fr, fq); else {
#pragma unroll
            for (int k = 0; k < 8; ++k) rr8[k] = 1.0f; }
#pragma unroll
        for (int ai = 0; ai < 2; ++ai)
#pragma unroll
            for (int m = 0; m < 4; ++m) { const int row = row0 + ai * HALF + m * 16; const float r = rr8[ai * 4 + m] * cs; bf16_t* rowp = O + (size_t)row * ldc + col0;
#pragma unroll
                for (int bj = 0; bj < 2; ++bj) { const f32x4 v0 = acc[ai][bj][m][0] * r, v1 = acc[ai][bj][m][1] * r;
                    u32x4 w; w.x = cvt_pk_bf16(v0[0], v0[1]); w.y = cvt_pk_bf16(v0[2], v0[3]); w.z = cvt_pk_bf16(v1[0], v1[1]); w.w = cvt_pk_bf16(v1[2], v1[3]);
                    *(u32x4*)(rowp + bj * HALF) = w; } }
    }
};
struct EpiInProj {
    static constexpr bool PERM = true, AFTER_DRAIN = false;
    bf16_t* O; const float* ssp; bf16_t* vt;
    __device__ __forceinline__ void operator()(const f32x4 (&acc)[2][2][4][2], const Unit& u, int wr, int wc, int fr, int fq) const {
        const int row0 = u.pm * BM + wr * 64 + fr;
        if (u.pn == 4 || u.pn == 5) {
            const int cv0 = (u.pn - 4) * BM + wc * 32 + 8 * fq; constexpr size_t CS = (size_t)32768 * 512;
#pragma unroll
            for (int ai = 0; ai < 2; ++ai)
#pragma unroll
                for (int m = 0; m < 4; ++m) { const int row = row0 + ai * HALF + m * 16; const float r = row_rs16(ssp, row); const int b = row >> 13, t = row & 8191;
                    const size_t o0 = (size_t)t, o1 = CS + (size_t)(t & 3) * 2048 + (t >> 2), o2 = 2 * CS + (size_t)(t & 15) * 512 + (t >> 4);
#pragma unroll
                    for (int bj = 0; bj < 2; ++bj)
#pragma unroll
                        for (int n = 0; n < 2; ++n) { const f32x4 v = acc[ai][bj][m][n] * r; const unsigned w01 = cvt_pk_bf16(v[0], v[1]), w23 = cvt_pk_bf16(v[2], v[3]);
                            bf16_t* p = vt + (size_t)(b * 512 + cv0 + bj * HALF + 4 * n) * 8192;
                            const bf16_t e0 = (bf16_t)(w01 & 0xffffu), e1 = (bf16_t)(w01 >> 16), e2 = (bf16_t)(w23 & 0xffffu), e3 = (bf16_t)(w23 >> 16);
                            p[o0] = e0; p[o1] = e0; p[o2] = e0; p[8192 + o0] = e1; p[8192 + o1] = e1; p[8192 + o2] = e1;
                            p[2 * 8192 + o0] = e2; p[2 * 8192 + o1] = e2; p[2 * 8192 + o2] = e2; p[3 * 8192 + o0] = e3; p[3 * 8192 + o1] = e3; p[3 * 8192 + o2] = e3; } }
        } else {
            const int col0 = u.pn * BM + wc * 32 + 8 * fq;
#pragma unroll
            for (int ai = 0; ai < 2; ++ai)
#pragma unroll
                for (int m = 0; m < 4; ++m) { const int row = row0 + ai * HALF + m * 16; const float r = row_rs16(ssp, row); bf16_t* rowp = O + (size_t)row * 2560 + col0;
#pragma unroll
                    for (int bj = 0; bj < 2; ++bj) { const f32x4 v0 = acc[ai][bj][m][0] * r, v1 = acc[ai][bj][m][1] * r;
                        u32x4 w; w.x = cvt_pk_bf16(v0[0], v0[1]); w.y = cvt_pk_bf16(v0[2], v0[3]); w.z = cvt_pk_bf16(v1[0], v1[1]); w.w = cvt_pk_bf16(v1[2], v1[3]);
                        *(u32x4*)(rowp + bj * HALF) = w; } }
        }
    }
};
struct EpiKV {
    static constexpr bool PERM = true, AFTER_DRAIN = false;
    bf16_t* kvx; bf16_t* vtx;
    __device__ __forceinline__ void operator()(const f32x4 (&acc)[2][2][4][2], const Unit& u, int wr, int wc, int fr, int fq) const {
        const int row0 = u.pm * BM + wr * 64 + fr, col0 = u.pn * BM + wc * 32 + 8 * fq;
        if ((u.pn & 3) >= 2) {
            const int lx = u.pn >> 2, dv0 = (col0 & 1023) - 512;
#pragma unroll
            for (int ai = 0; ai < 2; ++ai)
#pragma unroll
                for (int m = 0; m < 4; ++m) { const int row = row0 + ai * HALF + m * 16; const int b = row >> 8, key = row & 255;
#pragma unroll
                    for (int bj = 0; bj < 2; ++bj)
#pragma unroll
                        for (int n = 0; n < 2; ++n) { const f32x4 v = acc[ai][bj][m][n]; const unsigned w01 = cvt_pk_bf16(v[0], v[1]), w23 = cvt_pk_bf16(v[2], v[3]);
                            bf16_t* p = vtx + ((size_t)((lx * 4 + b) * 512 + dv0 + bj * HALF + 4 * n)) * 256 + key;
                            p[0] = (bf16_t)(w01 & 0xffffu); p[256] = (bf16_t)(w01 >> 16); p[512] = (bf16_t)(w23 & 0xffffu); p[768] = (bf16_t)(w23 >> 16); } }
        } else {
#pragma unroll
            for (int ai = 0; ai < 2; ++ai)
#pragma unroll
                for (int m = 0; m < 4; ++m) { const int row = row0 + ai * HALF + m * 16; bf16_t* rowp = kvx + (size_t)row * 4096 + col0;
#pragma unroll
                    for (int bj = 0; bj < 2; ++bj) { const f32x4 v0 = acc[ai][bj][m][0], v1 = acc[ai][bj][m][1];
                        u32x4 w; w.x = cvt_pk_bf16(v0[0], v0[1]); w.y = cvt_pk_bf16(v0[2], v0[3]); w.z = cvt_pk_bf16(v1[0], v1[1]); w.w = cvt_pk_bf16(v1[2], v1[3]);
                        *(u32x4*)(rowp + bj * HALF) = w; } }
        }
    }
};
__device__ __forceinline__ float silu_mul(float g, float u) { return g * u * __builtin_amdgcn_rcpf(1.0f + __expf(-g)); }
struct EpiSwiGLU {
    static constexpr bool PERM = true, AFTER_DRAIN = false;
    bf16_t* O; int ldc; const float* ssp; const float* rmul; int pn_mod;
    __device__ __forceinline__ void operator()(const f32x4 (&acc)[2][2][4][2], const Unit& u, int wr, int wc, int fr, int fq) const {
        const int pnl = pn_mod ? (u.pn % pn_mod) : u.pn;
        const int row0 = u.pm * BM + wr * 64 + fr, col0 = pnl * HALF + wc * 32 + 8 * fq;
        float rr8[8];
        if (ssp) row_rs16x8(rr8, ssp, row0, fr, fq); else {
#pragma unroll
            for (int k = 0; k < 8; ++k) rr8[k] = rmul[row0 + (k >> 2) * HALF + (k & 3) * 16]; }
#pragma unroll
        for (int ai = 0; ai < 2; ++ai)
#pragma unroll
            for (int m = 0; m < 4; ++m) { const int row = row0 + ai * HALF + m * 16; const float r = rr8[ai * 4 + m];
                const f32x4 g0 = acc[ai][0][m][0] * r, g1 = acc[ai][0][m][1] * r, u0 = acc[ai][1][m][0] * r, u1 = acc[ai][1][m][1] * r;
                u32x4 w; w.x = cvt_pk_bf16(silu_mul(g0[0], u0[0]), silu_mul(g0[1], u0[1])); w.y = cvt_pk_bf16(silu_mul(g0[2], u0[2]), silu_mul(g0[3], u0[3]));
                w.z = cvt_pk_bf16(silu_mul(g1[0], u1[0]), silu_mul(g1[1], u1[1])); w.w = cvt_pk_bf16(silu_mul(g1[2], u1[2]), silu_mul(g1[3], u1[3]));
                *(u32x4*)(O + (size_t)row * ldc + col0) = w; }
    }
};
__device__ __forceinline__ float sat8(float v) { return __builtin_amdgcn_fmed3f(v, -448.0f, 448.0f); }
__device__ __forceinline__ unsigned pk4_fp8_w(float a, float b, float c, float d) { int r = __builtin_amdgcn_cvt_pk_fp8_f32(a, b, 0, false); r = __builtin_amdgcn_cvt_pk_fp8_f32(c, d, r, true); return (unsigned)r; }
__device__ __forceinline__ unsigned pk4_fp8(float a, float b, float c, float d) { int r = __builtin_amdgcn_cvt_pk_fp8_f32(sat8(a), sat8(b), 0, false); r = __builtin_amdgcn_cvt_pk_fp8_f32(sat8(c), sat8(d), r, true); return (unsigned)r; }
struct EpiSwiGLU8 {
    static constexpr bool PERM = true, AFTER_DRAIN = false;
    unsigned char* O; int ldc; const float* rmul; int pn_mod; float cs, hs; const float* ssp;
    __device__ __forceinline__ void operator()(const f32x4 (&acc)[2][2][4][2], const Unit& u, int wr, int wc, int fr, int fq) const {
        const int pnl = pn_mod ? (u.pn % pn_mod) : u.pn;
        const int row0 = u.pm * BM + wr * 64 + fr, col0 = pnl * HALF + wc * 32 + 8 * fq;
        float rr8[8];
        if (ssp) row_rs16x8(rr8, ssp, row0, fr, fq); else {
#pragma unroll
            for (int k = 0; k < 8; ++k) rr8[k] = rmul[row0 + (k >> 2) * HALF + (k & 3) * 16]; }
#pragma unroll
        for (int ai = 0; ai < 2; ++ai)
#pragma unroll
            for (int m = 0; m < 4; ++m) { const int row = row0 + ai * HALF + m * 16; const float r = rr8[ai * 4 + m] * cs, r2 = r * -1.4426950408889634f, rrh = r * r * hs;
                unsigned w[2];
#pragma unroll
                for (int n = 0; n < 2; ++n) { const f32x4 ag = acc[ai][0][m][n], au = acc[ai][1][m][n]; const f32x4 t = ag * r2;
                    f32x4 d; d[0] = __builtin_amdgcn_exp2f(t[0]); d[1] = __builtin_amdgcn_exp2f(t[1]); d[2] = __builtin_amdgcn_exp2f(t[2]); d[3] = __builtin_amdgcn_exp2f(t[3]);
                    d = d + 1.0f;
                    f32x4 iv; iv[0] = __builtin_amdgcn_rcpf(d[0]); iv[1] = __builtin_amdgcn_rcpf(d[1]); iv[2] = __builtin_amdgcn_rcpf(d[2]); iv[3] = __builtin_amdgcn_rcpf(d[3]);
                    const f32x4 hv = ((ag * au) * rrh) * iv;
                    w[n] = pk4_fp8(hv[0], hv[1], hv[2], hv[3]); }
                typedef unsigned u32x2_t __attribute__((ext_vector_type(2)));
                *(u32x2_t*)(O + (size_t)row * ldc + col0) = (u32x2_t){w[0], w[1]}; }
    }
};
struct EpiResid {
    static constexpr bool PERM = true, AFTER_DRAIN = false;
    const float* base32; bf16_t* xb; float* ssp_out; unsigned char* xb8; float cs; int w8;
    __device__ __forceinline__ void operator()(const f32x4 (&acc)[2][2][4][2], const Unit& u, int wr, int wc, int fr, int fq) const {
        const int row0 = u.pm * BM + wr * 64 + fr, col0 = u.pn * BM + wc * 32 + 8 * fq;
        u32x4 xw[2][4][2];
        if (!base32) {
#pragma unroll
            for (int ai = 0; ai < 2; ++ai)
#pragma unroll
                for (int m = 0; m < 4; ++m)
#pragma unroll
                    for (int bj = 0; bj < 2; ++bj) xw[ai][m][bj] = *(const u32x4*)(xb + (size_t)(row0 + ai * HALF + m * 16) * 1024 + col0 + bj * HALF);
        }
#pragma unroll
        for (int ai = 0; ai < 2; ++ai)
#pragma unroll
            for (int m = 0; m < 4; ++m) { const int row = row0 + ai * HALF + m * 16; const size_t off = (size_t)row * 1024 + col0; float q = 0.f;
#pragma unroll
                for (int bj = 0; bj < 2; ++bj) { f32x4 b0, b1;
                    if (base32) { b0 = *(const f32x4*)(base32 + off + bj * HALF); b1 = *(const f32x4*)(base32 + off + bj * HALF + 4); }
                    else { const u32x4 w4 = xw[ai][m][bj];
                        b0 = (f32x4){__uint_as_float(w4.x << 16), __uint_as_float(w4.x & 0xffff0000u), __uint_as_float(w4.y << 16), __uint_as_float(w4.y & 0xffff0000u)};
                        b1 = (f32x4){__uint_as_float(w4.z << 16), __uint_as_float(w4.z & 0xffff0000u), __uint_as_float(w4.w << 16), __uint_as_float(w4.w & 0xffff0000u)}; }
                    const f32x4 v0 = b0 + acc[ai][bj][m][0] * cs, v1 = b1 + acc[ai][bj][m][1] * cs;
                    u32x4 w; w.x = cvt_pk_bf16(v0[0], v0[1]); w.y = cvt_pk_bf16(v0[2], v0[3]); w.z = cvt_pk_bf16(v1[0], v1[1]); w.w = cvt_pk_bf16(v1[2], v1[3]);
                    *(u32x4*)(xb + off + bj * HALF) = w;
                    if (w8) { typedef unsigned u32x2_t __attribute__((ext_vector_type(2))); *(u32x2_t*)(xb8 + off + bj * HALF) = (u32x2_t){pk4_fp8(v0[0], v0[1], v0[2], v0[3]), pk4_fp8(v1[0], v1[1], v1[2], v1[3])}; }
                    q += ((v0[0] * v0[0] + v0[1] * v0[1]) + (v0[2] * v0[2] + v0[3] * v0[3])) + ((v1[0] * v1[0] + v1[1] * v1[1]) + (v1[2] * v1[2] + v1[3] * v1[3])); }
                q += __int_as_float(__builtin_amdgcn_ds_bpermute((((fq * 16 + fr) ^ 16) << 2), __float_as_int(q)));
                { const auto rr = __builtin_amdgcn_permlane32_swap(__float_as_uint(q), __float_as_uint(q), false, false); q = __uint_as_float(rr[0]) + __uint_as_float(rr[1]); }
                if (fq == 0) ssp_out[(size_t)row * 16 + u.pn * 4 + wc] = q;
                if (base32 && (m & 1)) asm volatile("" ::: "memory"); }
    }
};
struct EpiMoeOut {
    static constexpr bool PERM = true, AFTER_DRAIN = false;
    bf16_t* Y; const float* gate; float cs = 1.0f;
    __device__ __forceinline__ void operator()(const f32x4 (&acc)[2][2][4][2], const Unit& u, int wr, int wc, int fr, int fq) const {
        const int row0 = u.pm * BM + wr * 64 + fr, col0 = (u.pn & 3) * BM + wc * 32 + 8 * fq;
#pragma unroll
        for (int ai = 0; ai < 2; ++ai)
#pragma unroll
            for (int m = 0; m < 4; ++m) { const int row = row0 + ai * HALF + m * 16; const float gt = gate[row] * cs; bf16_t* rowp = Y + (size_t)row * 1024 + col0;
#pragma unroll
                for (int bj = 0; bj < 2; ++bj) { const f32x4 v0 = acc[ai][bj][m][0] * gt, v1 = acc[ai][bj][m][1] * gt;
                    u32x4 w; w.x = cvt_pk_bf16(v0[0], v0[1]); w.y = cvt_pk_bf16(v0[2], v0[3]); w.z = cvt_pk_bf16(v1[0], v1[1]); w.w = cvt_pk_bf16(v1[2], v1[3]);
                    *(u32x4*)(rowp + bj * HALF) = w; } }
    }
};
struct EpiNull {
    static constexpr bool PERM = true, AFTER_DRAIN = false;
    float* sink;
    __device__ __forceinline__ void operator()(const f32x4 (&acc)[2][2][4][2], const Unit& u, int wr, int wc, int fr, int fq) const {
        float s = 0.f;
#pragma unroll
        for (int ai = 0; ai < 2; ++ai)
#pragma unroll
            for (int bj = 0; bj < 2; ++bj)
#pragma unroll
                for (int m = 0; m < 4; ++m)
#pragma unroll
                    for (int n = 0; n < 2; ++n) s += (acc[ai][bj][m][n][0] + acc[ai][bj][m][n][1]) + (acc[ai][bj][m][n][2] + acc[ai][bj][m][n][3]);
        if (s == 12345.6789f) sink[u.pm * 4 + wr] = s;
    }
};
struct EpiMoePart {
    static constexpr bool PERM = true, AFTER_DRAIN = false;
    bf16_t* P; const float* gate; float cs = 1.0f; int kshift = 10;
    __device__ __forceinline__ void operator()(const f32x4 (&acc)[2][2][4][2], const Unit& u, int wr, int wc, int fr, int fq) const {
        const int row0 = u.pm * BM + wr * 64 + fr, col0 = (u.pn & 3) * BM + wc * 32 + 8 * fq; bf16_t* base = P + (size_t)(u.ko >> kshift) * (2048 * 1024);
#pragma unroll
        for (int ai = 0; ai < 2; ++ai)
#pragma unroll
            for (int m = 0; m < 4; ++m) { const int row = row0 + ai * HALF + m * 16; const float gt = gate[row] * cs; bf16_t* rowp = base + (size_t)(row - 65536) * 1024 + col0;
#pragma unroll
                for (int bj = 0; bj < 2; ++bj) { const f32x4 v0 = acc[ai][bj][m][0] * gt, v1 = acc[ai][bj][m][1] * gt;
                    u32x4 w; w.x = cvt_pk_bf16(v0[0], v0[1]); w.y = cvt_pk_bf16(v0[2], v0[3]); w.z = cvt_pk_bf16(v1[0], v1[1]); w.w = cvt_pk_bf16(v1[2], v1[3]);
                    *(u32x4*)(rowp + bj * HALF) = w; } }
    }
};
struct MoeTailOrder {
    int npieces, G, c; int te[8]; int kstep = 1024;
    __device__ __forceinline__ bool next(int i, Unit& u) const {
        const int p = i * G + c; if (p >= npieces) return false;
        const int tt = p / 7, kp = p - tt * 7; const int pm = 256 + (tt >> 2);
        int e = 0;
#pragma unroll
        for (int k = 0; k < 7; ++k) e += (pm >= te[k]) ? 1 : 0;
        u.pm = pm; u.pn = e * 4 + (tt & 3); u.ko = kp * kstep; return true;
    }
    __device__ __forceinline__ void a_ready(const Unit&) const {}
    __device__ __forceinline__ void done(const Unit&) const {}
};
struct TeamOrder {
    int pm, pn0, npn;
    __device__ __forceinline__ bool next(int i, Unit& u) const { if (i >= npn) return false; u.pm = pm; u.pn = pn0 + i; return true; }
    __device__ __forceinline__ void a_ready(const Unit&) const {}
    __device__ __forceinline__ void done(const Unit&) const {}
};
struct MoeOrder {
    StaticOrder so; int nNl; int te[8];
    __device__ __forceinline__ bool next(int i, Unit& u) const {
        if (!so.next(i, u)) return false;
        int e = 0;
#pragma unroll
        for (int k = 0; k < 7; ++k) e += (u.pm >= te[k]) ? 1 : 0;
        u.pn += e * nNl; return true;
    }
    __device__ __forceinline__ void a_ready(const Unit&) const {}
    __device__ __forceinline__ void done(const Unit&) const {}
};

template <class Epi, class Sched, bool ALIGN_EPI = false, bool SP2 = false, bool F8 = false>
__device__ __forceinline__ void gemm_phase(PG8_LAS unsigned char* lds, const Gemm g, const Sched& S, const Epi& E, const int tid) {
    const int wid = __builtin_amdgcn_readfirstlane(tid >> 6), lane = tid & 63, wr = wid >> 2, wc = wid & 3, fr = lane & 15, fq = lane >> 4;
    const int K = g.K, nt = K / BK, LD = g.ld ? g.ld : K;
    unsigned voffA[2], voffB[2];
#pragma unroll
    for (int i = 0; i < 2; ++i) { int R, C; stage_rc(tid * 16 + i * 8192, R, C); const int Rb = Epi::PERM ? ((R & ~31) + perm32(R & 31)) : R;
        voffA[i] = (unsigned)(R * LD + C) * 2u; voffB[i] = (unsigned)(Rb * LD + C) * 2u; }
    const size_t kstep = (size_t)(BK * 2);
    const size_t hstep = (size_t)HALF * LD * 2;
    const size_t tstep = 2 * hstep;
    const unsigned ldsw = (unsigned)wid * 1024u;
    const int aoff = lds_byte(wr * 64 + fr, fq * 8), boff = lds_byte(wc * 32 + fr, fq * 8);
#define PG8_SA(b, h) (((b) * 2 + (h)) * HTB)
#define PG8_SB(b, h) ((4 + (b) * 2 + (h)) * HTB)
#define PG8_STAGE(bufoff, gbase, voff) do { _Pragma("unroll") for (int _i = 0; _i < 2; ++_i) \
        __builtin_amdgcn_global_load_lds((const unsigned*)((const char*)(gbase) + (voff)[_i]), (PG8_LAS unsigned*)(lds + (bufoff) + ldsw + _i * 8192), 16, 0, 0); } while (0)
#define PG8_CAT8(x, y) __builtin_shufflevector(__builtin_bit_cast(v4i_t, x), __builtin_bit_cast(v4i_t, y), 0, 1, 2, 3, 4, 5, 6, 7)
#define PG8_LDA(dst, b, h) do { _Pragma("unroll") for (int m = 0; m < 4; ++m) { if constexpr (F8) dst##8[m] = PG8_CAT8(*(const PG8_LAS bf16x8*)(lds + PG8_SA(b, h) + aoff + m * 2048), *(const PG8_LAS bf16x8*)(lds + PG8_SA(b, h) + aoff + m * 2048 + 1024)); \
        else { _Pragma("unroll") for (int k = 0; k < 2; ++k) dst[m][k] = *(const PG8_LAS bf16x8*)(lds + PG8_SA(b, h) + aoff + m * 2048 + k * 1024); } } } while (0)
#define PG8_LDB(dst, b, h) do { _Pragma("unroll") for (int n = 0; n < 2; ++n) { if constexpr (F8) dst##8[n] = PG8_CAT8(*(const PG8_LAS bf16x8*)(lds + PG8_SB(b, h) + boff + n * 2048), *(const PG8_LAS bf16x8*)(lds + PG8_SB(b, h) + boff + n * 2048 + 1024)); \
        else { _Pragma("unroll") for (int k = 0; k < 2; ++k) dst[n][k] = *(const PG8_LAS bf16x8*)(lds + PG8_SB(b, h) + boff + n * 2048 + k * 1024); } } } while (0)
#define PG8_MMA(ai, bj, At, Bt) do { __builtin_amdgcn_s_setprio(1); _Pragma("unroll") for (int m = 0; m < 4; ++m) _Pragma("unroll") for (int n = 0; n < 2; ++n) { \
        if constexpr (F8) asm volatile("v_mfma_scale_f32_16x16x128_f8f6f4 %0, %1, %2, %0, %3, %3 op_sel_hi:[0,0,0]" : "+v"(acc[ai][bj][m][n]) : "v"(Bt##8[n]), "v"(At##8[m]), "v"(f8scale)); \
        else { _Pragma("unroll") for (int k = 0; k < 2; ++k) acc[ai][bj][m][n] = __builtin_amdgcn_mfma_f32_16x16x32_bf16(Bt[n][k], At[m][k], acc[ai][bj][m][n], 0, 0, 0); } } __builtin_amdgcn_s_setprio(0); } while (0)
#define PG8_WAIT_V(n) asm volatile("s_waitcnt vmcnt(" #n ")" ::: "memory")
#define PG8_WAIT_L(n) asm volatile("s_waitcnt lgkmcnt(" #n ")" ::: "memory")
#define PG8_BAR __builtin_amdgcn_s_barrier()
#define PG8_SCHED __builtin_amdgcn_sched_barrier(0)
    Unit cur, nxt; int ui = 0;
    if (!S.next(0, cur)) return;
    f32x4 acc[2][2][4][2];
#pragma unroll
    for (int a = 0; a < 2; ++a)
#pragma unroll
        for (int b = 0; b < 2; ++b)
#pragma unroll
            for (int m = 0; m < 4; ++m)
#pragma unroll
                for (int n = 0; n < 2; ++n) acc[a][b][m][n] = (f32x4){0.f, 0.f, 0.f, 0.f};
    const int f8scale = 0x7f7f7f7f;
    bf16x8 At[4][2], B0[2][2], B1[2][2]; v8i_t At8[4], B08[2], B18[2];
    const char* cA = (const char*)g.A + (size_t)cur.pm * tstep + cur.ko; const char* cB = (const char*)g.Bt + (size_t)cur.pn * tstep + cur.ko;
    S.a_ready(cur);
    if constexpr (SP2) {
        PG8_STAGE(PG8_SB(0, 0), cB, voffB); PG8_STAGE(PG8_SB(0, 1), cB + hstep, voffB); PG8_STAGE(PG8_SA(0, 0), cA, voffA); PG8_STAGE(PG8_SA(0, 1), cA + hstep, voffA);
        if (wr == 1) PG8_BAR;
        PG8_WAIT_V(2); PG8_BAR;
        PG8_STAGE(PG8_SB(1, 0), cB + kstep, voffB); PG8_STAGE(PG8_SA(1, 0), cA + kstep, voffA); PG8_STAGE(PG8_SB(1, 1), cB + hstep + kstep, voffB);
        PG8_WAIT_V(6); PG8_BAR;
    } else {
        PG8_STAGE(PG8_SB(0, 0), cB, voffB); PG8_STAGE(PG8_SA(0, 0), cA, voffA); PG8_STAGE(PG8_SB(0, 1), cB + hstep, voffB); PG8_STAGE(PG8_SA(0, 1), cA + hstep, voffA);
        if (wr == 1) PG8_BAR;
        PG8_WAIT_V(4); PG8_BAR;
        PG8_STAGE(PG8_SB(1, 0), cB + kstep, voffB); PG8_STAGE(PG8_SA(1, 0), cA + kstep, voffA); PG8_STAGE(PG8_SB(1, 1), cB + hstep + kstep, voffB);
        PG8_WAIT_V(6); PG8_BAR;
    }
    for (;;) {
        const bool has_next = S.next(ui + 1, nxt);
        const char* nA = has_next ? (const char*)g.A + (size_t)nxt.pm * tstep + nxt.ko : cA; const char* nB = has_next ? (const char*)g.Bt + (size_t)nxt.pn * tstep + nxt.ko : cB;
        for (int t = 0; t < nt; t += 2) {
            const bool last = (t == nt - 2);
            const char* a1 = cA + (size_t)(t + 1) * kstep;
            const char* a2 = last ? nA : cA + (size_t)(t + 2) * kstep; const char* b2 = last ? nB : cB + (size_t)(t + 2) * kstep;
            const char* a3 = a2 + kstep; const char* b3 = b2 + kstep;
            if (last && has_next) S.a_ready(nxt);
            if constexpr (SP2) {
            PG8_LDB(B0, 0, 0); PG8_LDB(B1, 0, 1); PG8_SCHED; PG8_LDA(At, 0, 0); PG8_STAGE(PG8_SA(1, 1), a1 + hstep, voffA);
            PG8_WAIT_V(8); PG8_WAIT_L(0); PG8_BAR; PG8_MMA(0, 0, At, B0); PG8_MMA(0, 1, At, B1); PG8_BAR; PG8_SCHED;
            PG8_LDA(At, 0, 1); PG8_STAGE(PG8_SB(0, 0), b2, voffB); PG8_STAGE(PG8_SB(0, 1), b2 + hstep, voffB); PG8_STAGE(PG8_SA(0, 0), a2, voffA);
            PG8_WAIT_V(8); PG8_WAIT_L(0); PG8_BAR; PG8_MMA(1, 0, At, B0); PG8_MMA(1, 1, At, B1); PG8_BAR; PG8_SCHED;
            PG8_LDB(B0, 1, 0); PG8_LDB(B1, 1, 1); PG8_SCHED; PG8_LDA(At, 1, 0); PG8_STAGE(PG8_SA(0, 1), a2 + hstep, voffA);
            PG8_WAIT_V(8); PG8_WAIT_L(0); PG8_BAR; PG8_MMA(0, 0, At, B0); PG8_MMA(0, 1, At, B1); PG8_BAR; PG8_SCHED;
            PG8_LDA(At, 1, 1); PG8_STAGE(PG8_SB(1, 0), b3, voffB); PG8_STAGE(PG8_SB(1, 1), b3 + hstep, voffB); PG8_STAGE(PG8_SA(1, 0), a3, voffA);
            PG8_WAIT_V(8); PG8_WAIT_L(0); PG8_BAR; PG8_MMA(1, 0, At, B0); PG8_MMA(1, 1, At, B1); PG8_BAR; PG8_SCHED;
            } else {
            PG8_LDB(B0, 0, 0); PG8_SCHED; PG8_LDA(At, 0, 0); PG8_STAGE(PG8_SA(1, 1), a1 + hstep, voffA);
            PG8_WAIT_L(8); PG8_BAR; PG8_WAIT_L(0); PG8_MMA(0, 0, At, B0); PG8_BAR; PG8_SCHED;
            PG8_LDB(B1, 0, 1); PG8_STAGE(PG8_SB(0, 0), b2, voffB);
            PG8_BAR; PG8_WAIT_L(0); PG8_MMA(0, 1, At, B1); PG8_BAR;
            PG8_LDA(At, 0, 1); PG8_STAGE(PG8_SA(0, 0), a2, voffA);
            PG8_BAR; PG8_WAIT_L(0); PG8_MMA(1, 0, At, B0); PG8_BAR; PG8_SCHED;
            PG8_STAGE(PG8_SB(0, 1), b2 + hstep, voffB);
            PG8_WAIT_V(6); PG8_BAR; PG8_MMA(1, 1, At, B1); PG8_BAR;
            PG8_LDB(B0, 1, 0); PG8_SCHED; PG8_LDA(At, 1, 0); PG8_STAGE(PG8_SA(0, 1), a2 + hstep, voffA);
            PG8_WAIT_L(8); PG8_BAR; PG8_WAIT_L(0); PG8_MMA(0, 0, At, B0); PG8_BAR; PG8_SCHED;
            PG8_LDB(B1, 1, 1); PG8_STAGE(PG8_SB(1, 0), b3, voffB);
            PG8_BAR; PG8_WAIT_L(0); PG8_MMA(0, 1, At, B1); PG8_BAR;
            PG8_LDA(At, 1, 1); PG8_STAGE(PG8_SA(1, 0), a3, voffA);
            PG8_BAR; PG8_WAIT_L(0); PG8_MMA(1, 0, At, B0); PG8_BAR; PG8_SCHED;
            PG8_STAGE(PG8_SB(1, 1), b3 + hstep, voffB);
            PG8_WAIT_V(6); PG8_BAR; PG8_MMA(1, 1, At, B1); PG8_BAR;
            }
        }
        if constexpr (ALIGN_EPI) { if (wr == 0) PG8_BAR; }
        if constexpr (F8) asm volatile("s_nop 15\n\ts_nop 15" ::: "memory");
        if constexpr (!Epi::AFTER_DRAIN) { int fr_ = fr, fq_ = fq; asm volatile("" : "+v"(fr_), "+v"(fq_)); E(acc, cur, wr, wc, fr_, fq_); S.done(cur); }
        if (!has_next) break;
#pragma unroll
        for (int a = 0; a < 2; ++a)
#pragma unroll
            for (int b = 0; b < 2; ++b)
#pragma unroll
                for (int m = 0; m < 4; ++m)
#pragma unroll
                    for (int n = 0; n < 2; ++n) acc[a][b][m][n] = (f32x4){0.f, 0.f, 0.f, 0.f};
        cur = nxt; cA = nA; cB = nB; ++ui;
        if constexpr (ALIGN_EPI) { if (wr == 1) PG8_BAR; }
    }
    PG8_WAIT_V(0);
    if constexpr (!ALIGN_EPI) { if (wr == 0) PG8_BAR; }
    PG8_BAR;
    if constexpr (Epi::AFTER_DRAIN) { E.fused(acc, cur, wr, wc, fr, fq, lds, wid, lane); S.done(cur); }
#undef PG8_SA
#undef PG8_SB
#undef PG8_STAGE
#undef PG8_LDA
#undef PG8_LDB
#undef PG8_MMA
#undef PG8_CAT8
#undef PG8_WAIT_V
#undef PG8_WAIT_L
#undef PG8_BAR
#undef PG8_SCHED
}
}
#define GAS __attribute__((address_space(1)))
#define LAS __attribute__((address_space(3)))
typedef unsigned short bf16;
typedef unsigned v4u __attribute__((ext_vector_type(4)));
typedef float f32x4 __attribute__((ext_vector_type(4)));
typedef short bf16x8 __attribute__((ext_vector_type(8)));
typedef GAS unsigned gu32;
typedef GAS unsigned long long gu64;
#define RLX_AGENT __ATOMIC_RELAXED, __HIP_MEMORY_SCOPE_AGENT
#define LDS_WAIT() asm volatile("s_waitcnt lgkmcnt(0)" ::: "memory")
#define VM_WAIT() asm volatile("s_waitcnt vmcnt(0)" ::: "memory")
__device__ __forceinline__ unsigned long long rt() { return __builtin_amdgcn_s_memrealtime(); }
__device__ __forceinline__ unsigned f2bf(float f) { unsigned u = __builtin_bit_cast(unsigned, f); return (u + 0x7fffu + ((u >> 16) & 1u)) >> 16; }
__device__ __forceinline__ unsigned pk2(float lo, float hi) { return f2bf(lo) | (f2bf(hi) << 16); }
#define XB_TMO      128
#define XB_XCNT(j)  (256  + 64 * (j))
#define XB_XSUB(j)  (1280 + 64 * (j))
#define XB_XGEN(j)  (2304 + 64 * (j))
#define XB_TOP      3328
#define XB_TOPGEN   3392
#define XCD_BAR_WORDS 3456
#define XB_SPIN_CAP (1u << 18)

__device__ __forceinline__ unsigned xb_ld(unsigned* p)              { return __hip_atomic_load(p, __ATOMIC_RELAXED, __HIP_MEMORY_SCOPE_AGENT); }
__device__ __forceinline__ unsigned xb_add(unsigned* p, unsigned v) { return __hip_atomic_fetch_add(p, v, __ATOMIC_RELAXED, __HIP_MEMORY_SCOPE_AGENT); }
__device__ __forceinline__ unsigned xb_xcc_id() { return (unsigned)__builtin_amdgcn_s_getreg((3 << 11) | 20) & 0xFu; }
#define XB_SPIN(cond, bar) do { unsigned _sp = 0; while (cond) { __builtin_amdgcn_s_sleep(1); \
    if ((++_sp & 255u) == 0u) { if (xb_ld(&(bar)[XB_TMO])) break; if (_sp > XB_SPIN_CAP) { atomicAdd(&(bar)[XB_TMO], 1u); break; } } } } while (0)

struct XcdBarrier {
    unsigned* bar; unsigned x;
    volatile LAS unsigned* st;
};

__device__ __forceinline__ XcdBarrier xcd_barrier_post(unsigned* bar, volatile LAS unsigned* st) {
    XcdBarrier b; b.bar = bar; b.x = xb_xcc_id(); b.st = st;
    if (threadIdx.x == 0) (void)xb_add(&bar[XB_XCNT(b.x)], 1u);
    return b;
}
__device__ __forceinline__ void xcd_barrier_complete(unsigned* bar, unsigned x, unsigned& nloc, unsigned& nx) {
    const unsigned G = gridDim.x * gridDim.y * gridDim.z;
    unsigned sum, cnt, mine, sp = 0u;
    for (;;) {
        sum = 0u; cnt = 0u; mine = 0u;
#pragma unroll
        for (unsigned j = 0; j < 16; ++j) { const unsigned c = xb_ld(&bar[XB_XCNT(j)]); sum += c; cnt += (c > 0u) ? 1u : 0u; mine = (j == x) ? c : mine; }
        if (sum == G) break;
        __builtin_amdgcn_s_sleep(1);
        if ((++sp & 255u) == 0u) { if (xb_ld(&bar[XB_TMO])) break; if (sp > XB_SPIN_CAP) { atomicAdd(&bar[XB_TMO], 1u); break; } }
    }
    nloc = mine > 0u ? mine : 1u; nx = cnt > 0u ? cnt : 1u;
}

__device__ __forceinline__ void xcd_barrier(const XcdBarrier& b) {
    asm volatile("s_waitcnt vmcnt(0)" ::: "memory");
    __syncthreads();
    if (threadIdx.x == 0) {
        unsigned* bar = b.bar;
        __builtin_amdgcn_s_waitcnt(0);
        unsigned nloc = b.st[0], nx = b.st[1];
        if (nloc == 0u) { xcd_barrier_complete(bar, b.x, nloc, nx); b.st[0] = nloc; b.st[1] = nx; }
        const unsigned old = xb_add(&bar[XB_XSUB(b.x)], 1u);
        const unsigned gen = old / nloc;
        if (old + 1u == (gen + 1u) * nloc) {
            __builtin_amdgcn_fence(__ATOMIC_RELEASE, "agent");
            asm volatile("s_waitcnt vmcnt(0)" ::: "memory");
            const unsigned og = xb_add(&bar[XB_TOP], 1u);
            const unsigned tg = og / nx;
            if (og + 1u == (tg + 1u) * nx) xb_add(&bar[XB_TOPGEN], 1u);
            else XB_SPIN(xb_ld(&bar[XB_TOPGEN]) == tg, bar);
            __builtin_amdgcn_fence(__ATOMIC_ACQUIRE, "agent");
            xb_add(&bar[XB_XGEN(b.x)], 1u);
            asm volatile("s_waitcnt vmcnt(0)" ::: "memory");
        } else {
            XB_SPIN(xb_ld(&bar[XB_XGEN(b.x)]) == gen, bar);
            __builtin_amdgcn_fence(__ATOMIC_ACQUIRE, "agent");
            asm volatile("s_waitcnt vmcnt(0)" ::: "memory");
        }
    }
    __syncthreads();
}
constexpr int NWAVES = 8;
constexpr int BATCH = 4, SEQ = 8192, D = 1024, T = BATCH * SEQ, DEPTH = 4, MEML = 256, MROWS = BATCH * MEML;
constexpr int NPROJ = 2560, FFD = 2816, FFE = 3584, NEXP = 8, XW = 512;
constexpr int MP = 2 * T + NEXP * 256;
constexpr float F8_S1 = 16.0f, F8_S2 = 32.0f, F8_SH = 4.0f;
constexpr int NKEYS = 321;
constexpr int NPH = 1 + 8 + 11 + 8 + 11;
constexpr int PC_Q = 0, PC_K = 512, PC_V = 1024, PC_POOL = 1536, PC_BG = 1792, PC_CG = 2048, PC_HC = 2304;
constexpr size_t MiB = 1u << 20;
constexpr size_t WS_CTL = 0, CTL_ZERO_BYTES = 64 * 1024;
constexpr size_t WS_PWT = 256 * 1024;
constexpr size_t WS_CNT = 1 * MiB, WS_META = 1 * MiB + 64 * 1024;
constexpr size_t WS_TOKE = 1 * MiB + 512 * 1024, WS_TOKG = 2 * MiB, WS_TOKPOS = 2 * MiB + 512 * 1024, WS_ROWGATE = 3 * MiB, WS_ROWRS = 3 * MiB + 512 * 1024;
constexpr size_t WS_SSP = 4 * MiB;
constexpr size_t WS_KVX = 30 * MiB, WS_MEMN = 38 * MiB;
constexpr size_t WS_WIN = 40 * MiB, WS_WOUT = 60 * MiB, WS_WQ = 68 * MiB, WS_WKV = 72 * MiB, WS_WO = 80 * MiB, WS_W13D = 84 * MiB, WS_W2D = 106 * MiB, WS_W13M = 117 * MiB, WS_W2M = 341 * MiB;
constexpr size_t WS_XB = 453 * MiB, WS_QX = 517 * MiB, WS_OX = 549 * MiB, WS_AG = 581 * MiB, WS_YM = 713 * MiB, WS_RA = 977 * MiB, WS_VTX = 1439 * MiB, WS_END = 1443 * MiB;
constexpr size_t WS_PROJ = WS_RA, WS_Y = WS_RA + 160 * MiB, WS_H = WS_RA, WS_VT = WS_RA + 224 * MiB, WS_OPART = WS_RA + 320 * MiB, WS_LSE = WS_RA + 416 * MiB;
constexpr size_t VT_STRIDE = (size_t)T * 512, OP_STRIDE = (size_t)T * 512;
static_assert(WS_AG + (size_t)MP * D * 2 <= WS_YM && WS_YM + (size_t)MP * D * 4 <= WS_RA && WS_RA + (size_t)MP * FFE * 2 <= WS_VTX, "ws map");
constexpr int CW_BAR = 4096, CW_TEAM = 8192;
constexpr size_t WS_XCCTAB = 128 * 1024;
constexpr int RING_BYTES = 131072, LDSCTL_OFF = 159744, MISC_OFF = LDSCTL_OFF + 320, LDS_BYTES = 163840;

__device__ __forceinline__ float shx(float v, int mask, int lane) { return __int_as_float(__builtin_amdgcn_ds_bpermute((lane ^ mask) << 2, __float_as_int(v))); }
__device__ __forceinline__ float xsum32(float v) { const auto rr = __builtin_amdgcn_permlane32_swap(__float_as_uint(v), __float_as_uint(v), false, false); return __uint_as_float(rr[0]) + __uint_as_float(rr[1]); }
__device__ __forceinline__ float xmax32(float v) { const auto rr = __builtin_amdgcn_permlane32_swap(__float_as_uint(v), __float_as_uint(v), false, false); return fmaxf(__uint_as_float(rr[0]), __uint_as_float(rr[1])); }
__device__ __forceinline__ float wave_sum(float v, int lane) {
#pragma unroll
    for (int o = 1; o < 32; o <<= 1) v += shx(v, o, lane);
    return xsum32(v);
}
__device__ __forceinline__ float bflo(unsigned u) { return __uint_as_float(u << 16); }
__device__ __forceinline__ float bfhi(unsigned u) { return __uint_as_float(u & 0xffff0000u); }
__device__ __forceinline__ float bf1(bf16 h) { return __uint_as_float(((unsigned)h) << 16); }
__device__ __forceinline__ float dot8(v4u a, v4u b) {
    return (bflo(a.x) * bflo(b.x) + bfhi(a.x) * bfhi(b.x)) + (bflo(a.y) * bflo(b.y) + bfhi(a.y) * bfhi(b.y)) + (bflo(a.z) * bflo(b.z) + bfhi(a.z) * bfhi(b.z)) + (bflo(a.w) * bflo(b.w) + bfhi(a.w) * bfhi(b.w));
}
__device__ __forceinline__ int key_dist(int i) { return i < 129 ? i : (i < 225 ? 132 + 4 * (i - 129) : 528 + 16 * (i - 225)); }
__device__ __forceinline__ int key_mult(int d) { return d <= 128 ? 1 + ((d & 3) == 0 ? 1 : 0) + ((d & 15) == 0 ? 1 : 0) : (d <= 512 ? 1 + ((d & 15) == 0 ? 1 : 0) : 1); }
__device__ __forceinline__ int t5_bucket(int d) {
    if (d < 16) return d;
    int b = 16 + (int)(logf((float)d / 16.0f) / logf(8.0f) * 16.0f);
    return b < 31 ? b : 31;
}

struct Args { const float* in[21]; float* out; unsigned char* ws; int ph_lo, ph_hi; };

__device__ __forceinline__ void conv_item(const float* W, int K, int N, bf16* WT, const float* gain, int swF, LAS float* scr, int item, int lane) {
    const int nblk = N / 64, kb = item / nblk, nb = item % nblk, k0 = 64 * kb, n0 = 64 * nb;
    float wv[64];
#pragma unroll
    for (int i = 0; i < 64; ++i) wv[i] = W[(size_t)(k0 + i) * N + n0 + lane];
    if (gain) {
#pragma unroll
        for (int i = 0; i < 64; ++i) wv[i] *= gain[k0 + i]; }
#pragma unroll
    for (int i = 0; i < 64; ++i) scr[i * 65 + lane] = wv[i];
    LDS_WAIT(); asm volatile("" ::: "memory");
    int orow0 = n0;
    if (swF) { const int isup = n0 >= swF ? 1 : 0; const int j = n0 - isup * swF; orow0 = (j >> 7) * 256 + isup * 128 + (j & 127); }
    const int c = lane & 7;
#pragma unroll
    for (int j = 0; j < 8; ++j) { const int n = (lane >> 3) + 8 * j; const LAS float* s = scr + (8 * c) * 65 + n;
        v4u o; o.x = pk2(s[0 * 65], s[1 * 65]); o.y = pk2(s[2 * 65], s[3 * 65]); o.z = pk2(s[4 * 65], s[5 * 65]); o.w = pk2(s[6 * 65], s[7 * 65]);
        *(GAS v4u*)(WT + (size_t)(orow0 + n) * K + k0 + 8 * c) = o; }
    LDS_WAIT(); asm volatile("" ::: "memory");
}

typedef unsigned u32x2 __attribute__((ext_vector_type(2)));
__device__ __forceinline__ void conv_item8(const float* W, int K, int N, unsigned char* WT, const float* gain, int swF, float scale, LAS float* scr, int item, int lane) {
    const int nblk = N / 64, kb = item / nblk, nb = item % nblk, k0 = 64 * kb, n0 = 64 * nb;
    float wv[64];
#pragma unroll
    for (int i = 0; i < 64; ++i) wv[i] = W[(size_t)(k0 + i) * N + n0 + lane];
#pragma unroll
    for (int i = 0; i < 64; ++i) wv[i] *= gain ? gain[k0 + i] * scale : scale;
#pragma unroll
    for (int i = 0; i < 64; ++i) scr[i * 65 + lane] = wv[i];
    LDS_WAIT(); asm volatile("" ::: "memory");
    int orow0 = n0;
    if (swF) { const int isup = n0 >= swF ? 1 : 0; const int j = n0 - isup * swF; orow0 = (j >> 7) * 256 + isup * 128 + (j & 127); }
    const int c = lane & 7;
#pragma unroll
    for (int j = 0; j < 8; ++j) { const int n = (lane >> 3) + 8 * j; const LAS float* s = scr + (8 * c) * 65 + n;
        u32x2 o; o.x = pg8::pk4_fp8_w(s[0 * 65], s[1 * 65], s[2 * 65], s[3 * 65]); o.y = pg8::pk4_fp8_w(s[4 * 65], s[5 * 65], s[6 * 65], s[7 * 65]);
        *(GAS u32x2*)(WT + (size_t)(orow0 + n) * K + k0 + 8 * c) = o; }
    LDS_WAIT(); asm volatile("" ::: "memory");
}

typedef float f32x16 __attribute__((ext_vector_type(16)));
typedef float f32x2_t __attribute__((ext_vector_type(2))); typedef __bf16 bf16x2_t __attribute__((ext_vector_type(2)));
__device__ __forceinline__ unsigned cvtpk(float lo, float hi) { f32x2_t v = {lo, hi}; bf16x2_t b = __builtin_convertvector(v, bf16x2_t); return __builtin_bit_cast(unsigned, b); }
__device__ __forceinline__ bf16x8 mk8(unsigned a, unsigned b, unsigned c, unsigned d) { v4u t = {a, b, c, d}; return __builtin_bit_cast(bf16x8, t); }
__device__ __forceinline__ bf16x8 mk8u2(u32x2 lo, u32x2 hi) { v4u t = {lo.x, lo.y, hi.x, hi.y}; return __builtin_bit_cast(bf16x8, t); }
#define NEGINF (-__builtin_inff())
constexpr int BT_LD = 200, BT_OFF = 32;
__device__ __forceinline__ void dil_load_k(bf16x8 (&kf)[4], const bf16* pj, int sh, int b, int h, int r, int k0, int q, int hh) {
    const int sg = (q & ~12) | ((q & 4) << 1) | ((q & 8) >> 1);
    const int tk = b * SEQ + r + ((k0 + sg) << sh);
    const bf16* kp = pj + (size_t)tk * NPROJ + PC_K + h * 64 + 32 * hh;
#pragma unroll
    for (int ks = 0; ks < 4; ++ks) kf[ks] = *(const GAS bf16x8*)(kp + 8 * ks);
}
__device__ __forceinline__ void dil_load_v(bf16x8 (&vf)[2][2], const bf16* vrow, int sh, int k0) {
#pragma unroll
    for (int db = 0; db < 2; ++db)
#pragma unroll
        for (int s2 = 0; s2 < 2; ++s2) { const bf16* vp = vrow + (size_t)db * 32 * SEQ + (sh == 4 ? ((k0 >> 4) + s2) * 256 : k0 + 16 * s2); vf[db][s2] = *(const GAS bf16x8*)vp; }
}
__device__ __forceinline__ void dil_blk(const bf16x8 (&kf)[4], const bf16x8 (&vf)[2][2], const bf16x8 (&qf)[4], f32x16& O0, f32x16& O1, float& m, float& l, const LAS float* btl) {
    f32x16 st;
#pragma unroll
    for (int i = 0; i < 16; ++i) st[i] = 0.f;
#pragma unroll
    for (int ks = 0; ks < 4; ++ks) st = __builtin_amdgcn_mfma_f32_32x32x16_bf16(kf[ks], qf[ks], st, 0, 0, 0);
    float mx = NEGINF;
#pragma unroll
    for (int i = 0; i < 16; ++i) { st[i] = st[i] * 0.18033688011112042f + btl[23 - (16 * (i >> 3) + 4 * ((i >> 2) & 1) + (i & 3))]; mx = fmaxf(mx, st[i]); }
    { const auto rr = __builtin_amdgcn_permlane32_swap(__float_as_uint(mx), __float_as_uint(mx), false, false); mx = fmaxf(__uint_as_float(rr[0]), __uint_as_float(rr[1])); }
    const float mn = fmaxf(m, mx), ms = mn == NEGINF ? 0.f : mn, alpha = __builtin_amdgcn_exp2f(m - ms);
    float ls = 0.f;
#pragma unroll
    for (int i = 0; i < 16; ++i) { st[i] = __builtin_amdgcn_exp2f(st[i] - ms); ls += st[i]; }
    l = l * alpha + ls; m = mn;
#pragma unroll
    for (int i = 0; i < 16; ++i) { O0[i] *= alpha; O1[i] *= alpha; }
    const bf16x8 p0 = mk8(cvtpk(st[0], st[1]), cvtpk(st[2], st[3]), cvtpk(st[4], st[5]), cvtpk(st[6], st[7]));
    const bf16x8 p1 = mk8(cvtpk(st[8], st[9]), cvtpk(st[10], st[11]), cvtpk(st[12], st[13]), cvtpk(st[14], st[15]));
    O0 = __builtin_amdgcn_mfma_f32_32x32x16_bf16(vf[0][0], p0, O0, 0, 0, 0); O0 = __builtin_amdgcn_mfma_f32_32x32x16_bf16(vf[0][1], p1, O0, 0, 0, 0);
    O1 = __builtin_amdgcn_mfma_f32_32x32x16_bf16(vf[1][0], p0, O1, 0, 0, 0); O1 = __builtin_amdgcn_mfma_f32_32x32x16_bf16(vf[1][1], p1, O1, 0, 0, 0);
}
__device__ __forceinline__ void dil_store(const f32x16& O0, const f32x16& O1, float m, float l, bf16* opart, float* lsep, int tq, int h, int hh) {
    l = xsum32(l);
    const float inv = l > 0.f ? 1.0f / l : 0.f;
    bf16* op = opart + (size_t)tq * 512 + h * 64 + 4 * hh;
#pragma unroll
    for (int g4 = 0; g4 < 4; ++g4) {
        u32x2 w0, w1; w0.x = cvtpk(O0[4 * g4] * inv, O0[4 * g4 + 1] * inv); w0.y = cvtpk(O0[4 * g4 + 2] * inv, O0[4 * g4 + 3] * inv);
        w1.x = cvtpk(O1[4 * g4] * inv, O1[4 * g4 + 1] * inv); w1.y = cvtpk(O1[4 * g4 + 2] * inv, O1[4 * g4 + 3] * inv);
        *(GAS u32x2*)(op + 8 * g4) = w0; *(GAS u32x2*)(op + 32 + 8 * g4) = w1; }
    if (hh == 0) lsep[(size_t)tq * 8 + h] = l > 0.f ? (m + __builtin_amdgcn_logf(l)) * 0.6931471805599453f : NEGINF;
}
template <int JLO>
__device__ __forceinline__ void dil_unit32(const bf16* pj, const bf16* vt, bf16* opart, float* lsep, const LAS float* bt, int sh, int b, int h, int r, int n0, bool do_store) {
    constexpr int NT = JLO == 0 ? 5 : 4;
    int lane; asm volatile("v_mbcnt_lo_u32_b32 %0, -1, 0\n\tv_mbcnt_hi_u32_b32 %0, -1, %0" : "=v"(lane));
    const int q = lane & 31, hh = lane >> 5;
    const int L = SEQ >> sh;
    const int tq = b * SEQ + r + ((n0 + q) << sh);
    bf16x8 qf[4];
    { const bf16* qp = pj + (size_t)tq * NPROJ + PC_Q + h * 64 + 32 * hh;
#pragma unroll
      for (int ks = 0; ks < 4; ++ks) qf[ks] = *(const GAS bf16x8*)(qp + 8 * ks); }
    f32x16 O0, O1;
#pragma unroll
    for (int i = 0; i < 16; ++i) { O0[i] = 0.f; O1[i] = 0.f; }
    float m = NEGINF, l = 0.f;
    const bf16* vrow = vt + ((size_t)((b * 8 + h) * 64 + q) * SEQ) + (sh == 4 ? r * 16 : r * L) + 8 * hh;
    bf16x8 kf[2][4], vf[2][2][2];
    { const int k0 = n0 - 128 < 0 ? 0 : n0 - 128; dil_load_k(kf[0], pj, sh, b, h, r, k0, q, hh); dil_load_v(vf[0], vrow, sh, k0); }
#pragma unroll
    for (int t = 0; t < NT; ++t) {
        const int k0 = n0 - 128 + 32 * t;
        if (t + 1 < NT) { const int k1 = k0 + 32 < 0 ? 0 : k0 + 32; dil_load_k(kf[(t + 1) & 1], pj, sh, b, h, r, k1, q, hh); dil_load_v(vf[(t + 1) & 1], vrow, sh, k1); }
        const int jq = k0 < 0 ? 160 : q - 8 * hh + 128 - 32 * t;
        dil_blk(kf[t & 1], vf[t & 1], qf, O0, O1, m, l, bt + jq + BT_OFF - 23);
    }
    if (do_store) dil_store(O0, O1, m, l, opart, lsep, tq, h, hh);
}

constexpr int DK_PITCH = 144, DV_PITCH = 784, DK_BYTES = 384 * DK_PITCH, DV_BYTES = 64 * DV_PITCH;
__device__ __forceinline__ void dil_stage_load_k(v4u (&sk)[6], const bf16* pj, int sh, int b, int h, int r, int n0, int tid) {
    const int ws = n0 - 128;
#pragma unroll
    for (int k = 0; k < 6; ++k) { const int idx = tid + 512 * k, row = idx >> 3, ch = idx & 7; int kk = ws + row; kk = kk < 0 ? 0 : kk;
        sk[k] = *(const GAS v4u*)(pj + (size_t)(b * SEQ + r + (kk << sh)) * NPROJ + PC_K + h * 64 + ch * 8); }
}
__device__ __forceinline__ void dil_stage_load_v(v4u (&sv)[6], const bf16* pj, int sh, int b, int h, int r, int n0, int tid) {
    const int ws = n0 - 128;
#pragma unroll
    for (int k = 0; k < 6; ++k) { const int idx = tid + 512 * k, row = idx >> 3, ch = idx & 7; int kk = ws + row; kk = kk < 0 ? 0 : kk;
        sv[k] = *(const GAS v4u*)(pj + (size_t)(b * SEQ + r + (kk << sh)) * NPROJ + PC_V + h * 64 + ch * 8); }
}
__device__ __forceinline__ void dil_stage_write_k(LAS unsigned char* lds, const v4u (&sk)[6], int tid) {
#pragma unroll
    for (int k = 0; k < 6; ++k) { const int idx = tid + 512 * k, row = idx >> 3, ch = idx & 7; *(LAS v4u*)(lds + row * DK_PITCH + ch * 16) = sk[k]; }
}
__device__ __forceinline__ void dil_stage_write_v(LAS unsigned char* lds, const v4u (&sv)[6], int tid) {
#pragma unroll
    for (int k = 0; k < 6; ++k) { const int idx = tid + 512 * k, row = idx >> 3, ch = idx & 7;
        LAS unsigned short* d = (LAS unsigned short*)(lds + DK_BYTES + (8 * ch) * DV_PITCH + ((((row >> 3) ^ ch) << 3) | (row & 7)) * 2);
        d[0] = (unsigned short)(sv[k].x & 0xffffu); d[DV_PITCH / 2] = (unsigned short)(sv[k].x >> 16); d[2 * (DV_PITCH / 2)] = (unsigned short)(sv[k].y & 0xffffu); d[3 * (DV_PITCH / 2)] = (unsigned short)(sv[k].y >> 16);
        d[4 * (DV_PITCH / 2)] = (unsigned short)(sv[k].z & 0xffffu); d[5 * (DV_PITCH / 2)] = (unsigned short)(sv[k].z >> 16); d[6 * (DV_PITCH / 2)] = (unsigned short)(sv[k].w & 0xffffu); d[7 * (DV_PITCH / 2)] = (unsigned short)(sv[k].w >> 16); }
}
template <int JLO>
__device__ __forceinline__ void dil_wg_compute(const LAS unsigned char* lds, const bf16x8 (&qf)[4], bf16* opart, float* lsep, const LAS float* bt, int tq, int h, int k00, int lane, int wave, bool do_store) {
    constexpr int NT = JLO == 0 ? 5 : 4;
    asm volatile("" : "+v"(lane));
    const int q = lane & 31, hh = lane >> 5;
    f32x16 O0, O1;
#pragma unroll
    for (int i = 0; i < 16; ++i) { O0[i] = 0.f; O1[i] = 0.f; }
    float m = NEGINF, l = 0.f;
    const int sg = (q & ~12) | ((q & 4) << 1) | ((q & 8) >> 1);
    const LAS unsigned char* kl = lds + (32 * wave + sg) * DK_PITCH + 64 * hh;
    const LAS unsigned char* vl = lds + DK_BYTES + q * DV_PITCH;
    bf16x8 kf[2][4], vf[2][2][2];
#define DIL_LDFRAG(t_) do { _Pragma("unroll") for (int ks = 0; ks < 4; ++ks) kf[(t_) & 1][ks] = *(const LAS bf16x8*)(kl + (t_) * 32 * DK_PITCH + 16 * ks); \
        _Pragma("unroll") for (int db = 0; db < 2; ++db) _Pragma("unroll") for (int s2 = 0; s2 < 2; ++s2) \
            vf[(t_) & 1][db][s2] = *(const LAS bf16x8*)(vl + db * 32 * DV_PITCH + (((4 * wave + 4 * (t_) + 2 * s2 + hh) ^ (((32 * db + q) >> 3) & 7)) << 4)); } while (0)
    DIL_LDFRAG(0);
#pragma unroll
    for (int t = 0; t < NT; ++t) {
        if (t + 1 < NT) DIL_LDFRAG(t + 1);
        const int jq = k00 + 32 * t < 0 ? 160 : q - 8 * hh + 128 - 32 * t;
        dil_blk(kf[t & 1], vf[t & 1], qf, O0, O1, m, l, bt + jq + BT_OFF - 23);
        __builtin_amdgcn_sched_barrier(0);
    }
#undef DIL_LDFRAG
    if (do_store) dil_store(O0, O1, m, l, opart, lsep, tq, h, hh);
}

__device__ __forceinline__ void xat_unit(const bf16* qxp, const bf16* kb, const bf16* vtb, bf16* oxp, int t0, int h, int lane) {
    const int q = lane & 31, hh = lane >> 5;
    bf16x8 qf[8];
    { const bf16* qp = qxp + (size_t)(t0 + q) * XW + h * 128 + 64 * hh;
#pragma unroll
      for (int ks = 0; ks < 8; ++ks) qf[ks] = *(const GAS bf16x8*)(qp + 8 * ks); }
    f32x16 O[4];
#pragma unroll
    for (int d = 0; d < 4; ++d)
#pragma unroll
        for (int i = 0; i < 16; ++i) O[d][i] = 0.f;
    float m = NEGINF, l = 0.f;
    const bf16* vrow = vtb + (size_t)(h * 128 + q) * MEML + 4 * hh;
    for (int k0 = 0; k0 < MEML; k0 += 32) {
        const bf16* kp = kb + (size_t)(k0 + q) * 4096 + h * 128 + 64 * hh;
        f32x16 st;
#pragma unroll
        for (int i = 0; i < 16; ++i) st[i] = 0.f;
#pragma unroll
        for (int ks = 0; ks < 8; ++ks) st = __builtin_amdgcn_mfma_f32_32x32x16_bf16(*(const GAS bf16x8*)(kp + 8 * ks), qf[ks], st, 0, 0, 0);
        bf16x8 vf[4][2];
#pragma unroll
        for (int db = 0; db < 4; ++db)
#pragma unroll
            for (int s2 = 0; s2 < 2; ++s2) { const bf16* vp = vrow + (size_t)db * 32 * MEML + k0 + 16 * s2; vf[db][s2] = mk8u2(*(const GAS u32x2*)vp, *(const GAS u32x2*)(vp + 8)); }
        float mx = st[0];
#pragma unroll
        for (int i = 1; i < 16; ++i) mx = fmaxf(mx, st[i]);
        mx = xmax32(mx);
        const float mn = fmaxf(m, mx), alpha = __expf(m - mn);
        float ls = 0.f;
#pragma unroll
        for (int i = 0; i < 16; ++i) { st[i] = __expf(st[i] - mn); ls += st[i]; }
        l = l * alpha + ls; m = mn;
#pragma unroll
        for (int d = 0; d < 4; ++d)
#pragma unroll
            for (int i = 0; i < 16; ++i) O[d][i] *= alpha;
        const bf16x8 p0 = mk8(cvtpk(st[0], st[1]), cvtpk(st[2], st[3]), cvtpk(st[4], st[5]), cvtpk(st[6], st[7]));
        const bf16x8 p1 = mk8(cvtpk(st[8], st[9]), cvtpk(st[10], st[11]), cvtpk(st[12], st[13]), cvtpk(st[14], st[15]));
#pragma unroll
        for (int d = 0; d < 4; ++d) { O[d] = __builtin_amdgcn_mfma_f32_32x32x16_bf16(vf[d][0], p0, O[d], 0, 0, 0); O[d] = __builtin_amdgcn_mfma_f32_32x32x16_bf16(vf[d][1], p1, O[d], 0, 0, 0); }
    }
    l = xsum32(l);
    const float inv = 1.0f / l;
    bf16* op = oxp + (size_t)(t0 + q) * XW + h * 128 + 4 * hh;
#pragma unroll
    for (int d = 0; d < 4; ++d)
#pragma unroll
        for (int g4 = 0; g4 < 4; ++g4) { u32x2 w; w.x = cvtpk(O[d][4 * g4] * inv, O[d][4 * g4 + 1] * inv); w.y = cvtpk(O[d][4 * g4 + 2] * inv, O[d][4 * g4 + 3] * inv); *(GAS u32x2*)(op + 32 * d + 8 * g4) = w; }
}

constexpr int XK_PITCH = 272, XV_PITCH = 528, XK_BYTES = 256 * XK_PITCH, XV_BYTES = 128 * XV_PITCH;
__device__ __forceinline__ void xat_wg_unit(LAS unsigned char* lds, const bf16* qxp, const bf16* kb, const bf16* vtb, bf16* oxp, int t0, int h, int tid) {
    const int lane = tid & 63, q = lane & 31, hh = lane >> 5;
    __syncthreads();
#pragma unroll
    for (int k = 0; k < 8; ++k) { const int idx = tid + 512 * k, row = idx >> 4, ch = idx & 15;
        const v4u x = *(const GAS v4u*)(kb + (size_t)row * 4096 + h * 128 + ch * 8); *(LAS v4u*)(lds + row * XK_PITCH + ch * 16) = x; }
#pragma unroll
    for (int k = 0; k < 8; ++k) { const int idx = tid + 512 * k, row = idx >> 5, ch = idx & 31;
        const v4u x = *(const GAS v4u*)(vtb + (size_t)(h * 128 + row) * MEML + ch * 8); *(LAS v4u*)(lds + XK_BYTES + row * XV_PITCH + ch * 16) = x; }
    bf16x8 qf[8];
    { const bf16* qp = qxp + (size_t)(t0 + q) * XW + h * 128 + 64 * hh;
#pragma unroll
      for (int ks = 0; ks < 8; ++ks) qf[ks] = *(const GAS bf16x8*)(qp + 8 * ks); }
    __syncthreads();
    f32x16 O[4];
#pragma unroll
    for (int d = 0; d < 4; ++d)
#pragma unroll
        for (int i = 0; i < 16; ++i) O[d][i] = 0.f;
    float m = NEGINF, l = 0.f;
    const int sg = (q & ~12) | ((q & 4) << 1) | ((q & 8) >> 1);
    const LAS unsigned char* kl = lds + sg * XK_PITCH + 128 * hh;
    const LAS unsigned char* vl = lds + XK_BYTES + q * XV_PITCH + 16 * hh;
#pragma unroll
    for (int kt = 0; kt < 8; ++kt) {
        f32x16 st;
#pragma unroll
        for (int i = 0; i < 16; ++i) st[i] = 0.f;
#pragma unroll
        for (int ks = 0; ks < 8; ++ks) st = __builtin_amdgcn_mfma_f32_32x32x16_bf16(*(const LAS bf16x8*)(kl + kt * 32 * XK_PITCH + ks * 16), qf[ks], st, 0, 0, 0);
        float mx = st[0];
#pragma unroll
        for (int i = 1; i < 16; ++i) mx = fmaxf(mx, st[i]);
        mx = xmax32(mx);
        const float mn = fmaxf(m, mx), alpha = __builtin_amdgcn_exp2f((m - mn) * 1.4426950408889634f);
        float ls = 0.f;
#pragma unroll
        for (int i = 0; i < 16; ++i) { st[i] = __builtin_amdgcn_exp2f((st[i] - mn) * 1.4426950408889634f); ls += st[i]; }
        l = l * alpha + ls; m = mn;
#pragma unroll
        for (int d = 0; d < 4; ++d)
#pragma unroll
            for (int i = 0; i < 16; ++i) O[d][i] *= alpha;
        const bf16x8 p0 = mk8(cvtpk(st[0], st[1]), cvtpk(st[2], st[3]), cvtpk(st[4], st[5]), cvtpk(st[6], st[7]));
        const bf16x8 p1 = mk8(cvtpk(st[8], st[9]), cvtpk(st[10], st[11]), cvtpk(st[12], st[13]), cvtpk(st[14], st[15]));
#pragma unroll
        for (int d = 0; d < 4; ++d) { const LAS unsigned char* vp = vl + d * 32 * XV_PITCH + kt * 64;
            O[d] = __builtin_amdgcn_mfma_f32_32x32x16_bf16(*(const LAS bf16x8*)vp, p0, O[d], 0, 0, 0); O[d] = __builtin_amdgcn_mfma_f32_32x32x16_bf16(*(const LAS bf16x8*)(vp + 32), p1, O[d], 0, 0, 0); }
    }
    l = xsum32(l);
    const float inv = 1.0f / l;
    bf16* op = oxp + (size_t)(t0 + q) * XW + h * 128 + 4 * hh;
#pragma unroll
    for (int d = 0; d < 4; ++d)
#pragma unroll
        for (int g4 = 0; g4 < 4; ++g4) { u32x2 w; w.x = cvtpk(O[d][4 * g4] * inv, O[d][4 * g4 + 1] * inv); w.y = cvtpk(O[d][4 * g4 + 2] * inv, O[d][4 * g4 + 3] * inv); *(GAS u32x2*)(op + 32 * d + 8 * g4) = w; }
}

__device__ __forceinline__ void pool_unit(const bf16* pj, const bf16* pwT, const float* psc, bf16* ymixp, int t0, int lane, LAS unsigned char* scr) {
    constexpr int PITCH = 144;
    const int q = lane & 31, hh = lane >> 5; const int t = t0 + q, pos = t & (SEQ - 1), pos0 = t0 & (SEQ - 1);
    const int sr = lane >> 3, sc = lane & 7;
    v4u st[6];
#define POOL_LD(g_) do { _Pragma("unroll") for (int k = 0; k < 6; ++k) { const int r = 8 * k + sr, w_ = 2 << (g_); const bool ok = pos0 - (w_ - 1) + r >= 0 && r < 31 + w_; \
        st[k] = *(const GAS v4u*)(pj + (size_t)(ok ? t0 - (w_ - 1) + r : t0) * NPROJ + PC_POOL + (g_) * 64 + 8 * sc); if (!ok) st[k] = (v4u){0u, 0u, 0u, 0u}; } } while (0)
    POOL_LD(0);
#pragma unroll
    for (int g = 0; g < 4; ++g) {
        const int w = 2 << g; const float rn = 1.0f / (float)(pos + 1 < w ? pos + 1 : w);
#pragma unroll
        for (int k = 0; k < 6; ++k) *(LAS v4u*)(scr + (8 * k + sr) * PITCH + 16 * sc) = st[k];
        if (g < 3) POOL_LD(g + 1);
        f32x16 D0, D1;
#pragma unroll
        for (int i = 0; i < 16; ++i) { D0[i] = 0.f; D1[i] = 0.f; }
#pragma unroll
        for (int ks = 0; ks < 4; ++ks) {
            const LAS unsigned char* p0 = scr + (q + w - 1) * PITCH + 16 * (2 * ks + hh);
            const v4u x0 = *(const LAS v4u*)p0;
            float a0 = bflo(x0.x), a1 = bfhi(x0.x), a2 = bflo(x0.y), a3 = bfhi(x0.y), a4 = bflo(x0.z), a5 = bfhi(x0.z), a6 = bflo(x0.w), a7 = bfhi(x0.w);
#pragma unroll
            for (int i = 1; i < w; ++i) { const v4u xi = *(const LAS v4u*)(p0 - i * PITCH);
                a0 += bflo(xi.x); a1 += bfhi(xi.x); a2 += bflo(xi.y); a3 += bfhi(xi.y); a4 += bflo(xi.z); a5 += bfhi(xi.z); a6 += bflo(xi.w); a7 += bfhi(xi.w); }
            const bf16x8 bfr = mk8(cvtpk(a0 * rn - bflo(x0.x), a1 * rn - bfhi(x0.x)), cvtpk(a2 * rn - bflo(x0.y), a3 * rn - bfhi(x0.y)), cvtpk(a4 * rn - bflo(x0.z), a5 * rn - bfhi(x0.z)), cvtpk(a6 * rn - bflo(x0.w), a7 * rn - bfhi(x0.w)));
            const bf16* wp = pwT + (size_t)(g * 64 + q) * 64 + 16 * ks + 8 * hh;
            D0 = __builtin_amdgcn_mfma_f32_32x32x16_bf16(*(const GAS bf16x8*)wp, bfr, D0, 0, 0, 0);
            D1 = __builtin_amdgcn_mfma_f32_32x32x16_bf16(*(const GAS bf16x8*)(wp + 32 * 64), bfr, D1, 0, 0, 0);
        }
        bf16* op = ymixp + (size_t)t * D + 512 + g * 64 + 4 * hh; const float* sp = psc + g * 64 + 4 * hh;
#pragma unroll
        for (int k = 0; k < 4; ++k) { const f32x4 s0 = *(const GAS f32x4*)(sp + 8 * k), s1 = *(const GAS f32x4*)(sp + 32 + 8 * k);
            u32x2 w0, w1; w0.x = cvtpk(D0[4 * k] * s0[0], D0[4 * k + 1] * s0[1]); w0.y = cvtpk(D0[4 * k + 2] * s0[2], D0[4 * k + 3] * s0[3]);
            w1.x = cvtpk(D1[4 * k] * s1[0], D1[4 * k + 1] * s1[1]); w1.y = cvtpk(D1[4 * k + 2] * s1[2], D1[4 * k + 3] * s1[3]);
            *(GAS u32x2*)(op + 8 * k) = w0; *(GAS u32x2*)(op + 32 + 8 * k) = w1; }
    }
#undef POOL_LD
}
__device__ __forceinline__ void mergeconv_unit(const bf16* pj, const bf16* opartp, const float* lsepp, const float* cw, bf16* ymixp, int t0, int lane) {
    const int c4 = 4 * lane, h = lane >> 3;
    const f32x4 w0 = *(const GAS f32x4*)(cw + c4), w1 = *(const GAS f32x4*)(cw + 256 + c4), w2 = *(const GAS f32x4*)(cw + 512 + c4);
    f32x4 u1 = {0.f, 0.f, 0.f, 0.f}, u2 = {0.f, 0.f, 0.f, 0.f};
    const int pos0 = t0 & (SEQ - 1);
    if (pos0 >= 2) {
        const bf16* r1 = pj + (size_t)(t0 - 1) * NPROJ; const bf16* r2 = r1 - NPROJ;
        const u32x2 c1 = *(const GAS u32x2*)(r1 + PC_CG + c4), h1 = *(const GAS u32x2*)(r1 + PC_HC + c4), c2 = *(const GAS u32x2*)(r2 + PC_CG + c4), h2 = *(const GAS u32x2*)(r2 + PC_HC + c4);
        u1 = (f32x4){bflo(c1.x) * bflo(h1.x), bfhi(c1.x) * bfhi(h1.x), bflo(c1.y) * bflo(h1.y), bfhi(c1.y) * bfhi(h1.y)};
        u2 = (f32x4){bflo(c2.x) * bflo(h2.x), bfhi(c2.x) * bfhi(h2.x), bflo(c2.y) * bflo(h2.y), bfhi(c2.y) * bfhi(h2.y)};
    }
    constexpr int NB = 8;
    for (int j0 = 0; j0 < 32; j0 += NB) {
        u32x2 cg[NB], hc[NB], bg[NB]; float l0[NB], l1[NB], l2[NB]; v4u pa[NB], pb[NB], pc[NB];
#pragma unroll
        for (int j = 0; j < NB; ++j) { const int t = t0 + j0 + j; const bf16* row = pj + (size_t)t * NPROJ;
            cg[j] = *(const GAS u32x2*)(row + PC_CG + c4); hc[j] = *(const GAS u32x2*)(row + PC_HC + c4); bg[j] = *(const GAS u32x2*)(row + PC_BG + c4);
            l0[j] = lsepp[(size_t)t * 8 + h]; l1[j] = lsepp[(size_t)T * 8 + (size_t)t * 8 + h]; l2[j] = lsepp[(size_t)2 * T * 8 + (size_t)t * 8 + h];
            pa[j] = *(const GAS v4u*)(opartp + (size_t)t * 512 + 8 * lane); pb[j] = *(const GAS v4u*)(opartp + OP_STRIDE + (size_t)t * 512 + 8 * lane); pc[j] = *(const GAS v4u*)(opartp + 2 * OP_STRIDE + (size_t)t * 512 + 8 * lane); }
        asm volatile("" ::: "memory");
#pragma unroll
        for (int j = 0; j < NB; ++j) { const int t = t0 + j0 + j;
            const f32x4 u0 = {bflo(cg[j].x) * bflo(hc[j].x), bfhi(cg[j].x) * bfhi(hc[j].x), bflo(cg[j].y) * bflo(hc[j].y), bfhi(cg[j].y) * bfhi(hc[j].y)};
            const f32x4 y = (f32x4){bflo(bg[j].x), bfhi(bg[j].x), bflo(bg[j].y), bfhi(bg[j].y)} * (w0 * u0 + w1 * u1 + w2 * u2);
            u32x2 yo; yo.x = cvtpk(y[0], y[1]); yo.y = cvtpk(y[2], y[3]);
            *(GAS u32x2*)(ymixp + (size_t)t * D + 768 + c4) = yo;
            u2 = u1; u1 = u0;
            const float M = fmaxf(l0[j], fmaxf(l1[j], l2[j])); float e0 = __expf(l0[j] - M), e1 = __expf(l1[j] - M), e2 = __expf(l2[j] - M); const float inv = 1.0f / (e0 + e1 + e2); e0 *= inv; e1 *= inv; e2 *= inv;
            const v4u a = pa[j], bq = pb[j], c = pc[j];
            v4u o; o.x = cvtpk(e0 * bflo(a.x) + e1 * bflo(bq.x) + e2 * bflo(c.x), e0 * bfhi(a.x) + e1 * bfhi(bq.x) + e2 * bfhi(c.x));
            o.y = cvtpk(e0 * bflo(a.y) + e1 * bflo(bq.y) + e2 * bflo(c.y), e0 * bfhi(a.y) + e1 * bfhi(bq.y) + e2 * bfhi(c.y));
            o.z = cvtpk(e0 * bflo(a.z) + e1 * bflo(bq.z) + e2 * bflo(c.z), e0 * bfhi(a.z) + e1 * bfhi(bq.z) + e2 * bfhi(c.z));
            o.w = cvtpk(e0 * bflo(a.w) + e1 * bflo(bq.w) + e2 * bflo(c.w), e0 * bfhi(a.w) + e1 * bfhi(bq.w) + e2 * bfhi(c.w));
            *(GAS v4u*)(ymixp + (size_t)t * D + 8 * lane) = o; }
    }
}

__device__ __forceinline__ void vt_transpose_tile(LAS unsigned char* lds, const bf16* pj, bf16* vt, int pm, int vh, int tid) {
    constexpr int PW = 65;
    LAS unsigned* img = (LAS unsigned*)lds;
    const int row0 = pm * 256, b = row0 >> 13, tt = row0 & 8191;
    for (int hf = 0; hf < 2; ++hf) {
        __syncthreads();
        { const int r = tid >> 1, hc = tid & 1;
            const bf16* src = pj + (size_t)(row0 + r) * NPROJ + PC_V + vh * 256 + hf * 128 + hc * 64;
#pragma unroll
            for (int k = 0; k < 8; ++k) { const v4u x = *(const GAS v4u*)(src + 8 * k); LAS unsigned* d = img + r * PW + hc * 32 + 4 * k; d[0] = x.x; d[1] = x.y; d[2] = x.z; d[3] = x.w; } }
        __syncthreads();
        const LAS unsigned short* im16 = (const LAS unsigned short*)lds;
        bf16* vcol = vt + (size_t)(b * 512 + vh * 256 + hf * 128) * SEQ;
#pragma unroll 2
        for (int k = 0; k < 8; ++k) { const int id = tid + 512 * k, d = id >> 5, c = id & 31;
            {
#define RD16(j) ((unsigned)im16[(8 * c + (j)) * (2 * PW) + d])
              v4u o; o.x = RD16(0) | (RD16(1) << 16); o.y = RD16(2) | (RD16(3) << 16); o.z = RD16(4) | (RD16(5) << 16); o.w = RD16(6) | (RD16(7) << 16);
#undef RD16
              *(GAS v4u*)(vcol + (size_t)d * SEQ + tt + 8 * c) = o; }
            { const int r = c >> 3, n0 = 8 * (c & 7);
#define RD16(j) ((unsigned)im16[(4 * (n0 + (j)) + r) * (2 * PW) + d])
              v4u o; o.x = RD16(0) | (RD16(1) << 16); o.y = RD16(2) | (RD16(3) << 16); o.z = RD16(4) | (RD16(5) << 16); o.w = RD16(6) | (RD16(7) << 16);
#undef RD16
              *(GAS v4u*)(vcol + VT_STRIDE + (size_t)d * SEQ + r * 2048 + (tt >> 2) + n0) = o; }
            { const int r = c >> 1, n0 = 8 * (c & 1);
#define RD16(j) ((unsigned)im16[(16 * (n0 + (j)) + r) * (2 * PW) + d])
              v4u o; o.x = RD16(0) | (RD16(1) << 16); o.y = RD16(2) | (RD16(3) << 16); o.z = RD16(4) | (RD16(5) << 16); o.w = RD16(6) | (RD16(7) << 16);
#undef RD16
              *(GAS v4u*)(vcol + 2 * VT_STRIDE + (size_t)d * SEQ + (tt >> 8) * 256 + r * 16 + n0) = o; }
        }
    }
    __syncthreads();
}

#define x_in (args.in[0])
#define mem_in (args.in[1])
#define rel_bias (args.in[2])
#define mem_g (args.in[3])
#define mix_g (args.in[4])
#define w_in (args.in[5])
#define conv_w (args.in[6])
#define pool_w (args.in[7])
#define pool_scale (args.in[8])
#define w_out (args.in[9])
#define xat_g (args.in[10])
#define wq_x (args.in[11])
#define wkv_x (args.in[12])
#define wo_x (args.in[13])
#define ffn_g (args.in[14])
#define w13_d (args.in[15])
#define w2_d (args.in[16])
#define router_w (args.in[17])
#define w13_m (args.in[18])
#define w2_m (args.in[19])
#define fin_g (args.in[20])
#define out (args.out)
#define Win_t ((bf16*)(ws + WS_WIN))
#define Wout_t ((bf16*)(ws + WS_WOUT))
#define Wq_t ((bf16*)(ws + WS_WQ))
#define Wkv_t ((bf16*)(ws + WS_WKV))
#define Wo_t ((bf16*)(ws + WS_WO))
#define W13d_t ((bf16*)(ws + WS_W13D))
#define W2d_t ((bf16*)(ws + WS_W2D))
#define W13m_t ((bf16*)(ws + WS_W13M))
#define W2m_t ((bf16*)(ws + WS_W2M))
#define xb ((bf16*)(ws + WS_XB))
#define qx ((bf16*)(ws + WS_QX))
#define ox ((bf16*)(ws + WS_OX))
#define Ag ((bf16*)(ws + WS_AG))
#define ym ((bf16*)(ws + WS_YM))
#define ypart ((bf16*)(ws + WS_YM + 136 * MiB))
#define proj ((bf16*)(ws + WS_PROJ))
#define ymix ((bf16*)(ws + WS_Y))
#define hbuf ((bf16*)(ws + WS_H))
#define kvx ((bf16*)(ws + WS_KVX))
#define memn ((bf16*)(ws + WS_MEMN))
#define vtb ((bf16*)(ws + WS_VT))
#define opart ((bf16*)(ws + WS_OPART))
#define lsep ((float*)(ws + WS_LSE))
#define vtx ((bf16*)(ws + WS_VTX))
#define ssp ((float*)(ws + WS_SSP))
#define cnts ((int*)(ws + WS_CNT))
#define meta ((int*)(ws + WS_META))
#define tok_e ((int*)(ws + WS_TOKE))
#define tok_g ((float*)(ws + WS_TOKG))
#define tok_pos ((int*)(ws + WS_TOKPOS))
#define row_gate ((float*)(ws + WS_ROWGATE))
#define row_rs ((float*)(ws + WS_ROWRS))
#ifndef PROBE
#define PROBE 0
#endif
#ifndef N_LAUNCH_MODE
#define N_LAUNCH_MODE 0
#endif

__device__ __forceinline__ void pair_barrier(unsigned* cnt, unsigned target, bool same_xcc, unsigned* tmo, int wave0) {
    asm volatile("s_waitcnt vmcnt(0)" ::: "memory");
    __syncthreads();
    int ln; asm volatile("v_mbcnt_lo_u32_b32 %0, -1, 0\n\tv_mbcnt_hi_u32_b32 %0, -1, %0" : "=v"(ln));
    if (wave0 == 0 && ln == 0) {
        if (!same_xcc) { __builtin_amdgcn_fence(__ATOMIC_RELEASE, "agent"); asm volatile("s_waitcnt vmcnt(0)" ::: "memory"); }
        (void)xb_add(cnt, 1u);
        unsigned sp = 0u;
        while (xb_ld(cnt) < target) { __builtin_amdgcn_s_sleep(1); if ((++sp & 255u) == 0u) { if (xb_ld(tmo)) break; if (sp > XB_SPIN_CAP) { atomicAdd(tmo, 1u); break; } } }
        __builtin_amdgcn_fence(__ATOMIC_ACQUIRE, "agent");
        asm volatile("s_waitcnt vmcnt(0)" ::: "memory");
    }
    __syncthreads();
}
__global__ void __launch_bounds__(NWAVES * 64, 2) trunk_fwd(Args args) {
    extern __shared__ __attribute__((aligned(16))) unsigned char lds_raw[];
    LAS unsigned char* lds = (LAS unsigned char*)lds_raw;
    volatile LAS unsigned* MISC = (volatile LAS unsigned*)(lds + MISC_OFF);
    const int tid0 = threadIdx.x;
    const int G0 = gridDim.x, blk0 = blockIdx.x, wave0 = __builtin_amdgcn_readfirstlane(tid0 >> 6);
    unsigned char* ws0 = args.ws;
    gu32* ctl = (gu32*)(ws0 + WS_CTL);
#define PH_VARS int lane_; asm volatile("v_mbcnt_lo_u32_b32 %0, -1, 0\n\tv_mbcnt_hi_u32_b32 %0, -1, %0" : "=v"(lane_)); int wv_ = wave0; asm volatile("" : "+s"(wv_)); int blk = blk0; asm volatile("" : "+s"(blk)); int G = G0; asm volatile("" : "+s"(G)); \
    unsigned char* ws = ws0; asm volatile("" : "+s"(ws)); const int lane = lane_, wave = wv_, tid = wv_ * 64 + lane_; const int gw = blk * NWAVES + wave, NGW = G * NWAVES; (void)lane; (void)gw; (void)NGW; (void)ws; (void)tid
    for (int u = tid0; u < (LDS_BYTES - LDSCTL_OFF) / 4; u += NWAVES * 64) ((LAS unsigned*)(lds + LDSCTL_OFF))[u] = 0u;
    __syncthreads();
    XcdBarrier bar = xcd_barrier_post((unsigned*)(ctl + CW_BAR), MISC + 8);
    bar.x = __builtin_amdgcn_readfirstlane(bar.x);
    if (tid0 == 0) __hip_atomic_store((unsigned*)(ws0 + WS_XCCTAB) + blk0, bar.x, __ATOMIC_RELAXED, __HIP_MEMORY_SCOPE_AGENT);
    const int tpm0 = (blk0 & 7) + 8 * (blk0 >> 4), tmb0 = (blk0 >> 3) & 1;
    unsigned pepoch = 0u; bool same_xcc = false;
#define PAIR_BAR do { pepoch += 2u; unsigned* tc_ = (unsigned*)(ctl + CW_TEAM) + 64 * tpm0; asm volatile("" : "+s"(tc_)); pair_barrier(tc_, pepoch, same_xcc, (unsigned*)(ctl + CW_BAR) + XB_TMO, wave0); } while (0)
#if N_LAUNCH_MODE == 0
#define PH_ON true
#define PH_END do { for (int br_ = 0; br_ < ((PROBE & 1024) ? 3 : 1); ++br_) { XcdBarrier b_ = bar; asm volatile("" : "+s"(b_.x)); asm volatile("" : "+s"(b_.bar)); xcd_barrier(b_); } } while (0)
#else
    const int lo = args.ph_lo, hi = args.ph_hi;
    int ph = 0;
#define PH_ON (ph >= lo && ph < hi)
#define PH_END do { if (ph >= lo && ph + 1 < hi) { XcdBarrier b_ = bar; asm volatile("" : "+s"(b_.x)); asm volatile("" : "+s"(b_.bar)); xcd_barrier(b_); } ++ph; } while (0)
#endif

    constexpr size_t SSP_STRIDE = (size_t)T * 16;

    if (PH_ON) { PH_VARS;
        LAS float* scr = (LAS float*)(lds + wave * 16896);
        constexpr int I_IN = 16 * 40, I_OUT = 16 * 16, I_Q = 16 * 8, I_KV = 16 * 16, I_O = 8 * 16, I_13D = 16 * 88, I_2D = 44 * 16, I_13M = 16 * 112, I_2M = 56 * 16;
        constexpr int C0 = 4 * I_IN, C1 = C0 + 4 * I_OUT, C2 = C1 + 4 * I_Q, C3 = C2 + 4 * I_KV, C4 = C3 + 4 * I_O, C5 = C4 + 2 * I_13D, C6 = C5 + 2 * I_2D, C7 = C6 + 16 * I_13M, C8 = C7 + 16 * I_2M;
        for (int rep = 0; rep < ((PROBE & 16) ? 2 : 1); ++rep)
        for (int it = gw; it < C8; it += NGW) {
            if (it < C0) { const int m = it / I_IN, r = it % I_IN; if (m < 2) conv_item(w_in + (size_t)m * D * NPROJ, D, NPROJ, Win_t + (size_t)m * NPROJ * D, mix_g + m * D, 0, scr, r, lane);
                else conv_item8(w_in + (size_t)m * D * NPROJ, D, NPROJ, (unsigned char*)(Win_t + (size_t)m * NPROJ * D), mix_g + m * D, 0, F8_S1, scr, r, lane); }
            else if (it < C1) { const int q = it - C0, m = q / I_OUT, r = q % I_OUT; conv_item(w_out + (size_t)m * D * D, D, D, Wout_t + (size_t)m * D * D, nullptr, 0, scr, r, lane); }
            else if (it < C2) { const int q = it - C1, m = q / I_Q, r = q % I_Q; conv_item(wq_x + (size_t)m * D * XW, D, XW, Wq_t + (size_t)m * XW * D, xat_g + m * D, 0, scr, r, lane); }
            else if (it < C3) { const int q = it - C2, m = q / I_KV, r = q % I_KV; conv_item(wkv_x + (size_t)m * D * 1024, D, 1024, Wkv_t + (size_t)m * 1024 * D, nullptr, 0, scr, r, lane); }
            else if (it < C4) { const int q = it - C3, m = q / I_O, r = q % I_O; conv_item(wo_x + (size_t)m * XW * D, XW, D, Wo_t + (size_t)m * D * XW, nullptr, 0, scr, r, lane); }
            else if (it < C5) { const int q = it - C4, m = q / I_13D, r = q % I_13D; if (m == 0) conv_item(w13_d, D, 2 * FFD, W13d_t, ffn_g, FFD, scr, r, lane); else conv_item8(w13_d + (size_t)D * 2 * FFD, D, 2 * FFD, (unsigned char*)(W13d_t + (size_t)2 * FFD * D), ffn_g + 2 * D, FFD, F8_S1, scr, r, lane); }
            else if (it < C6) { const int q = it - C5, m = q / I_2D, r = q % I_2D; if (m == 0) conv_item(w2_d, FFD, D, W2d_t, nullptr, 0, scr, r, lane); else conv_item8(w2_d + (size_t)FFD * D, FFD, D, (unsigned char*)(W2d_t + (size_t)D * FFD), nullptr, 0, F8_S2, scr, r, lane); }
            else if (it < C7) { const int q = it - C6, m = q / I_13M, r = q % I_13M; conv_item8(w13_m + (size_t)m * D * 2 * FFE, D, 2 * FFE, (unsigned char*)W13m_t + (size_t)m * 2 * FFE * D, ffn_g + (2 * (m >> 3) + 1) * D, FFE, F8_S1, scr, r, lane); }
            else { const int q = it - C7, m = q / I_2M, r = q % I_2M; conv_item8(w2_m + (size_t)m * FFE * D, FFE, D, (unsigned char*)W2m_t + (size_t)m * D * FFE, nullptr, 0, F8_S2, scr, r, lane); }
        }
        for (int idx = gw * 64 + lane; idx < DEPTH * 4 * 64 * 64; idx += NGW * 64) { const int c = idx & 63, dp = (idx >> 6) & 63, lg = idx >> 12;
            ((bf16*)(ws + WS_PWT))[idx] = (bf16)f2bf(pool_w[(size_t)(lg * 64 + c) * 64 + dp]); }
        for (int m = gw; m < T; m += NGW) {
            const GAS f32x4* xr = (const GAS f32x4*)(x_in + (size_t)m * D) + lane; f32x4 v[4]; float s = 0.f;
#pragma unroll
            for (int j = 0; j < 4; ++j) { v[j] = xr[64 * j]; s += (v[j].x * v[j].x + v[j].y * v[j].y) + (v[j].z * v[j].z + v[j].w * v[j].w); }
            s = wave_sum(s, lane);
            GAS unsigned long long* o8 = (GAS unsigned long long*)(xb + (size_t)m * D) + lane;
#pragma unroll
            for (int j = 0; j < 4; ++j) o8[64 * j] = (unsigned long long)pk2(v[j].x, v[j].y) | ((unsigned long long)pk2(v[j].z, v[j].w) << 32);
            if (lane < 16) ssp[(size_t)m * 16 + lane] = lane == 0 ? s : 0.f;
        }
        for (int m = gw; m < MROWS; m += NGW) {
            const GAS f32x4* xr = (const GAS f32x4*)(mem_in + (size_t)m * D) + lane; const GAS f32x4* gr = (const GAS f32x4*)mem_g + lane; f32x4 v[4]; float s = 0.f;
#pragma unroll
            for (int j = 0; j < 4; ++j) { v[j] = xr[64 * j]; s += (v[j].x * v[j].x + v[j].y * v[j].y) + (v[j].z * v[j].z + v[j].w * v[j].w); }
            const float r = 1.0f / sqrtf(wave_sum(s, lane) * (1.0f / D) + 1e-6f);
            GAS unsigned long long* o8 = (GAS unsigned long long*)(memn + (size_t)m * D) + lane;
#pragma unroll
            for (int j = 0; j < 4; ++j) { const f32x4 g = gr[64 * j]; o8[64 * j] = (unsigned long long)pk2(v[j].x * r * g.x, v[j].y * r * g.y) | ((unsigned long long)pk2(v[j].z * r * g.z, v[j].w * r * g.w) << 32); }
        }
    }
    PH_END;
    same_xcc = (unsigned)__builtin_amdgcn_readfirstlane((int)xb_ld((unsigned*)(ws0 + WS_XCCTAB) + (blk0 ^ 8))) == bar.x;

    for (int l = 0; l < DEPTH; ++l) {
#define ssp_a (ssp + (size_t)(3 * l) * SSP_STRIDE)
#define ssp_b (ssp + (size_t)(3 * l + 1) * SSP_STRIDE)
#define ssp_c (ssp + (size_t)(3 * l + 2) * SSP_STRIDE)
#define ssp_d (ssp + (size_t)(3 * l + 3) * SSP_STRIDE)
        if (PH_ON) { PH_VARS;
            if (l == 0) {
                pg8::Gemm g{memn, Wkv_t, MROWS, 4096, D}; pg8::StaticOrder S; S.init(MROWS, 4096, G, blk);
                pg8::EpiKV E{kvx, vtx};
                pg8::gemm_phase<pg8::EpiKV, pg8::StaticOrder, true, true>(lds, g, S, E, tid);
#if PROBE & (1 | 64)
                pg8::gemm_phase<pg8::EpiKV, pg8::StaticOrder, true, true>(lds, g, S, E, tid);
#endif
            }
        }
        if (PH_ON) {
            if (l >= 2) { PH_VARS;
                pg8::Gemm g{Ag, Win_t + (size_t)l * NPROJ * D, T, NPROJ, D / 2}; pg8::StaticOrder S; S.init(T, NPROJ, G, blk);
                pg8::EpiRowScale E{proj, NPROJ, ssp_a, 1.0f / F8_S1};
                pg8::gemm_phase<pg8::EpiRowScale, pg8::StaticOrder, true, true, true>(lds, g, S, E, tid);
            } else { PH_VARS;
                pg8::Gemm g{xb, Win_t + (size_t)l * NPROJ * D, T, NPROJ, D}; pg8::StaticOrder S; S.init(T, NPROJ, G, blk);
                pg8::EpiRowScale E{proj, NPROJ, ssp_a, 1.0f};
                pg8::gemm_phase<pg8::EpiRowScale, pg8::StaticOrder, true, true>(lds, g, S, E, tid);
            }
        }
        PH_END;
        if (PH_ON) { PH_VARS;
            LAS float* bt = (LAS float*)lds;
            for (int idx = tid; idx < 3 * 8 * BT_LD; idx += NWAVES * 64) { const int part = idx / (8 * BT_LD), rem = idx % (8 * BT_LD), h = rem / BT_LD, j = rem % BT_LD - BT_OFF, sh = 2 * part, jlo = part ? 33 : 0;
                float v = NEGINF; if (j <= 128 && j >= jlo) { const int d = j << sh; v = (rel_bias[t5_bucket(d) * 8 + h] + logf((float)key_mult(d))) * 1.4426950408889634f; } bt[idx] = v; }
            __syncthreads();
            for (int rep = 0; rep < ((PROBE & (2 | 2048)) ? 2 : 1); ++rep) {
            v4u sk[6], sv[6];
#define DIL_DEC(u_) const int part = (u_) >> 10, v_ = (u_) & 1023, sh = 2 * part, b = v_ >> 8, h = (v_ >> 5) & 7, w5 = v_ & 31, nbs = 5 - sh, r = w5 >> nbs, n0 = 256 * (w5 & ((1 << nbs) - 1))
            { const int u0 = blk < 3 * 1024 ? blk : 0; DIL_DEC(u0); dil_stage_load_k(sk, proj, sh, b, h, r, n0, tid); dil_stage_load_v(sv, proj, sh, b, h, r, n0, tid); }
            for (int u = blk; u < 3 * 1024; u += G) {
                DIL_DEC(u);
                const bool dst = !((PROBE & 2048) && rep == 1);
                __syncthreads();
                dil_stage_write_k(lds + 20480, sk, tid); dil_stage_write_v(lds + 20480, sv, tid);
                const int tq = b * SEQ + r + ((n0 + 32 * wave + (lane & 31)) << sh);
                bf16x8 qf[4];
                { const bf16* qp = proj + (size_t)tq * NPROJ + PC_Q + h * 64 + 32 * (lane >> 5);
#pragma unroll
                  for (int ks = 0; ks < 4; ++ks) qf[ks] = *(const GAS bf16x8*)(qp + 8 * ks); }
                __syncthreads();
                { const int un = u + G < 3 * 1024 ? u + G : u, part2 = un >> 10, v2 = un & 1023, sh2 = 2 * part2, nbs2 = 5 - sh2, w52 = v2 & 31, b2 = v2 >> 8, h2 = (v2 >> 5) & 7, r2 = w52 >> nbs2, n02 = 256 * (w52 & ((1 << nbs2) - 1));
                    dil_stage_load_k(sk, proj, sh2, b2, h2, r2, n02, tid); dil_stage_load_v(sv, proj, sh2, b2, h2, r2, n02, tid); }
                if (part == 0) dil_wg_compute<0>(lds + 20480, qf, opart, lsep, bt + h * BT_LD, tq, h, n0 + 32 * wave - 128, lane, wave, dst);
                else dil_wg_compute<33>(lds + 20480, qf, opart + (size_t)part * OP_STRIDE, lsep + (size_t)part * T * 8, bt + (part * 8 + h) * BT_LD, tq, h, n0 + 32 * wave - 128, lane, wave, dst);
            }
#undef DIL_DEC
            }
            __syncthreads();
        }
        PH_END;
        if (PH_ON) { PH_VARS;
            const bf16* pwT = (const bf16*)(ws + WS_PWT) + (size_t)l * 4 * 64 * 64;
            const int t0 = 32 * (tpm0 * 8 + 4 * tmb0 + (wave >> 1));
            if ((wave & 1) == 0) pool_unit(proj, pwT, pool_scale + (size_t)l * 256, ymix, t0, lane, lds + wave * 16896);
            else mergeconv_unit(proj, opart, lsep, conv_w + (size_t)l * 768, ymix, t0, lane);
        }
        PAIR_BAR;
        if (PH_ON) { PH_VARS;
            pg8::Gemm g{ymix, Wout_t + (size_t)l * D * D, T, D, D}; pg8::TeamOrder S{tpm0, 2 * tmb0, 2};
            pg8::EpiResid E{l == 0 ? x_in : (const float*)nullptr, xb, ssp_b, nullptr, 1.0f, 0};
            pg8::gemm_phase<pg8::EpiResid, pg8::TeamOrder, true, true>(lds, g, S, E, tid);
        }
        PAIR_BAR;
        if (PH_ON) { PH_VARS;
            pg8::Gemm g{xb, Wq_t + (size_t)l * XW * D, T, XW, D}; pg8::TeamOrder S{tpm0, tmb0, 1};
            pg8::EpiRowScale E{qx, XW, ssp_b, 0.08838834764831845f};
            pg8::gemm_phase<pg8::EpiRowScale, pg8::TeamOrder, true, true>(lds, g, S, E, tid);
            { const int b = (tpm0 * 256) / SEQ;
              for (int h2 = 0; h2 < 2; ++h2) xat_wg_unit(lds, qx, kvx + (size_t)(b * MEML) * 4096 + l * 1024, vtx + (size_t)((l * 4 + b) * 512) * MEML, ox, tpm0 * 256 + wave * 32, 2 * tmb0 + h2, tid); }
            __syncthreads();
        }
        PAIR_BAR;
        if (PH_ON) { PH_VARS;
            pg8::Gemm g{ox, Wo_t + (size_t)l * D * XW, T, D, XW}; pg8::TeamOrder S{tpm0, 2 * tmb0, 2};
            pg8::EpiResid E{nullptr, xb, ssp_c, (unsigned char*)Ag, 1.0f, l == 2 ? 1 : 0};
            pg8::gemm_phase<pg8::EpiResid, pg8::TeamOrder, true, true>(lds, g, S, E, tid);
        }
        PH_END;
        if ((l & 1) == 0) {
            if (PH_ON) { PH_VARS;
                pg8::StaticOrder S; S.init(T, 2 * FFD, G, blk);
                if (l == 2) {
                    pg8::Gemm g{Ag, W13d_t + (size_t)2 * FFD * D, T, 2 * FFD, D / 2};
                    pg8::EpiSwiGLU8 E{(unsigned char*)hbuf, FFD, nullptr, 0, 1.0f / F8_S1, F8_SH, ssp_c};
                    pg8::gemm_phase<pg8::EpiSwiGLU8, pg8::StaticOrder, true, true, true>(lds, g, S, E, tid);
                } else {
                    pg8::Gemm g{xb, W13d_t, T, 2 * FFD, D};
                    pg8::EpiSwiGLU E{hbuf, FFD, ssp_c, nullptr, 0};
                    pg8::gemm_phase<pg8::EpiSwiGLU, pg8::StaticOrder, true, true>(lds, g, S, E, tid);
                }
            }
            PH_END;
            if (PH_ON) { PH_VARS;
                pg8::StaticOrder S; S.init(T, D, G, blk);
                if (l == 2) {
                    pg8::Gemm g{hbuf, W2d_t + (size_t)D * FFD, T, D, FFD / 2};
                    pg8::EpiResid E{nullptr, xb, ssp_d, (unsigned char*)Ag, 1.0f / (F8_S2 * F8_SH), 1};
                    pg8::gemm_phase<pg8::EpiResid, pg8::StaticOrder, true, true, true>(lds, g, S, E, tid);
                } else {
                    pg8::Gemm g{hbuf, W2d_t, T, D, FFD};
                    pg8::EpiResid E{nullptr, xb, ssp_d, nullptr, 1.0f, 0};
                    pg8::gemm_phase<pg8::EpiResid, pg8::StaticOrder, true, true>(lds, g, S, E, tid);
                }
            }
            PH_END;
        } else {
#define chunk ((T + G - 1) / G)
            if (PH_ON) { PH_VARS;
                LAS int* lcnt = (LAS int*)lds; const float* rw = router_w + (size_t)(l >> 1) * D * NEXP; const float* fg = ffn_g + (size_t)l * D;
                if (tid < NEXP) lcnt[tid] = 0;
                __syncthreads();
                f32x4 gv[4];
#pragma unroll
                for (int j = 0; j < 4; ++j) gv[j] = *((const GAS f32x4*)fg + lane + 64 * j);
                static_assert(T / 256 == 128 && 128 % (4 * NWAVES) == 0, "router batches");
                for (int i0 = wave; i0 < chunk; i0 += 4 * NWAVES) {
                    int ln_ = lane; asm volatile("" : "+v"(ln_)); const float* rwl = rw + (size_t)ln_ * 32;
                    float r[4]; u32x2 xw[4][4];
#pragma unroll
                    for (int k = 0; k < 4; ++k) { const int t = blk * chunk + i0 + k * NWAVES; r[k] = pg8::row_rs16(ssp_c, t);
#pragma unroll
                        for (int j = 0; j < 4; ++j) xw[k][j] = *((const GAS u32x2*)(xb + (size_t)t * D) + lane + 64 * j); }
                    asm volatile("" ::: "memory");
                    float lg[4][8];
#pragma unroll
                    for (int k = 0; k < 4; ++k)
#pragma unroll
                        for (int e = 0; e < 8; ++e) lg[k][e] = 0.f;
#pragma unroll
                    for (int j = 0; j < 4; ++j)
#pragma unroll
                        for (int c = 0; c < 4; ++c) { const f32x4 w0 = *(const GAS f32x4*)(rwl + j * 2048 + c * 8), w1 = *(const GAS f32x4*)(rwl + j * 2048 + c * 8 + 4);
#pragma unroll
                            for (int k = 0; k < 4; ++k) { const unsigned xx = (c & 2) ? xw[k][j].y : xw[k][j].x; const float xv = (c & 1) ? bfhi(xx) : bflo(xx); const float hn = xv * r[k] * gv[j][c];
                                lg[k][0] += hn * w0[0]; lg[k][1] += hn * w0[1]; lg[k][2] += hn * w0[2]; lg[k][3] += hn * w0[3]; lg[k][4] += hn * w1[0]; lg[k][5] += hn * w1[1]; lg[k][6] += hn * w1[2]; lg[k][7] += hn * w1[3]; } }
#pragma unroll
                    for (int k = 0; k < 4; ++k) { const int t = blk * chunk + i0 + k * NWAVES;
#pragma unroll
                        for (int e = 0; e < 8; ++e) lg[k][e] = wave_sum(lg[k][e], lane);
                        int e0 = 0; float v0 = lg[k][0];
#pragma unroll
                        for (int e = 1; e < 8; ++e) if (lg[k][e] > v0) { v0 = lg[k][e]; e0 = e; }
                        int e1 = -1; float v1 = -3.0e38f;
#pragma unroll
                        for (int e = 0; e < 8; ++e) if (e != e0 && lg[k][e] > v1) { v1 = lg[k][e]; e1 = e; }
                        const float p0 = 1.0f / (1.0f + __expf(v1 - v0)), p1 = 1.0f - p0;
                        if (lane == 0) { tok_e[2 * t] = e0; tok_e[2 * t + 1] = e1; tok_g[2 * t] = p0; tok_g[2 * t + 1] = p1; atomicAdd((int*)&lcnt[e0], 1); atomicAdd((int*)&lcnt[e1], 1); } }
                }
                __syncthreads();
                if (tid < NEXP) cnts[blk * NEXP + tid] = lcnt[tid];
                __syncthreads();
            }
            PH_END;
            if (PH_ON) { PH_VARS;
                LAS int* lc = (LAS int*)lds;
                LAS int* lbase = (LAS int*)(lds + 32768);
                LAS int* lseg = (LAS int*)(lds + 32768 + 64);
                LAS int* lpos = (LAS int*)(lds + 36864);
                for (int i = tid; i < G * NEXP; i += NWAVES * 64) lc[i] = cnts[i];
                __syncthreads();
                { int base = 0, tot = 0;
                  for (int b2 = lane; b2 < G; b2 += 64) { const int c = lc[b2 * NEXP + wave]; tot += c; base += b2 < blk ? c : 0; }
                  for (int o = 1; o < 32; o <<= 1) { tot += __builtin_amdgcn_ds_bpermute((lane ^ o) << 2, tot); base += __builtin_amdgcn_ds_bpermute((lane ^ o) << 2, base); }
                  tot += __builtin_amdgcn_ds_bpermute((lane ^ 32) << 2, tot); base += __builtin_amdgcn_ds_bpermute((lane ^ 32) << 2, base);
                  if (lane == 0) { lbase[wave] = base; lseg[8 + wave] = tot; } }
                __syncthreads();
                if (tid == 0) { int s = 0; for (int e = 0; e < NEXP; ++e) { lseg[e] = s; lbase[e] += s; s += (lseg[8 + e] + 255) & ~255; lseg[16 + e] = s; if (blk == 0) meta[e] = s >> 8; } }
                __syncthreads();
                if (wave == 0) {
                    int run[8];
#pragma unroll
                    for (int e = 0; e < 8; ++e) run[e] = lbase[e];
                    const int nent = 2 * chunk;
                    for (int r0 = 0; r0 < nent; r0 += 64) { const int idx = r0 + lane; const int t = blk * chunk + (idx >> 1); const bool ok = idx < nent && t < T;
                        const int e = ok ? tok_e[2 * t + (idx & 1)] : -1; int pos = 0;
#pragma unroll
                        for (int ee = 0; ee < 8; ++ee) { const unsigned long long mk = __ballot(e == ee); if (e == ee) pos = run[ee] + __popcll(mk & ((1ull << lane) - 1ull)); run[ee] += __popcll(mk); }
                        if (ok) { tok_pos[2 * t + (idx & 1)] = pos; row_gate[pos] = tok_g[2 * t + (idx & 1)]; row_rs[pos] = pg8::row_rs16(ssp_c, t); lpos[idx] = pos; } }
                }
                __syncthreads();
                for (int idx = wave; idx < 2 * chunk; idx += NWAVES) { const int t = blk * chunk + (idx >> 1); if (t >= T) break; const int pos = lpos[idx];
                    const GAS v4u* src = (const GAS v4u*)(xb + (size_t)t * D); const v4u a = src[2 * lane], c = src[2 * lane + 1];
                    v4u o; o.x = pg8::pk4_fp8(bflo(a.x), bfhi(a.x), bflo(a.y), bfhi(a.y)); o.y = pg8::pk4_fp8(bflo(a.z), bfhi(a.z), bflo(a.w), bfhi(a.w));
                    o.z = pg8::pk4_fp8(bflo(c.x), bfhi(c.x), bflo(c.y), bfhi(c.y)); o.w = pg8::pk4_fp8(bflo(c.z), bfhi(c.z), bflo(c.w), bfhi(c.w));
                    *((GAS v4u*)((unsigned char*)Ag + (size_t)pos * D) + lane) = o; }
                if (blk < NEXP) { const int r0 = lseg[blk] + lseg[8 + blk], r1 = lseg[16 + blk];
                    for (int r = r0 + wave; r < r1; r += NWAVES) { GAS v4u* dst = (GAS v4u*)((unsigned char*)Ag + (size_t)r * D); unsigned z0; asm volatile("v_mov_b32 %0, 0" : "=v"(z0)); const v4u z = {z0, z0, z0, z0}; dst[lane] = z; if (lane == 0) { row_gate[r] = 0.f; row_rs[r] = 0.f; } } }
                __syncthreads();
            }
            PH_END;
            if (PH_ON) { PH_VARS;
                pg8::MoeOrder S;
#pragma unroll
                for (int e = 0; e < 8; ++e) S.te[e] = __builtin_amdgcn_readfirstlane(meta[e]);
                S.nNl = 2 * FFE / 256; S.so.init(S.te[7] * 256, 2 * FFE, G, blk);
                pg8::Gemm g{Ag, W13m_t + (size_t)(l >> 1) * NEXP * 2 * FFE * (D / 2), MP, NEXP * 2 * FFE, D / 2};
                pg8::EpiSwiGLU8 E{(unsigned char*)hbuf, FFE, row_rs, 2 * FFE / 256, 1.0f / F8_S1, F8_SH, nullptr};
                pg8::gemm_phase<pg8::EpiSwiGLU8, pg8::MoeOrder, true, true, true>(lds, g, S, E, tid);
#if PROBE & (1 | 512)
                pg8::gemm_phase<pg8::EpiSwiGLU8, pg8::MoeOrder, true, true, true>(lds, g, S, E, tid);
#endif
            }
            PH_END;
            if (PH_ON) { PH_VARS;
                pg8::MoeOrder S;
#pragma unroll
                for (int e = 0; e < 8; ++e) S.te[e] = __builtin_amdgcn_readfirstlane(meta[e]);
                const int ntile = S.te[7], nmain = ntile < 256 ? ntile : 256;
                S.nNl = D / 256; S.so.init(nmain * 256, D, G, blk);
                pg8::Gemm g{hbuf, W2m_t + (size_t)(l >> 1) * NEXP * D * (FFE / 2), MP, NEXP * D, FFE / 2};
                pg8::EpiMoeOut E{ym, row_gate, 1.0f / (F8_S2 * F8_SH)};
                pg8::gemm_phase<pg8::EpiMoeOut, pg8::MoeOrder, true, true, true>(lds, g, S, E, tid);
#if PROBE & (1 | 512)
                pg8::gemm_phase<pg8::EpiMoeOut, pg8::MoeOrder, true, true, true>(lds, g, S, E, tid);
#endif
                if (ntile > 256) {
                    pg8::MoeTailOrder ST; ST.npieces = (ntile - 256) * 4 * 7; ST.G = G; ST.c = blk; ST.kstep = 512;
#pragma unroll
                    for (int e = 0; e < 8; ++e) ST.te[e] = S.te[e];
                    pg8::Gemm g2{hbuf, W2m_t + (size_t)(l >> 1) * NEXP * D * (FFE / 2), MP, NEXP * D, 256, FFE / 2};
                    pg8::EpiMoePart EP{ypart, row_gate, 1.0f / (F8_S2 * F8_SH), 9};
                    pg8::gemm_phase<pg8::EpiMoePart, pg8::MoeTailOrder, true, true, true>(lds, g2, ST, EP, tid);
                }
            }
            PH_END;
            if (PH_ON) { PH_VARS;
                const bool last = (l == DEPTH - 1);
                static_assert(T % (4 * 256 * NWAVES) == 0, "combine batches"); constexpr int NBC = 4;
                for (int tb = gw; tb < T; tb += NBC * NGW) {
                    int p0[NBC], p1[NBC];
#pragma unroll
                    for (int k = 0; k < NBC; ++k) { const int t = tb + k * NGW; p0[k] = tok_pos[2 * t]; p1[k] = tok_pos[2 * t + 1]; }
                    u32x2 xa[NBC][4], ya[NBC][4], yb[NBC][4];
#pragma unroll
                    for (int k = 0; k < NBC; ++k) { const int t = tb + k * NGW;
                        const GAS u32x2* xr = (const GAS u32x2*)(xb + (size_t)t * D) + lane;
                        const GAS u32x2* y0 = (const GAS u32x2*)(ym + (size_t)(p0[k] < 65536 ? p0[k] : 0) * D) + lane; const GAS u32x2* y1 = (const GAS u32x2*)(ym + (size_t)(p1[k] < 65536 ? p1[k] : 0) * D) + lane;
#pragma unroll
                        for (int j = 0; j < 4; ++j) { xa[k][j] = xr[64 * j]; ya[k][j] = y0[64 * j]; yb[k][j] = y1[64 * j]; } }
                    asm volatile("" ::: "memory");
#pragma unroll
                    for (int k = 0; k < NBC; ++k) { const int t = tb + k * NGW;
                        f32x4 v[4]; float s = 0.f;
#pragma unroll
                        for (int j = 0; j < 4; ++j) { const u32x2 a = xa[k][j]; f32x4 e0, e1;
                            if (p0[k] < 65536) { const u32x2 b0 = ya[k][j]; e0 = (f32x4){bflo(b0.x), bfhi(b0.x), bflo(b0.y), bfhi(b0.y)}; }
                            else { e0 = (f32x4){0.f, 0.f, 0.f, 0.f};
                                for (int kp = 0; kp < 7; ++kp) { const u32x2 b0 = *((const GAS u32x2*)(ypart + ((size_t)kp * 2048 + (p0[k] - 65536)) * D) + lane + 64 * j); e0 += (f32x4){bflo(b0.x), bfhi(b0.x), bflo(b0.y), bfhi(b0.y)}; } }
                            if (p1[k] < 65536) { const u32x2 b1 = yb[k][j]; e1 = (f32x4){bflo(b1.x), bfhi(b1.x), bflo(b1.y), bfhi(b1.y)}; }
                            else { e1 = (f32x4){0.f, 0.f, 0.f, 0.f};
                                for (int kp = 0; kp < 7; ++kp) { const u32x2 b1 = *((const GAS u32x2*)(ypart + ((size_t)kp * 2048 + (p1[k] - 65536)) * D) + lane + 64 * j); e1 += (f32x4){bflo(b1.x), bfhi(b1.x), bflo(b1.y), bfhi(b1.y)}; } }
                            v[j] = ((f32x4){bflo(a.x), bfhi(a.x), bflo(a.y), bfhi(a.y)} + e0) + e1;
                            s += (v[j].x * v[j].x + v[j].y * v[j].y) + (v[j].z * v[j].z + v[j].w * v[j].w); }
                        s = wave_sum(s, lane);
                        GAS f32x4* orow = (GAS f32x4*)(out + (size_t)t * D) + lane;
                        if (last) { const float r = 1.0f / sqrtf(s * (1.0f / D) + 1e-6f); const GAS f32x4* gr = (const GAS f32x4*)fin_g + lane;
#pragma unroll
                            for (int j = 0; j < 4; ++j) orow[64 * j] = v[j] * r * gr[64 * j]; }
                        else { GAS unsigned long long* o8 = (GAS unsigned long long*)(xb + (size_t)t * D) + lane;
#pragma unroll
                            for (int j = 0; j < 4; ++j) o8[64 * j] = (unsigned long long)pk2(v[j].x, v[j].y) | ((unsigned long long)pk2(v[j].z, v[j].w) << 32);
                            { GAS unsigned* o4 = (GAS unsigned*)((unsigned char*)Ag + (size_t)t * D) + lane;
#pragma unroll
                              for (int j = 0; j < 4; ++j) o4[64 * j] = pg8::pk4_fp8(v[j].x, v[j].y, v[j].z, v[j].w); }
                            if (lane < 16) ssp_d[(size_t)t * 16 + lane] = lane == 0 ? s : 0.f; }
                    }
                }
            }
            if (l != DEPTH - 1) { PH_END; }
        }
    }
#undef PH_ON
#undef PH_END
}
#undef x_in
#undef mem_in
#undef rel_bias
#undef mem_g
#undef mix_g
#undef w_in
#undef conv_w
#undef pool_w
#undef pool_scale
#undef w_out
#undef xat_g
#undef wq_x
#undef wkv_x
#undef wo_x
#undef ffn_g
#undef w13_d
#undef w2_d
#undef router_w
#undef w13_m
#undef w2_m
#undef fin_g
#undef out
#undef Win_t
#undef Wout_t
#undef Wq_t
#undef Wkv_t
#undef Wo_t
#undef W13d_t
#undef W2d_t
#undef W13m_t
#undef W2m_t
#undef xb
#undef qx
#undef ox
#undef Ag
#undef ym
#undef proj
#undef ymix
#undef hbuf
#undef kvx
#undef memn
#undef ssp
#undef cnts
#undef meta
#undef tok_e
#undef tok_g
#undef tok_pos
#undef row_gate
#undef row_rs
#undef ssp_a
#undef ssp_b
#undef ssp_c
#undef ssp_d
#undef PH_VARS
#undef ypart
#undef chunk
#undef vtb
#undef opart
#undef lsep
#undef vtx

extern "C" void kernel_launch(void* const* d_in, const int* in_sizes, int n_in, void* d_out, int out_size, void* d_ws, size_t ws_size, hipStream_t stream) {
    static int grid = 0;
    if (grid == 0) {
        if (n_in != 21 || in_sizes[0] != T * D || out_size != T * D || ws_size < WS_END) { fprintf(stderr, "kernel_launch: unexpected shapes: n_in %d in0 %d out %d ws %zu (need %zu)\n", n_in, n_in > 0 ? in_sizes[0] : -1, out_size, ws_size, (size_t)WS_END); grid = -1; return; }
        int dev = 0, cus = 0, per_cu = 0;
        if (hipGetDevice(&dev) != hipSuccess || hipDeviceGetAttribute(&cus, hipDeviceAttributeMultiprocessorCount, dev) != hipSuccess) { fprintf(stderr, "kernel_launch: device query failed\n"); grid = -1; return; }
        if (hipFuncSetAttribute((const void*)trunk_fwd, hipFuncAttributeMaxDynamicSharedMemorySize, LDS_BYTES) != hipSuccess) { fprintf(stderr, "kernel_launch: hipFuncSetAttribute failed\n"); grid = -1; return; }
        if (hipOccupancyMaxActiveBlocksPerMultiprocessor(&per_cu, (const void*)trunk_fwd, NWAVES * 64, LDS_BYTES) != hipSuccess || per_cu < 1) fprintf(stderr, "kernel_launch: occupancy query reports %d\n", per_cu);
        (void)hipGetLastError();
        if (cus != T / 256 * 2) { fprintf(stderr, "kernel_launch: the team mapping needs %d CUs, device has %d\n", T / 256 * 2, cus); grid = -1; return; }
        grid = cus;
    }
    if (grid < 0) return;
    if (hipMemsetAsync((char*)d_ws + WS_CTL, 0, CTL_ZERO_BYTES, stream) != hipSuccess) { fprintf(stderr, "kernel_launch: memset failed\n"); return; }
    Args a{};
    for (int i = 0; i < 21; ++i) a.in[i] = (const float*)d_in[i];
    a.out = (float*)d_out; a.ws = (unsigned char*)d_ws;
#if N_LAUNCH_MODE == 0
    a.ph_lo = 0; a.ph_hi = NPH;
    hipLaunchKernelGGL(trunk_fwd, dim3(grid), dim3(NWAVES * 64), LDS_BYTES, stream, a);
#else
    for (int p = 0; p < NPH; ++p) { a.ph_lo = p; a.ph_hi = p + 1; hipLaunchKernelGGL(trunk_fwd, dim3(grid), dim3(NWAVES * 64), LDS_BYTES, stream, a); }
#endif
    const hipError_t le = hipPeekAtLastError();
    if (le != hipSuccess) fprintf(stderr, "kernel_launch: launch failed: %s\n", hipGetErrorName(le));
}
```

```cpp
#define PROBE 0
#include <hip/hip_runtime.h>
#include <cstdio>
#include <cstdint>
namespace pg8 {
#define PG8_LAS __attribute__((address_space(3)))
typedef unsigned short bf16_t;
typedef short bf16x8 __attribute__((ext_vector_type(8)));
typedef float f32x4 __attribute__((ext_vector_type(4)));
typedef unsigned u32x4 __attribute__((ext_vector_type(4)));
typedef int v4i_t __attribute__((ext_vector_type(4)));
typedef long v2l_t __attribute__((ext_vector_type(2)));
typedef int v8i_t __attribute__((ext_vector_type(8)));
constexpr int BM = 256, BK = 64, HALF = 128, HTB = HALF * BK * 2  , STAGE_BYTES = 8 * HTB, NXCD = 8, WGM = 8;

__host__ __device__ __forceinline__ int lds_byte(int r, int c) { const int st = (r >> 4) * 2 + (c >> 5), rr = r & 15, cc = c & 31, ob = rr * 64 + cc * 2; return st * 1024 + (ob ^ (((ob >> 9) & 1) << 5)); }
__host__ __device__ __forceinline__ void stage_rc(int b, int& R, int& C) { const int st = b / 1024, sb = b % 1024, swz = sb ^ (((sb >> 9) & 1) << 5); R = (st >> 1) * 16 + swz / 64; C = (st & 1) * 32 + (swz % 64) / 2; }
__host__ __device__ __forceinline__ int perm32(int rho) { const int n = rho >> 4, i = rho & 15; return 8 * (i >> 2) + 4 * n + (i & 3); }

struct Unit { int pm, pn; int ko = 0; };
struct Gemm { const bf16_t* A; const bf16_t* Bt; int M, N, K; int ld = 0; };

struct StaticOrder {
    int nM, nN, nwg, G, c;
    __host__ __device__ void init(int M, int N, int G_, int c_) { nM = M / BM; nN = N / BM; nwg = nM * nN; G = G_; c = c_; }
    __host__ __device__ __forceinline__ bool next(int i, Unit& u) const {
        const long L = (long)i * G + c; if (L >= nwg) return false;
        int wgid = (int)L; { const int q = nwg / NXCD, r = nwg % NXCD, xcd = wgid % NXCD, off = wgid / NXCD; wgid = (xcd < r ? xcd * (q + 1) : r * (q + 1) + (xcd - r) * q) + off; }
        const int nig = WGM * nN, gid = wgid / nig, fm = gid * WGM, gsz = (nM - fm) < WGM ? (nM - fm) : WGM;
        u.pm = fm + ((wgid % nig) % gsz); u.pn = (wgid % nig) / gsz; return true;
    }
    __device__ __forceinline__ void a_ready(const Unit&) const {}
    __device__ __forceinline__ void done(const Unit&) const {}
};

__device__ __forceinline__ unsigned cvt_pk_bf16(float lo, float hi) { unsigned r; asm volatile("v_cvt_pk_bf16_f32 %0, %1, %2" : "=v"(r) : "v"(lo), "v"(hi)); return r; }
typedef float f32x2 __attribute__((ext_vector_type(2)));
__device__ __forceinline__ float row_rs16(const float* ssp, int row) {
    const f32x4* sp = (const f32x4*)(ssp + (size_t)row * 16); const f32x4 s0 = sp[0], s1 = sp[1], s2 = sp[2], s3 = sp[3];
    const float s = (((s0[0] + s0[1]) + (s0[2] + s0[3])) + ((s1[0] + s1[1]) + (s1[2] + s1[3]))) + (((s2[0] + s2[1]) + (s2[2] + s2[3])) + ((s3[0] + s3[1]) + (s3[2] + s3[3])));
    return __builtin_amdgcn_rsqf(s * (1.0f / 1024.0f) + 1e-6f);
}
__device__ __forceinline__ void row_rs16x8(float (&r)[8], const float* ssp, int row0, int fr, int fq) {
    f32x4 c[8];
#pragma unroll
    for (int k = 0; k < 8; ++k) c[k] = *(const f32x4*)(ssp + (size_t)(row0 + (k >> 2) * HALF + (k & 3) * 16) * 16 + 4 * fq);
#pragma unroll
    for (int k = 0; k < 8; ++k) { float s = (c[k][0] + c[k][1]) + (c[k][2] + c[k][3]);
        s += __int_as_float(__builtin_amdgcn_ds_bpermute((((fq * 16 + fr) ^ 16) << 2), __float_as_int(s)));
        { const auto rr = __builtin_amdgcn_permlane32_swap(__float_as_uint(s), __float_as_uint(s), false, false); s = __uint_as_float(rr[0]) + __uint_as_float(rr[1]); }
        r[k] = __builtin_amdgcn_rsqf(s * (1.0f / 1024.0f) + 1e-6f); }
}
struct EpiRowScale {
    static constexpr bool PERM = true, AFTER_DRAIN = false;
    bf16_t* O; int ldc; const float* ssp; float cs;
    __device__ __forceinline__ void operator()(const f32x4 (&acc)[2][2][4][2], const Unit& u, int wr, int wc, int fr, int fq) const {
        const int row0 = u.pm * BM + wr * 64 + fr, col0 = u.pn * BM + wc * 32 + 8 * fq;
        float rr8[8];
        if (ssp) row_rs16x8(rr8, ssp, row0, fr, fq); else {
#pragma unroll
            for (int k = 0; k < 8; ++k) rr8[k] = 1.0f; }
#pragma unroll
        for (int ai = 0; ai < 2; ++ai)
#pragma unroll
            for (int m = 0; m < 4; ++m) { const int row = row0 + ai * HALF + m * 16; const float r = rr8[ai * 4 + m] * cs; bf16_t* rowp = O + (size_t)row * ldc + col0;
#pragma unroll
                for (int bj = 0; bj < 2; ++bj) { const f32x4 v0 = acc[ai][bj][m][0] * r, v1 = acc[ai][bj][m][1] * r;
                    u32x4 w; w.x = cvt_pk_bf16(v0[0], v0[1]); w.y = cvt_pk_bf16(v0[2], v0[3]); w.z = cvt_pk_bf16(v1[0], v1[1]); w.w = cvt_pk_bf16(v1[2], v1[3]);
                    *(u32x4*)(rowp + bj * HALF) = w; } }
    }
};
struct EpiInProj {
    static constexpr bool PERM = true, AFTER_DRAIN = false;
    bf16_t* O; const float* ssp; bf16_t* vt;
    __device__ __forceinline__ void operator()(const f32x4 (&acc)[2][2][4][2], const Unit& u, int wr, int wc, int fr, int fq) const {
        const int row0 = u.pm * BM + wr * 64 + fr;
        if (u.pn == 4 || u.pn == 5) {
            const int cv0 = (u.pn - 4) * BM + wc * 32 + 8 * fq; constexpr size_t CS = (size_t)32768 * 512;
#pragma unroll
            for (int ai = 0; ai < 2; ++ai)
#pragma unroll
                for (int m = 0; m < 4; ++m) { const int row = row0 + ai * HALF + m * 16; const float r = row_rs16(ssp, row); const int b = row >> 13, t = row & 8191;
                    const size_t o0 = (size_t)t, o1 = CS + (size_t)(t & 3) * 2048 + (t >> 2), o2 = 2 * CS + (size_t)(t & 15) * 512 + (t >> 4);
#pragma unroll
                    for (int bj = 0; bj < 2; ++bj)
#pragma unroll
                        for (int n = 0; n < 2; ++n) { const f32x4 v = acc[ai][bj][m][n] * r; const unsigned w01 = cvt_pk_bf16(v[0], v[1]), w23 = cvt_pk_bf16(v[2], v[3]);
                            bf16_t* p = vt + (size_t)(b * 512 + cv0 + bj * HALF + 4 * n) * 8192;
                            const bf16_t e0 = (bf16_t)(w01 & 0xffffu), e1 = (bf16_t)(w01 >> 16), e2 = (bf16_t)(w23 & 0xffffu), e3 = (bf16_t)(w23 >> 16);
                            p[o0] = e0; p[o1] = e0; p[o2] = e0; p[8192 + o0] = e1; p[8192 + o1] = e1; p[8192 + o2] = e1;
                            p[2 * 8192 + o0] = e2; p[2 * 8192 + o1] = e2; p[2 * 8192 + o2] = e2; p[3 * 8192 + o0] = e3; p[3 * 8192 + o1] = e3; p[3 * 8192 + o2] = e3; } }
        } else {
            const int col0 = u.pn * BM + wc * 32 + 8 * fq;
#pragma unroll
            for (int ai = 0; ai < 2; ++ai)
#pragma unroll
                for (int m = 0; m < 4; ++m) { const int row = row0 + ai * HALF + m * 16; const float r = row_rs16(ssp, row); bf16_t* rowp = O + (size_t)row * 2560 + col0;
#pragma unroll
                    for (int bj = 0; bj < 2; ++bj) { const f32x4 v0 = acc[ai][bj][m][0] * r, v1 = acc[ai][bj][m][1] * r;
                        u32x4 w; w.x = cvt_pk_bf16(v0[0], v0[1]); w.y = cvt_pk_bf16(v0[2], v0[3]); w.z = cvt_pk_bf16(v1[0], v1[1]); w.w = cvt_pk_bf16(v1[2], v1[3]);
                        *(u32x4*)(rowp + bj * HALF) = w; } }
        }
    }
};
struct EpiKV {
    static constexpr bool PERM = true, AFTER_DRAIN = false;
    bf16_t* kvx; bf16_t* vtx;
    __device__ __forceinline__ void operator()(const f32x4 (&acc)[2][2][4][2], const Unit& u, int wr, int wc, int fr, int fq) const {
        const int row0 = u.pm * BM + wr * 64 + fr, col0 = u.pn * BM + wc * 32 + 8 * fq;
        if ((u.pn & 3) >= 2) {
            const int lx = u.pn >> 2, dv0 = (col0 & 1023) - 512;
#pragma unroll
            for (int ai = 0; ai < 2; ++ai)
#pragma unroll
                for (int m = 0; m < 4; ++m) { const int row = row0 + ai * HALF + m * 16; const int b = row >> 8, key = row & 255;
#pragma unroll
                    for (int bj = 0; bj < 2; ++bj)
#pragma unroll
                        for (int n = 0; n < 2; ++n) { const f32x4 v = acc[ai][bj][m][n]; const unsigned w01 = cvt_pk_bf16(v[0], v[1]), w23 = cvt_pk_bf16(v[2], v[3]);
                            bf16_t* p = vtx + ((size_t)((lx * 4 + b) * 512 + dv0 + bj * HALF + 4 * n)) * 256 + key;
                            p[0] = (bf16_t)(w01 & 0xffffu); p[256] = (bf16_t)(w01 >> 16); p[512] = (bf16_t)(w23 & 0xffffu); p[768] = (bf16_t)(w23 >> 16); } }
        } else {
#pragma unroll
            for (int ai = 0; ai < 2; ++ai)
#pragma unroll
                for (int m = 0; m < 4; ++m) { const int row = row0 + ai * HALF + m * 16; bf16_t* rowp = kvx + (size_t)row * 4096 + col0;
#pragma unroll
                    for (int bj = 0; bj < 2; ++bj) { const f32x4 v0 = acc[ai][bj][m][0], v1 = acc[ai][bj][m][1];
                        u32x4 w; w.x = cvt_pk_bf16(v0[0], v0[1]); w.y = cvt_pk_bf16(v0[2], v0[3]); w.z = cvt_pk_bf16(v1[0], v1[1]); w.w = cvt_pk_bf16(v1[2], v1[3]);
                        *(u32x4*)(rowp + bj * HALF) = w; } }
        }
    }
};
__device__ __forceinline__ float silu_mul(float g, float u) { return g * u * __builtin_amdgcn_rcpf(1.0f + __expf(-g)); }
struct EpiSwiGLU {
    static constexpr bool PERM = true, AFTER_DRAIN = false;
    bf16_t* O; int ldc; const float* ssp; const float* rmul; int pn_mod;
    __device__ __forceinline__ void operator()(const f32x4 (&acc)[2][2][4][2], const Unit& u, int wr, int wc, int fr, int fq) const {
        const int pnl = pn_mod ? (u.pn % pn_mod) : u.pn;
        const int row0 = u.pm * BM + wr * 64 + fr, col0 = pnl * HALF + wc * 32 + 8 * fq;
        float rr8[8];
        if (ssp) row_rs16x8(rr8, ssp, row0, fr, fq); else {
#pragma unroll
            for (int k = 0; k < 8; ++k) rr8[k] = rmul[row0 + (k >> 2) * HALF + (k & 3) * 16]; }
#pragma unroll
        for (int ai = 0; ai < 2; ++ai)
#pragma unroll
            for (int m = 0; m < 4; ++m) { const int row = row0 + ai * HALF + m * 16; const float r = rr8[ai * 4 + m];
                const f32x4 g0 = acc[ai][0][m][0] * r, g1 = acc[ai][0][m][1] * r, u0 = acc[ai][1][m][0] * r, u1 = acc[ai][1][m][1] * r;
                u32x4 w; w.x = cvt_pk_bf16(silu_mul(g0[0], u0[0]), silu_mul(g0[1], u0[1])); w.y = cvt_pk_bf16(silu_mul(g0[2], u0[2]), silu_mul(g0[3], u0[3]));
                w.z = cvt_pk_bf16(silu_mul(g1[0], u1[0]), silu_mul(g1[1], u1[1])); w.w = cvt_pk_bf16(silu_mul(g1[2], u1[2]), silu_mul(g1[3], u1[3]));
                *(u32x4*)(O + (size_t)row * ldc + col0) = w; }
    }
};
__device__ __forceinline__ float sat8(float v) { return __builtin_amdgcn_fmed3f(v, -448.0f, 448.0f); }
__device__ __forceinline__ unsigned pk4_fp8_w(float a, float b, float c, float d) { int r = __builtin_amdgcn_cvt_pk_fp8_f32(a, b, 0, false); r = __builtin_amdgcn_cvt_pk_fp8_f32(c, d, r, true); return (unsigned)r; }
__device__ __forceinline__ unsigned pk4_fp8(float a, float b, float c, float d) { int r = __builtin_amdgcn_cvt_pk_fp8_f32(sat8(a), sat8(b), 0, false); r = __builtin_amdgcn_cvt_pk_fp8_f32(sat8(c), sat8(d), r, true); return (unsigned)r; }
struct EpiSwiGLU8 {
    static constexpr bool PERM = true, AFTER_DRAIN = false;
    unsigned char* O; int ldc; const float* rmul; int pn_mod; float cs, hs; const float* ssp;
    __device__ __forceinline__ void operator()(const f32x4 (&acc)[2][2][4][2], const Unit& u, int wr, int wc, int fr, int fq) const {
        const int pnl = pn_mod ? (u.pn % pn_mod) : u.pn;
        const int row0 = u.pm * BM + wr * 64 + fr, col0 = pnl * HALF + wc * 32 + 8 * fq;
        float rr8[8];
        if (ssp) row_rs16x8(rr8, ssp, row0, fr, fq); else {
#pragma unroll
            for (int k = 0; k < 8; ++k) rr8[k] = rmul[row0 + (k >> 2) * HALF + (k & 3) * 16]; }
#pragma unroll
        for (int ai = 0; ai < 2; ++ai)
#pragma unroll
            for (int m = 0; m < 4; ++m) { const int row = row0 + ai * HALF + m * 16; const float r = rr8[ai * 4 + m] * cs, r2 = r * -1.4426950408889634f, rrh = r * r * hs;
                unsigned w[2];
#pragma unroll
                for (int n = 0; n < 2; ++n) { const f32x4 ag = acc[ai][0][m][n], au = acc[ai][1][m][n]; const f32x4 t = ag * r2;
                    f32x4 d; d[0] = __builtin_amdgcn_exp2f(t[0]); d[1] = __builtin_amdgcn_exp2f(t[1]); d[2] = __builtin_amdgcn_exp2f(t[2]); d[3] = __builtin_amdgcn_exp2f(t[3]);
                    d = d + 1.0f;
                    f32x4 iv; iv[0] = __builtin_amdgcn_rcpf(d[0]); iv[1] = __builtin_amdgcn_rcpf(d[1]); iv[2] = __builtin_amdgcn_rcpf(d[2]); iv[3] = __builtin_amdgcn_rcpf(d[3]);
                    const f32x4 hv = ((ag * au) * rrh) * iv;
                    w[n] = pk4_fp8(hv[0], hv[1], hv[2], hv[3]); }
                typedef unsigned u32x2_t __attribute__((ext_vector_type(2)));
                *(u32x2_t*)(O + (size_t)row * ldc + col0) = (u32x2_t){w[0], w[1]}; }
    }
};
struct EpiResid {
    static constexpr bool PERM = true, AFTER_DRAIN = false;
    const float* base32; bf16_t* xb; float* ssp_out; unsigned char* xb8; float cs; int w8;
    __device__ __forceinline__ void operator()(const f32x4 (&acc)[2][2][4][2], const Unit& u, int wr, int wc, int fr, int fq) const {
        const int row0 = u.pm * BM + wr * 64 + fr, col0 = u.pn * BM + wc * 32 + 8 * fq;
        u32x4 xw[2][4][2];
        if (!base32) {
#pragma unroll
            for (int ai = 0; ai < 2; ++ai)
#pragma unroll
                for (int m = 0; m < 4; ++m)
#pragma unroll
                    for (int bj = 0; bj < 2; ++bj) xw[ai][m][bj] = *(const u32x4*)(xb + (size_t)(row0 + ai * HALF + m * 16) * 1024 + col0 + bj * HALF);
        }
#pragma unroll
        for (int ai = 0; ai < 2; ++ai)
#pragma unroll
            for (int m = 0; m < 4; ++m) { const int row = row0 + ai * HALF + m * 16; const size_t off = (size_t)row * 1024 + col0; float q = 0.f;
#pragma unroll
                for (int bj = 0; bj < 2; ++bj) { f32x4 b0, b1;
                    if (base32) { b0 = *(const f32x4*)(base32 + off + bj * HALF); b1 = *(const f32x4*)(base32 + off + bj * HALF + 4); }
                    else { const u32x4 w4 = xw[ai][m][bj];
                        b0 = (f32x4){__uint_as_float(w4.x << 16), __uint_as_float(w4.x & 0xffff0000u), __uint_as_float(w4.y << 16), __uint_as_float(w4.y & 0xffff0000u)};
                        b1 = (f32x4){__uint_as_float(w4.z << 16), __uint_as_float(w4.z & 0xffff0000u), __uint_as_float(w4.w << 16), __uint_as_float(w4.w & 0xffff0000u)}; }
                    const f32x4 v0 = b0 + acc[ai][bj][m][0] * cs, v1 = b1 + acc[ai][bj][m][1] * cs;
                    u32x4 w; w.x = cvt_pk_bf16(v0[0], v0[1]); w.y = cvt_pk_bf16(v0[2], v0[3]); w.z = cvt_pk_bf16(v1[0], v1[1]); w.w = cvt_pk_bf16(v1[2], v1[3]);
                    *(u32x4*)(xb + off + bj * HALF) = w;
                    if (w8) { typedef unsigned u32x2_t __attribute__((ext_vector_type(2))); *(u32x2_t*)(xb8 + off + bj * HALF) = (u32x2_t){pk4_fp8(v0[0], v0[1], v0[2], v0[3]), pk4_fp8(v1[0], v1[1], v1[2], v1[3])}; }
                    q += ((v0[0] * v0[0] + v0[1] * v0[1]) + (v0[2] * v0[2] + v0[3] * v0[3])) + ((v1[0] * v1[0] + v1[1] * v1[1]) + (v1[2] * v1[2] + v1[3] * v1[3])); }
                q += __int_as_float(__builtin_amdgcn_ds_bpermute((((fq * 16 + fr) ^ 16) << 2), __float_as_int(q)));
                { const auto rr = __builtin_amdgcn_permlane32_swap(__float_as_uint(q), __float_as_uint(q), false, false); q = __uint_as_float(rr[0]) + __uint_as_float(rr[1]); }
                if (fq == 0) ssp_out[(size_t)row * 16 + u.pn * 4 + wc] = q;
                if (base32 && (m & 1)) asm volatile("" ::: "memory"); }
    }
};
struct EpiMoeOut {
    static constexpr bool PERM = true, AFTER_DRAIN = false;
    bf16_t* Y; const float* gate; float cs = 1.0f;
    __device__ __forceinline__ void operator()(const f32x4 (&acc)[2][2][4][2], const Unit& u, int wr, int wc, int fr, int fq) const {
        const int row0 = u.pm * BM + wr * 64 + fr, col0 = (u.pn & 3) * BM + wc * 32 + 8 * fq;
#pragma unroll
        for (int ai = 0; ai < 2; ++ai)
#pragma unroll
            for (int m = 0; m < 4; ++m) { const int row = row0 + ai * HALF + m * 16; const float gt = gate[row] * cs; bf16_t* rowp = Y + (size_t)row * 1024 + col0;
#pragma unroll
                for (int bj = 0; bj < 2; ++bj) { const f32x4 v0 = acc[ai][bj][m][0] * gt, v1 = acc[ai][bj][m][1] * gt;
                    u32x4 w; w.x = cvt_pk_bf16(v0[0], v0[1]); w.y = cvt_pk_bf16(v0[2], v0[3]); w.z = cvt_pk_bf16(v1[0], v1[1]); w.w = cvt_pk_bf16(v1[2], v1[3]);
                    *(u32x4*)(rowp + bj * HALF) = w; } }
    }
};
struct EpiNull {
    static constexpr bool PERM = true, AFTER_DRAIN = false;
    float* sink;
    __device__ __forceinline__ void operator()(const f32x4 (&acc)[2][2][4][2], const Unit& u, int wr, int wc, int fr, int fq) const {
        float s = 0.f;
#pragma unroll
        for (int ai = 0; ai < 2; ++ai)
#pragma unroll
            for (int bj = 0; bj < 2; ++bj)
#pragma unroll
                for (int m = 0; m < 4; ++m)
#pragma unroll
                    for (int n = 0; n < 2; ++n) s += (acc[ai][bj][m][n][0] + acc[ai][bj][m][n][1]) + (acc[ai][bj][m][n][2] + acc[ai][bj][m][n][3]);
        if (s == 12345.6789f) sink[u.pm * 4 + wr] = s;
    }
};
struct EpiMoePart {
    static constexpr bool PERM = true, AFTER_DRAIN = false;
    bf16_t* P; const float* gate; float cs = 1.0f; int kshift = 10;
    __device__ __forceinline__ void operator()(const f32x4 (&acc)[2][2][4][2], const Unit& u, int wr, int wc, int fr, int fq) const {
        const int row0 = u.pm * BM + wr * 64 + fr, col0 = (u.pn & 3) * BM + wc * 32 + 8 * fq; bf16_t* base = P + (size_t)(u.ko >> kshift) * (2048 * 1024);
#pragma unroll
        for (int ai = 0; ai < 2; ++ai)
#pragma unroll
            for (int m = 0; m < 4; ++m) { const int row = row0 + ai * HALF + m * 16; const float gt = gate[row] * cs; bf16_t* rowp = base + (size_t)(row - 65536) * 1024 + col0;
#pragma unroll
                for (int bj = 0; bj < 2; ++bj) { const f32x4 v0 = acc[ai][bj][m][0] * gt, v1 = acc[ai][bj][m][1] * gt;
                    u32x4 w; w.x = cvt_pk_bf16(v0[0], v0[1]); w.y = cvt_pk_bf16(v0[2], v0[3]); w.z = cvt_pk_bf16(v1[0], v1[1]); w.w = cvt_pk_bf16(v1[2], v1[3]);
                    *(u32x4*)(rowp + bj * HALF) = w; } }
    }
};
struct MoeTailOrder {
    int npieces, G, c; int te[8]; int kstep = 1024;
    __device__ __forceinline__ bool next(int i, Unit& u) const {
        const int p = i * G + c; if (p >= npieces) return false;
        const int tt = p / 7, kp = p - tt * 7; const int pm = 256 + (tt >> 2);
        int e = 0;
#pragma unroll
        for (int k = 0; k < 7; ++k) e += (pm >= te[k]) ? 1 : 0;
        u.pm = pm; u.pn = e * 4 + (tt & 3); u.ko = kp * kstep; return true;
    }
    __device__ __forceinline__ void a_ready(const Unit&) const {}
    __device__ __forceinline__ void done(const Unit&) const {}
};
struct TeamOrder {
    int pm, pn0, npn;
    __device__ __forceinline__ bool next(int i, Unit& u) const { if (i >= npn) return false; u.pm = pm; u.pn = pn0 + i; return true; }
    __device__ __forceinline__ void a_ready(const Unit&) const {}
    __device__ __forceinline__ void done(const Unit&) const {}
};
struct MoeOrder {
    StaticOrder so; int nNl; int te[8];
    __device__ __forceinline__ bool next(int i, Unit& u) const {
        if (!so.next(i, u)) return false;
        int e = 0;
#pragma unroll
        for (int k = 0; k < 7; ++k) e += (u.pm >= te[k]) ? 1 : 0;
        u.pn += e * nNl; return true;
    }
    __device__ __forceinline__ void a_ready(const Unit&) const {}
    __device__ __forceinline__ void done(const Unit&) const {}
};

template <class Epi, class Sched, bool ALIGN_EPI = false, bool SP2 = false, bool F8 = false>
__device__ __forceinline__ void gemm_phase(PG8_LAS unsigned char* lds, const Gemm g, const Sched& S, const Epi& E, const int tid) {
    const int wid = __builtin_amdgcn_readfirstlane(tid >> 6), lane = tid & 63, wr = wid >> 2, wc = wid & 3, fr = lane & 15, fq = lane >> 4;
    const int K = g.K, nt = K / BK, LD = g.ld ? g.ld : K;
    unsigned voffA[2], voffB[2];
#pragma unroll
    for (int i = 0; i < 2; ++i) { int R, C; stage_rc(tid * 16 + i * 8192, R, C); const int Rb = Epi::PERM ? ((R & ~31) + perm32(R & 31)) : R;
        voffA[i] = (unsigned)(R * LD + C) * 2u; voffB[i] = (unsigned)(Rb * LD + C) * 2u; }
    const size_t kstep = (size_t)(BK * 2);
    const size_t hstep = (size_t)HALF * LD * 2;
    const size_t tstep = 2 * hstep;
    const unsigned ldsw = (unsigned)wid * 1024u;
    const int aoff = lds_byte(wr * 64 + fr, fq * 8), boff = lds_byte(wc * 32 + fr, fq * 8);
#define PG8_SA(b, h) (((b) * 2 + (h)) * HTB)
#define PG8_SB(b, h) ((4 + (b) * 2 + (h)) * HTB)
#define PG8_STAGE(bufoff, gbase, voff) do { _Pragma("unroll") for (int _i = 0; _i < 2; ++_i) \
        __builtin_amdgcn_global_load_lds((const unsigned*)((const char*)(gbase) + (voff)[_i]), (PG8_LAS unsigned*)(lds + (bufoff) + ldsw + _i * 8192), 16, 0, 0); } while (0)
#define PG8_CAT8(x, y) __builtin_shufflevector(__builtin_bit_cast(v4i_t, x), __builtin_bit_cast(v4i_t, y), 0, 1, 2, 3, 4, 5, 6, 7)
#define PG8_LDA(dst, b, h) do { _Pragma("unroll") for (int m = 0; m < 4; ++m) { if constexpr (F8) dst##8[m] = PG8_CAT8(*(const PG8_LAS bf16x8*)(lds + PG8_SA(b, h) + aoff + m * 2048), *(const PG8_LAS bf16x8*)(lds + PG8_SA(b, h) + aoff + m * 2048 + 1024)); \
        else { _Pragma("unroll") for (int k = 0; k < 2; ++k) dst[m][k] = *(const PG8_LAS bf16x8*)(lds + PG8_SA(b, h) + aoff + m * 2048 + k * 1024); } } } while (0)
#define PG8_LDB(dst, b, h) do { _Pragma("unroll") for (int n = 0; n < 2; ++n) { if constexpr (F8) dst##8[n] = PG8_CAT8(*(const PG8_LAS bf16x8*)(lds + PG8_SB(b, h) + boff + n * 2048), *(const PG8_LAS bf16x8*)(lds + PG8_SB(b, h) + boff + n * 2048 + 1024)); \
        else { _Pragma("unroll") for (int k = 0; k < 2; ++k) dst[n][k] = *(const PG8_LAS bf16x8*)(lds + PG8_SB(b, h) + boff + n * 2048 + k * 1024); } } } while (0)
#define PG8_MMA(ai, bj, At, Bt) do { __builtin_amdgcn_s_setprio(1); _Pragma("unroll") for (int m = 0; m < 4; ++m) _Pragma("unroll") for (int n = 0; n < 2; ++n) { \
        if constexpr (F8) asm volatile("v_mfma_scale_f32_16x16x128_f8f6f4 %0, %1, %2, %0, %3, %3 op_sel_hi:[0,0,0]" : "+v"(acc[ai][bj][m][n]) : "v"(Bt##8[n]), "v"(At##8[m]), "v"(f8scale)); \
        else { _Pragma("unroll") for (int k = 0; k < 2; ++k) acc[ai][bj][m][n] = __builtin_amdgcn_mfma_f32_16x16x32_bf16(Bt[n][k], At[m][k], acc[ai][bj][m][n], 0, 0, 0); } } __builtin_amdgcn_s_setprio(0); } while (0)
#define PG8_WAIT_V(n) asm volatile("s_waitcnt vmcnt(" #n ")" ::: "memory")
#define PG8_WAIT_L(n) asm volatile("s_waitcnt lgkmcnt(" #n ")" ::: "memory")
#define PG8_BAR __builtin_amdgcn_s_barrier()
#define PG8_SCHED __builtin_amdgcn_sched_barrier(0)
    Unit cur, nxt; int ui = 0;
    if (!S.next(0, cur)) return;
    f32x4 acc[2][2][4][2];
#pragma unroll
    for (int a = 0; a < 2; ++a)
#pragma unroll
        for (int b = 0; b < 2; ++b)
#pragma unroll
            for (int m = 0; m < 4; ++m)
#pragma unroll
                for (int n = 0; n < 2; ++n) acc[a][b][m][n] = (f32x4){0.f, 0.f, 0.f, 0.f};
    const int f8scale = 0x7f7f7f7f;
    bf16x8 At[4][2], B0[2][2], B1[2][2]; v8i_t At8[4], B08[2], B18[2];
    const char* cA = (const char*)g.A + (size_t)cur.pm * tstep + cur.ko; const char* cB = (const char*)g.Bt + (size_t)cur.pn * tstep + cur.ko;
    S.a_ready(cur);
    if constexpr (SP2) {
        PG8_STAGE(PG8_SB(0, 0), cB, voffB); PG8_STAGE(PG8_SB(0, 1), cB + hstep, voffB); PG8_STAGE(PG8_SA(0, 0), cA, voffA); PG8_STAGE(PG8_SA(0, 1), cA + hstep, voffA);
        if (wr == 1) PG8_BAR;
        PG8_WAIT_V(2); PG8_BAR;
        PG8_STAGE(PG8_SB(1, 0), cB + kstep, voffB); PG8_STAGE(PG8_SA(1, 0), cA + kstep, voffA); PG8_STAGE(PG8_SB(1, 1), cB + hstep + kstep, voffB);
        PG8_WAIT_V(6); PG8_BAR;
    } else {
        PG8_STAGE(PG8_SB(0, 0), cB, voffB); PG8_STAGE(PG8_SA(0, 0), cA, voffA); PG8_STAGE(PG8_SB(0, 1), cB + hstep, voffB); PG8_STAGE(PG8_SA(0, 1), cA + hstep, voffA);
        if (wr == 1) PG8_BAR;
        PG8_WAIT_V(4); PG8_BAR;
        PG8_STAGE(PG8_SB(1, 0), cB + kstep, voffB); PG8_STAGE(PG8_SA(1, 0), cA + kstep, voffA); PG8_STAGE(PG8_SB(1, 1), cB + hstep + kstep, voffB);
        PG8_WAIT_V(6); PG8_BAR;
    }
    for (;;) {
        const bool has_next = S.next(ui + 1, nxt);
        const char* nA = has_next ? (const char*)g.A + (size_t)nxt.pm * tstep + nxt.ko : cA; const char* nB = has_next ? (const char*)g.Bt + (size_t)nxt.pn * tstep + nxt.ko : cB;
        for (int t = 0; t < nt; t += 2) {
            const bool last = (t == nt - 2);
            const char* a1 = cA + (size_t)(t + 1) * kstep;
            const char* a2 = last ? nA : cA + (size_t)(t + 2) * kstep; const char* b2 = last ? nB : cB + (size_t)(t + 2) * kstep;
            const char* a3 = a2 + kstep; const char* b3 = b2 + kstep;
            if (last && has_next) S.a_ready(nxt);
            if constexpr (SP2) {
            PG8_LDB(B0, 0, 0); PG8_LDB(B1, 0, 1); PG8_SCHED; PG8_LDA(At, 0, 0); PG8_STAGE(PG8_SA(1, 1), a1 + hstep, voffA);
            PG8_WAIT_V(8); PG8_WAIT_L(0); PG8_BAR; PG8_MMA(0, 0, At, B0); PG8_MMA(0, 1, At, B1); PG8_BAR; PG8_SCHED;
            PG8_LDA(At, 0, 1); PG8_STAGE(PG8_SB(0, 0), b2, voffB); PG8_STAGE(PG8_SB(0, 1), b2 + hstep, voffB); PG8_STAGE(PG8_SA(0, 0), a2, voffA);
            PG8_WAIT_V(8); PG8_WAIT_L(0); PG8_BAR; PG8_MMA(1, 0, At, B0); PG8_MMA(1, 1, At, B1); PG8_BAR; PG8_SCHED;
            PG8_LDB(B0, 1, 0); PG8_LDB(B1, 1, 1); PG8_SCHED; PG8_LDA(At, 1, 0); PG8_STAGE(PG8_SA(0, 1), a2 + hstep, voffA);
            PG8_WAIT_V(8); PG8_WAIT_L(0); PG8_BAR; PG8_MMA(0, 0, At, B0); PG8_MMA(0, 1, At, B1); PG8_BAR; PG8_SCHED;
            PG8_LDA(At, 1, 1); PG8_STAGE(PG8_SB(1, 0), b3, voffB); PG8_STAGE(PG8_SB(1, 1), b3 + hstep, voffB); PG8_STAGE(PG8_SA(1, 0), a3, voffA);
            PG8_WAIT_V(8); PG8_WAIT_L(0); PG8_BAR; PG8_MMA(1, 0, At, B0); PG8_MMA(1, 1, At, B1); PG8_BAR; PG8_SCHED;
            } else {
            PG8_LDB(B0, 0, 0); PG8_SCHED; PG8_LDA(At, 0, 0); PG8_STAGE(PG8_SA(1, 1), a1 + hstep, voffA);
            PG8_WAIT_L(8); PG8_BAR; PG8_WAIT_L(0); PG8_MMA(0, 0, At, B0); PG8_BAR; PG8_SCHED;
            PG8_LDB(B1, 0, 1); PG8_STAGE(PG8_SB(0, 0), b2, voffB);
            PG8_BAR; PG8_WAIT_L(0); PG8_MMA(0, 1, At, B1); PG8_BAR;
            PG8_LDA(At, 0, 1); PG8_STAGE(PG8_SA(0, 0), a2, voffA);
            PG8_BAR; PG8_WAIT_L(0); PG8_MMA(1, 0, At, B0); PG8_BAR; PG8_SCHED;
            PG8_STAGE(PG8_SB(0, 1), b2 + hstep, voffB);
            PG8_WAIT_V(6); PG8_BAR; PG8_MMA(1, 1, At, B1); PG8_BAR;
            PG8_LDB(B0, 1, 0); PG8_SCHED; PG8_LDA(At, 1, 0); PG8_STAGE(PG8_SA(0, 1), a2 + hstep, voffA);
            PG8_WAIT_L(8); PG8_BAR; PG8_WAIT_L(0); PG8_MMA(0, 0, At, B0); PG8_BAR; PG8_SCHED;
            PG8_LDB(B1, 1, 1); PG8_STAGE(PG8_SB(1, 0), b3, voffB);
            PG8_BAR; PG8_WAIT_L(0); PG8_MMA(0, 1, At, B1); PG8_BAR;
            PG8_LDA(At, 1, 1); PG8_STAGE(PG8_SA(1, 0), a3, voffA);
            PG8_BAR; PG8_WAIT_L(0); PG8_MMA(1, 0, At, B0); PG8_BAR; PG8_SCHED;
            PG8_STAGE(PG8_SB(1, 1), b3 + hstep, voffB);
            PG8_WAIT_V(6); PG8_BAR; PG8_MMA(1, 1, At, B1); PG8_BAR;
            }
        }
        if constexpr (ALIGN_EPI) { if (wr == 0) PG8_BAR; }
        if constexpr (F8) asm volatile("s_nop 15\n\ts_nop 15" ::: "memory");
        if constexpr (!Epi::AFTER_DRAIN) { int fr_ = fr, fq_ = fq; asm volatile("" : "+v"(fr_), "+v"(fq_)); E(acc, cur, wr, wc, fr_, fq_); S.done(cur); }
        if (!has_next) break;
#pragma unroll
        for (int a = 0; a < 2; ++a)
#pragma unroll
            for (int b = 0; b < 2; ++b)
#pragma unroll
                for (int m = 0; m < 4; ++m)
#pragma unroll
                    for (int n = 0; n < 2; ++n) acc[a][b][m][n] = (f32x4){0.f, 0.f, 0.f, 0.f};
        cur = nxt; cA = nA; cB = nB; ++ui;
        if constexpr (ALIGN_EPI) { if (wr == 1) PG8_BAR; }
    }
    PG8_WAIT_V(0);
    if constexpr (!ALIGN_EPI) { if (wr == 0) PG8_BAR; }
    PG8_BAR;
    if constexpr (Epi::AFTER_DRAIN) { E.fused(acc, cur, wr, wc, fr, fq, lds, wid, lane); S.done(cur); }
#undef PG8_SA
#undef PG8_SB
#undef PG8_STAGE
#undef PG8_LDA
#undef PG8_LDB
#undef PG8_MMA
#undef PG8_CAT8
#undef PG8_WAIT_V
#undef PG8_WAIT_L
#undef PG8_BAR
#undef PG8_SCHED
}
}
#define GAS __attribute__((address_space(1)))
#define LAS __attribute__((address_space(3)))
typedef unsigned short bf16;
typedef unsigned v4u __attribute__((ext_vector_type(4)));
typedef float f32x4 __attribute__((ext_vector_type(4)));
typedef short bf16x8 __attribute__((ext_vector_type(8)));
typedef GAS unsigned gu32;
typedef GAS unsigned long long gu64;
#define RLX_AGENT __ATOMIC_RELAXED, __HIP_MEMORY_SCOPE_AGENT
#define LDS_WAIT() asm volatile("s_waitcnt lgkmcnt(0)" ::: "memory")
#define VM_WAIT() asm volatile("s_waitcnt vmcnt(0)" ::: "memory")
__device__ __forceinline__ unsigned long long rt() { return __builtin_amdgcn_s_memrealtime(); }
__device__ __forceinline__ unsigned f2bf(float f) { unsigned u = __builtin_bit_cast(unsigned, f); return (u + 0x7fffu + ((u >> 16) & 1u)) >> 16; }
__device__ __forceinline__ unsigned pk2(float lo, float hi) { return f2bf(lo) | (f2bf(hi) << 16); }
#define XB_TMO      128
#define XB_XCNT(j)  (256  + 64 * (j))
#define XB_XSUB(j)  (1280 + 64 * (j))
#define XB_XGEN(j)  (2304 + 64 * (j))
#define XB_TOP      3328
#define XB_TOPGEN   3392
#define XCD_BAR_WORDS 3456
#define XB_SPIN_CAP (1u << 18)

__device__ __forceinline__ unsigned xb_ld(unsigned* p)              { return __hip_atomic_load(p, __ATOMIC_RELAXED, __HIP_MEMORY_SCOPE_AGENT); }
__device__ __forceinline__ unsigned xb_add(unsigned* p, unsigned v) { return __hip_atomic_fetch_add(p, v, __ATOMIC_RELAXED, __HIP_MEMORY_SCOPE_AGENT); }
__device__ __forceinline__ unsigned xb_xcc_id() { return (unsigned)__builtin_amdgcn_s_getreg((3 << 11) | 20) & 0xFu; }
#define XB_SPIN(cond, bar) do { unsigned _sp = 0; while (cond) { __builtin_amdgcn_s_sleep(1); \
    if ((++_sp & 255u) == 0u) { if (xb_ld(&(bar)[XB_TMO])) break; if (_sp > XB_SPIN_CAP) { atomicAdd(&(bar)[XB_TMO], 1u); break; } } } } while (0)

struct XcdBarrier {
    unsigned* bar; unsigned x;
    volatile LAS unsigned* st;
};

__device__ __forceinline__ XcdBarrier xcd_barrier_post(unsigned* bar, volatile LAS unsigned* st) {
    XcdBarrier b; b.bar = bar; b.x = xb_xcc_id(); b.st = st;
    if (threadIdx.x == 0) (void)xb_add(&bar[XB_XCNT(b.x)], 1u);
    return b;
}
__device__ __forceinline__ void xcd_barrier_complete(unsigned* bar, unsigned x, unsigned& nloc, unsigned& nx) {
    const unsigned G = gridDim.x * gridDim.y * gridDim.z;
    unsigned sum, cnt, mine, sp = 0u;
    for (;;) {
        sum = 0u; cnt = 0u; mine = 0u;
#pragma unroll
        for (unsigned j = 0; j < 16; ++j) { const unsigned c = xb_ld(&bar[XB_XCNT(j)]); sum += c; cnt += (c > 0u) ? 1u : 0u; mine = (j == x) ? c : mine; }
        if (sum == G) break;
        __builtin_amdgcn_s_sleep(1);
        if ((++sp & 255u) == 0u) { if (xb_ld(&bar[XB_TMO])) break; if (sp > XB_SPIN_CAP) { atomicAdd(&bar[XB_TMO], 1u); break; } }
    }
    nloc = mine > 0u ? mine : 1u; nx = cnt > 0u ? cnt : 1u;
}

__device__ __forceinline__ void xcd_barrier(const XcdBarrier& b) {
    asm volatile("s_waitcnt vmcnt(0)" ::: "memory");
    __syncthreads();
    if (threadIdx.x == 0) {
        unsigned* bar = b.bar;
        __builtin_amdgcn_s_waitcnt(0);
        unsigned nloc = b.st[0], nx = b.st[1];
        if (nloc == 0u) { xcd_barrier_complete(bar, b.x, nloc, nx); b.st[0] = nloc; b.st[1] = nx; }
        const unsigned old = xb_add(&bar[XB_XSUB(b.x)], 1u);
        const unsigned gen = old / nloc;
        if (old + 1u == (gen + 1u) * nloc) {
            __builtin_amdgcn_fence(__ATOMIC_RELEASE, "agent");
            asm volatile("s_waitcnt vmcnt(0)" ::: "memory");
            const unsigned og = xb_add(&bar[XB_TOP], 1u);
            const unsigned tg = og / nx;
            if (og + 1u == (tg + 1u) * nx) xb_add(&bar[XB_TOPGEN], 1u);
            else XB_SPIN(xb_ld(&bar[XB_TOPGEN]) == tg, bar);
            __builtin_amdgcn_fence(__ATOMIC_ACQUIRE, "agent");
            xb_add(&bar[XB_XGEN(b.x)], 1u);
            asm volatile("s_waitcnt vmcnt(0)" ::: "memory");
        } else {
            XB_SPIN(xb_ld(&bar[XB_XGEN(b.x)]) == gen, bar);
            __builtin_amdgcn_fence(__ATOMIC_ACQUIRE, "agent");
            asm volatile("s_waitcnt vmcnt(0)" ::: "memory");
        }
    }
    __syncthreads();
}
constexpr int NWAVES = 8;
constexpr int BATCH = 4, SEQ = 8192, D = 1024, T = BATCH * SEQ, DEPTH = 4, MEML = 256, MROWS = BATCH * MEML;
constexpr int NPROJ = 2560, FFD = 2816, FFE = 3584, NEXP = 8, XW = 512;
constexpr int MP = 2 * T + NEXP * 256;
constexpr float F8_S1 = 16.0f, F8_S2 = 32.0f, F8_SH = 4.0f;
constexpr int NKEYS = 321;
constexpr int NPH = 1 + 8 + 11 + 8 + 11;
constexpr int PC_Q = 0, PC_K = 512, PC_V = 1024, PC_POOL = 1536, PC_BG = 1792, PC_CG = 2048, PC_HC = 2304;
constexpr size_t MiB = 1u << 20;
constexpr size_t WS_CTL = 0, CTL_ZERO_BYTES = 64 * 1024;
constexpr size_t WS_PWT = 256 * 1024;
constexpr size_t WS_CNT = 1 * MiB, WS_META = 1 * MiB + 64 * 1024;
constexpr size_t WS_TOKE = 1 * MiB + 512 * 1024, WS_TOKG = 2 * MiB, WS_TOKPOS = 2 * MiB + 512 * 1024, WS_ROWGATE = 3 * MiB, WS_ROWRS = 3 * MiB + 512 * 1024;
constexpr size_t WS_SSP = 4 * MiB;
constexpr size_t WS_KVX = 30 * MiB, WS_MEMN = 38 * MiB;
constexpr size_t WS_WIN = 40 * MiB, WS_WOUT = 60 * MiB, WS_WQ = 68 * MiB, WS_WKV = 72 * MiB, WS_WO = 80 * MiB, WS_W13D = 84 * MiB, WS_W2D = 106 * MiB, WS_W13M = 117 * MiB, WS_W2M = 341 * MiB;
constexpr size_t WS_XB = 453 * MiB, WS_QX = 517 * MiB, WS_OX = 549 * MiB, WS_AG = 581 * MiB, WS_YM = 713 * MiB, WS_RA = 977 * MiB, WS_VTX = 1439 * MiB, WS_END = 1443 * MiB;
constexpr size_t WS_PROJ = WS_RA, WS_Y = WS_RA + 160 * MiB, WS_H = WS_RA, WS_VT = WS_RA + 224 * MiB, WS_OPART = WS_RA + 320 * MiB, WS_LSE = WS_RA + 416 * MiB;
constexpr size_t VT_STRIDE = (size_t)T * 512, OP_STRIDE = (size_t)T * 512;
static_assert(WS_AG + (size_t)MP * D * 2 <= WS_YM && WS_YM + (size_t)MP * D * 4 <= WS_RA && WS_RA + (size_t)MP * FFE * 2 <= WS_VTX, "ws map");
constexpr int CW_BAR = 4096, CW_TEAM = 8192;
constexpr size_t WS_XCCTAB = 128 * 1024;
constexpr int RING_BYTES = 131072, LDSCTL_OFF = 159744, MISC_OFF = LDSCTL_OFF + 320, LDS_BYTES = 163840;

__device__ __forceinline__ float shx(float v, int mask, int lane) { return __int_as_float(__builtin_amdgcn_ds_bpermute((lane ^ mask) << 2, __float_as_int(v))); }
__device__ __forceinline__ float xsum32(float v) { const auto rr = __builtin_amdgcn_permlane32_swap(__float_as_uint(v), __float_as_uint(v), false, false); return __uint_as_float(rr[0]) + __uint_as_float(rr[1]); }
__device__ __forceinline__ float xmax32(float v) { const auto rr = __builtin_amdgcn_permlane32_swap(__float_as_uint(v), __float_as_uint(v), false, false); return fmaxf(__uint_as_float(rr[0]), __uint_as_float(rr[1])); }
__device__ __forceinline__ float wave_sum_dpp(float v) {
    v += __int_as_float(__builtin_amdgcn_update_dpp(0, __float_as_int(v), 0xB1, 0xf, 0xf, false));
    v += __int_as_float(__builtin_amdgcn_update_dpp(0, __float_as_int(v), 0x4E, 0xf, 0xf, false));
    v += __int_as_float(__builtin_amdgcn_update_dpp(0, __float_as_int(v), 0x141, 0xf, 0xf, false));
    v += __int_as_float(__builtin_amdgcn_update_dpp(0, __float_as_int(v), 0x140, 0xf, 0xf, false));
    v += __int_as_float(__builtin_amdgcn_update_dpp(0, __float_as_int(v), 0x142, 0xa, 0xf, false));
    v += __int_as_float(__builtin_amdgcn_update_dpp(0, __float_as_int(v), 0x143, 0xc, 0xf, false));
    return __int_as_float(__builtin_amdgcn_readlane(__float_as_int(v), 63));
}
__device__ __forceinline__ float wave_sum(float v, int lane) {
#pragma unroll
    for (int o = 1; o < 32; o <<= 1) v += shx(v, o, lane);
    return xsum32(v);
}
__device__ __forceinline__ float bflo(unsigned u) { return __uint_as_float(u << 16); }
__device__ __forceinline__ float bfhi(unsigned u) { return __uint_as_float(u & 0xffff0000u); }
__device__ __forceinline__ float bf1(bf16 h) { return __uint_as_float(((unsigned)h) << 16); }
__device__ __forceinline__ float dot8(v4u a, v4u b) {
    return (bflo(a.x) * bflo(b.x) + bfhi(a.x) * bfhi(b.x)) + (bflo(a.y) * bflo(b.y) + bfhi(a.y) * bfhi(b.y)) + (bflo(a.z) * bflo(b.z) + bfhi(a.z) * bfhi(b.z)) + (bflo(a.w) * bflo(b.w) + bfhi(a.w) * bfhi(b.w));
}
__device__ __forceinline__ int key_dist(int i) { return i < 129 ? i : (i < 225 ? 132 + 4 * (i - 129) : 528 + 16 * (i - 225)); }
__device__ __forceinline__ int key_mult(int d) { return d <= 128 ? 1 + ((d & 3) == 0 ? 1 : 0) + ((d & 15) == 0 ? 1 : 0) : (d <= 512 ? 1 + ((d & 15) == 0 ? 1 : 0) : 1); }
__device__ __forceinline__ int t5_bucket(int d) {
    if (d < 16) return d;
    int b = 16 + (int)(logf((float)d / 16.0f) / logf(8.0f) * 16.0f);
    return b < 31 ? b : 31;
}

struct Args { const float* in[21]; float* out; unsigned char* ws; int ph_lo, ph_hi; };

__device__ __forceinline__ void conv_item(const float* W, int K, int N, bf16* WT, const float* gain, int swF, LAS float* scr, int item, int lane) {
    const int nblk = N / 64, kb = item / nblk, nb = item % nblk, k0 = 64 * kb, n0 = 64 * nb;
    float wv[64];
#pragma unroll
    for (int i = 0; i < 64; ++i) wv[i] = W[(size_t)(k0 + i) * N + n0 + lane];
    if (gain) {
#pragma unroll
        for (int i = 0; i < 64; ++i) wv[i] *= gain[k0 + i]; }
#pragma unroll
    for (int i = 0; i < 64; ++i) scr[i * 65 + lane] = wv[i];
    LDS_WAIT(); asm volatile("" ::: "memory");
    int orow0 = n0;
    if (swF) { const int isup = n0 >= swF ? 1 : 0; const int j = n0 - isup * swF; orow0 = (j >> 7) * 256 + isup * 128 + (j & 127); }
    const int c = lane & 7;
#pragma unroll
    for (int j = 0; j < 8; ++j) { const int n = (lane >> 3) + 8 * j; const LAS float* s = scr + (8 * c) * 65 + n;
        v4u o; o.x = pk2(s[0 * 65], s[1 * 65]); o.y = pk2(s[2 * 65], s[3 * 65]); o.z = pk2(s[4 * 65], s[5 * 65]); o.w = pk2(s[6 * 65], s[7 * 65]);
        *(GAS v4u*)(WT + (size_t)(orow0 + n) * K + k0 + 8 * c) = o; }
    LDS_WAIT(); asm volatile("" ::: "memory");
}

typedef unsigned u32x2 __attribute__((ext_vector_type(2)));
__device__ __forceinline__ void conv_item8(const float* W, int K, int N, unsigned char* WT, const float* gain, int swF, float scale, LAS float* scr, int item, int lane) {
    const int nblk = N / 64, kb = item / nblk, nb = item % nblk, k0 = 64 * kb, n0 = 64 * nb;
    float wv[64];
#pragma unroll
    for (int i = 0; i < 64; ++i) wv[i] = W[(size_t)(k0 + i) * N + n0 + lane];
#pragma unroll
    for (int i = 0; i < 64; ++i) wv[i] *= gain ? gain[k0 + i] * scale : scale;
#pragma unroll
    for (int i = 0; i < 64; ++i) scr[i * 65 + lane] = wv[i];
    LDS_WAIT(); asm volatile("" ::: "memory");
    int orow0 = n0;
    if (swF) { const int isup = n0 >= swF ? 1 : 0; const int j = n0 - isup * swF; orow0 = (j >> 7) * 256 + isup * 128 + (j & 127); }
    const int c = lane & 7;
#pragma unroll
    for (int j = 0; j < 8; ++j) { const int n = (lane >> 3) + 8 * j; const LAS float* s = scr + (8 * c) * 65 + n;
        u32x2 o; o.x = pg8::pk4_fp8_w(s[0 * 65], s[1 * 65], s[2 * 65], s[3 * 65]); o.y = pg8::pk4_fp8_w(s[4 * 65], s[5 * 65], s[6 * 65], s[7 * 65]);
        *(GAS u32x2*)(WT + (size_t)(orow0 + n) * K + k0 + 8 * c) = o; }
    LDS_WAIT(); asm volatile("" ::: "memory");
}

typedef float f32x16 __attribute__((ext_vector_type(16)));
typedef float f32x2_t __attribute__((ext_vector_type(2))); typedef __bf16 bf16x2_t __attribute__((ext_vector_type(2)));
__device__ __forceinline__ unsigned cvtpk(float lo, float hi) { f32x2_t v = {lo, hi}; bf16x2_t b = __builtin_convertvector(v, bf16x2_t); return __builtin_bit_cast(unsigned, b); }
__device__ __forceinline__ bf16x8 mk8(unsigned a, unsigned b, unsigned c, unsigned d) { v4u t = {a, b, c, d}; return __builtin_bit_cast(bf16x8, t); }
__device__ __forceinline__ bf16x8 mk8u2(u32x2 lo, u32x2 hi) { v4u t = {lo.x, lo.y, hi.x, hi.y}; return __builtin_bit_cast(bf16x8, t); }
#define NEGINF (-__builtin_inff())
constexpr int BT_LD = 200, BT_OFF = 32;
__device__ __forceinline__ void dil_load_k(bf16x8 (&kf)[4], const bf16* pj, int sh, int b, int h, int r, int k0, int q, int hh) {
    const int sg = (q & ~12) | ((q & 4) << 1) | ((q & 8) >> 1);
    const int tk = b * SEQ + r + ((k0 + sg) << sh);
    const bf16* kp = pj + (size_t)tk * NPROJ + PC_K + h * 64 + 32 * hh;
#pragma unroll
    for (int ks = 0; ks < 4; ++ks) kf[ks] = *(const GAS bf16x8*)(kp + 8 * ks);
}
__device__ __forceinline__ void dil_load_v(bf16x8 (&vf)[2][2], const bf16* vrow, int sh, int k0) {
#pragma unroll
    for (int db = 0; db < 2; ++db)
#pragma unroll
        for (int s2 = 0; s2 < 2; ++s2) { const bf16* vp = vrow + (size_t)db * 32 * SEQ + (sh == 4 ? ((k0 >> 4) + s2) * 256 : k0 + 16 * s2); vf[db][s2] = *(const GAS bf16x8*)vp; }
}
__device__ __forceinline__ void dil_blk(const bf16x8 (&kf)[4], const bf16x8 (&vf)[2][2], const bf16x8 (&qf)[4], f32x16& O0, f32x16& O1, float& m, float& l, const LAS float* btl) {
    f32x16 st;
#pragma unroll
    for (int i = 0; i < 16; ++i) st[i] = 0.f;
#pragma unroll
    for (int ks = 0; ks < 4; ++ks) st = __builtin_amdgcn_mfma_f32_32x32x16_bf16(kf[ks], qf[ks], st, 0, 0, 0);
    float mx = NEGINF;
#pragma unroll
    for (int i = 0; i < 16; ++i) { st[i] = st[i] * 0.18033688011112042f + btl[23 - (16 * (i >> 3) + 4 * ((i >> 2) & 1) + (i & 3))]; mx = fmaxf(mx, st[i]); }
    { const auto rr = __builtin_amdgcn_permlane32_swap(__float_as_uint(mx), __float_as_uint(mx), false, false); mx = fmaxf(__uint_as_float(rr[0]), __uint_as_float(rr[1])); }
    const float mn = fmaxf(m, mx), ms = mn == NEGINF ? 0.f : mn, alpha = __builtin_amdgcn_exp2f(m - ms);
    float ls = 0.f;
#pragma unroll
    for (int i = 0; i < 16; ++i) { st[i] = __builtin_amdgcn_exp2f(st[i] - ms); ls += st[i]; }
    l = l * alpha + ls; m = mn;
#pragma unroll
    for (int i = 0; i < 16; ++i) { O0[i] *= alpha; O1[i] *= alpha; }
    const bf16x8 p0 = mk8(cvtpk(st[0], st[1]), cvtpk(st[2], st[3]), cvtpk(st[4], st[5]), cvtpk(st[6], st[7]));
    const bf16x8 p1 = mk8(cvtpk(st[8], st[9]), cvtpk(st[10], st[11]), cvtpk(st[12], st[13]), cvtpk(st[14], st[15]));
    O0 = __builtin_amdgcn_mfma_f32_32x32x16_bf16(vf[0][0], p0, O0, 0, 0, 0); O0 = __builtin_amdgcn_mfma_f32_32x32x16_bf16(vf[0][1], p1, O0, 0, 0, 0);
    O1 = __builtin_amdgcn_mfma_f32_32x32x16_bf16(vf[1][0], p0, O1, 0, 0, 0); O1 = __builtin_amdgcn_mfma_f32_32x32x16_bf16(vf[1][1], p1, O1, 0, 0, 0);
}
__device__ __forceinline__ void dil_store(const f32x16& O0, const f32x16& O1, float m, float l, bf16* opart, float* lsep, int tq, int h, int hh) {
    l = xsum32(l);
    const float inv = l > 0.f ? 1.0f / l : 0.f;
    bf16* op = opart + (size_t)tq * 512 + h * 64 + 4 * hh;
#pragma unroll
    for (int g4 = 0; g4 < 4; ++g4) {
        u32x2 w0, w1; w0.x = cvtpk(O0[4 * g4] * inv, O0[4 * g4 + 1] * inv); w0.y = cvtpk(O0[4 * g4 + 2] * inv, O0[4 * g4 + 3] * inv);
        w1.x = cvtpk(O1[4 * g4] * inv, O1[4 * g4 + 1] * inv); w1.y = cvtpk(O1[4 * g4 + 2] * inv, O1[4 * g4 + 3] * inv);
        *(GAS u32x2*)(op + 8 * g4) = w0; *(GAS u32x2*)(op + 32 + 8 * g4) = w1; }
    if (hh == 0) lsep[(size_t)tq * 8 + h] = l > 0.f ? (m + __builtin_amdgcn_logf(l)) * 0.6931471805599453f : NEGINF;
}
template <int JLO>
__device__ __forceinline__ void dil_unit32(const bf16* pj, const bf16* vt, bf16* opart, float* lsep, const LAS float* bt, int sh, int b, int h, int r, int n0, bool do_store) {
    constexpr int NT = JLO == 0 ? 5 : 4;
    int lane; asm volatile("v_mbcnt_lo_u32_b32 %0, -1, 0\n\tv_mbcnt_hi_u32_b32 %0, -1, %0" : "=v"(lane));
    const int q = lane & 31, hh = lane >> 5;
    const int L = SEQ >> sh;
    const int tq = b * SEQ + r + ((n0 + q) << sh);
    bf16x8 qf[4];
    { const bf16* qp = pj + (size_t)tq * NPROJ + PC_Q + h * 64 + 32 * hh;
#pragma unroll
      for (int ks = 0; ks < 4; ++ks) qf[ks] = *(const GAS bf16x8*)(qp + 8 * ks); }
    f32x16 O0, O1;
#pragma unroll
    for (int i = 0; i < 16; ++i) { O0[i] = 0.f; O1[i] = 0.f; }
    float m = NEGINF, l = 0.f;
    const bf16* vrow = vt + ((size_t)((b * 8 + h) * 64 + q) * SEQ) + (sh == 4 ? r * 16 : r * L) + 8 * hh;
    bf16x8 kf[2][4], vf[2][2][2];
    { const int k0 = n0 - 128 < 0 ? 0 : n0 - 128; dil_load_k(kf[0], pj, sh, b, h, r, k0, q, hh); dil_load_v(vf[0], vrow, sh, k0); }
#pragma unroll
    for (int t = 0; t < NT; ++t) {
        const int k0 = n0 - 128 + 32 * t;
        if (t + 1 < NT) { const int k1 = k0 + 32 < 0 ? 0 : k0 + 32; dil_load_k(kf[(t + 1) & 1], pj, sh, b, h, r, k1, q, hh); dil_load_v(vf[(t + 1) & 1], vrow, sh, k1); }
        const int jq = k0 < 0 ? 160 : q - 8 * hh + 128 - 32 * t;
        dil_blk(kf[t & 1], vf[t & 1], qf, O0, O1, m, l, bt + jq + BT_OFF - 23);
    }
    if (do_store) dil_store(O0, O1, m, l, opart, lsep, tq, h, hh);
}

constexpr int DK_PITCH = 144, DV_PITCH = 784, DK_BYTES = 384 * DK_PITCH, DV_BYTES = 64 * DV_PITCH;
__device__ __forceinline__ void dil_stage_load_k(v4u (&sk)[6], const bf16* pj, int sh, int b, int h, int r, int n0, int tid) {
    const int ws = n0 - 128;
#pragma unroll
    for (int k = 0; k < 6; ++k) { const int idx = tid + 512 * k, row = idx >> 3, ch = idx & 7; int kk = ws + row; kk = kk < 0 ? 0 : kk;
        sk[k] = *(const GAS v4u*)(pj + (size_t)(b * SEQ + r + (kk << sh)) * NPROJ + PC_K + h * 64 + ch * 8); }
}
__device__ __forceinline__ void dil_stage_load_v(v4u (&sv)[6], const bf16* pj, int sh, int b, int h, int r, int n0, int tid) {
    const int ws = n0 - 128;
#pragma unroll
    for (int k = 0; k < 6; ++k) { const int idx = tid + 512 * k, row = idx >> 3, ch = idx & 7; int kk = ws + row; kk = kk < 0 ? 0 : kk;
        sv[k] = *(const GAS v4u*)(pj + (size_t)(b * SEQ + r + (kk << sh)) * NPROJ + PC_V + h * 64 + ch * 8); }
}
__device__ __forceinline__ void dil_stage_write_k(LAS unsigned char* lds, const v4u (&sk)[6], int tid) {
#pragma unroll
    for (int k = 0; k < 6; ++k) { const int idx = tid + 512 * k, row = idx >> 3, ch = idx & 7; *(LAS v4u*)(lds + row * DK_PITCH + ch * 16) = sk[k]; }
}
__device__ __forceinline__ void dil_stage_write_v(LAS unsigned char* lds, const v4u (&sv)[6], int tid) {
#pragma unroll
    for (int k = 0; k < 6; ++k) { const int idx = tid + 512 * k, row = idx >> 3, ch = idx & 7;
        LAS unsigned short* d = (LAS unsigned short*)(lds + DK_BYTES + (8 * ch) * DV_PITCH + ((((row >> 3) ^ ch) << 3) | (row & 7)) * 2);
        d[0] = (unsigned short)(sv[k].x & 0xffffu); d[DV_PITCH / 2] = (unsigned short)(sv[k].x >> 16); d[2 * (DV_PITCH / 2)] = (unsigned short)(sv[k].y & 0xffffu); d[3 * (DV_PITCH / 2)] = (unsigned short)(sv[k].y >> 16);
        d[4 * (DV_PITCH / 2)] = (unsigned short)(sv[k].z & 0xffffu); d[5 * (DV_PITCH / 2)] = (unsigned short)(sv[k].z >> 16); d[6 * (DV_PITCH / 2)] = (unsigned short)(sv[k].w & 0xffffu); d[7 * (DV_PITCH / 2)] = (unsigned short)(sv[k].w >> 16); }
}
template <int JLO>
__device__ __forceinline__ void dil_wg_compute(const LAS unsigned char* lds, const bf16x8 (&qf)[4], bf16* opart, float* lsep, const LAS float* bt, int tq, int h, int k00, int lane, int wave, bool do_store) {
    constexpr int NT = JLO == 0 ? 5 : 4;
    asm volatile("" : "+v"(lane));
    const int q = lane & 31, hh = lane >> 5;
    f32x16 O0, O1;
#pragma unroll
    for (int i = 0; i < 16; ++i) { O0[i] = 0.f; O1[i] = 0.f; }
    float m = NEGINF, l = 0.f;
    const int sg = (q & ~12) | ((q & 4) << 1) | ((q & 8) >> 1);
    const LAS unsigned char* kl = lds + (32 * wave + sg) * DK_PITCH + 64 * hh;
    const LAS unsigned char* vl = lds + DK_BYTES + q * DV_PITCH;
    bf16x8 kf[2][4], vf[2][2][2];
#define DIL_LDFRAG(t_) do { _Pragma("unroll") for (int ks = 0; ks < 4; ++ks) kf[(t_) & 1][ks] = *(const LAS bf16x8*)(kl + (t_) * 32 * DK_PITCH + 16 * ks); \
        _Pragma("unroll") for (int db = 0; db < 2; ++db) _Pragma("unroll") for (int s2 = 0; s2 < 2; ++s2) \
            vf[(t_) & 1][db][s2] = *(const LAS bf16x8*)(vl + db * 32 * DV_PITCH + (((4 * wave + 4 * (t_) + 2 * s2 + hh) ^ (((32 * db + q) >> 3) & 7)) << 4)); } while (0)
    DIL_LDFRAG(0);
#pragma unroll
    for (int t = 0; t < NT; ++t) {
        if (t + 1 < NT) DIL_LDFRAG(t + 1);
        const int jq = k00 + 32 * t < 0 ? 160 : q - 8 * hh + 128 - 32 * t;
        dil_blk(kf[t & 1], vf[t & 1], qf, O0, O1, m, l, bt + jq + BT_OFF - 23);
        __builtin_amdgcn_sched_barrier(0);
    }
#undef DIL_LDFRAG
    if (do_store) dil_store(O0, O1, m, l, opart, lsep, tq, h, hh);
}

__device__ __forceinline__ void xat_unit(const bf16* qxp, const bf16* kb, const bf16* vtb, bf16* oxp, int t0, int h, int lane) {
    const int q = lane & 31, hh = lane >> 5;
    bf16x8 qf[8];
    { const bf16* qp = qxp + (size_t)(t0 + q) * XW + h * 128 + 64 * hh;
#pragma unroll
      for (int ks = 0; ks < 8; ++ks) qf[ks] = *(const GAS bf16x8*)(qp + 8 * ks); }
    f32x16 O[4];
#pragma unroll
    for (int d = 0; d < 4; ++d)
#pragma unroll
        for (int i = 0; i < 16; ++i) O[d][i] = 0.f;
    float m = NEGINF, l = 0.f;
    const bf16* vrow = vtb + (size_t)(h * 128 + q) * MEML + 4 * hh;
    for (int k0 = 0; k0 < MEML; k0 += 32) {
        const bf16* kp = kb + (size_t)(k0 + q) * 4096 + h * 128 + 64 * hh;
        f32x16 st;
#pragma unroll
        for (int i = 0; i < 16; ++i) st[i] = 0.f;
#pragma unroll
        for (int ks = 0; ks < 8; ++ks) st = __builtin_amdgcn_mfma_f32_32x32x16_bf16(*(const GAS bf16x8*)(kp + 8 * ks), qf[ks], st, 0, 0, 0);
        bf16x8 vf[4][2];
#pragma unroll
        for (int db = 0; db < 4; ++db)
#pragma unroll
            for (int s2 = 0; s2 < 2; ++s2) { const bf16* vp = vrow + (size_t)db * 32 * MEML + k0 + 16 * s2; vf[db][s2] = mk8u2(*(const GAS u32x2*)vp, *(const GAS u32x2*)(vp + 8)); }
        float mx = st[0];
#pragma unroll
        for (int i = 1; i < 16; ++i) mx = fmaxf(mx, st[i]);
        mx = xmax32(mx);
        const float mn = fmaxf(m, mx), alpha = __expf(m - mn);
        float ls = 0.f;
#pragma unroll
        for (int i = 0; i < 16; ++i) { st[i] = __expf(st[i] - mn); ls += st[i]; }
        l = l * alpha + ls; m = mn;
#pragma unroll
        for (int d = 0; d < 4; ++d)
#pragma unroll
            for (int i = 0; i < 16; ++i) O[d][i] *= alpha;
        const bf16x8 p0 = mk8(cvtpk(st[0], st[1]), cvtpk(st[2], st[3]), cvtpk(st[4], st[5]), cvtpk(st[6], st[7]));
        const bf16x8 p1 = mk8(cvtpk(st[8], st[9]), cvtpk(st[10], st[11]), cvtpk(st[12], st[13]), cvtpk(st[14], st[15]));
#pragma unroll
        for (int d = 0; d < 4; ++d) { O[d] = __builtin_amdgcn_mfma_f32_32x32x16_bf16(vf[d][0], p0, O[d], 0, 0, 0); O[d] = __builtin_amdgcn_mfma_f32_32x32x16_bf16(vf[d][1], p1, O[d], 0, 0, 0); }
    }
    l = xsum32(l);
    const float inv = 1.0f / l;
    bf16* op = oxp + (size_t)(t0 + q) * XW + h * 128 + 4 * hh;
#pragma unroll
    for (int d = 0; d < 4; ++d)
#pragma unroll
        for (int g4 = 0; g4 < 4; ++g4) { u32x2 w; w.x = cvtpk(O[d][4 * g4] * inv, O[d][4 * g4 + 1] * inv); w.y = cvtpk(O[d][4 * g4 + 2] * inv, O[d][4 * g4 + 3] * inv); *(GAS u32x2*)(op + 32 * d + 8 * g4) = w; }
}

constexpr int XK_PITCH = 272, XV_PITCH = 528, XK_BYTES = 256 * XK_PITCH, XV_BYTES = 128 * XV_PITCH;
__device__ __forceinline__ void xat_wg_unit(LAS unsigned char* lds, const bf16* qxp, const bf16* kb, const bf16* vtb, bf16* oxp, int t0, int h, int tid) {
    const int lane = tid & 63, q = lane & 31, hh = lane >> 5;
    __syncthreads();
#pragma unroll
    for (int k = 0; k < 8; ++k) { const int idx = tid + 512 * k, row = idx >> 4, ch = idx & 15;
        const v4u x = *(const GAS v4u*)(kb + (size_t)row * 4096 + h * 128 + ch * 8); *(LAS v4u*)(lds + row * XK_PITCH + ch * 16) = x; }
#pragma unroll
    for (int k = 0; k < 8; ++k) { const int idx = tid + 512 * k, row = idx >> 5, ch = idx & 31;
        const v4u x = *(const GAS v4u*)(vtb + (size_t)(h * 128 + row) * MEML + ch * 8); *(LAS v4u*)(lds + XK_BYTES + row * XV_PITCH + ch * 16) = x; }
    bf16x8 qf[8];
    { const bf16* qp = qxp + (size_t)(t0 + q) * XW + h * 128 + 64 * hh;
#pragma unroll
      for (int ks = 0; ks < 8; ++ks) qf[ks] = *(const GAS bf16x8*)(qp + 8 * ks); }
    __syncthreads();
    f32x16 O[4];
#pragma unroll
    for (int d = 0; d < 4; ++d)
#pragma unroll
        for (int i = 0; i < 16; ++i) O[d][i] = 0.f;
    float m = NEGINF, l = 0.f;
    const int sg = (q & ~12) | ((q & 4) << 1) | ((q & 8) >> 1);
    const LAS unsigned char* kl = lds + sg * XK_PITCH + 128 * hh;
    const LAS unsigned char* vl = lds + XK_BYTES + q * XV_PITCH + 16 * hh;
#pragma unroll
    for (int kt = 0; kt < 8; ++kt) {
        f32x16 st;
#pragma unroll
        for (int i = 0; i < 16; ++i) st[i] = 0.f;
#pragma unroll
        for (int ks = 0; ks < 8; ++ks) st = __builtin_amdgcn_mfma_f32_32x32x16_bf16(*(const LAS bf16x8*)(kl + kt * 32 * XK_PITCH + ks * 16), qf[ks], st, 0, 0, 0);
        float mx = st[0];
#pragma unroll
        for (int i = 1; i < 16; ++i) mx = fmaxf(mx, st[i]);
        mx = xmax32(mx);
        const float mn = fmaxf(m, mx), alpha = __builtin_amdgcn_exp2f((m - mn) * 1.4426950408889634f);
        float ls = 0.f;
#pragma unroll
        for (int i = 0; i < 16; ++i) { st[i] = __builtin_amdgcn_exp2f((st[i] - mn) * 1.4426950408889634f); ls += st[i]; }
        l = l * alpha + ls; m = mn;
#pragma unroll
        for (int d = 0; d < 4; ++d)
#pragma unroll
            for (int i = 0; i < 16; ++i) O[d][i] *= alpha;
        const bf16x8 p0 = mk8(cvtpk(st[0], st[1]), cvtpk(st[2], st[3]), cvtpk(st[4], st[5]), cvtpk(st[6], st[7]));
        const bf16x8 p1 = mk8(cvtpk(st[8], st[9]), cvtpk(st[10], st[11]), cvtpk(st[12], st[13]), cvtpk(st[14], st[15]));
#pragma unroll
        for (int d = 0; d < 4; ++d) { const LAS unsigned char* vp = vl + d * 32 * XV_PITCH + kt * 64;
            O[d] = __builtin_amdgcn_mfma_f32_32x32x16_bf16(*(const LAS bf16x8*)vp, p0, O[d], 0, 0, 0); O[d] = __builtin_amdgcn_mfma_f32_32x32x16_bf16(*(const LAS bf16x8*)(vp + 32), p1, O[d], 0, 0, 0); }
    }
    l = xsum32(l);
    const float inv = 1.0f / l;
    bf16* op = oxp + (size_t)(t0 + q) * XW + h * 128 + 4 * hh;
#pragma unroll
    for (int d = 0; d < 4; ++d)
#pragma unroll
        for (int g4 = 0; g4 < 4; ++g4) { u32x2 w; w.x = cvtpk(O[d][4 * g4] * inv, O[d][4 * g4 + 1] * inv); w.y = cvtpk(O[d][4 * g4 + 2] * inv, O[d][4 * g4 + 3] * inv); *(GAS u32x2*)(op + 32 * d + 8 * g4) = w; }
}

__device__ __forceinline__ void pool_unit(const bf16* pj, const bf16* pwT, const float* psc, bf16* ymixp, int t0, int lane, LAS unsigned char* scr) {
    constexpr int PITCH = 144;
    const int q = lane & 31, hh = lane >> 5; const int t = t0 + q, pos = t & (SEQ - 1), pos0 = t0 & (SEQ - 1);
    const int sr = lane >> 3, sc = lane & 7;
    v4u st[6];
#define POOL_LD(g_) do { _Pragma("unroll") for (int k = 0; k < 6; ++k) { const int r = 8 * k + sr, w_ = 2 << (g_); const bool ok = pos0 - (w_ - 1) + r >= 0 && r < 31 + w_; \
        st[k] = *(const GAS v4u*)(pj + (size_t)(ok ? t0 - (w_ - 1) + r : t0) * NPROJ + PC_POOL + (g_) * 64 + 8 * sc); if (!ok) st[k] = (v4u){0u, 0u, 0u, 0u}; } } while (0)
    POOL_LD(0);
#pragma unroll
    for (int g = 0; g < 4; ++g) {
        const int w = 2 << g; const float rn = 1.0f / (float)(pos + 1 < w ? pos + 1 : w);
#pragma unroll
        for (int k = 0; k < 6; ++k) *(LAS v4u*)(scr + (8 * k + sr) * PITCH + 16 * sc) = st[k];
        if (g < 3) POOL_LD(g + 1);
        f32x16 D0, D1;
#pragma unroll
        for (int i = 0; i < 16; ++i) { D0[i] = 0.f; D1[i] = 0.f; }
#pragma unroll
        for (int ks = 0; ks < 4; ++ks) {
            const LAS unsigned char* p0 = scr + (q + w - 1) * PITCH + 16 * (2 * ks + hh);
            const v4u x0 = *(const LAS v4u*)p0;
            float a0 = bflo(x0.x), a1 = bfhi(x0.x), a2 = bflo(x0.y), a3 = bfhi(x0.y), a4 = bflo(x0.z), a5 = bfhi(x0.z), a6 = bflo(x0.w), a7 = bfhi(x0.w);
#pragma unroll
            for (int i = 1; i < w; ++i) { const v4u xi = *(const LAS v4u*)(p0 - i * PITCH);
                a0 += bflo(xi.x); a1 += bfhi(xi.x); a2 += bflo(xi.y); a3 += bfhi(xi.y); a4 += bflo(xi.z); a5 += bfhi(xi.z); a6 += bflo(xi.w); a7 += bfhi(xi.w); }
            const bf16x8 bfr = mk8(cvtpk(a0 * rn - bflo(x0.x), a1 * rn - bfhi(x0.x)), cvtpk(a2 * rn - bflo(x0.y), a3 * rn - bfhi(x0.y)), cvtpk(a4 * rn - bflo(x0.z), a5 * rn - bfhi(x0.z)), cvtpk(a6 * rn - bflo(x0.w), a7 * rn - bfhi(x0.w)));
            const bf16* wp = pwT + (size_t)(g * 64 + q) * 64 + 16 * ks + 8 * hh;
            D0 = __builtin_amdgcn_mfma_f32_32x32x16_bf16(*(const GAS bf16x8*)wp, bfr, D0, 0, 0, 0);
            D1 = __builtin_amdgcn_mfma_f32_32x32x16_bf16(*(const GAS bf16x8*)(wp + 32 * 64), bfr, D1, 0, 0, 0);
        }
        bf16* op = ymixp + (size_t)t * D + 512 + g * 64 + 4 * hh; const float* sp = psc + g * 64 + 4 * hh;
#pragma unroll
        for (int k = 0; k < 4; ++k) { const f32x4 s0 = *(const GAS f32x4*)(sp + 8 * k), s1 = *(const GAS f32x4*)(sp + 32 + 8 * k);
            u32x2 w0, w1; w0.x = cvtpk(D0[4 * k] * s0[0], D0[4 * k + 1] * s0[1]); w0.y = cvtpk(D0[4 * k + 2] * s0[2], D0[4 * k + 3] * s0[3]);
            w1.x = cvtpk(D1[4 * k] * s1[0], D1[4 * k + 1] * s1[1]); w1.y = cvtpk(D1[4 * k + 2] * s1[2], D1[4 * k + 3] * s1[3]);
            *(GAS u32x2*)(op + 8 * k) = w0; *(GAS u32x2*)(op + 32 + 8 * k) = w1; }
    }
#undef POOL_LD
}
__device__ __forceinline__ void mergeconv_unit(const bf16* pj, const bf16* opartp, const float* lsepp, const float* cw, bf16* ymixp, int t0, int lane) {
    const int c4 = 4 * lane, h = lane >> 3;
    const f32x4 w0 = *(const GAS f32x4*)(cw + c4), w1 = *(const GAS f32x4*)(cw + 256 + c4), w2 = *(const GAS f32x4*)(cw + 512 + c4);
    f32x4 u1 = {0.f, 0.f, 0.f, 0.f}, u2 = {0.f, 0.f, 0.f, 0.f};
    const int pos0 = t0 & (SEQ - 1);
    if (pos0 >= 2) {
        const bf16* r1 = pj + (size_t)(t0 - 1) * NPROJ; const bf16* r2 = r1 - NPROJ;
        const u32x2 c1 = *(const GAS u32x2*)(r1 + PC_CG + c4), h1 = *(const GAS u32x2*)(r1 + PC_HC + c4), c2 = *(const GAS u32x2*)(r2 + PC_CG + c4), h2 = *(const GAS u32x2*)(r2 + PC_HC + c4);
        u1 = (f32x4){bflo(c1.x) * bflo(h1.x), bfhi(c1.x) * bfhi(h1.x), bflo(c1.y) * bflo(h1.y), bfhi(c1.y) * bfhi(h1.y)};
        u2 = (f32x4){bflo(c2.x) * bflo(h2.x), bfhi(c2.x) * bfhi(h2.x), bflo(c2.y) * bflo(h2.y), bfhi(c2.y) * bfhi(h2.y)};
    }
    constexpr int NB = 8;
    for (int j0 = 0; j0 < 32; j0 += NB) {
        u32x2 cg[NB], hc[NB], bg[NB]; float l0[NB], l1[NB], l2[NB]; v4u pa[NB], pb[NB], pc[NB];
#pragma unroll
        for (int j = 0; j < NB; ++j) { const int t = t0 + j0 + j; const bf16* row = pj + (size_t)t * NPROJ;
            cg[j] = *(const GAS u32x2*)(row + PC_CG + c4); hc[j] = *(const GAS u32x2*)(row + PC_HC + c4); bg[j] = *(const GAS u32x2*)(row + PC_BG + c4);
            l0[j] = lsepp[(size_t)t * 8 + h]; l1[j] = lsepp[(size_t)T * 8 + (size_t)t * 8 + h]; l2[j] = lsepp[(size_t)2 * T * 8 + (size_t)t * 8 + h];
            pa[j] = *(const GAS v4u*)(opartp + (size_t)t * 512 + 8 * lane); pb[j] = *(const GAS v4u*)(opartp + OP_STRIDE + (size_t)t * 512 + 8 * lane); pc[j] = *(const GAS v4u*)(opartp + 2 * OP_STRIDE + (size_t)t * 512 + 8 * lane); }
        asm volatile("" ::: "memory");
#pragma unroll
        for (int j = 0; j < NB; ++j) { const int t = t0 + j0 + j;
            const f32x4 u0 = {bflo(cg[j].x) * bflo(hc[j].x), bfhi(cg[j].x) * bfhi(hc[j].x), bflo(cg[j].y) * bflo(hc[j].y), bfhi(cg[j].y) * bfhi(hc[j].y)};
            const f32x4 y = (f32x4){bflo(bg[j].x), bfhi(bg[j].x), bflo(bg[j].y), bfhi(bg[j].y)} * (w0 * u0 + w1 * u1 + w2 * u2);
            u32x2 yo; yo.x = cvtpk(y[0], y[1]); yo.y = cvtpk(y[2], y[3]);
            *(GAS u32x2*)(ymixp + (size_t)t * D + 768 + c4) = yo;
            u2 = u1; u1 = u0;
            const float M = fmaxf(l0[j], fmaxf(l1[j], l2[j])); float e0 = __expf(l0[j] - M), e1 = __expf(l1[j] - M), e2 = __expf(l2[j] - M); const float inv = 1.0f / (e0 + e1 + e2); e0 *= inv; e1 *= inv; e2 *= inv;
            const v4u a = pa[j], bq = pb[j], c = pc[j];
            v4u o; o.x = cvtpk(e0 * bflo(a.x) + e1 * bflo(bq.x) + e2 * bflo(c.x), e0 * bfhi(a.x) + e1 * bfhi(bq.x) + e2 * bfhi(c.x));
            o.y = cvtpk(e0 * bflo(a.y) + e1 * bflo(bq.y) + e2 * bflo(c.y), e0 * bfhi(a.y) + e1 * bfhi(bq.y) + e2 * bfhi(c.y));
            o.z = cvtpk(e0 * bflo(a.z) + e1 * bflo(bq.z) + e2 * bflo(c.z), e0 * bfhi(a.z) + e1 * bfhi(bq.z) + e2 * bfhi(c.z));
            o.w = cvtpk(e0 * bflo(a.w) + e1 * bflo(bq.w) + e2 * bflo(c.w), e0 * bfhi(a.w) + e1 * bfhi(bq.w) + e2 * bfhi(c.w));
            *(GAS v4u*)(ymixp + (size_t)t * D + 8 * lane) = o; }
    }
}

__device__ __forceinline__ void vt_transpose_tile(LAS unsigned char* lds, const bf16* pj, bf16* vt, int pm, int vh, int tid) {
    constexpr int PW = 65;
    LAS unsigned* img = (LAS unsigned*)lds;
    const int row0 = pm * 256, b = row0 >> 13, tt = row0 & 8191;
    for (int hf = 0; hf < 2; ++hf) {
        __syncthreads();
        { const int r = tid >> 1, hc = tid & 1;
            const bf16* src = pj + (size_t)(row0 + r) * NPROJ + PC_V + vh * 256 + hf * 128 + hc * 64;
#pragma unroll
            for (int k = 0; k < 8; ++k) { const v4u x = *(const GAS v4u*)(src + 8 * k); LAS unsigned* d = img + r * PW + hc * 32 + 4 * k; d[0] = x.x; d[1] = x.y; d[2] = x.z; d[3] = x.w; } }
        __syncthreads();
        const LAS unsigned short* im16 = (const LAS unsigned short*)lds;
        bf16* vcol = vt + (size_t)(b * 512 + vh * 256 + hf * 128) * SEQ;
#pragma unroll 2
        for (int k = 0; k < 8; ++k) { const int id = tid + 512 * k, d = id >> 5, c = id & 31;
            {
#define RD16(j) ((unsigned)im16[(8 * c + (j)) * (2 * PW) + d])
              v4u o; o.x = RD16(0) | (RD16(1) << 16); o.y = RD16(2) | (RD16(3) << 16); o.z = RD16(4) | (RD16(5) << 16); o.w = RD16(6) | (RD16(7) << 16);
#undef RD16
              *(GAS v4u*)(vcol + (size_t)d * SEQ + tt + 8 * c) = o; }
            { const int r = c >> 3, n0 = 8 * (c & 7);
#define RD16(j) ((unsigned)im16[(4 * (n0 + (j)) + r) * (2 * PW) + d])
              v4u o; o.x = RD16(0) | (RD16(1) << 16); o.y = RD16(2) | (RD16(3) << 16); o.z = RD16(4) | (RD16(5) << 16); o.w = RD16(6) | (RD16(7) << 16);
#undef RD16
              *(GAS v4u*)(vcol + VT_STRIDE + (size_t)d * SEQ + r * 2048 + (tt >> 2) + n0) = o; }
            { const int r = c >> 1, n0 = 8 * (c & 1);
#define RD16(j) ((unsigned)im16[(16 * (n0 + (j)) + r) * (2 * PW) + d])
              v4u o; o.x = RD16(0) | (RD16(1) << 16); o.y = RD16(2) | (RD16(3) << 16); o.z = RD16(4) | (RD16(5) << 16); o.w = RD16(6) | (RD16(7) << 16);
#undef RD16
              *(GAS v4u*)(vcol + 2 * VT_STRIDE + (size_t)d * SEQ + (tt >> 8) * 256 + r * 16 + n0) = o; }
        }
    }
    __syncthreads();
}

#define x_in (args.in[0])
#define mem_in (args.in[1])
#define rel_bias (args.in[2])
#define mem_g (args.in[3])
#define mix_g (args.in[4])
#define w_in (args.in[5])
#define conv_w (args.in[6])
#define pool_w (args.in[7])
#define pool_scale (args.in[8])
#define w_out (args.in[9])
#define xat_g (args.in[10])
#define wq_x (args.in[11])
#define wkv_x (args.in[12])
#define wo_x (args.in[13])
#define ffn_g (args.in[14])
#define w13_d (args.in[15])
#define w2_d (args.in[16])
#define router_w (args.in[17])
#define w13_m (args.in[18])
#define w2_m (args.in[19])
#define fin_g (args.in[20])
#define out (args.out)
#define Win_t ((bf16*)(ws + WS_WIN))
#define Wout_t ((bf16*)(ws + WS_WOUT))
#define Wq_t ((bf16*)(ws + WS_WQ))
#define Wkv_t ((bf16*)(ws + WS_WKV))
#define Wo_t ((bf16*)(ws + WS_WO))
#define W13d_t ((bf16*)(ws + WS_W13D))
#define W2d_t ((bf16*)(ws + WS_W2D))
#define W13m_t ((bf16*)(ws + WS_W13M))
#define W2m_t ((bf16*)(ws + WS_W2M))
#define xb ((bf16*)(ws + WS_XB))
#define qx ((bf16*)(ws + WS_QX))
#define ox ((bf16*)(ws + WS_OX))
#define Ag ((bf16*)(ws + WS_AG))
#define ym ((bf16*)(ws + WS_YM))
#define ypart ((bf16*)(ws + WS_YM + 136 * MiB))
#define proj ((bf16*)(ws + WS_PROJ))
#define ymix ((bf16*)(ws + WS_Y))
#define hbuf ((bf16*)(ws + WS_H))
#define kvx ((bf16*)(ws + WS_KVX))
#define memn ((bf16*)(ws + WS_MEMN))
#define vtb ((bf16*)(ws + WS_VT))
#define opart ((bf16*)(ws + WS_OPART))
#define lsep ((float*)(ws + WS_LSE))
#define vtx ((bf16*)(ws + WS_VTX))
#define ssp ((float*)(ws + WS_SSP))
#define cnts ((int*)(ws + WS_CNT))
#define meta ((int*)(ws + WS_META))
#define tok_e ((int*)(ws + WS_TOKE))
#define tok_g ((float*)(ws + WS_TOKG))
#define tok_pos ((int*)(ws + WS_TOKPOS))
#define row_gate ((float*)(ws + WS_ROWGATE))
#define row_rs ((float*)(ws + WS_ROWRS))
#ifndef PROBE
#define PROBE 0
#endif
#ifndef N_LAUNCH_MODE
#define N_LAUNCH_MODE 0
#endif

__device__ __forceinline__ void pair_barrier(unsigned* cnt, unsigned target, bool same_xcc, unsigned* tmo, int wave0) {
    asm volatile("s_waitcnt vmcnt(0)" ::: "memory");
    __syncthreads();
    int ln; asm volatile("v_mbcnt_lo_u32_b32 %0, -1, 0\n\tv_mbcnt_hi_u32_b32 %0, -1, %0" : "=v"(ln));
    if (wave0 == 0 && ln == 0) {
        if (!same_xcc) { __builtin_amdgcn_fence(__ATOMIC_RELEASE, "agent"); asm volatile("s_waitcnt vmcnt(0)" ::: "memory"); }
        (void)xb_add(cnt, 1u);
        unsigned sp = 0u;
        while (xb_ld(cnt) < target) { __builtin_amdgcn_s_sleep(1); if ((++sp & 255u) == 0u) { if (xb_ld(tmo)) break; if (sp > XB_SPIN_CAP) { atomicAdd(tmo, 1u); break; } } }
        __builtin_amdgcn_fence(__ATOMIC_ACQUIRE, "agent");
        asm volatile("s_waitcnt vmcnt(0)" ::: "memory");
    }
    __syncthreads();
}
__global__ void __launch_bounds__(NWAVES * 64, 2) trunk_fwd(Args args) {
    extern __shared__ __attribute__((aligned(16))) unsigned char lds_raw[];
    LAS unsigned char* lds = (LAS unsigned char*)lds_raw;
    volatile LAS unsigned* MISC = (volatile LAS unsigned*)(lds + MISC_OFF);
    const int tid0 = threadIdx.x;
    const int G0 = gridDim.x, blk0 = blockIdx.x, wave0 = __builtin_amdgcn_readfirstlane(tid0 >> 6);
    unsigned char* ws0 = args.ws;
    gu32* ctl = (gu32*)(ws0 + WS_CTL);
#define PH_VARS int lane_; asm volatile("v_mbcnt_lo_u32_b32 %0, -1, 0\n\tv_mbcnt_hi_u32_b32 %0, -1, %0" : "=v"(lane_)); int wv_ = wave0; asm volatile("" : "+s"(wv_)); int blk = blk0; asm volatile("" : "+s"(blk)); int G = G0; asm volatile("" : "+s"(G)); \
    unsigned char* ws = ws0; asm volatile("" : "+s"(ws)); const int lane = lane_, wave = wv_, tid = wv_ * 64 + lane_; const int gw = blk * NWAVES + wave, NGW = G * NWAVES; (void)lane; (void)gw; (void)NGW; (void)ws; (void)tid
    for (int u = tid0; u < (LDS_BYTES - LDSCTL_OFF) / 4; u += NWAVES * 64) ((LAS unsigned*)(lds + LDSCTL_OFF))[u] = 0u;
    __syncthreads();
    XcdBarrier bar = xcd_barrier_post((unsigned*)(ctl + CW_BAR), MISC + 8);
    bar.x = __builtin_amdgcn_readfirstlane(bar.x);
    if (tid0 == 0) __hip_atomic_store((unsigned*)(ws0 + WS_XCCTAB) + blk0, bar.x, __ATOMIC_RELAXED, __HIP_MEMORY_SCOPE_AGENT);
    const int tpm0 = (blk0 & 7) + 8 * (blk0 >> 4), tmb0 = (blk0 >> 3) & 1;
    unsigned pepoch = 0u; bool same_xcc = false;
#define PAIR_BAR do { pepoch += 2u; unsigned* tc_ = (unsigned*)(ctl + CW_TEAM) + 64 * tpm0; asm volatile("" : "+s"(tc_)); pair_barrier(tc_, pepoch, same_xcc, (unsigned*)(ctl + CW_BAR) + XB_TMO, wave0); } while (0)
#if N_LAUNCH_MODE == 0
#define PH_ON true
#define PH_END do { for (int br_ = 0; br_ < ((PROBE & 1024) ? 3 : 1); ++br_) { XcdBarrier b_ = bar; asm volatile("" : "+s"(b_.x)); asm volatile("" : "+s"(b_.bar)); xcd_barrier(b_); } } while (0)
#else
    const int lo = args.ph_lo, hi = args.ph_hi;
    int ph = 0;
#define PH_ON (ph >= lo && ph < hi)
#define PH_END do { if (ph >= lo && ph + 1 < hi) { XcdBarrier b_ = bar; asm volatile("" : "+s"(b_.x)); asm volatile("" : "+s"(b_.bar)); xcd_barrier(b_); } ++ph; } while (0)
#endif

    constexpr size_t SSP_STRIDE = (size_t)T * 16;

    if (PH_ON) { PH_VARS;
        LAS float* scr = (LAS float*)(lds + wave * 16896);
        constexpr int I_IN = 16 * 40, I_OUT = 16 * 16, I_Q = 16 * 8, I_KV = 16 * 16, I_O = 8 * 16, I_13D = 16 * 88, I_2D = 44 * 16, I_13M = 16 * 112, I_2M = 56 * 16;
        constexpr int C0 = 4 * I_IN, C1 = C0 + 4 * I_OUT, C2 = C1 + 4 * I_Q, C3 = C2 + 4 * I_KV, C4 = C3 + 4 * I_O, C5 = C4 + 2 * I_13D, C6 = C5 + 2 * I_2D, C7 = C6 + 16 * I_13M, C8 = C7 + 16 * I_2M;
        for (int rep = 0; rep < ((PROBE & 16) ? 2 : 1); ++rep)
        for (int it = gw; it < C8; it += NGW) {
            if (it < C0) { const int m = it / I_IN, r = it % I_IN; if (m < 2) conv_item(w_in + (size_t)m * D * NPROJ, D, NPROJ, Win_t + (size_t)m * NPROJ * D, mix_g + m * D, 0, scr, r, lane);
                else conv_item8(w_in + (size_t)m * D * NPROJ, D, NPROJ, (unsigned char*)(Win_t + (size_t)m * NPROJ * D), mix_g + m * D, 0, F8_S1, scr, r, lane); }
            else if (it < C1) { const int q = it - C0, m = q / I_OUT, r = q % I_OUT; conv_item(w_out + (size_t)m * D * D, D, D, Wout_t + (size_t)m * D * D, nullptr, 0, scr, r, lane); }
            else if (it < C2) { const int q = it - C1, m = q / I_Q, r = q % I_Q; conv_item(wq_x + (size_t)m * D * XW, D, XW, Wq_t + (size_t)m * XW * D, xat_g + m * D, 0, scr, r, lane); }
            else if (it < C3) { const int q = it - C2, m = q / I_KV, r = q % I_KV; conv_item(wkv_x + (size_t)m * D * 1024, D, 1024, Wkv_t + (size_t)m * 1024 * D, nullptr, 0, scr, r, lane); }
            else if (it < C4) { const int q = it - C3, m = q / I_O, r = q % I_O; conv_item(wo_x + (size_t)m * XW * D, XW, D, Wo_t + (size_t)m * D * XW, nullptr, 0, scr, r, lane); }
            else if (it < C5) { const int q = it - C4, m = q / I_13D, r = q % I_13D; if (m == 0) conv_item(w13_d, D, 2 * FFD, W13d_t, ffn_g, FFD, scr, r, lane); else conv_item8(w13_d + (size_t)D * 2 * FFD, D, 2 * FFD, (unsigned char*)(W13d_t + (size_t)2 * FFD * D), ffn_g + 2 * D, FFD, F8_S1, scr, r, lane); }
            else if (it < C6) { const int q = it - C5, m = q / I_2D, r = q % I_2D; if (m == 0) conv_item(w2_d, FFD, D, W2d_t, nullptr, 0, scr, r, lane); else conv_item8(w2_d + (size_t)FFD * D, FFD, D, (unsigned char*)(W2d_t + (size_t)D * FFD), nullptr, 0, F8_S2, scr, r, lane); }
            else if (it < C7) { const int q = it - C6, m = q / I_13M, r = q % I_13M; conv_item8(w13_m + (size_t)m * D * 2 * FFE, D, 2 * FFE, (unsigned char*)W13m_t + (size_t)m * 2 * FFE * D, ffn_g + (2 * (m >> 3) + 1) * D, FFE, F8_S1, scr, r, lane); }
            else { const int q = it - C7, m = q / I_2M, r = q % I_2M; conv_item8(w2_m + (size_t)m * FFE * D, FFE, D, (unsigned char*)W2m_t + (size_t)m * D * FFE, nullptr, 0, F8_S2, scr, r, lane); }
        }
        for (int idx = gw * 64 + lane; idx < DEPTH * 4 * 64 * 64; idx += NGW * 64) { const int c = idx & 63, dp = (idx >> 6) & 63, lg = idx >> 12;
            ((bf16*)(ws + WS_PWT))[idx] = (bf16)f2bf(pool_w[(size_t)(lg * 64 + c) * 64 + dp]); }
        for (int m = gw; m < T; m += NGW) {
            const GAS f32x4* xr = (const GAS f32x4*)(x_in + (size_t)m * D) + lane; f32x4 v[4]; float s = 0.f;
#pragma unroll
            for (int j = 0; j < 4; ++j) { v[j] = xr[64 * j]; s += (v[j].x * v[j].x + v[j].y * v[j].y) + (v[j].z * v[j].z + v[j].w * v[j].w); }
            s = wave_sum(s, lane);
            GAS unsigned long long* o8 = (GAS unsigned long long*)(xb + (size_t)m * D) + lane;
#pragma unroll
            for (int j = 0; j < 4; ++j) o8[64 * j] = (unsigned long long)pk2(v[j].x, v[j].y) | ((unsigned long long)pk2(v[j].z, v[j].w) << 32);
            if (lane < 16) ssp[(size_t)m * 16 + lane] = lane == 0 ? s : 0.f;
        }
        for (int m = gw; m < MROWS; m += NGW) {
            const GAS f32x4* xr = (const GAS f32x4*)(mem_in + (size_t)m * D) + lane; const GAS f32x4* gr = (const GAS f32x4*)mem_g + lane; f32x4 v[4]; float s = 0.f;
#pragma unroll
            for (int j = 0; j < 4; ++j) { v[j] = xr[64 * j]; s += (v[j].x * v[j].x + v[j].y * v[j].y) + (v[j].z * v[j].z + v[j].w * v[j].w); }
            const float r = 1.0f / sqrtf(wave_sum(s, lane) * (1.0f / D) + 1e-6f);
            GAS unsigned long long* o8 = (GAS unsigned long long*)(memn + (size_t)m * D) + lane;
#pragma unroll
            for (int j = 0; j < 4; ++j) { const f32x4 g = gr[64 * j]; o8[64 * j] = (unsigned long long)pk2(v[j].x * r * g.x, v[j].y * r * g.y) | ((unsigned long long)pk2(v[j].z * r * g.z, v[j].w * r * g.w) << 32); }
        }
    }
    PH_END;
    same_xcc = (unsigned)__builtin_amdgcn_readfirstlane((int)xb_ld((unsigned*)(ws0 + WS_XCCTAB) + (blk0 ^ 8))) == bar.x;

    for (int l = 0; l < DEPTH; ++l) {
#define ssp_a (ssp + (size_t)(3 * l) * SSP_STRIDE)
#define ssp_b (ssp + (size_t)(3 * l + 1) * SSP_STRIDE)
#define ssp_c (ssp + (size_t)(3 * l + 2) * SSP_STRIDE)
#define ssp_d (ssp + (size_t)(3 * l + 3) * SSP_STRIDE)
        if (PH_ON) { PH_VARS;
            if (l == 0) {
                pg8::Gemm g{memn, Wkv_t, MROWS, 4096, D}; pg8::StaticOrder S; S.init(MROWS, 4096, G, blk);
                pg8::EpiKV E{kvx, vtx};
                pg8::gemm_phase<pg8::EpiKV, pg8::StaticOrder, true, true>(lds, g, S, E, tid);
#if PROBE & (1 | 64)
                pg8::gemm_phase<pg8::EpiKV, pg8::StaticOrder, true, true>(lds, g, S, E, tid);
#endif
            }
        }
        if (PH_ON) {
            if (l >= 2) { PH_VARS;
                pg8::Gemm g{Ag, Win_t + (size_t)l * NPROJ * D, T, NPROJ, D / 2}; pg8::StaticOrder S; S.init(T, NPROJ, G, blk);
                pg8::EpiRowScale E{proj, NPROJ, ssp_a, 1.0f / F8_S1};
                pg8::gemm_phase<pg8::EpiRowScale, pg8::StaticOrder, true, true, true>(lds, g, S, E, tid);
            } else { PH_VARS;
                pg8::Gemm g{xb, Win_t + (size_t)l * NPROJ * D, T, NPROJ, D}; pg8::StaticOrder S; S.init(T, NPROJ, G, blk);
                pg8::EpiRowScale E{proj, NPROJ, ssp_a, 1.0f};
                pg8::gemm_phase<pg8::EpiRowScale, pg8::StaticOrder, true, true>(lds, g, S, E, tid);
            }
        }
        PH_END;
        if (PH_ON) { PH_VARS;
            LAS float* bt = (LAS float*)lds;
            for (int idx = tid; idx < 3 * 8 * BT_LD; idx += NWAVES * 64) { const int part = idx / (8 * BT_LD), rem = idx % (8 * BT_LD), h = rem / BT_LD, j = rem % BT_LD - BT_OFF, sh = 2 * part, jlo = part ? 33 : 0;
                float v = NEGINF; if (j <= 128 && j >= jlo) { const int d = j << sh; v = (rel_bias[t5_bucket(d) * 8 + h] + logf((float)key_mult(d))) * 1.4426950408889634f; } bt[idx] = v; }
            __syncthreads();
            for (int rep = 0; rep < ((PROBE & (2 | 2048)) ? 2 : 1); ++rep) {
            v4u sk[6], sv[6];
#define DIL_DEC(u_) const int part = (u_) >> 10, v_ = (u_) & 1023, sh = 2 * part, b = v_ >> 8, h = (v_ >> 5) & 7, w5 = v_ & 31, nbs = 5 - sh, r = w5 >> nbs, n0 = 256 * (w5 & ((1 << nbs) - 1))
            { const int u0 = blk < 3 * 1024 ? blk : 0; DIL_DEC(u0); dil_stage_load_k(sk, proj, sh, b, h, r, n0, tid); dil_stage_load_v(sv, proj, sh, b, h, r, n0, tid); }
            for (int u = blk; u < 3 * 1024; u += G) {
                DIL_DEC(u);
                const bool dst = !((PROBE & 2048) && rep == 1);
                __syncthreads();
                dil_stage_write_k(lds + 20480, sk, tid); dil_stage_write_v(lds + 20480, sv, tid);
                const int tq = b * SEQ + r + ((n0 + 32 * wave + (lane & 31)) << sh);
                bf16x8 qf[4];
                { const bf16* qp = proj + (size_t)tq * NPROJ + PC_Q + h * 64 + 32 * (lane >> 5);
#pragma unroll
                  for (int ks = 0; ks < 4; ++ks) qf[ks] = *(const GAS bf16x8*)(qp + 8 * ks); }
                __syncthreads();
                { const int un = u + G < 3 * 1024 ? u + G : u, part2 = un >> 10, v2 = un & 1023, sh2 = 2 * part2, nbs2 = 5 - sh2, w52 = v2 & 31, b2 = v2 >> 8, h2 = (v2 >> 5) & 7, r2 = w52 >> nbs2, n02 = 256 * (w52 & ((1 << nbs2) - 1));
                    dil_stage_load_k(sk, proj, sh2, b2, h2, r2, n02, tid); dil_stage_load_v(sv, proj, sh2, b2, h2, r2, n02, tid); }
                if (part == 0) dil_wg_compute<0>(lds + 20480, qf, opart, lsep, bt + h * BT_LD, tq, h, n0 + 32 * wave - 128, lane, wave, dst);
                else dil_wg_compute<33>(lds + 20480, qf, opart + (size_t)part * OP_STRIDE, lsep + (size_t)part * T * 8, bt + (part * 8 + h) * BT_LD, tq, h, n0 + 32 * wave - 128, lane, wave, dst);
            }
#undef DIL_DEC
            }
            __syncthreads();
        }
        PH_END;
        if (PH_ON) { PH_VARS;
            const bf16* pwT = (const bf16*)(ws + WS_PWT) + (size_t)l * 4 * 64 * 64;
            const int t0 = 32 * (tpm0 * 8 + 4 * tmb0 + (wave >> 1));
            if ((wave & 1) == 0) pool_unit(proj, pwT, pool_scale + (size_t)l * 256, ymix, t0, lane, lds + wave * 16896);
            else mergeconv_unit(proj, opart, lsep, conv_w + (size_t)l * 768, ymix, t0, lane);
        }
        PAIR_BAR;
        if (PH_ON) { PH_VARS;
            pg8::Gemm g{ymix, Wout_t + (size_t)l * D * D, T, D, D}; pg8::TeamOrder S{tpm0, 2 * tmb0, 2};
            pg8::EpiResid E{l == 0 ? x_in : (const float*)nullptr, xb, ssp_b, nullptr, 1.0f, 0};
            pg8::gemm_phase<pg8::EpiResid, pg8::TeamOrder, true, true>(lds, g, S, E, tid);
        }
        PAIR_BAR;
        if (PH_ON) { PH_VARS;
            pg8::Gemm g{xb, Wq_t + (size_t)l * XW * D, T, XW, D}; pg8::TeamOrder S{tpm0, tmb0, 1};
            pg8::EpiRowScale E{qx, XW, ssp_b, 0.08838834764831845f};
            pg8::gemm_phase<pg8::EpiRowScale, pg8::TeamOrder, true, true>(lds, g, S, E, tid);
            { const int b = (tpm0 * 256) / SEQ;
              for (int h2 = 0; h2 < 2; ++h2) xat_wg_unit(lds, qx, kvx + (size_t)(b * MEML) * 4096 + l * 1024, vtx + (size_t)((l * 4 + b) * 512) * MEML, ox, tpm0 * 256 + wave * 32, 2 * tmb0 + h2, tid); }
            __syncthreads();
        }
        PAIR_BAR;
        if (PH_ON) { PH_VARS;
            pg8::Gemm g{ox, Wo_t + (size_t)l * D * XW, T, D, XW}; pg8::TeamOrder S{tpm0, 2 * tmb0, 2};
            pg8::EpiResid E{nullptr, xb, ssp_c, (unsigned char*)Ag, 1.0f, l == 2 ? 1 : 0};
            pg8::gemm_phase<pg8::EpiResid, pg8::TeamOrder, true, true>(lds, g, S, E, tid);
        }
        PH_END;
        if ((l & 1) == 0) {
            if (PH_ON) { PH_VARS;
                pg8::StaticOrder S; S.init(T, 2 * FFD, G, blk);
                if (l == 2) {
                    pg8::Gemm g{Ag, W13d_t + (size_t)2 * FFD * D, T, 2 * FFD, D / 2};
                    pg8::EpiSwiGLU8 E{(unsigned char*)hbuf, FFD, nullptr, 0, 1.0f / F8_S1, F8_SH, ssp_c};
                    pg8::gemm_phase<pg8::EpiSwiGLU8, pg8::StaticOrder, true, true, true>(lds, g, S, E, tid);
                } else {
                    pg8::Gemm g{xb, W13d_t, T, 2 * FFD, D};
                    pg8::EpiSwiGLU E{hbuf, FFD, ssp_c, nullptr, 0};
                    pg8::gemm_phase<pg8::EpiSwiGLU, pg8::StaticOrder, true, true>(lds, g, S, E, tid);
                }
            }
            PH_END;
            if (PH_ON) { PH_VARS;
                pg8::StaticOrder S; S.init(T, D, G, blk);
                if (l == 2) {
                    pg8::Gemm g{hbuf, W2d_t + (size_t)D * FFD, T, D, FFD / 2};
                    pg8::EpiResid E{nullptr, xb, ssp_d, (unsigned char*)Ag, 1.0f / (F8_S2 * F8_SH), 1};
                    pg8::gemm_phase<pg8::EpiResid, pg8::StaticOrder, true, true, true>(lds, g, S, E, tid);
                } else {
                    pg8::Gemm g{hbuf, W2d_t, T, D, FFD};
                    pg8::EpiResid E{nullptr, xb, ssp_d, nullptr, 1.0f, 0};
                    pg8::gemm_phase<pg8::EpiResid, pg8::StaticOrder, true, true>(lds, g, S, E, tid);
                }
            }
            PH_END;
        } else {
#define chunk ((T + G - 1) / G)
            if (PH_ON) { PH_VARS;
                LAS int* lcnt = (LAS int*)lds; const float* rw = router_w + (size_t)(l >> 1) * D * NEXP; const float* fg = ffn_g + (size_t)l * D;
                if (tid < NEXP) lcnt[tid] = 0;
                __syncthreads();
                f32x4 gv[4];
#pragma unroll
                for (int j = 0; j < 4; ++j) gv[j] = *((const GAS f32x4*)fg + lane + 64 * j);
                static_assert(T / 256 == 128 && 128 % (4 * NWAVES) == 0, "router batches");
                for (int i0 = wave; i0 < chunk; i0 += 4 * NWAVES) {
                    int ln_ = lane; asm volatile("" : "+v"(ln_)); const float* rwl = rw + (size_t)ln_ * 32;
                    float r[4]; u32x2 xw[4][4];
#pragma unroll
                    for (int k = 0; k < 4; ++k) { const int t = blk * chunk + i0 + k * NWAVES; r[k] = pg8::row_rs16(ssp_c, t);
#pragma unroll
                        for (int j = 0; j < 4; ++j) xw[k][j] = *((const GAS u32x2*)(xb + (size_t)t * D) + lane + 64 * j); }
                    asm volatile("" ::: "memory");
                    float lg[4][8];
#pragma unroll
                    for (int k = 0; k < 4; ++k)
#pragma unroll
                        for (int e = 0; e < 8; ++e) lg[k][e] = 0.f;
#pragma unroll
                    for (int j = 0; j < 4; ++j)
#pragma unroll
                        for (int c = 0; c < 4; ++c) { const f32x4 w0 = *(const GAS f32x4*)(rwl + j * 2048 + c * 8), w1 = *(const GAS f32x4*)(rwl + j * 2048 + c * 8 + 4);
#pragma unroll
                            for (int k = 0; k < 4; ++k) { const unsigned xx = (c & 2) ? xw[k][j].y : xw[k][j].x; const float xv = (c & 1) ? bfhi(xx) : bflo(xx); const float hn = xv * r[k] * gv[j][c];
                                lg[k][0] += hn * w0[0]; lg[k][1] += hn * w0[1]; lg[k][2] += hn * w0[2]; lg[k][3] += hn * w0[3]; lg[k][4] += hn * w1[0]; lg[k][5] += hn * w1[1]; lg[k][6] += hn * w1[2]; lg[k][7] += hn * w1[3]; } }
#pragma unroll
                    for (int k = 0; k < 4; ++k) { const int t = blk * chunk + i0 + k * NWAVES;
#pragma unroll
                        for (int e = 0; e < 8; ++e) lg[k][e] = wave_sum_dpp(lg[k][e]);
                        int e0 = 0; float v0 = lg[k][0];
#pragma unroll
                        for (int e = 1; e < 8; ++e) if (lg[k][e] > v0) { v0 = lg[k][e]; e0 = e; }
                        int e1 = -1; float v1 = -3.0e38f;
#pragma unroll
                        for (int e = 0; e < 8; ++e) if (e != e0 && lg[k][e] > v1) { v1 = lg[k][e]; e1 = e; }
                        const float p0 = 1.0f / (1.0f + __expf(v1 - v0)), p1 = 1.0f - p0;
                        if (lane == 0) { tok_e[2 * t] = e0; tok_e[2 * t + 1] = e1; tok_g[2 * t] = p0; tok_g[2 * t + 1] = p1; atomicAdd((int*)&lcnt[e0], 1); atomicAdd((int*)&lcnt[e1], 1); } }
                }
                __syncthreads();
                if (tid < NEXP) cnts[blk * NEXP + tid] = lcnt[tid];
                __syncthreads();
            }
            PH_END;
            if (PH_ON) { PH_VARS;
                LAS int* lc = (LAS int*)lds;
                LAS int* lbase = (LAS int*)(lds + 32768);
                LAS int* lseg = (LAS int*)(lds + 32768 + 64);
                LAS int* lpos = (LAS int*)(lds + 36864);
                for (int i = tid; i < G * NEXP; i += NWAVES * 64) lc[i] = cnts[i];
                __syncthreads();
                { int base = 0, tot = 0;
                  for (int b2 = lane; b2 < G; b2 += 64) { const int c = lc[b2 * NEXP + wave]; tot += c; base += b2 < blk ? c : 0; }
                  for (int o = 1; o < 32; o <<= 1) { tot += __builtin_amdgcn_ds_bpermute((lane ^ o) << 2, tot); base += __builtin_amdgcn_ds_bpermute((lane ^ o) << 2, base); }
                  tot += __builtin_amdgcn_ds_bpermute((lane ^ 32) << 2, tot); base += __builtin_amdgcn_ds_bpermute((lane ^ 32) << 2, base);
                  if (lane == 0) { lbase[wave] = base; lseg[8 + wave] = tot; } }
                __syncthreads();
                if (tid == 0) { int s = 0; for (int e = 0; e < NEXP; ++e) { lseg[e] = s; lbase[e] += s; s += (lseg[8 + e] + 255) & ~255; lseg[16 + e] = s; if (blk == 0) meta[e] = s >> 8; } }
                __syncthreads();
                if (wave == 0) {
                    int run[8];
#pragma unroll
                    for (int e = 0; e < 8; ++e) run[e] = lbase[e];
                    const int nent = 2 * chunk;
                    for (int r0 = 0; r0 < nent; r0 += 64) { const int idx = r0 + lane; const int t = blk * chunk + (idx >> 1); const bool ok = idx < nent && t < T;
                        const int e = ok ? tok_e[2 * t + (idx & 1)] : -1; int pos = 0;
#pragma unroll
                        for (int ee = 0; ee < 8; ++ee) { const unsigned long long mk = __ballot(e == ee); if (e == ee) pos = run[ee] + __popcll(mk & ((1ull << lane) - 1ull)); run[ee] += __popcll(mk); }
                        if (ok) { tok_pos[2 * t + (idx & 1)] = pos; row_gate[pos] = tok_g[2 * t + (idx & 1)]; row_rs[pos] = pg8::row_rs16(ssp_c, t); lpos[idx] = pos; } }
                }
                __syncthreads();
                static_assert((2 * (T / 256)) % (8 * NWAVES) == 0, "gather batches");
                for (int i0 = wave; i0 < 2 * chunk; i0 += 8 * NWAVES) {
                    v4u ra[8], rc[8]; int ps[8];
#pragma unroll
                    for (int k = 0; k < 8; ++k) { const int idx = i0 + k * NWAVES, t = blk * chunk + (idx >> 1); ps[k] = lpos[idx];
                        const GAS v4u* src = (const GAS v4u*)(xb + (size_t)t * D); ra[k] = src[2 * lane]; rc[k] = src[2 * lane + 1]; }
                    asm volatile("" ::: "memory");
#pragma unroll
                    for (int k = 0; k < 8; ++k) { const v4u a = ra[k], c = rc[k];
                        v4u o; o.x = pg8::pk4_fp8(bflo(a.x), bfhi(a.x), bflo(a.y), bfhi(a.y)); o.y = pg8::pk4_fp8(bflo(a.z), bfhi(a.z), bflo(a.w), bfhi(a.w));
                        o.z = pg8::pk4_fp8(bflo(c.x), bfhi(c.x), bflo(c.y), bfhi(c.y)); o.w = pg8::pk4_fp8(bflo(c.z), bfhi(c.z), bflo(c.w), bfhi(c.w));
                        *((GAS v4u*)((unsigned char*)Ag + (size_t)ps[k] * D) + lane) = o; }
                }
                if (blk < NEXP) { const int r0 = lseg[blk] + lseg[8 + blk], r1 = lseg[16 + blk];
                    for (int r = r0 + wave; r < r1; r += NWAVES) { GAS v4u* dst = (GAS v4u*)((unsigned char*)Ag + (size_t)r * D); unsigned z0; asm volatile("v_mov_b32 %0, 0" : "=v"(z0)); const v4u z = {z0, z0, z0, z0}; dst[lane] = z; if (lane == 0) { row_gate[r] = 0.f; row_rs[r] = 0.f; } } }
                __syncthreads();
            }
            PH_END;
            if (PH_ON) { PH_VARS;
                pg8::MoeOrder S;
#pragma unroll
                for (int e = 0; e < 8; ++e) S.te[e] = __builtin_amdgcn_readfirstlane(meta[e]);
                S.nNl = 2 * FFE / 256; S.so.init(S.te[7] * 256, 2 * FFE, G, blk);
                pg8::Gemm g{Ag, W13m_t + (size_t)(l >> 1) * NEXP * 2 * FFE * (D / 2), MP, NEXP * 2 * FFE, D / 2};
                pg8::EpiSwiGLU8 E{(unsigned char*)hbuf, FFE, row_rs, 2 * FFE / 256, 1.0f / F8_S1, F8_SH, nullptr};
                pg8::gemm_phase<pg8::EpiSwiGLU8, pg8::MoeOrder, true, true, true>(lds, g, S, E, tid);
#if PROBE & (1 | 512)
                pg8::gemm_phase<pg8::EpiSwiGLU8, pg8::MoeOrder, true, true, true>(lds, g, S, E, tid);
#endif
            }
            PH_END;
            if (PH_ON) { PH_VARS;
                pg8::MoeOrder S;
#pragma unroll
                for (int e = 0; e < 8; ++e) S.te[e] = __builtin_amdgcn_readfirstlane(meta[e]);
                const int ntile = S.te[7], nmain = ntile < 256 ? ntile : 256;
                S.nNl = D / 256; S.so.init(nmain * 256, D, G, blk);
                pg8::Gemm g{hbuf, W2m_t + (size_t)(l >> 1) * NEXP * D * (FFE / 2), MP, NEXP * D, FFE / 2};
                pg8::EpiMoeOut E{ym, row_gate, 1.0f / (F8_S2 * F8_SH)};
                pg8::gemm_phase<pg8::EpiMoeOut, pg8::MoeOrder, true, true, true>(lds, g, S, E, tid);
#if PROBE & (1 | 512)
                pg8::gemm_phase<pg8::EpiMoeOut, pg8::MoeOrder, true, true, true>(lds, g, S, E, tid);
#endif
                if (ntile > 256) {
                    pg8::MoeTailOrder ST; ST.npieces = (ntile - 256) * 4 * 7; ST.G = G; ST.c = blk; ST.kstep = 512;
#pragma unroll
                    for (int e = 0; e < 8; ++e) ST.te[e] = S.te[e];
                    pg8::Gemm g2{hbuf, W2m_t + (size_t)(l >> 1) * NEXP * D * (FFE / 2), MP, NEXP * D, 256, FFE / 2};
                    pg8::EpiMoePart EP{ypart, row_gate, 1.0f / (F8_S2 * F8_SH), 9};
                    pg8::gemm_phase<pg8::EpiMoePart, pg8::MoeTailOrder, true, true, true>(lds, g2, ST, EP, tid);
                }
            }
            PH_END;
            if (PH_ON) { PH_VARS;
                const bool last = (l == DEPTH - 1);
                static_assert(T % (4 * 256 * NWAVES) == 0, "combine batches"); constexpr int NBC = 4;
                for (int tb = gw; tb < T; tb += NBC * NGW) {
                    int p0[NBC], p1[NBC];
#pragma unroll
                    for (int k = 0; k < NBC; ++k) { const int t = tb + k * NGW; p0[k] = tok_pos[2 * t]; p1[k] = tok_pos[2 * t + 1]; }
                    u32x2 xa[NBC][4], ya[NBC][4], yb[NBC][4];
#pragma unroll
                    for (int k = 0; k < NBC; ++k) { const int t = tb + k * NGW;
                        const GAS u32x2* xr = (const GAS u32x2*)(xb + (size_t)t * D) + lane;
                        const GAS u32x2* y0 = (const GAS u32x2*)(ym + (size_t)(p0[k] < 65536 ? p0[k] : 0) * D) + lane; const GAS u32x2* y1 = (const GAS u32x2*)(ym + (size_t)(p1[k] < 65536 ? p1[k] : 0) * D) + lane;
#pragma unroll
                        for (int j = 0; j < 4; ++j) { xa[k][j] = xr[64 * j]; ya[k][j] = y0[64 * j]; yb[k][j] = y1[64 * j]; } }
                    asm volatile("" ::: "memory");
#pragma unroll
                    for (int k = 0; k < NBC; ++k) { const int t = tb + k * NGW;
                        f32x4 v[4]; float s = 0.f;
#pragma unroll
                        for (int j = 0; j < 4; ++j) { const u32x2 a = xa[k][j]; f32x4 e0, e1;
                            if (p0[k] < 65536) { const u32x2 b0 = ya[k][j]; e0 = (f32x4){bflo(b0.x), bfhi(b0.x), bflo(b0.y), bfhi(b0.y)}; }
                            else { e0 = (f32x4){0.f, 0.f, 0.f, 0.f};
                                for (int kp = 0; kp < 7; ++kp) { const u32x2 b0 = *((const GAS u32x2*)(ypart + ((size_t)kp * 2048 + (p0[k] - 65536)) * D) + lane + 64 * j); e0 += (f32x4){bflo(b0.x), bfhi(b0.x), bflo(b0.y), bfhi(b0.y)}; } }
                            if (p1[k] < 65536) { const u32x2 b1 = yb[k][j]; e1 = (f32x4){bflo(b1.x), bfhi(b1.x), bflo(b1.y), bfhi(b1.y)}; }
                            else { e1 = (f32x4){0.f, 0.f, 0.f, 0.f};
                                for (int kp = 0; kp < 7; ++kp) { const u32x2 b1 = *((const GAS u32x2*)(ypart + ((size_t)kp * 2048 + (p1[k] - 65536)) * D) + lane + 64 * j); e1 += (f32x4){bflo(b1.x), bfhi(b1.x), bflo(b1.y), bfhi(b1.y)}; } }
                            v[j] = ((f32x4){bflo(a.x), bfhi(a.x), bflo(a.y), bfhi(a.y)} + e0) + e1;
                            s += (v[j].x * v[j].x + v[j].y * v[j].y) + (v[j].z * v[j].z + v[j].w * v[j].w); }
                        s = wave_sum(s, lane);
                        GAS f32x4* orow = (GAS f32x4*)(out + (size_t)t * D) + lane;
                        if (last) { const float r = 1.0f / sqrtf(s * (1.0f / D) + 1e-6f); const GAS f32x4* gr = (const GAS f32x4*)fin_g + lane;
#pragma unroll
                            for (int j = 0; j < 4; ++j) orow[64 * j] = v[j] * r * gr[64 * j]; }
                        else { GAS unsigned long long* o8 = (GAS unsigned long long*)(xb + (size_t)t * D) + lane;
#pragma unroll
                            for (int j = 0; j < 4; ++j) o8[64 * j] = (unsigned long long)pk2(v[j].x, v[j].y) | ((unsigned long long)pk2(v[j].z, v[j].w) << 32);
                            { GAS unsigned* o4 = (GAS unsigned*)((unsigned char*)Ag + (size_t)t * D) + lane;
#pragma unroll
                              for (int j = 0; j < 4; ++j) o4[64 * j] = pg8::pk4_fp8(v[j].x, v[j].y, v[j].z, v[j].w); }
                            if (lane < 16) ssp_d[(size_t)t * 16 + lane] = lane == 0 ? s : 0.f; }
                    }
                }
            }
            if (l != DEPTH - 1) { PH_END; }
        }
    }
#undef PH_ON
#undef PH_END
}
#undef x_in
#undef mem_in
#undef rel_bias
#undef mem_g
#undef mix_g
#undef w_in
#undef conv_w
#undef pool_w
#undef pool_scale
#undef w_out
#undef xat_g
#undef wq_x
#undef wkv_x
#undef wo_x
#undef ffn_g
#undef w13_d
#undef w2_d
#undef router_w
#undef w13_m
#undef w2_m
#undef fin_g
#undef out
#undef Win_t
#undef Wout_t
#undef Wq_t
#undef Wkv_t
#undef Wo_t
#undef W13d_t
#undef W2d_t
#undef W13m_t
#undef W2m_t
#undef xb
#undef qx
#undef ox
#undef Ag
#undef ym
#undef proj
#undef ymix
#undef hbuf
#undef kvx
#undef memn
#undef ssp
#undef cnts
#undef meta
#undef tok_e
#undef tok_g
#undef tok_pos
#undef row_gate
#undef row_rs
#undef ssp_a
#undef ssp_b
#undef ssp_c
#undef ssp_d
#undef PH_VARS
#undef ypart
#undef chunk
#undef vtb
#undef opart
#undef lsep
#undef vtx

extern "C" void kernel_launch(void* const* d_in, const int* in_sizes, int n_in, void* d_out, int out_size, void* d_ws, size_t ws_size, hipStream_t stream) {
    static int grid = 0;
    if (grid == 0) {
        if (n_in != 21 || in_sizes[0] != T * D || out_size != T * D || ws_size < WS_END) { fprintf(stderr, "kernel_launch: unexpected shapes: n_in %d in0 %d out %d ws %zu (need %zu)\n", n_in, n_in > 0 ? in_sizes[0] : -1, out_size, ws_size, (size_t)WS_END); grid = -1; return; }
        int dev = 0, cus = 0, per_cu = 0;
        if (hipGetDevice(&dev) != hipSuccess || hipDeviceGetAttribute(&cus, hipDeviceAttributeMultiprocessorCount, dev) != hipSuccess) { fprintf(stderr, "kernel_launch: device query failed\n"); grid = -1; return; }
        if (hipFuncSetAttribute((const void*)trunk_fwd, hipFuncAttributeMaxDynamicSharedMemorySize, LDS_BYTES) != hipSuccess) { fprintf(stderr, "kernel_launch: hipFuncSetAttribute failed\n"); grid = -1; return; }
        if (hipOccupancyMaxActiveBlocksPerMultiprocessor(&per_cu, (const void*)trunk_fwd, NWAVES * 64, LDS_BYTES) != hipSuccess || per_cu < 1) fprintf(stderr, "kernel_launch: occupancy query reports %d\n", per_cu);
        (void)hipGetLastError();
        if (cus != T / 256 * 2) { fprintf(stderr, "kernel_launch: the team mapping needs %d CUs, device has %d\n", T / 256 * 2, cus); grid = -1; return; }
        grid = cus;
    }
    if (grid < 0) return;
    if (hipMemsetAsync((char*)d_ws + WS_CTL, 0, CTL_ZERO_BYTES, stream) != hipSuccess) { fprintf(stderr, "kernel_launch: memset failed\n"); return; }
    Args a{};
    for (int i = 0; i < 21; ++i) a.in[i] = (const float*)d_in[i];
    a.out = (float*)d_out; a.ws = (unsigned char*)d_ws;
#if N_LAUNCH_MODE == 0
    a.ph_lo = 0; a.ph_hi = NPH;
    hipLaunchKernelGGL(trunk_fwd, dim3(grid), dim3(NWAVES * 64), LDS_BYTES, stream, a);
#else
    for (int p = 0; p < NPH; ++p) { a.ph_lo = p; a.ph_hi = p + 1; hipLaunchKernelGGL(trunk_fwd, dim3(grid), dim3(NWAVES * 64), LDS_BYTES, stream, a); }
#endif
    const hipError_t le = hipPeekAtLastError();
    if (le != hipSuccess) fprintf(stderr, "kernel_launch: launch failed: %s\n", hipGetErrorName(le));
}
```
